# Optimizing an MI355X kernel written in HIP

```python
import math
import jax, jax.numpy as jnp
from jax import lax
import numpy as np

D_MODEL = 1024
BATCH = 32
SEQ = 2048
DEPTH = 1
DEC_BATCH = 16
DEC_SEQ = 32
PAST_LEN = 2048

CHUNK = 64
A_HEADS = 4
A_HEAD_DIM = 256
A_WIDTH = A_HEADS * A_HEAD_DIM
B_HEADS = 8
B_HEAD_DIM = 128
B_WIDTH = B_HEADS * B_HEAD_DIM
IDX_HEADS = 8
IDX_DIM = 64
TOPK_MAX = 256
Q_BLOCK = 16
N_BUCKETS = 32
MAX_DISTANCE = 128
LN_EPS = 1e-5
HEAD_NORM_EPS = 1e-6
DN_ALPHA = (2 * DEPTH) ** 0.25
DN_BETA = (8 * DEPTH) ** -0.25

COL_SIZES = (A_WIDTH, A_WIDTH, A_WIDTH, A_WIDTH, A_WIDTH, A_HEADS, A_HEADS,
             B_WIDTH, B_WIDTH, B_WIDTH, B_WIDTH, IDX_HEADS * IDX_DIM, IDX_DIM, IDX_HEADS,
             D_MODEL, D_MODEL)
IN_COLS = sum(COL_SIZES)

kernel_name = 'hybrid_mlstm_dsa_stream_step'


def layer_norm(x, g, b):
    xf = x.astype(jnp.float32)
    mu = xf.mean(-1, keepdims=True)
    var = jnp.square(xf - mu).mean(-1, keepdims=True)
    return ((xf - mu) * lax.rsqrt(var + LN_EPS) * g.astype(jnp.float32) + b.astype(jnp.float32)).astype(x.dtype)


def t5_bucket(rel):
    half = N_BUCKETS // 2
    max_exact = half // 2
    ret = jnp.where(rel > 0, half, 0)
    n = jnp.abs(rel)
    nf = jnp.maximum(n, 1).astype(jnp.float32)
    large = max_exact + (jnp.log(nf / max_exact) / math.log(MAX_DISTANCE / max_exact)
                         * (half - max_exact)).astype(jnp.int32)
    large = jnp.minimum(large, half - 1)
    return ret + jnp.where(n < max_exact, n, large)


def project(x, w_in, b_gates):
    B, T, _ = x.shape
    p = x @ w_in
    cuts = [int(c) for c in np.cumsum(COL_SIZES)[:-1]]
    (qa, ka, va, oa, za, ia, fa, qb, kb, vb, zb, qi, ki, wi, ga, gb) = jnp.split(p, cuts, axis=-1)
    ig = ia.astype(jnp.float32) + b_gates[:A_HEADS].astype(jnp.float32)
    lf = jax.nn.log_sigmoid(fa.astype(jnp.float32) + b_gates[A_HEADS:].astype(jnp.float32))
    mlstm_in = (qa.reshape(B, T, A_HEADS, A_HEAD_DIM),
                ka.reshape(B, T, A_HEADS, A_HEAD_DIM) * (A_HEAD_DIM ** -0.5),
                va.reshape(B, T, A_HEADS, A_HEAD_DIM), ig, lf)
    attn_in = (qb.reshape(B, T, B_HEADS, B_HEAD_DIM), kb.reshape(B, T, B_HEADS, B_HEAD_DIM),
               vb.reshape(B, T, B_HEADS, B_HEAD_DIM), qi.reshape(B, T, IDX_HEADS, IDX_DIM), ki, wi)
    gates = (oa, za, zb, ga, gb)
    return mlstm_in, attn_in, gates


def mlstm_chunk(carry, inp):
    C, n, m = carry
    q, k, v, ig, lf = inp
    q = q.astype(jnp.float32)
    k = k.astype(jnp.float32)
    v = v.astype(jnp.float32)
    L = q.shape[1]
    b = jnp.swapaxes(jnp.cumsum(lf, axis=1), 1, 2)
    igt = jnp.swapaxes(ig, 1, 2)
    causal = jnp.tril(jnp.ones((L, L), dtype=bool))
    dmat = jnp.where(causal, b[..., :, None] - b[..., None, :] + igt[..., None, :], -jnp.inf)
    a_inter = b + m[..., None]
    m_j = jnp.maximum(a_inter, dmat.max(-1))
    wmat = jnp.exp(dmat - m_j[..., None])
    inter = jnp.exp(a_inter - m_j)
    s = jnp.einsum('blhd,bshd->bhls', q, k) * wmat
    num = (jnp.einsum('bhls,bshd->blhd', s, v)
           + jnp.einsum('blhk,bhkv->blhv', q, C) * jnp.swapaxes(inter, 1, 2)[..., None])
    den = s.sum(-1) + inter * jnp.einsum('blhk,bhk->bhl', q, n)
    h = num / jnp.swapaxes(jnp.maximum(jnp.abs(den), jnp.exp(-m_j)), 1, 2)[..., None]
    b_last = b[..., -1]
    g = b_last[..., None] - b + igt
    m_new = jnp.maximum(b_last + m, g.max(-1))
    decay = jnp.exp(b_last + m - m_new)
    w_s = jnp.exp(g - m_new[..., None])
    C_new = decay[..., None, None] * C + jnp.einsum('bhs,bshk,bshv->bhkv', w_s, k, v)
    n_new = decay[..., None] * n + jnp.einsum('bhs,bshk->bhk', w_s, k)
    return (C_new, n_new, m_new), h


def mlstm_prompt(q, k, v, ig, lf):
    B, T, H, D = q.shape
    nc = T // CHUNK
    to_chunks = lambda a: jnp.swapaxes(a.reshape((B, nc, CHUNK) + a.shape[2:]), 0, 1)
    init = (jnp.zeros((B, H, D, D), jnp.float32), jnp.zeros((B, H, D), jnp.float32),
            jnp.zeros((B, H), jnp.float32))
    state, h = lax.scan(mlstm_chunk, init, tuple(to_chunks(a) for a in (q, k, v, ig, lf)))
    return jnp.swapaxes(h, 0, 1).reshape(B, T, H, D), state


def dsa_block(q, qi, wi, qpos, k, v, ki, rel_bias, k_sel):
    S = k.shape[1]
    sc = jnp.einsum('bqhd,bsd->bqhs', qi, ki).astype(jnp.float32) * (IDX_DIM ** -0.5)
    score = jnp.einsum('bqh,bqhs->bqs', wi.astype(jnp.float32) * (IDX_HEADS ** -0.5), jax.nn.relu(sc))
    limit = (qpos // CHUNK + 1) * CHUNK
    adm = jnp.arange(S, dtype=jnp.int32)[None, :] < limit[:, None]
    score = jnp.where(adm[None], score, -jnp.inf)
    _, idx = lax.top_k(score, k_sel)
    gather = jax.vmap(lambda rows, ii: rows[ii])
    kg = gather(k, idx)
    vg = gather(v, idx)
    logits = jnp.einsum('bqhd,bqkhd->bhqk', q, kg).astype(jnp.float32) * (B_HEAD_DIM ** -0.5)
    bias = rel_bias[t5_bucket(idx - qpos[None, :, None])]
    logits = logits + jnp.moveaxis(bias, -1, 1).astype(jnp.float32)
    ok = idx < limit[None, :, None]
    logits = jnp.where(ok[:, None], logits, -jnp.inf)
    p = jax.nn.softmax(logits, axis=-1)
    return jnp.einsum('bhqk,bqkhd->bqhd', p.astype(v.dtype), vg)


def dsa_prompt(q, k, v, qi, ki, wi, rel_bias):
    B, T = q.shape[:2]
    k_sel = min(TOPK_MAX, T // 4)
    nb = T // Q_BLOCK
    to_blocks = lambda a: jnp.swapaxes(a.reshape((B, nb, Q_BLOCK) + a.shape[2:]), 0, 1)
    pos_blocks = jnp.arange(T, dtype=jnp.int32).reshape(nb, Q_BLOCK)
    out = lax.map(lambda a: dsa_block(a[0], a[1], a[2], a[3], k, v, ki, rel_bias, k_sel),
                  (to_blocks(q), to_blocks(qi), to_blocks(wi), pos_blocks))
    return jnp.swapaxes(out, 0, 1).reshape(B, T, B_HEADS, B_HEAD_DIM)


def dsa_sample(q, k_new, v_new, qi, ki_new, wi, cache_k, cache_v, cache_idx_k, rel_bias):
    past = cache_k.shape[1]
    T = q.shape[1]
    k = jnp.concatenate([cache_k, k_new], axis=1)
    v = jnp.concatenate([cache_v, v_new], axis=1)
    ki = jnp.concatenate([cache_idx_k, ki_new], axis=1)
    k_sel = min(TOPK_MAX, (past + T) // 4)
    qpos = past + jnp.arange(T, dtype=jnp.int32)
    return dsa_block(q, qi, wi, qpos, k, v, ki, rel_bias, k_sel)


def merge(x, h_a, o_b, gates, a_norm_g, w_out_a, w_out_b, w_o, ln_g, ln_b):
    oa, za, zb, ga, gb = gates
    B, T, _ = x.shape
    mu = h_a.mean(-1, keepdims=True)
    var = jnp.square(h_a - mu).mean(-1, keepdims=True)
    hn = ((h_a - mu) * lax.rsqrt(var + HEAD_NORM_EPS)).reshape(B, T, A_WIDTH) * a_norm_g.astype(jnp.float32)
    branch_a = (hn * jax.nn.sigmoid(oa.astype(jnp.float32))).astype(x.dtype) * jax.nn.silu(za)
    branch_b = o_b.reshape(B, T, B_WIDTH) * jax.nn.silu(zb)
    mixed = jax.nn.sigmoid(ga) * (branch_a @ w_out_a) + jax.nn.sigmoid(gb) * (branch_b @ w_out_b)
    return layer_norm(DN_ALPHA * x + mixed @ w_o, ln_g, ln_b)


def setup_inputs(seed: int = 0) -> dict:
    key = jax.random.key(seed)
    ks = jax.random.split(key, 20)
    nrm = lambda i, shape: jax.random.normal(ks[i], shape, jnp.float32)
    return {
        'x_prompt': nrm(0, (BATCH, SEQ, D_MODEL)),
        'x_sample': nrm(1, (DEC_BATCH, DEC_SEQ, D_MODEL)),
        'cache_k': nrm(2, (DEC_BATCH, PAST_LEN, B_HEADS, B_HEAD_DIM)),
        'cache_v': nrm(3, (DEC_BATCH, PAST_LEN, B_HEADS, B_HEAD_DIM)),
        'cache_idx_k': nrm(4, (DEC_BATCH, PAST_LEN, IDX_DIM)),
        'state_C': nrm(5, (DEC_BATCH, A_HEADS, A_HEAD_DIM, A_HEAD_DIM)) * 0.1,
        'state_n': nrm(6, (DEC_BATCH, A_HEADS, A_HEAD_DIM)) * 0.5,
        'state_m': nrm(7, (DEC_BATCH, A_HEADS)),
        'w_in': nrm(8, (D_MODEL, IN_COLS)) * (D_MODEL ** -0.5),
        'b_gates': jnp.concatenate([0.1 * nrm(9, (A_HEADS,)),
                                    jnp.linspace(3.0, 6.0, A_HEADS, dtype=jnp.float32) + 0.01 * nrm(10, (A_HEADS,))]),
        'a_norm_g': 1.0 + 0.01 * nrm(11, (A_WIDTH,)),
        'w_out_a': nrm(12, (A_WIDTH, D_MODEL)) * (A_WIDTH ** -0.5) * DN_BETA,
        'w_out_b': nrm(13, (B_WIDTH, D_MODEL)) * (B_WIDTH ** -0.5) * DN_BETA,
        'w_o': nrm(14, (D_MODEL, D_MODEL)) * (D_MODEL ** -0.5) * DN_BETA,
        'rel_bias': 0.2 * nrm(15, (N_BUCKETS, B_HEADS)),
        'ln_g': 1.0 + 0.01 * nrm(16, (D_MODEL,)),
        'ln_b': 0.01 * nrm(17, (D_MODEL,)),
    }


def reference(x_prompt, x_sample, cache_k, cache_v, cache_idx_k, state_C, state_n, state_m,
              w_in, b_gates, a_norm_g, w_out_a, w_out_b, w_o, rel_bias, ln_g, ln_b):
    for _ in range(DEPTH):
        (qa, ka, va, ig, lf), (qb, kb, vb, qi, ki, wi), gates_p = project(x_prompt, w_in, b_gates)
        h_a, (c_p, n_p, m_p) = mlstm_prompt(qa, ka, va, ig, lf)
        o_b = dsa_prompt(qb, kb, vb, qi, ki, wi, rel_bias)
        y_prompt = merge(x_prompt, h_a, o_b, gates_p, a_norm_g, w_out_a, w_out_b, w_o, ln_g, ln_b)
        (qa_s, ka_s, va_s, ig_s, lf_s), (qb_s, kb_s, vb_s, qi_s, ki_s, wi_s), gates_s = project(x_sample, w_in, b_gates)
        carry = (state_C.astype(jnp.float32), state_n.astype(jnp.float32), state_m.astype(jnp.float32))
        (c_s, n_s, m_s), h_a_s = mlstm_chunk(carry, (qa_s, ka_s, va_s, ig_s, lf_s))
        o_b_s = dsa_sample(qb_s, kb_s, vb_s, qi_s, ki_s, wi_s, cache_k, cache_v, cache_idx_k, rel_bias)
        y_sample = merge(x_sample, h_a_s, o_b_s, gates_s, a_norm_g, w_out_a, w_out_b, w_o, ln_g, ln_b)
    return (y_prompt, y_sample, kb, vb, ki, c_p, n_p, m_p, kb_s, vb_s, ki_s, c_s, n_s, m_s)
```

```cpp
#ifdef HOST_EMU
#include <cstddef>
#include <cmath>
#define __global__
#define __device__
#define __host__
typedef void* hipStream_t;
#else
#include <hip/hip_runtime.h>
#endif
#include <math.h>
#include <stdint.h>

#ifndef D_MODEL
#define D_MODEL 1024
#define BATCH 32
#define SEQ 2048
#define DEC_BATCH 16
#define DEC_SEQ 32
#define PAST_LEN 2048
#define CHUNK 64
#define A_HEADS 4
#define A_HEAD_DIM 256
#define B_HEADS 8
#define B_HEAD_DIM 128
#define IDX_HEADS 8
#define IDX_DIM 64
#define TOPK_MAX 256
#define GROUP_B 4
#endif
#define A_WIDTH (A_HEADS * A_HEAD_DIM)
#define B_WIDTH (B_HEADS * B_HEAD_DIM)
#define C_QA 0
#define C_KA (C_QA + A_WIDTH)
#define C_VA (C_KA + A_WIDTH)
#define C_OA (C_VA + A_WIDTH)
#define C_ZA (C_OA + A_WIDTH)
#define C_IA (C_ZA + A_WIDTH)
#define C_FA (C_IA + A_HEADS)
#define C_QB (C_FA + A_HEADS)
#define C_KB (C_QB + B_WIDTH)
#define C_VB (C_KB + B_WIDTH)
#define C_ZB (C_VB + B_WIDTH)
#define C_QI (C_ZB + B_WIDTH)
#define C_KI (C_QI + IDX_HEADS * IDX_DIM)
#define C_WI (C_KI + IDX_DIM)
#define C_GA (C_WI + IDX_HEADS)
#define C_GB (C_GA + D_MODEL)
#define IN_COLS (C_GB + D_MODEL)
#define LN_EPS 1e-5f
#define HEAD_NORM_EPS 1e-6f
#define DN_ALPHA 1.189207115002721f

#ifdef HOST_EMU
static long g_gid;
#define GIDX() g_gid
#define LAUNCH(kern, total, ...) do { for (long _g = 0; _g < (long)(total); ++_g) { g_gid = _g; kern(__VA_ARGS__); } } while (0)
#else
#define GIDX() ((long)blockIdx.x * 256L + (long)threadIdx.x)
#define LAUNCH(kern, total, ...) do { long _t = (long)(total); if (_t > 0) kern<<<dim3((unsigned)((_t + 255) / 256)), dim3(256), 0, stream>>>(__VA_ARGS__); } while (0)
#endif

__device__ __host__ inline float sigmoidf_(float x) { return 1.0f / (1.0f + expf(-x)); }
__device__ __host__ inline float siluf_(float x) { return x * sigmoidf_(x); }
__device__ __host__ inline float log_sigmoidf_(float x) { return fminf(x, 0.0f) - log1pf(expf(-fabsf(x))); }
__device__ __host__ inline int t5_bucket(int rel) {
    int ret = rel > 0 ? 16 : 0;
    int n = rel < 0 ? -rel : rel;
    int v;
    if (n < 8) v = n;
    else v = 8 + (n >= 12) + (n >= 16) + (n >= 23) + (n >= 32) + (n >= 46) + (n >= 64) + (n >= 91);
    return ret + v;
}

__global__ void k_gemm(const float* A, int lda, const float* B, int ldb, float* C, int ldc, int M, int N, int K, long total) {
    long g = GIDX(); if (g >= total) return;
    const int ncg = N / 4; const int cg = (int)(g % ncg); const int rg = (int)(g / ncg);
    const int j0 = cg * 4, i0 = rg * 8;
    float acc[8][4];
    for (int i = 0; i < 8; ++i) for (int j = 0; j < 4; ++j) acc[i][j] = 0.f;
    for (int k = 0; k < K; k += 4) {
        float b[4][4];
        for (int kk = 0; kk < 4; ++kk) for (int j = 0; j < 4; ++j) b[kk][j] = B[(long)(k + kk) * ldb + j0 + j];
        for (int i = 0; i < 8; ++i) {
            const float* ar = A + (long)(i0 + i) * lda + k;
            const float a0 = ar[0], a1 = ar[1], a2 = ar[2], a3 = ar[3];
            for (int j = 0; j < 4; ++j) acc[i][j] += a0 * b[0][j] + a1 * b[1][j] + a2 * b[2][j] + a3 * b[3][j];
        }
    }
    for (int i = 0; i < 8; ++i) for (int j = 0; j < 4; ++j) C[(long)(i0 + i) * ldc + j0 + j] = acc[i][j];
}

struct Grp {
    const float* x;
    float* P;
    int GB, T, L, nc;
    int S, past, ksel;
    const float* cache_k; const float* cache_v; const float* cache_ik;
    float* Cst; float* nst; float* mst;
    const float* m0;
    float* out_k; float* out_v; float* out_ik; float* y;
    float* bc; float* wv; float* Mv; float* mch;
    float* Smat;
    float* ha;
    float* score;
    unsigned char* sel;
    float* ob;
    float* bra; float* brb;
    float* ya; float* yb;
    float* mixed; float* z;
};

__global__ void k_fill(float* p, float v, long total) { long g = GIDX(); if (g >= total) return; p[g] = v; }
__global__ void k_copy(float* d, const float* s, long total) { long g = GIDX(); if (g >= total) return; d[g] = s[g]; }

__global__ void k_proj_out(Grp G, long total) {
    long g = GIDX(); if (g >= total) return;
    const int W = 2 * B_WIDTH + IDX_DIM; const long tok = g / W; const int c = (int)(g % W);
    const float* pr = G.P + tok * IN_COLS;
    if (c < B_WIDTH) G.out_k[tok * B_WIDTH + c] = pr[C_KB + c];
    else if (c < 2 * B_WIDTH) G.out_v[tok * B_WIDTH + (c - B_WIDTH)] = pr[C_VB + (c - B_WIDTH)];
    else G.out_ik[tok * IDX_DIM + (c - 2 * B_WIDTH)] = pr[C_KI + (c - 2 * B_WIDTH)];
}

__global__ void k_gates(Grp G, const float* b_gates, long total) {
    long g = GIDX(); if (g >= total) return;
    const int h = (int)(g % A_HEADS), b = (int)(g / A_HEADS);
    float m = G.m0 ? G.m0[b * A_HEADS + h] : 0.0f;
    const float bi = b_gates[h], bf = b_gates[A_HEADS + h];
    for (int c = 0; c < G.nc; ++c) {
        G.mch[((long)b * A_HEADS + h) * (G.nc + 1) + c] = m;
        float cum = 0.f, cmax = -INFINITY;
        for (int l = 0; l < G.L; ++l) {
            const long tok = (long)b * G.T + c * G.L + l;
            const float* pr = G.P + tok * IN_COLS;
            const float ig = pr[C_IA + h] + bi;
            const float lf = log_sigmoidf_(pr[C_FA + h] + bf);
            cum += lf;
            const float w = ig - cum;
            cmax = fmaxf(cmax, w);
            G.bc[tok * A_HEADS + h] = cum; G.wv[tok * A_HEADS + h] = w; G.Mv[tok * A_HEADS + h] = fmaxf(m, cmax);
        }
        m = cum + fmaxf(m, cmax);
    }
    G.mch[((long)b * A_HEADS + h) * (G.nc + 1) + G.nc] = m;
    G.mst[b * A_HEADS + h] = m;
}
__global__ void k_smat(Grp G, int c, long total) {
    long g = GIDX(); if (g >= total) return;
    const int L = G.L; const int s = (int)(g % L); long r = g / L; const int l = (int)(r % L); r /= L; const int h = (int)(r % A_HEADS); const int b = (int)(r / A_HEADS);
    float val = 0.f;
    if (s <= l) {
        const long tl = (long)b * G.T + c * L + l, ts = (long)b * G.T + c * L + s;
        const float* q = G.P + tl * IN_COLS + C_QA + h * A_HEAD_DIM; const float* k = G.P + ts * IN_COLS + C_KA + h * A_HEAD_DIM;
        float d = 0.f; for (int i = 0; i < A_HEAD_DIM; ++i) d += q[i] * k[i];
        d *= 1.0f / sqrtf((float)A_HEAD_DIM);
        val = d * expf(G.wv[ts * A_HEADS + h] - G.Mv[tl * A_HEADS + h]);
    }
    G.Smat[g] = val;
}
__global__ void k_hout(Grp G, int c, long total) {
    long g = GIDX(); if (g >= total) return;
    const int L = G.L; const int dv = (int)(g % A_HEAD_DIM); long r = g / A_HEAD_DIM; const int h = (int)(r % A_HEADS); r /= A_HEADS; const int l = (int)(r % L); const int b = (int)(r / L);
    const long tl = (long)b * G.T + c * L + l;
    const float* q = G.P + tl * IN_COLS + C_QA + h * A_HEAD_DIM;
    const float* Sr = G.Smat + (((long)b * A_HEADS + h) * L + l) * L;
    const float* Cm = G.Cst + ((long)b * A_HEADS + h) * A_HEAD_DIM * A_HEAD_DIM; const float* nv = G.nst + ((long)b * A_HEADS + h) * A_HEAD_DIM;
    const float mc = G.mch[((long)b * A_HEADS + h) * (G.nc + 1) + c];
    const float Ml = G.Mv[tl * A_HEADS + h], bl = G.bc[tl * A_HEADS + h];
    const float inter = expf(mc - Ml);
    float num = 0.f, den = 0.f;
    for (int s = 0; s <= l; ++s) { const long ts = (long)b * G.T + c * L + s; num += Sr[s] * G.P[ts * IN_COLS + C_VA + h * A_HEAD_DIM + dv]; den += Sr[s]; }
    float qc = 0.f, qn = 0.f;
    for (int i = 0; i < A_HEAD_DIM; ++i) { qc += q[i] * Cm[(long)i * A_HEAD_DIM + dv]; qn += q[i] * nv[i]; }
    num += inter * qc; den += inter * qn;
    G.ha[tl * A_WIDTH + h * A_HEAD_DIM + dv] = num / fmaxf(fabsf(den), expf(-(bl + Ml)));
}
__global__ void k_state(Grp G, int c, long total) {
    long g = GIDX(); if (g >= total) return;
    const int L = G.L; const int dv = (int)(g % A_HEAD_DIM); long r = g / A_HEAD_DIM; const int dk = (int)(r % A_HEAD_DIM); r /= A_HEAD_DIM; const int h = (int)(r % A_HEADS); const int b = (int)(r / A_HEADS);
    const float mc = G.mch[((long)b * A_HEADS + h) * (G.nc + 1) + c];
    const long tlast = (long)b * G.T + c * L + (L - 1);
    const float Mlast = G.Mv[tlast * A_HEADS + h];
    const float decay = expf(mc - Mlast);
    const float ksc = 1.0f / sqrtf((float)A_HEAD_DIM);
    float accC = 0.f, accn = 0.f;
    for (int s = 0; s < L; ++s) {
        const long ts = (long)b * G.T + c * L + s; const float* pr = G.P + ts * IN_COLS;
        const float ws = expf(G.wv[ts * A_HEADS + h] - Mlast);
        const float kk = pr[C_KA + h * A_HEAD_DIM + dk] * ksc;
        accC += ws * kk * pr[C_VA + h * A_HEAD_DIM + dv]; accn += ws * kk;
    }
    float* Cp = G.Cst + (((long)b * A_HEADS + h) * A_HEAD_DIM + dk) * A_HEAD_DIM + dv;
    *Cp = decay * (*Cp) + accC;
    if (dv == 0) { float* np_ = G.nst + ((long)b * A_HEADS + h) * A_HEAD_DIM + dk; *np_ = decay * (*np_) + accn; }
}

__device__ __host__ inline const float* key_row(const Grp& G, int b, int s, int col_new, const float* cache, int cache_w) {
    if (s < G.past) return cache + ((long)b * G.past + s) * cache_w;
    return G.P + ((long)b * G.T + (s - G.past)) * IN_COLS + col_new;
}
__device__ __host__ inline int q_limit(const Grp& G, int q) { const int qpos = G.past + q; int lim = (qpos / CHUNK + 1) * CHUNK; return lim < G.S ? lim : G.S; }
__global__ void k_score(Grp G, long total) {
    long g = GIDX(); if (g >= total) return;
    const int s = (int)(g % G.S); long r = g / G.S; const int q = (int)(r % G.T); const int b = (int)(r / G.T);
    const long tq = (long)b * G.T + q;
    if (s >= q_limit(G, q)) { G.score[g] = -INFINITY; return; }
    const float* ki = key_row(G, b, s, C_KI, G.cache_ik, IDX_DIM);
    const float* pr = G.P + tq * IN_COLS;
    float sc = 0.f;
    for (int h = 0; h < IDX_HEADS; ++h) {
        const float* qi = pr + C_QI + h * IDX_DIM; float d = 0.f;
        for (int i = 0; i < IDX_DIM; ++i) d += qi[i] * ki[i];
        d *= 1.0f / sqrtf((float)IDX_DIM);
        sc += (pr[C_WI + h] * (1.0f / sqrtf((float)IDX_HEADS))) * fmaxf(d, 0.f);
    }
    G.score[g] = sc;
}
__global__ void k_select(Grp G, long total) {
    long g = GIDX(); if (g >= total) return;
    const int s = (int)(g % G.S); long r = g / G.S; const int q = (int)(r % G.T);
    const int lim = q_limit(G, q);
    unsigned char keep = 0;
    if (s < lim) {
        if (lim <= G.ksel) keep = 1;
        else {
            const float* row = G.score + (g - s); const float v = row[s]; int rank = 0;
            for (int j = 0; j < lim; ++j) { const float u = row[j]; rank += (u > v) || (u == v && j < s); }
            keep = rank < G.ksel;
        }
    }
    G.sel[g] = keep;
}
#define DCH 16
__global__ void k_attn(Grp G, const float* rel_bias, long total) {
    long g = GIDX(); if (g >= total) return;
    const int NDC = B_HEAD_DIM / DCH; const int dc = (int)(g % NDC); long r = g / NDC; const int h = (int)(r % B_HEADS); r /= B_HEADS; const int q = (int)(r % G.T); const int b = (int)(r / G.T);
    const long tq = (long)b * G.T + q; const int qpos = G.past + q; const int lim = q_limit(G, q);
    const float* qv = G.P + tq * IN_COLS + C_QB + h * B_HEAD_DIM;
    const unsigned char* selr = G.sel + tq * G.S;
    float mx = -INFINITY, sum = 0.f, o[DCH];
    for (int i = 0; i < DCH; ++i) o[i] = 0.f;
    for (int s = 0; s < lim; ++s) {
        if (!selr[s]) continue;
        const float* kr = key_row(G, b, s, C_KB, G.cache_k, B_WIDTH) + h * B_HEAD_DIM;
        float d = 0.f; for (int i = 0; i < B_HEAD_DIM; ++i) d += qv[i] * kr[i];
        const float lg = d * (1.0f / sqrtf((float)B_HEAD_DIM)) + rel_bias[t5_bucket(s - qpos) * B_HEADS + h];
        const float* vr = key_row(G, b, s, C_VB, G.cache_v, B_WIDTH) + h * B_HEAD_DIM + dc * DCH;
        if (lg > mx) { const float f = expf(mx - lg); sum *= f; for (int i = 0; i < DCH; ++i) o[i] *= f; mx = lg; }
        const float p = expf(lg - mx); sum += p;
        for (int i = 0; i < DCH; ++i) o[i] += p * vr[i];
    }
    for (int i = 0; i < DCH; ++i) G.ob[tq * B_WIDTH + h * B_HEAD_DIM + dc * DCH + i] = o[i] / sum;
}

__global__ void k_branch_a(Grp G, const float* a_norm_g, long total) {
    long g = GIDX(); if (g >= total) return;
    const int h = (int)(g % A_HEADS); const long tok = g / A_HEADS;
    const float* hv = G.ha + tok * A_WIDTH + h * A_HEAD_DIM; const float* pr = G.P + tok * IN_COLS;
    float mu = 0.f; for (int i = 0; i < A_HEAD_DIM; ++i) mu += hv[i]; mu /= (float)A_HEAD_DIM;
    float var = 0.f; for (int i = 0; i < A_HEAD_DIM; ++i) { const float d = hv[i] - mu; var += d * d; } var /= (float)A_HEAD_DIM;
    const float rs = 1.0f / sqrtf(var + HEAD_NORM_EPS);
    for (int i = 0; i < A_HEAD_DIM; ++i) { const int c = h * A_HEAD_DIM + i;
        const float hn = (hv[i] - mu) * rs * a_norm_g[c];
        G.bra[tok * A_WIDTH + c] = (hn * sigmoidf_(pr[C_OA + c])) * siluf_(pr[C_ZA + c]); }
}
__global__ void k_branch_b(Grp G, long total) {
    long g = GIDX(); if (g >= total) return;
    const int c = (int)(g % B_WIDTH); const long tok = g / B_WIDTH;
    G.brb[g] = G.ob[g] * siluf_(G.P[tok * IN_COLS + C_ZB + c]);
}
__global__ void k_mix(Grp G, long total) {
    long g = GIDX(); if (g >= total) return;
    const int c = (int)(g % D_MODEL); const long tok = g / D_MODEL; const float* pr = G.P + tok * IN_COLS;
    G.mixed[g] = sigmoidf_(pr[C_GA + c]) * G.ya[g] + sigmoidf_(pr[C_GB + c]) * G.yb[g];
}
__global__ void k_ln(Grp G, const float* ln_g, const float* ln_b, long total) {
    long g = GIDX(); if (g >= total) return;
    const long tok = g; const float* xr = G.x + tok * D_MODEL; const float* zr = G.z + tok * D_MODEL;
    float mu = 0.f; for (int i = 0; i < D_MODEL; ++i) mu += DN_ALPHA * xr[i] + zr[i]; mu /= (float)D_MODEL;
    float var = 0.f; for (int i = 0; i < D_MODEL; ++i) { const float d = DN_ALPHA * xr[i] + zr[i] - mu; var += d * d; } var /= (float)D_MODEL;
    const float rs = 1.0f / sqrtf(var + LN_EPS);
    for (int i = 0; i < D_MODEL; ++i) G.y[tok * D_MODEL + i] = (DN_ALPHA * xr[i] + zr[i] - mu) * rs * ln_g[i] + ln_b[i];
}

static inline size_t al256(size_t x) { return (x + 255) & ~(size_t)255; }

extern "C" void kernel_launch(void* const* d_in, const int* in_sizes, int n_in, void* d_out, int out_size, void* d_ws, size_t ws_size, hipStream_t stream) {
    const float* x_prompt = (const float*)d_in[0]; const float* x_sample = (const float*)d_in[1];
    const float* cache_k = (const float*)d_in[2]; const float* cache_v = (const float*)d_in[3]; const float* cache_ik = (const float*)d_in[4];
    const float* state_C = (const float*)d_in[5]; const float* state_n = (const float*)d_in[6]; const float* state_m = (const float*)d_in[7];
    const float* w_in = (const float*)d_in[8]; const float* b_gates = (const float*)d_in[9]; const float* a_norm_g = (const float*)d_in[10];
    const float* w_out_a = (const float*)d_in[11]; const float* w_out_b = (const float*)d_in[12]; const float* w_o = (const float*)d_in[13];
    const float* rel_bias = (const float*)d_in[14]; const float* ln_g = (const float*)d_in[15]; const float* ln_b = (const float*)d_in[16];
    float* out = (float*)d_out;
    float* y_prompt = out; float* y_sample = y_prompt + (size_t)BATCH * SEQ * D_MODEL;
    float* k_prompt = y_sample + (size_t)DEC_BATCH * DEC_SEQ * D_MODEL; float* v_prompt = k_prompt + (size_t)BATCH * SEQ * B_WIDTH;
    float* ik_prompt = v_prompt + (size_t)BATCH * SEQ * B_WIDTH; float* C_prompt = ik_prompt + (size_t)BATCH * SEQ * IDX_DIM;
    float* n_prompt = C_prompt + (size_t)BATCH * A_HEADS * A_HEAD_DIM * A_HEAD_DIM; float* m_prompt = n_prompt + (size_t)BATCH * A_HEADS * A_HEAD_DIM;
    float* k_sample = m_prompt + (size_t)BATCH * A_HEADS; float* v_sample = k_sample + (size_t)DEC_BATCH * DEC_SEQ * B_WIDTH;
    float* ik_sample = v_sample + (size_t)DEC_BATCH * DEC_SEQ * B_WIDTH; float* C_sample = ik_sample + (size_t)DEC_BATCH * DEC_SEQ * IDX_DIM;
    float* n_sample = C_sample + (size_t)DEC_BATCH * A_HEADS * A_HEAD_DIM * A_HEAD_DIM; float* m_sample = n_sample + (size_t)DEC_BATCH * A_HEADS * A_HEAD_DIM;

    const int n_pg = BATCH / GROUP_B;
    for (int gi = 0; gi <= n_pg; ++gi) {
        const bool samp = (gi == n_pg);
        Grp G{};
        G.GB = samp ? DEC_BATCH : GROUP_B; G.T = samp ? DEC_SEQ : SEQ; G.L = samp ? DEC_SEQ : CHUNK; G.nc = G.T / G.L;
        G.past = samp ? PAST_LEN : 0; G.S = G.past + G.T; G.ksel = TOPK_MAX < G.S / 4 ? TOPK_MAX : G.S / 4;
        const long b0 = samp ? 0 : (long)gi * GROUP_B; const long NT = (long)G.GB * G.T;
        G.x = samp ? x_sample : x_prompt + b0 * SEQ * D_MODEL;
        G.cache_k = samp ? cache_k : nullptr; G.cache_v = samp ? cache_v : nullptr; G.cache_ik = samp ? cache_ik : nullptr;
        G.Cst = samp ? C_sample : C_prompt + b0 * A_HEADS * A_HEAD_DIM * A_HEAD_DIM; G.nst = samp ? n_sample : n_prompt + b0 * A_HEADS * A_HEAD_DIM; G.mst = samp ? m_sample : m_prompt + b0 * A_HEADS;
        G.m0 = samp ? state_m : nullptr;
        G.out_k = samp ? k_sample : k_prompt + b0 * SEQ * B_WIDTH; G.out_v = samp ? v_sample : v_prompt + b0 * SEQ * B_WIDTH; G.out_ik = samp ? ik_sample : ik_prompt + b0 * SEQ * IDX_DIM;
        G.y = samp ? y_sample : y_prompt + b0 * SEQ * D_MODEL;
        char* w = (char*)d_ws; size_t o = 0;
        auto take = [&](size_t bytes) { char* p = w + o; o += al256(bytes); return p; };
        G.P = (float*)take((size_t)NT * IN_COLS * 4);
        G.bc = (float*)take((size_t)NT * A_HEADS * 4); G.wv = (float*)take((size_t)NT * A_HEADS * 4); G.Mv = (float*)take((size_t)NT * A_HEADS * 4);
        G.mch = (float*)take((size_t)G.GB * A_HEADS * (G.nc + 1) * 4);
        G.Smat = (float*)take((size_t)G.GB * A_HEADS * G.L * G.L * 4);
        G.ha = (float*)take((size_t)NT * A_WIDTH * 4);
        G.score = (float*)take((size_t)NT * G.S * 4);
        G.sel = (unsigned char*)take((size_t)NT * G.S);
        G.ob = (float*)take((size_t)NT * B_WIDTH * 4);
        G.bra = (float*)take((size_t)NT * A_WIDTH * 4); G.brb = (float*)take((size_t)NT * B_WIDTH * 4);
        G.ya = G.ha; G.yb = G.ob;
        G.mixed = G.bra; G.z = G.brb;
        if (o > ws_size) return;

        LAUNCH(k_gemm, (NT / 8) * (IN_COLS / 4), G.x, D_MODEL, w_in, IN_COLS, G.P, IN_COLS, (int)NT, IN_COLS, D_MODEL, (NT / 8) * (IN_COLS / 4));
        LAUNCH(k_proj_out, NT * (2 * B_WIDTH + IDX_DIM), G, NT * (2 * B_WIDTH + IDX_DIM));
        const long nC = (long)G.GB * A_HEADS * A_HEAD_DIM * A_HEAD_DIM, nN = (long)G.GB * A_HEADS * A_HEAD_DIM;
        if (samp) { LAUNCH(k_copy, nC, G.Cst, state_C, nC); LAUNCH(k_copy, nN, G.nst, state_n, nN); }
        else { LAUNCH(k_fill, nC, G.Cst, 0.f, nC); LAUNCH(k_fill, nN, G.nst, 0.f, nN); }
        LAUNCH(k_gates, (long)G.GB * A_HEADS, G, b_gates, (long)G.GB * A_HEADS);
        for (int c = 0; c < G.nc; ++c) {
            const long nS = (long)G.GB * A_HEADS * G.L * G.L; LAUNCH(k_smat, nS, G, c, nS);
            const long nH = (long)G.GB * G.L * A_WIDTH; LAUNCH(k_hout, nH, G, c, nH);
            LAUNCH(k_state, nC, G, c, nC);
        }
        LAUNCH(k_score, NT * G.S, G, NT * G.S);
        LAUNCH(k_select, NT * G.S, G, NT * G.S);
        LAUNCH(k_attn, NT * B_HEADS * (B_HEAD_DIM / DCH), G, rel_bias, NT * B_HEADS * (B_HEAD_DIM / DCH));
        LAUNCH(k_branch_a, NT * A_HEADS, G, a_norm_g, NT * A_HEADS);
        LAUNCH(k_branch_b, NT * B_WIDTH, G, NT * B_WIDTH);
        LAUNCH(k_gemm, (NT / 8) * (D_MODEL / 4), G.bra, A_WIDTH, w_out_a, D_MODEL, G.ya, D_MODEL, (int)NT, D_MODEL, A_WIDTH, (NT / 8) * (D_MODEL / 4));
        LAUNCH(k_gemm, (NT / 8) * (D_MODEL / 4), G.brb, B_WIDTH, w_out_b, D_MODEL, G.yb, D_MODEL, (int)NT, D_MODEL, B_WIDTH, (NT / 8) * (D_MODEL / 4));
        LAUNCH(k_mix, NT * D_MODEL, G, NT * D_MODEL);
        LAUNCH(k_gemm, (NT / 8) * (D_MODEL / 4), G.mixed, D_MODEL, w_o, D_MODEL, G.z, D_MODEL, (int)NT, D_MODEL, D_MODEL, (NT / 8) * (D_MODEL / 4));
        LAUNCH(k_ln, NT, G, ln_g, ln_b, NT);
    }
}
```

```cpp
#include <hip/hip_runtime.h>
#include <cstdio>
#include <cstdint>
#include <math.h>
#ifndef D_MODEL
#define D_MODEL 1024
#define BATCH 32
#define SEQ 2048
#define DEC_BATCH 16
#define DEC_SEQ 32
#define PAST_LEN 2048
#define CHUNK 64
#define A_HEADS 4
#define A_HEAD_DIM 256
#define B_HEADS 8
#define B_HEAD_DIM 128
#define IDX_HEADS 8
#define IDX_DIM 64
#define TOPK_MAX 256
#define GROUP_B 4
#endif
#define A_WIDTH (A_HEADS * A_HEAD_DIM)
#define B_WIDTH (B_HEADS * B_HEAD_DIM)
#define C_QA 0
#define C_KA (C_QA + A_WIDTH)
#define C_VA (C_KA + A_WIDTH)
#define C_OA (C_VA + A_WIDTH)
#define C_ZA (C_OA + A_WIDTH)
#define C_IA (C_ZA + A_WIDTH)
#define C_FA (C_IA + A_HEADS)
#define C_QB (C_FA + A_HEADS)
#define C_KB (C_QB + B_WIDTH)
#define C_VB (C_KB + B_WIDTH)
#define C_ZB (C_VB + B_WIDTH)
#define C_QI (C_ZB + B_WIDTH)
#define C_KI (C_QI + IDX_HEADS * IDX_DIM)
#define C_WI (C_KI + IDX_DIM)
#define C_GA (C_WI + IDX_HEADS)
#define C_GB (C_GA + D_MODEL)
#define IN_COLS (C_GB + D_MODEL)
#define LN_EPS 1e-5f
#define HEAD_NORM_EPS 1e-6f
#define DN_ALPHA 1.189207115002721f


#define GAS __attribute__((address_space(1)))
#define LAS __attribute__((address_space(3)))
typedef unsigned short bf16;
typedef unsigned v4u __attribute__((ext_vector_type(4)));
typedef float f32x4 __attribute__((ext_vector_type(4)));
typedef short bf16x8 __attribute__((ext_vector_type(8)));
typedef GAS unsigned gu32;
typedef GAS unsigned long long gu64;
#define RLX_AGENT __ATOMIC_RELAXED, __HIP_MEMORY_SCOPE_AGENT
#define LDS_WAIT() asm volatile("s_waitcnt lgkmcnt(0)" ::: "memory")
#define VM_WAIT() asm volatile("s_waitcnt vmcnt(0)" ::: "memory")
__device__ __forceinline__ unsigned long long rt() { return __builtin_amdgcn_s_memrealtime(); }
__device__ __forceinline__ unsigned f2bf(float f) { unsigned u = __builtin_bit_cast(unsigned, f); return (u + 0x7fffu + ((u >> 16) & 1u)) >> 16; }
__device__ __forceinline__ unsigned pk2(float lo, float hi) { return f2bf(lo) | (f2bf(hi) << 16); }

#define XB_TMO      128
#define XB_XCNT(j)  (256  + 64 * (j))
#define XB_XSUB(j)  (1280 + 64 * (j))
#define XB_XGEN(j)  (2304 + 64 * (j))
#define XB_TOP      3328
#define XB_TOPGEN   3392
#define XCD_BAR_WORDS 3456
#define XB_SPIN_CAP (1u << 18)

__device__ __forceinline__ unsigned xb_ld(unsigned* p)              { return __hip_atomic_load(p, __ATOMIC_RELAXED, __HIP_MEMORY_SCOPE_AGENT); }
__device__ __forceinline__ unsigned xb_add(unsigned* p, unsigned v) { return __hip_atomic_fetch_add(p, v, __ATOMIC_RELAXED, __HIP_MEMORY_SCOPE_AGENT); }
__device__ __forceinline__ unsigned xb_xcc_id() { return (unsigned)__builtin_amdgcn_s_getreg((3 << 11) | 20) & 0xFu; }
#define XB_SPIN(cond, bar) do { unsigned _sp = 0; while (cond) { __builtin_amdgcn_s_sleep(1); \
    if ((++_sp & 255u) == 0u) { if (xb_ld(&(bar)[XB_TMO])) break; if (_sp > XB_SPIN_CAP) { atomicAdd(&(bar)[XB_TMO], 1u); break; } } } } while (0)

struct XcdBarrier {
    unsigned* bar; unsigned x;
    volatile LAS unsigned* st;
};

__device__ __forceinline__ XcdBarrier xcd_barrier_post(unsigned* bar, volatile LAS unsigned* st) {
    XcdBarrier b; b.bar = bar; b.x = xb_xcc_id(); b.st = st;
    if (threadIdx.x == 0) (void)xb_add(&bar[XB_XCNT(b.x)], 1u);
    return b;
}
__device__ __forceinline__ void xcd_barrier_complete(unsigned* bar, unsigned x, unsigned& nloc, unsigned& nx) {
    const unsigned G = gridDim.x * gridDim.y * gridDim.z;
    unsigned sum, cnt, mine, sp = 0u;
    for (;;) {
        sum = 0u; cnt = 0u; mine = 0u;
#pragma unroll
        for (unsigned j = 0; j < 16; ++j) { const unsigned c = xb_ld(&bar[XB_XCNT(j)]); sum += c; cnt += (c > 0u) ? 1u : 0u; mine = (j == x) ? c : mine; }
        if (sum == G) break;
        __builtin_amdgcn_s_sleep(1);
        if ((++sp & 255u) == 0u) { if (xb_ld(&bar[XB_TMO])) break; if (sp > XB_SPIN_CAP) { atomicAdd(&bar[XB_TMO], 1u); break; } }
    }
    nloc = mine > 0u ? mine : 1u; nx = cnt > 0u ? cnt : 1u;
}

__device__ __forceinline__ void xcd_barrier(const XcdBarrier& b) {
    asm volatile("s_waitcnt vmcnt(0)" ::: "memory");
    __syncthreads();
    if (threadIdx.x == 0) {
        unsigned* bar = b.bar;
        __builtin_amdgcn_s_waitcnt(0);
        unsigned nloc = b.st[0], nx = b.st[1];
        if (nloc == 0u) { xcd_barrier_complete(bar, b.x, nloc, nx); b.st[0] = nloc; b.st[1] = nx; }
        const unsigned old = xb_add(&bar[XB_XSUB(b.x)], 1u);
        const unsigned gen = old / nloc;
        if (old + 1u == (gen + 1u) * nloc) {
            __builtin_amdgcn_fence(__ATOMIC_RELEASE, "agent");
            asm volatile("s_waitcnt vmcnt(0)" ::: "memory");
            const unsigned og = xb_add(&bar[XB_TOP], 1u);
            const unsigned tg = og / nx;
            if (og + 1u == (tg + 1u) * nx) xb_add(&bar[XB_TOPGEN], 1u);
            else XB_SPIN(xb_ld(&bar[XB_TOPGEN]) == tg, bar);
            __builtin_amdgcn_fence(__ATOMIC_ACQUIRE, "agent");
            xb_add(&bar[XB_XGEN(b.x)], 1u);
            asm volatile("s_waitcnt vmcnt(0)" ::: "memory");
        } else {
            XB_SPIN(xb_ld(&bar[XB_XGEN(b.x)]) == gen, bar);
            __builtin_amdgcn_fence(__ATOMIC_ACQUIRE, "agent");
            asm volatile("s_waitcnt vmcnt(0)" ::: "memory");
        }
    }
    __syncthreads();
}

namespace pg8 {
#define PG8_LAS __attribute__((address_space(3)))
typedef unsigned short bf16_t;
typedef short bf16x8 __attribute__((ext_vector_type(8)));
typedef float f32x4 __attribute__((ext_vector_type(4)));
typedef unsigned u32x4 __attribute__((ext_vector_type(4)));
constexpr int BM = 256, BK = 64, HALF = 128, HTB = HALF * BK * 2  , STAGE_BYTES = 8 * HTB, NXCD = 8, WGM = 8;

__host__ __device__ __forceinline__ int lds_byte(int r, int c) { const int st = (r >> 4) * 2 + (c >> 5), rr = r & 15, cc = c & 31, ob = rr * 64 + cc * 2; return st * 1024 + (ob ^ (((ob >> 9) & 1) << 5)); }
__host__ __device__ __forceinline__ void stage_rc(int b, int& R, int& C) { const int st = b / 1024, sb = b % 1024, swz = sb ^ (((sb >> 9) & 1) << 5); R = (st >> 1) * 16 + swz / 64; C = (st & 1) * 32 + (swz % 64) / 2; }
__host__ __device__ __forceinline__ int perm32(int rho) { const int n = rho >> 4, i = rho & 15; return 8 * (i >> 2) + 4 * n + (i & 3); }

struct Unit { int pm, pn; };
struct Gemm { const bf16_t* A; const bf16_t* Bt; int M, N, K; };

struct StaticOrder {
    int nM, nN, nwg, G, c;
    __host__ __device__ void init(int M, int N, int G_, int c_) { nM = M / BM; nN = N / BM; nwg = nM * nN; G = G_; c = c_; }
    __host__ __device__ bool next(int i, Unit& u) const {
        const long L = (long)i * G + c; if (L >= nwg) return false;
        int wgid = (int)L; { const int q = nwg / NXCD, r = nwg % NXCD, xcd = wgid % NXCD, off = wgid / NXCD; wgid = (xcd < r ? xcd * (q + 1) : r * (q + 1) + (xcd - r) * q) + off; }
        const int nig = WGM * nN, gid = wgid / nig, fm = gid * WGM, gsz = (nM - fm) < WGM ? (nM - fm) : WGM;
        u.pm = fm + ((wgid % nig) % gsz); u.pn = (wgid % nig) / gsz; return true;
    }
    __device__ __forceinline__ void a_ready(const Unit&) const {}
    __device__ __forceinline__ void done(const Unit&) const {}
};
__device__ __forceinline__ unsigned cvt_pk_bf16(float lo, float hi) { unsigned r; asm volatile("v_cvt_pk_bf16_f32 %0, %1, %2" : "=v"(r) : "v"(lo), "v"(hi)); return r; }
typedef float f32x2 __attribute__((ext_vector_type(2)));
template <class Epi, class Sched, bool ALIGN_EPI = false, bool SP2 = false>
__device__ __forceinline__ void gemm_phase(PG8_LAS unsigned char* lds, const Gemm g, const Sched& S, const Epi& E) {
    const int tid = threadIdx.x, wid = __builtin_amdgcn_readfirstlane(tid >> 6), lane = tid & 63, wr = wid >> 2, wc = wid & 3, fr = lane & 15, fq = lane >> 4;
    const int K = g.K, nt = K / BK;
    unsigned voffA[2], voffB[2];
#pragma unroll
    for (int i = 0; i < 2; ++i) { int R, C; stage_rc(tid * 16 + i * 8192, R, C); const int Rb = Epi::PERM ? ((R & ~31) + perm32(R & 31)) : R;
        voffA[i] = (unsigned)(R * K + C) * 2u; voffB[i] = (unsigned)(Rb * K + C) * 2u; }
    const size_t kstep = (size_t)(BK * 2);
    const size_t hstep = (size_t)HALF * K * 2;
    const size_t tstep = 2 * hstep;
    const unsigned ldsw = (unsigned)wid * 1024u;
    const int aoff = lds_byte(wr * 64 + fr, fq * 8), boff = lds_byte(wc * 32 + fr, fq * 8);
#define PG8_SA(b, h) (((b) * 2 + (h)) * HTB)
#define PG8_SB(b, h) ((4 + (b) * 2 + (h)) * HTB)
#define PG8_STAGE(bufoff, gbase, voff) do { _Pragma("unroll") for (int _i = 0; _i < 2; ++_i) \
        __builtin_amdgcn_global_load_lds((const unsigned*)((const char*)(gbase) + (voff)[_i]), (PG8_LAS unsigned*)(lds + (bufoff) + ldsw + _i * 8192), 16, 0, 0); } while (0)
#define PG8_LDA(dst, b, h) do { _Pragma("unroll") for (int m = 0; m < 4; ++m) _Pragma("unroll") for (int k = 0; k < 2; ++k) dst[m][k] = *(const PG8_LAS bf16x8*)(lds + PG8_SA(b, h) + aoff + m * 2048 + k * 1024); } while (0)
#define PG8_LDB(dst, b, h) do { _Pragma("unroll") for (int n = 0; n < 2; ++n) _Pragma("unroll") for (int k = 0; k < 2; ++k) dst[n][k] = *(const PG8_LAS bf16x8*)(lds + PG8_SB(b, h) + boff + n * 2048 + k * 1024); } while (0)
#define PG8_MMA(ai, bj, At, Bt) do { __builtin_amdgcn_s_setprio(1); _Pragma("unroll") for (int m = 0; m < 4; ++m) _Pragma("unroll") for (int n = 0; n < 2; ++n) _Pragma("unroll") for (int k = 0; k < 2; ++k) \
        acc[ai][bj][m][n] = __builtin_amdgcn_mfma_f32_16x16x32_bf16(Bt[n][k], At[m][k], acc[ai][bj][m][n], 0, 0, 0); __builtin_amdgcn_s_setprio(0); } while (0)
#define PG8_WAIT_V(n) asm volatile("s_waitcnt vmcnt(" #n ")" ::: "memory")
#define PG8_WAIT_L(n) asm volatile("s_waitcnt lgkmcnt(" #n ")" ::: "memory")
#define PG8_BAR __builtin_amdgcn_s_barrier()
#define PG8_SCHED __builtin_amdgcn_sched_barrier(0)
    Unit cur, nxt; int ui = 0;
    if (!S.next(0, cur)) return;
    f32x4 acc[2][2][4][2];
#pragma unroll
    for (int a = 0; a < 2; ++a)
#pragma unroll
        for (int b = 0; b < 2; ++b)
#pragma unroll
            for (int m = 0; m < 4; ++m)
#pragma unroll
                for (int n = 0; n < 2; ++n) acc[a][b][m][n] = (f32x4){0.f, 0.f, 0.f, 0.f};
    bf16x8 At[4][2], B0[2][2], B1[2][2];
    const char* cA = (const char*)g.A + (size_t)cur.pm * tstep; const char* cB = (const char*)g.Bt + (size_t)cur.pn * tstep;
    S.a_ready(cur);
    if constexpr (SP2) {
        PG8_STAGE(PG8_SB(0, 0), cB, voffB); PG8_STAGE(PG8_SB(0, 1), cB + hstep, voffB); PG8_STAGE(PG8_SA(0, 0), cA, voffA); PG8_STAGE(PG8_SA(0, 1), cA + hstep, voffA);
        if (wr == 1) PG8_BAR;
        PG8_WAIT_V(2); PG8_BAR;
        PG8_STAGE(PG8_SB(1, 0), cB + kstep, voffB); PG8_STAGE(PG8_SA(1, 0), cA + kstep, voffA); PG8_STAGE(PG8_SB(1, 1), cB + hstep + kstep, voffB);
        PG8_WAIT_V(6); PG8_BAR;
    } else {
        PG8_STAGE(PG8_SB(0, 0), cB, voffB); PG8_STAGE(PG8_SA(0, 0), cA, voffA); PG8_STAGE(PG8_SB(0, 1), cB + hstep, voffB); PG8_STAGE(PG8_SA(0, 1), cA + hstep, voffA);
        if (wr == 1) PG8_BAR;
        PG8_WAIT_V(4); PG8_BAR;
        PG8_STAGE(PG8_SB(1, 0), cB + kstep, voffB); PG8_STAGE(PG8_SA(1, 0), cA + kstep, voffA); PG8_STAGE(PG8_SB(1, 1), cB + hstep + kstep, voffB);
        PG8_WAIT_V(6); PG8_BAR;
    }
    for (;;) {
        const bool has_next = S.next(ui + 1, nxt);
        const char* nA = has_next ? (const char*)g.A + (size_t)nxt.pm * tstep : cA; const char* nB = has_next ? (const char*)g.Bt + (size_t)nxt.pn * tstep : cB;
        for (int t = 0; t < nt; t += 2) {
            const bool last = (t == nt - 2);
            const char* a1 = cA + (size_t)(t + 1) * kstep;
            const char* a2 = last ? nA : cA + (size_t)(t + 2) * kstep; const char* b2 = last ? nB : cB + (size_t)(t + 2) * kstep;
            const char* a3 = a2 + kstep; const char* b3 = b2 + kstep;
            if (last && has_next) S.a_ready(nxt);
            if constexpr (Epi::MIDK) { if (t == nt / 2) E.mid(acc, cur, wr, wc, fr, fq); }
            if constexpr (SP2) {
            PG8_LDB(B0, 0, 0); PG8_LDB(B1, 0, 1); PG8_SCHED; PG8_LDA(At, 0, 0); PG8_STAGE(PG8_SA(1, 1), a1 + hstep, voffA);
            PG8_WAIT_V(8); PG8_WAIT_L(0); PG8_BAR; PG8_MMA(0, 0, At, B0); PG8_MMA(0, 1, At, B1); PG8_BAR; PG8_SCHED;
            PG8_LDA(At, 0, 1); PG8_STAGE(PG8_SB(0, 0), b2, voffB); PG8_STAGE(PG8_SB(0, 1), b2 + hstep, voffB); PG8_STAGE(PG8_SA(0, 0), a2, voffA);
            PG8_WAIT_V(8); PG8_WAIT_L(0); PG8_BAR; PG8_MMA(1, 0, At, B0); PG8_MMA(1, 1, At, B1); PG8_BAR; PG8_SCHED;
            PG8_LDB(B0, 1, 0); PG8_LDB(B1, 1, 1); PG8_SCHED; PG8_LDA(At, 1, 0); PG8_STAGE(PG8_SA(0, 1), a2 + hstep, voffA);
            PG8_WAIT_V(8); PG8_WAIT_L(0); PG8_BAR; PG8_MMA(0, 0, At, B0); PG8_MMA(0, 1, At, B1); PG8_BAR; PG8_SCHED;
            PG8_LDA(At, 1, 1); PG8_STAGE(PG8_SB(1, 0), b3, voffB); PG8_STAGE(PG8_SB(1, 1), b3 + hstep, voffB); PG8_STAGE(PG8_SA(1, 0), a3, voffA);
            PG8_WAIT_V(8); PG8_WAIT_L(0); PG8_BAR; PG8_MMA(1, 0, At, B0); PG8_MMA(1, 1, At, B1); PG8_BAR; PG8_SCHED;
            } else {
            PG8_LDB(B0, 0, 0); PG8_SCHED; PG8_LDA(At, 0, 0); PG8_STAGE(PG8_SA(1, 1), a1 + hstep, voffA);
            PG8_WAIT_L(8); PG8_BAR; PG8_WAIT_L(0); PG8_MMA(0, 0, At, B0); PG8_BAR; PG8_SCHED;
            PG8_LDB(B1, 0, 1); PG8_STAGE(PG8_SB(0, 0), b2, voffB);
            PG8_BAR; PG8_WAIT_L(0); PG8_MMA(0, 1, At, B1); PG8_BAR;
            PG8_LDA(At, 0, 1); PG8_STAGE(PG8_SA(0, 0), a2, voffA);
            PG8_BAR; PG8_WAIT_L(0); PG8_MMA(1, 0, At, B0); PG8_BAR; PG8_SCHED;
            PG8_STAGE(PG8_SB(0, 1), b2 + hstep, voffB);
            PG8_WAIT_V(6); PG8_BAR; PG8_MMA(1, 1, At, B1); PG8_BAR;
            PG8_LDB(B0, 1, 0); PG8_SCHED; PG8_LDA(At, 1, 0); PG8_STAGE(PG8_SA(0, 1), a2 + hstep, voffA);
            PG8_WAIT_L(8); PG8_BAR; PG8_WAIT_L(0); PG8_MMA(0, 0, At, B0); PG8_BAR; PG8_SCHED;
            PG8_LDB(B1, 1, 1); PG8_STAGE(PG8_SB(1, 0), b3, voffB);
            PG8_BAR; PG8_WAIT_L(0); PG8_MMA(0, 1, At, B1); PG8_BAR;
            PG8_LDA(At, 1, 1); PG8_STAGE(PG8_SA(1, 0), a3, voffA);
            PG8_BAR; PG8_WAIT_L(0); PG8_MMA(1, 0, At, B0); PG8_BAR; PG8_SCHED;
            PG8_STAGE(PG8_SB(1, 1), b3 + hstep, voffB);
            PG8_WAIT_V(6); PG8_BAR; PG8_MMA(1, 1, At, B1); PG8_BAR;
            }
        }
        if constexpr (ALIGN_EPI) { if (wr == 0) PG8_BAR; }
        if constexpr (!Epi::AFTER_DRAIN) { E(acc, cur, wr, wc, fr, fq); S.done(cur); }
        if (!has_next) break;
#pragma unroll
        for (int a = 0; a < 2; ++a)
#pragma unroll
            for (int b = 0; b < 2; ++b)
#pragma unroll
                for (int m = 0; m < 4; ++m)
#pragma unroll
                    for (int n = 0; n < 2; ++n) acc[a][b][m][n] = (f32x4){0.f, 0.f, 0.f, 0.f};
        cur = nxt; cA = nA; cB = nB; ++ui;
        if constexpr (ALIGN_EPI) { if (wr == 1) PG8_BAR; }
    }
    PG8_WAIT_V(0);
    if constexpr (!ALIGN_EPI) { if (wr == 0) PG8_BAR; }
    PG8_BAR;
    if constexpr (Epi::AFTER_DRAIN) { E.fused(acc, cur, wr, wc, fr, fq, lds, wid, lane); S.done(cur); }
#undef PG8_SA
#undef PG8_SB
#undef PG8_STAGE
#undef PG8_LDA
#undef PG8_LDB
#undef PG8_MMA
#undef PG8_WAIT_V
#undef PG8_WAIT_L
#undef PG8_BAR
#undef PG8_SCHED
}
}

constexpr int NWAVES = 8;
constexpr int NTP = BATCH * SEQ, NTS = DEC_BATCH * DEC_SEQ, NTOK = NTP + NTS;
constexpr int NPM = NTOK / 256;
constexpr int N_MIX = 27 * 256, N_M1A = 12 * 256, N_M1B = 8 * 256;
static_assert(NTP % 256 == 0 && NTS % 256 == 0 && D_MODEL == 1024 && A_WIDTH == 1024 && B_WIDTH == 1024, "geometry");

constexpr size_t MiB = 1u << 20;
constexpr size_t WS_CTL = 0, CTL_ZERO_BYTES = 1 * MiB;
constexpr size_t WS_WMIX = 1 * MiB;
constexpr size_t WS_WMRG = WS_WMIX + 14 * MiB;
constexpr size_t WS_WAB  = WS_WMRG + 10 * MiB;
constexpr size_t WS_WO   = WS_WAB + 4 * MiB;
constexpr size_t WS_XB   = WS_WO + 2 * MiB;
constexpr size_t ROWBUF  = (size_t)NTOK * 1024 * 2;
constexpr size_t WS_QA   = WS_XB + ROWBUF;
constexpr size_t WS_KA   = WS_QA + ROWBUF;
constexpr size_t WS_VA   = WS_KA + ROWBUF;
constexpr size_t WS_QB   = WS_VA + ROWBUF;
constexpr size_t WS_QI   = WS_QB + ROWBUF;
constexpr size_t WS_KI   = WS_QI + 65 * MiB;
constexpr size_t WS_SM   = WS_KI + 9 * MiB;
constexpr size_t WS_MASK = WS_SM + 5 * MiB;
constexpr size_t WS_HST  = WS_MASK + 16 * MiB;
constexpr size_t WS_NAIVE = WS_HST + 3 * MiB;
constexpr size_t WS_NEED = WS_NAIVE;
static_assert(WS_WMIX + (size_t)N_MIX * 1024 * 2 <= WS_WMRG && WS_QI + (size_t)NTOK * 512 * 2 <= WS_KI && WS_KI + (size_t)NTOK * 64 * 2 <= WS_SM && WS_SM + (size_t)NTOK * 64 <= WS_MASK
              && WS_HST + (size_t)NTOK * 32 <= WS_NAIVE, "d_ws map");
constexpr int CW_BAR = 4096;
constexpr int RING_OFF = 0, RING_BYTES = 131072;
constexpr int LDSCTL_OFF = RING_BYTES, MISC_OFF = LDSCTL_OFF + 320;
constexpr int LDS_BYTES = 147456;

struct Args { const float* in[17]; float* out; unsigned char* ws; int ph_lo, ph_hi; };

__device__ __forceinline__ float bf2f(bf16 v) { return __uint_as_float((unsigned)v << 16); }
__device__ __forceinline__ float sigm(float x) { return 1.0f / (1.0f + __expf(-x)); }

__device__ __forceinline__ void tr_item(const float* W, int ldw, int c0, int nv, int k0, bf16* WT, int ldt, int r0, int kofs, LAS float* scr, int lane) {
    const int n_ = lane & 31;
#pragma unroll 8
    for (int i = 0; i < 32; ++i) { const int kk = 2 * i + (lane >> 5); scr[kk * 33 + n_] = (n_ < nv) ? W[(size_t)(k0 + kk) * ldw + c0 + n_] : 0.f; }
    LDS_WAIT(); asm volatile("" ::: "memory");
    const int c = lane & 7;
#pragma unroll
    for (int j = 0; j < 4; ++j) { const int n = (lane >> 3) + 8 * j; const LAS float* s = scr + (8 * c) * 33 + n;
        v4u o; o.x = pk2(s[0 * 33], s[1 * 33]); o.y = pk2(s[2 * 33], s[3 * 33]); o.z = pk2(s[4 * 33], s[5 * 33]); o.w = pk2(s[6 * 33], s[7 * 33]);
        if (n < nv) *(GAS v4u*)(WT + (size_t)(r0 + n) * ldt + kofs + k0 + 8 * c) = o; }
    LDS_WAIT(); asm volatile("" ::: "memory");
}
struct Seg { int src, n, dst; };
__device__ __forceinline__ Seg win_seg(int s) {
    switch (s) {
        case 0: return Seg{C_QA, 1024, 0};      case 1: return Seg{C_KA, 1024, 1024};  case 2: return Seg{C_VA, 1024, 2048};
        case 3: return Seg{C_QB, 1024, 3072};   case 4: return Seg{C_KB, 1024, 4096};  case 5: return Seg{C_VB, 1024, 5120};
        case 6: return Seg{C_QI, 512, 6144};    case 7: return Seg{C_KI, 64, 6656};    case 8: return Seg{C_WI, 8, 6720};
        case 9: return Seg{C_IA, 4, 6728};      case 10: return Seg{C_FA, 4, 6732};
        case 27: return Seg{C_ZB, 1024, 2048};  case 28: return Seg{C_GA, 1024, 3072}; case 29: return Seg{C_GB, 1024, 4096};
        default: { const int j = (s - 11) >> 1; return (s & 1) ? Seg{C_OA + 128 * j, 128, 256 * j} : Seg{C_ZA + 128 * j, 128, 256 * j + 128}; }
    }
}
struct P0Args { const float *xp, *xs, *w_in, *w_out_a, *w_out_b, *w_o; bf16 *XB, *WMIX, *WMRG, *WAB, *WO; };
__device__ __forceinline__ void p0_prologue(const P0Args& a, LAS unsigned char* lds, int vcu, int G, int wave, int lane) {
    LAS float* scr = (LAS float*)(lds + RING_OFF + wave * 16384);
    const int gw = vcu * NWAVES + wave, NGW = G * NWAVES;
    int base = 0;
    for (int s = 0; s < 30; ++s) {
        const Seg sg = win_seg(s); const int nblk = (sg.n + 31) / 32, nit = nblk * 16;
        bf16* WT = s < 11 ? a.WMIX : a.WMRG;
        for (int it = gw - (base % NGW); it < nit; it += NGW) { if (it < 0) continue; const int kb = it / nblk, nb = it % nblk; const int nv = sg.n - 32 * nb < 32 ? sg.n - 32 * nb : 32;
            tr_item(a.w_in, IN_COLS, sg.src + 32 * nb, nv, 64 * kb, WT, 1024, sg.dst + 32 * nb, 0, scr, lane); }
        base += nit;
    }
    for (int i = gw * 64 + lane; i < 176 * 128; i += NGW * 64) ((GAS v4u*)(a.WMIX + (size_t)6736 * 1024))[i] = (v4u){0u, 0u, 0u, 0u};
    for (int it = gw; it < 3 * 512; it += NGW) { const int w = it / 512, r = it % 512, kb = r / 32, nb = r % 32;
        if (w == 0) tr_item(a.w_out_a, 1024, 32 * nb, 32, 64 * kb, a.WAB, 2048, 32 * nb, 0, scr, lane);
        else if (w == 1) tr_item(a.w_out_b, 1024, 32 * nb, 32, 64 * kb, a.WAB, 2048, 32 * nb, 1024, scr, lane);
        else tr_item(a.w_o, 1024, 32 * nb, 32, 64 * kb, a.WO, 1024, 32 * nb, 0, scr, lane); }
    for (int m = gw; m < NTOK; m += NGW) {
        const float* xr = m < NTP ? a.xp + (size_t)m * 1024 : a.xs + (size_t)(m - NTP) * 1024;
        const GAS f32x4* xv = (const GAS f32x4*)xr + lane; GAS unsigned long long* o8 = (GAS unsigned long long*)(a.XB + (size_t)m * 1024) + lane;
#pragma unroll
        for (int j = 0; j < 4; ++j) { const f32x4 v = xv[64 * j]; o8[64 * j] = (unsigned long long)pk2(v.x, v.y) | ((unsigned long long)pk2(v.z, v.w) << 32); }
    }
}

namespace pg8 {
struct EpiMix {
    static constexpr bool PERM = true, AFTER_DRAIN = false, MIDK = false;
    bf16_t* QA4;
    bf16_t* KVc;
    bf16_t *QI, *KI; float* SM;
    float *okvp, *okvs;
    float *oikp, *oiks;
    __device__ __forceinline__ void mid(f32x4 (&)[2][2][4][2], const Unit&, int, int, int, int) const {}
    __device__ __forceinline__ void operator()(const f32x4 (&acc)[2][2][4][2], const Unit& u, int wr, int wc, int fr, int fq) const {
        const int pn = u.pn; const bool samp = u.pm >= NTP / 256;
        const int row0 = u.pm * BM + wr * 64 + fr, cl = wc * 32 + 8 * fq;
        if (pn < 16) {
            bf16_t* base = QA4 + (size_t)(pn >> 2) * ((size_t)NTOK * 1024); const float sc = (pn >= 4 && pn < 8) ? 0.0625f : 1.0f;
            const int col0 = (pn & 3) * 256 + cl;
#pragma unroll
            for (int ai = 0; ai < 2; ++ai)
#pragma unroll
                for (int m = 0; m < 4; ++m) { bf16_t* rowp = base + (size_t)(row0 + ai * HALF + m * 16) * 1024 + col0;
#pragma unroll
                    for (int bj = 0; bj < 2; ++bj) { const f32x4 v0 = acc[ai][bj][m][0] * sc, v1 = acc[ai][bj][m][1] * sc;
                        u32x4 w; w.x = cvt_pk_bf16(v0[0], v0[1]); w.y = cvt_pk_bf16(v0[2], v0[3]); w.z = cvt_pk_bf16(v1[0], v1[1]); w.w = cvt_pk_bf16(v1[2], v1[3]);
                        *(u32x4*)(rowp + bj * HALF) = w; } }
        } else if (pn < 24) {
            const int isV = pn >= 20 ? 1 : 0; const int col0 = (pn & 3) * 256 + cl;
            float* of = samp ? okvs + (size_t)isV * ((size_t)NTS * 1024) : okvp + (size_t)isV * ((size_t)NTP * 1024);
            bf16_t* cb = KVc + (size_t)isV * ((size_t)NTP * 1024);
#pragma unroll
            for (int ai = 0; ai < 2; ++ai)
#pragma unroll
                for (int m = 0; m < 4; ++m) { const int r = row0 + ai * HALF + m * 16; const int rr = samp ? r - NTP : r;
#pragma unroll
                    for (int bj = 0; bj < 2; ++bj) { const f32x4 v0 = acc[ai][bj][m][0], v1 = acc[ai][bj][m][1];
                        float* fp = of + (size_t)rr * 1024 + col0 + bj * HALF; *(f32x4*)fp = v0; *(f32x4*)(fp + 4) = v1;
                        if (!samp) { u32x4 w; w.x = cvt_pk_bf16(v0[0], v0[1]); w.y = cvt_pk_bf16(v0[2], v0[3]); w.z = cvt_pk_bf16(v1[0], v1[1]); w.w = cvt_pk_bf16(v1[2], v1[3]);
                            *(u32x4*)(cb + (size_t)r * 1024 + col0 + bj * HALF) = w; } } }
        } else if (pn < 26) {
            const int col0 = (pn - 24) * 256 + cl;
#pragma unroll
            for (int ai = 0; ai < 2; ++ai)
#pragma unroll
                for (int m = 0; m < 4; ++m) { bf16_t* rowp = QI + (size_t)(row0 + ai * HALF + m * 16) * 512 + col0;
#pragma unroll
                    for (int bj = 0; bj < 2; ++bj) { const f32x4 v0 = acc[ai][bj][m][0] * 0.125f, v1 = acc[ai][bj][m][1] * 0.125f;
                        u32x4 w; w.x = cvt_pk_bf16(v0[0], v0[1]); w.y = cvt_pk_bf16(v0[2], v0[3]); w.z = cvt_pk_bf16(v1[0], v1[1]); w.w = cvt_pk_bf16(v1[2], v1[3]);
                        *(u32x4*)(rowp + bj * HALF) = w; } }
        } else {
            float* oik = samp ? oiks : oikp;
#pragma unroll
            for (int ai = 0; ai < 2; ++ai)
#pragma unroll
                for (int m = 0; m < 4; ++m) { const int r = row0 + ai * HALF + m * 16; const int rr = samp ? r - NTP : r; const f32x4 v0 = acc[ai][0][m][0], v1 = acc[ai][0][m][1];
                    if (wc < 2) { float* fp = oik + (size_t)rr * 64 + cl; *(f32x4*)fp = v0; *(f32x4*)(fp + 4) = v1;
                        u32x4 w; w.x = cvt_pk_bf16(v0[0], v0[1]); w.y = cvt_pk_bf16(v0[2], v0[3]); w.z = cvt_pk_bf16(v1[0], v1[1]); w.w = cvt_pk_bf16(v1[2], v1[3]);
                        *(u32x4*)(KI + (size_t)r * 64 + cl) = w; }
                    else if (wc == 2 && fq < 2) { float* fp = SM + (size_t)r * 16 + 8 * fq; *(f32x4*)fp = v0; *(f32x4*)(fp + 4) = v1; } }
        }
    }
};
}


constexpr size_t WS_BC = WS_NAIVE, WS_WV = WS_BC + 2 * MiB, WS_CMX = WS_WV + 2 * MiB;
constexpr size_t WS_CHS = WS_CMX + 2 * MiB;
constexpr size_t WS_SMAT = WS_CHS + 1 * MiB;
constexpr size_t WS_CB = WS_SMAT + 3 * MiB;
constexpr size_t WS_NB = WS_CB + 64 * MiB;
constexpr size_t WS_MASKS = WS_NB + 1 * MiB;
constexpr size_t WS_HA = WS_MASKS + 1 * MiB;
constexpr size_t WS_END = WS_HA + ROWBUF;
constexpr int NCHK = BATCH * 4 * 32 + DEC_BATCH * 4;

__device__ __forceinline__ float logsig(float x) { return fminf(x, 0.0f) - log1pf(__expf(-fabsf(x))); }
__device__ __forceinline__ float siluf(float x) { return x / (1.0f + __expf(-x)); }
__device__ __forceinline__ int t5b(int rel) { const int n = rel < 0 ? -rel : rel; const int v = n < 8 ? n : 8 + (n >= 12) + (n >= 16) + (n >= 23) + (n >= 32) + (n >= 46) + (n >= 64) + (n >= 91); return (rel > 0 ? 16 : 0) + v; }

namespace pg8 {
__device__ __forceinline__ void unpack8(u32x4 w, float (&f)[8]) {
    f[0] = __uint_as_float(w.x << 16); f[1] = __uint_as_float(w.x & 0xffff0000u); f[2] = __uint_as_float(w.y << 16); f[3] = __uint_as_float(w.y & 0xffff0000u);
    f[4] = __uint_as_float(w.z << 16); f[5] = __uint_as_float(w.z & 0xffff0000u); f[6] = __uint_as_float(w.w << 16); f[7] = __uint_as_float(w.w & 0xffff0000u);
}
__device__ __forceinline__ u32x4 pack8f(const float (&f)[8]) { u32x4 w; w.x = cvt_pk_bf16(f[0], f[1]); w.y = cvt_pk_bf16(f[2], f[3]); w.z = cvt_pk_bf16(f[4], f[5]); w.w = cvt_pk_bf16(f[6], f[7]); return w; }
__device__ __forceinline__ float sg_(float x) { return 1.0f / (1.0f + __expf(-x)); }
struct EpiM1a {
    static constexpr bool PERM = true, AFTER_DRAIN = false, MIDK = false;
    const bf16_t* HA; const bf16_t* OB; const float* HST; const float* ang; bf16_t* BR;
    __device__ __forceinline__ void mid(f32x4 (&)[2][2][4][2], const Unit&, int, int, int, int) const {}
    __device__ __forceinline__ void operator()(const f32x4 (&acc)[2][2][4][2], const Unit& u, int wr, int wc, int fr, int fq) const {
        const int pn = u.pn; const int row0 = u.pm * BM + wr * 64 + fr, cl = wc * 32 + 8 * fq;
        if (pn < 8) {
            const int ch0 = 128 * pn + cl, head = pn >> 1;
            const f32x4 g0 = *(const f32x4*)(ang + ch0), g1 = *(const f32x4*)(ang + ch0 + 4);
            const float g[8] = {g0[0], g0[1], g0[2], g0[3], g1[0], g1[1], g1[2], g1[3]};
#pragma unroll
            for (int ai = 0; ai < 2; ++ai)
#pragma unroll
                for (int m = 0; m < 4; ++m) { const int r = row0 + ai * HALF + m * 16;
                    float h[8]; unpack8(*(const u32x4*)(HA + (size_t)r * 1024 + ch0), h);
                    const float mean = HST[((size_t)r * 4 + head) * 2], rstd = HST[((size_t)r * 4 + head) * 2 + 1];
                    const f32x4 o0 = acc[ai][0][m][0], o1 = acc[ai][0][m][1], z0 = acc[ai][1][m][0], z1 = acc[ai][1][m][1];
                    const float oa[8] = {o0[0], o0[1], o0[2], o0[3], o1[0], o1[1], o1[2], o1[3]}, za[8] = {z0[0], z0[1], z0[2], z0[3], z1[0], z1[1], z1[2], z1[3]};
                    float o[8];
#pragma unroll
                    for (int i = 0; i < 8; ++i) o[i] = ((h[i] - mean) * rstd * g[i] * sg_(oa[i])) * (za[i] * sg_(za[i]));
                    *(u32x4*)(BR + (size_t)r * 2048 + ch0) = pack8f(o); }
        } else {
#pragma unroll
            for (int ai = 0; ai < 2; ++ai)
#pragma unroll
                for (int m = 0; m < 4; ++m) { const int r = row0 + ai * HALF + m * 16;
#pragma unroll
                    for (int bj = 0; bj < 2; ++bj) { const int ch0 = 256 * (pn - 8) + 128 * bj + cl;
                        float ob[8]; unpack8(*(const u32x4*)(OB + (size_t)r * 1024 + ch0), ob);
                        const f32x4 z0 = acc[ai][bj][m][0], z1 = acc[ai][bj][m][1]; const float zb[8] = {z0[0], z0[1], z0[2], z0[3], z1[0], z1[1], z1[2], z1[3]};
                        float o[8];
#pragma unroll
                        for (int i = 0; i < 8; ++i) o[i] = ob[i] * (zb[i] * sg_(zb[i]));
                        *(u32x4*)(BR + (size_t)r * 2048 + 1024 + ch0) = pack8f(o); } }
        }
    }
};
struct EpiM1b {
    static constexpr bool PERM = true, AFTER_DRAIN = false, MIDK = false;
    bf16_t* SGA; bf16_t* SGB;
    __device__ __forceinline__ void mid(f32x4 (&)[2][2][4][2], const Unit&, int, int, int, int) const {}
    __device__ __forceinline__ void operator()(const f32x4 (&acc)[2][2][4][2], const Unit& u, int wr, int wc, int fr, int fq) const {
        const int pn = u.pn; const int row0 = u.pm * BM + wr * 64 + fr, cl = wc * 32 + 8 * fq;
        bf16_t* base = pn < 4 ? SGA : SGB; const int col0 = (pn & 3) * 256 + cl;
#pragma unroll
        for (int ai = 0; ai < 2; ++ai)
#pragma unroll
            for (int m = 0; m < 4; ++m) { bf16_t* rowp = base + (size_t)(row0 + ai * HALF + m * 16) * 1024 + col0;
#pragma unroll
                for (int bj = 0; bj < 2; ++bj) { const f32x4 v0 = acc[ai][bj][m][0], v1 = acc[ai][bj][m][1];
                    const float o[8] = {sg_(v0[0]), sg_(v0[1]), sg_(v0[2]), sg_(v0[3]), sg_(v1[0]), sg_(v1[1]), sg_(v1[2]), sg_(v1[3])};
                    *(u32x4*)(rowp + bj * HALF) = pack8f(o); } }
    }
};
struct EpiM2 {
    static constexpr bool PERM = true, AFTER_DRAIN = false, MIDK = true;
    const bf16_t* SGA; const bf16_t* SGB; bf16_t* MX;
    __device__ __forceinline__ void mid(f32x4 (&acc)[2][2][4][2], const Unit& u, int wr, int wc, int fr, int fq) const {
        int fr_ = fr, fq_ = fq; asm volatile("" : "+v"(fr_), "+v"(fq_));
        const int row0 = u.pm * BM + wr * 64 + fr_, col0 = u.pn * BM + wc * 32 + 8 * fq_;
#pragma unroll
        for (int ai = 0; ai < 2; ++ai)
#pragma unroll
            for (int m = 0; m < 4; ++m) { const size_t ro = (size_t)(row0 + ai * HALF + m * 16) * 1024 + col0;
#pragma unroll
                for (int bj = 0; bj < 2; ++bj) { float a[8], b[8]; unpack8(*(const u32x4*)(SGA + ro + bj * HALF), a); unpack8(*(const u32x4*)(SGB + ro + bj * HALF), b);
#pragma unroll
                    for (int i = 0; i < 4; ++i) { acc[ai][bj][m][0][i] *= a[i] * __builtin_amdgcn_rcpf(b[i]); acc[ai][bj][m][1][i] *= a[4 + i] * __builtin_amdgcn_rcpf(b[4 + i]); } }
                asm volatile("" ::: "memory"); }
    }
    __device__ __forceinline__ void operator()(const f32x4 (&acc)[2][2][4][2], const Unit& u, int wr, int wc, int fr, int fq) const {
        int fr_ = fr, fq_ = fq; asm volatile("" : "+v"(fr_), "+v"(fq_));
        const int row0 = u.pm * BM + wr * 64 + fr_, col0 = u.pn * BM + wc * 32 + 8 * fq_;
#pragma unroll
        for (int ai = 0; ai < 2; ++ai)
#pragma unroll
            for (int m = 0; m < 4; ++m) { const size_t ro = (size_t)(row0 + ai * HALF + m * 16) * 1024 + col0;
#pragma unroll
                for (int bj = 0; bj < 2; ++bj) { float b[8]; unpack8(*(const u32x4*)(SGB + ro + bj * HALF), b);
                    const f32x4 v0 = acc[ai][bj][m][0], v1 = acc[ai][bj][m][1];
                    const float o[8] = {v0[0] * b[0], v0[1] * b[1], v0[2] * b[2], v0[3] * b[3], v1[0] * b[4], v1[1] * b[5], v1[2] * b[6], v1[3] * b[7]};
                    *(u32x4*)(MX + ro + bj * HALF) = pack8f(o); }
                asm volatile("" ::: "memory"); }
    }
};
struct EpiM3 {
    static constexpr bool PERM = true, AFTER_DRAIN = false, MIDK = false;
    const float* xp; const float* xs; float* yp; float* ys;
    __device__ __forceinline__ void mid(f32x4 (&)[2][2][4][2], const Unit&, int, int, int, int) const {}
    __device__ __forceinline__ void operator()(const f32x4 (&acc)[2][2][4][2], const Unit& u, int wr, int wc, int fr, int fq) const {
        const bool samp = u.pm >= NTP / 256; const int row0 = (samp ? u.pm - NTP / 256 : u.pm) * BM + wr * 64 + fr, col0 = u.pn * BM + wc * 32 + 8 * fq;
        const float* xb = samp ? xs : xp; float* yb = samp ? ys : yp;
#pragma unroll
        for (int ai = 0; ai < 2; ++ai)
#pragma unroll
            for (int m = 0; m < 4; ++m) { const size_t ro = (size_t)(row0 + ai * HALF + m * 16) * 1024 + col0;
#pragma unroll
                for (int bj = 0; bj < 2; ++bj) { const f32x4 x0 = *(const f32x4*)(xb + ro + bj * HALF), x1 = *(const f32x4*)(xb + ro + bj * HALF + 4);
                    *(f32x4*)(yb + ro + bj * HALF) = x0 * DN_ALPHA + acc[ai][bj][m][0]; *(f32x4*)(yb + ro + bj * HALF + 4) = x1 * DN_ALPHA + acc[ai][bj][m][1]; } }
    }
};
}

__device__ __forceinline__ float wave_sum(float v) {
#pragma unroll
    for (int o = 1; o < 64; o <<= 1) v += __shfl_xor(v, o);
    return v;
}

__global__ void __launch_bounds__(NWAVES * 64, 2) mk_fwd(Args args) {
    extern __shared__ __attribute__((aligned(16))) unsigned char lds_raw[];
    LAS unsigned char* lds = (LAS unsigned char*)lds_raw;
    volatile LAS unsigned* MISC = (volatile LAS unsigned*)(lds + MISC_OFF);
    gu32* ctl = (gu32*)(args.ws + WS_CTL);
    for (int u = threadIdx.x; u < (LDS_BYTES - LDSCTL_OFF) / 4; u += NWAVES * 64) ((LAS unsigned*)(lds + LDSCTL_OFF))[u] = 0u;
    __syncthreads();
    XcdBarrier bar = xcd_barrier_post((unsigned*)(ctl + CW_BAR), MISC + 8);
    const int lo = args.ph_lo, hi = args.ph_hi;
#ifndef PHMASK
#define PHMASK 0x3ff
#endif
#define IN(k) (((PHMASK >> (k)) & 1) && lo <= (k) && (k) < hi)
#define GBAR() xcd_barrier(bar)
#define WMIX ((bf16*)(args.ws + WS_WMIX))
#define WMRG ((bf16*)(args.ws + WS_WMRG))
#define WAB ((bf16*)(args.ws + WS_WAB))
#define WO ((bf16*)(args.ws + WS_WO))
#define XB ((bf16*)(args.ws + WS_XB))
#define QA ((bf16*)(args.ws + WS_QA))
#define KA ((bf16*)(args.ws + WS_KA))
#define VA ((bf16*)(args.ws + WS_VA))
#define QB ((bf16*)(args.ws + WS_QB))
#define QI ((bf16*)(args.ws + WS_QI))
#define KI ((bf16*)(args.ws + WS_KI))
#define SM ((float*)(args.ws + WS_SM))
#define MASK ((unsigned long long*)(args.ws + WS_MASK))
#define MASKS ((unsigned long long*)(args.ws + WS_MASKS))
#define HST ((float*)(args.ws + WS_HST))
#define BC ((float*)(args.ws + WS_BC))
#define WV ((float*)(args.ws + WS_WV))
#define CMX ((float*)(args.ws + WS_CMX))
#define CHS ((float*)(args.ws + WS_CHS))
#define MCH (CHS + 2 * NCHK)
#define SMATP ((float*)(args.ws + WS_SMAT))
#define SMATS (SMATP + 128 * 4096)
#define CB ((float*)(args.ws + WS_CB))
#define NBf ((float*)(args.ws + WS_NB))
#define HA ((bf16*)(args.ws + WS_HA))
#define OB QA
#define BR KA
#define SGA QA
#define SGB QB
#define MX XB
#define y_prompt (args.out)
#define y_sample (y_prompt + (size_t)NTP * 1024)
#define k_prompt (y_sample + (size_t)NTS * 1024)
#define v_prompt (k_prompt + (size_t)NTP * 1024)
#define ik_prompt (v_prompt + (size_t)NTP * 1024)
#define C_prompt (ik_prompt + (size_t)NTP * 64)
#define n_prompt (C_prompt + (size_t)BATCH * 4 * 65536)
#define m_prompt (n_prompt + (size_t)BATCH * 1024)
#define k_sample (m_prompt + BATCH * 4)
#define v_sample (k_sample + (size_t)NTS * 1024)
#define ik_sample (v_sample + (size_t)NTS * 1024)
#define C_sample (ik_sample + (size_t)NTS * 64)
#define n_sample (C_sample + (size_t)DEC_BATCH * 4 * 65536)
#define m_sample (n_sample + (size_t)DEC_BATCH * 1024)
#define KBc ((bf16*)y_prompt)
#define VBc (KBc + (size_t)NTP * 1024)
#define cache_k (args.in[2])
#define cache_v (args.in[3])
#define cache_ik (args.in[4])
#define state_C (args.in[5])
#define state_n (args.in[6])
#define state_m (args.in[7])
#define b_gates (args.in[9])
#define a_norm_g (args.in[10])
#define rel_bias (args.in[14])
#define ln_g (args.in[15])
#define ln_b (args.in[16])
#define gtid ((long)blockIdx.x * (NWAVES * 64) + (long)threadIdx.x)
#define GT ((long)gridDim.x * (NWAVES * 64))
#define gw (vcu * NWAVES + wave)
#define NGW ((int)gridDim.x * NWAVES)
#define tid ((int)threadIdx.x)
#define lane ((int)(threadIdx.x & 63))
#define wave (__builtin_amdgcn_readfirstlane((int)(threadIdx.x >> 6)))
#define G ((int)gridDim.x)
#define vcu ((G % 8 == 0) ? ((int)blockIdx.x % 8) * (G / 8) + (int)blockIdx.x / 8 : (int)blockIdx.x)

    if (IN(0)) {
        P0Args a{args.in[0], args.in[1], args.in[8], args.in[11], args.in[12], args.in[13], XB, WMIX, WMRG, WAB, WO};
        p0_prologue(a, lds, vcu, G, wave, lane);
        GBAR();
    }
    if (IN(1)) {
        pg8::Gemm g{XB, WMIX, NTOK, N_MIX, 1024}; pg8::StaticOrder S; S.init(NTOK, N_MIX, G, (int)blockIdx.x);
        pg8::EpiMix E{QA, KBc, QI, KI, SM, k_prompt, k_sample, ik_prompt, ik_sample};
        pg8::gemm_phase<pg8::EpiMix, pg8::StaticOrder, true, true>(lds + RING_OFF, g, S, E);
        GBAR();
    }
    if (IN(2)) {
        for (long t = gtid; t < NCHK; t += GT) {
            int h, L; long tok0;
            if (t < 4096) { const int b = (int)(t >> 7); h = (int)((t >> 5) & 3); const int c = (int)(t & 31); tok0 = (long)b * SEQ + c * 64; L = 64; }
            else { const int b = (int)((t - 4096) >> 2); h = (int)((t - 4096) & 3); tok0 = NTP + (long)b * DEC_SEQ; L = DEC_SEQ; }
            const float bi = b_gates[h], bfg = b_gates[4 + h]; float cum = 0.f, cmax = -INFINITY;
            for (int l = 0; l < L; ++l) { const long tok = tok0 + l; const float ig = SM[tok * 16 + 8 + h] + bi; const float lf = logsig(SM[tok * 16 + 12 + h] + bfg);
                cum += lf; const float w = ig - cum; cmax = fmaxf(cmax, w); BC[tok * 4 + h] = cum; WV[tok * 4 + h] = w; CMX[tok * 4 + h] = cmax; }
            CHS[2 * t] = cum; CHS[2 * t + 1] = cmax;
        }
        GBAR();
        for (long t = gtid; t < BATCH * 4 + DEC_BATCH * 4; t += GT) {
            if (t < BATCH * 4) { float m = 0.f; for (int c = 0; c < 32; ++c) { const long i = t * 32 + c; MCH[i] = m; m = CHS[2 * i] + fmaxf(m, CHS[2 * i + 1]); } m_prompt[t] = m; }
            else { const long j = t - BATCH * 4; const long i = 4096 + j; float m = state_m[j]; MCH[i] = m; m = CHS[2 * i] + fmaxf(m, CHS[2 * i + 1]); m_sample[j] = m; }
        }
        GBAR();
        for (int c = 0; c < 32; ++c) {
            const long nSp = 128L * 4096, nSs = (c == 0) ? 64L * 1024 : 0;
            for (long t = gtid; t < nSp + nSs; t += GT) {
                int bh, l, s, L; long tok0; float* dst;
                if (t < nSp) { bh = (int)(t >> 12); l = (int)((t >> 6) & 63); s = (int)(t & 63); L = 64; tok0 = (long)(bh >> 2) * SEQ + c * 64; dst = SMATP + t; }
                else { const long u = t - nSp; bh = (int)(u >> 10); l = (int)((u >> 5) & 31); s = (int)(u & 31); L = 32; tok0 = NTP + (long)(bh >> 2) * DEC_SEQ; dst = SMATS + u; }
                const int h = bh & 3; float val = 0.f;
                if (s <= l) { const long tl = tok0 + l, ts = tok0 + s; const bf16* q = QA + tl * 1024 + h * 256; const bf16* k = KA + ts * 1024 + h * 256;
                    float d = 0.f; for (int i = 0; i < 256; ++i) d += bf2f(q[i]) * bf2f(k[i]);
                    const long ci = (t < nSp) ? (long)bh * 32 + c : 4096 + bh;
                    val = d * __expf(WV[ts * 4 + h] - fmaxf(MCH[ci], CMX[tl * 4 + h])); }
                *dst = val;
            }
            GBAR();
            const long nHp = 32L * 64 * 1024, nHs = (c == 0) ? 16L * 32 * 1024 : 0, nCp = 128L * 65536, nCs = (c == 0) ? 64L * 65536 : 0;
            for (long t = gtid; t < nHp + nHs + nCp + nCs; t += GT) {
                if (t < nHp + nHs) {
                    int b, l, h, dv, L; long tok0, ci; const float* Sr; const float* Cm; const float* nv; bool zero = false;
                    if (t < nHp) { b = (int)(t >> 16); l = (int)((t >> 10) & 63); h = (int)((t >> 8) & 3); dv = (int)(t & 255); L = 64; tok0 = (long)b * SEQ + c * 64; ci = (long)(b * 4 + h) * 32 + c;
                        Sr = SMATP + ((long)(b * 4 + h) * 64 + l) * 64; Cm = CB + (size_t)(c & 1) * 128 * 65536 + (size_t)(b * 4 + h) * 65536; nv = NBf + (c & 1) * 128 * 256 + (b * 4 + h) * 256; zero = (c == 0); }
                    else { const long u = t - nHp; b = (int)(u >> 15); l = (int)((u >> 10) & 31); h = (int)((u >> 8) & 3); dv = (int)(u & 255); L = 32; tok0 = NTP + (long)b * DEC_SEQ; ci = 4096 + b * 4 + h;
                        Sr = SMATS + ((long)(b * 4 + h) * 32 + l) * 32; Cm = state_C + (size_t)(b * 4 + h) * 65536; nv = state_n + (b * 4 + h) * 256; }
                    const long tl = tok0 + l; const bf16* q = QA + tl * 1024 + h * 256;
                    const float mc = MCH[ci], Ml = fmaxf(mc, CMX[tl * 4 + h]), bl = BC[tl * 4 + h]; const float inter = __expf(mc - Ml);
                    float num = 0.f, den = 0.f;
                    for (int s = 0; s <= l; ++s) { const float sv = Sr[s]; num += sv * bf2f(VA[(tok0 + s) * 1024 + h * 256 + dv]); den += sv; }
                    if (!zero) { float qc = 0.f, qn = 0.f; for (int i = 0; i < 256; ++i) { const float qi_ = bf2f(q[i]); qc += qi_ * Cm[(size_t)i * 256 + dv]; qn += qi_ * nv[i]; } num += inter * qc; den += inter * qn; }
                    const float hv = num / fmaxf(fabsf(den), __expf(-(bl + Ml)));
                    HA[tl * 1024 + h * 256 + dv] = (bf16)f2bf(hv);
                } else {
                    const long u0 = t - (nHp + nHs); int bh, dk, dv, L; long tok0, ci; const float* Cs; const float* ns; float* Cd; float* nd; bool zero = false;
                    if (u0 < nCp) { bh = (int)(u0 >> 16); dk = (int)((u0 >> 8) & 255); dv = (int)(u0 & 255); L = 64; tok0 = (long)(bh >> 2) * SEQ + c * 64; ci = (long)bh * 32 + c; zero = (c == 0);
                        Cs = CB + (size_t)(c & 1) * 128 * 65536 + (size_t)bh * 65536; ns = NBf + (c & 1) * 128 * 256 + bh * 256;
                        Cd = (c == 31) ? C_prompt + (size_t)bh * 65536 : CB + (size_t)((c + 1) & 1) * 128 * 65536 + (size_t)bh * 65536; nd = (c == 31) ? n_prompt + bh * 256 : NBf + ((c + 1) & 1) * 128 * 256 + bh * 256; }
                    else { const long u = u0 - nCp; bh = (int)(u >> 16); dk = (int)((u >> 8) & 255); dv = (int)(u & 255); L = 32; tok0 = NTP + (long)(bh >> 2) * DEC_SEQ; ci = 4096 + bh;
                        Cs = state_C + (size_t)bh * 65536; ns = state_n + bh * 256; Cd = C_sample + (size_t)bh * 65536; nd = n_sample + bh * 256; }
                    const int h = bh & 3; const float mc = MCH[ci]; const float Mlast = fmaxf(mc, CMX[(tok0 + L - 1) * 4 + h]); const float decay = __expf(mc - Mlast);
                    float aC = 0.f, an = 0.f;
                    for (int s = 0; s < L; ++s) { const long ts = tok0 + s; const float wsv = __expf(WV[ts * 4 + h] - Mlast); const float kk = bf2f(KA[ts * 1024 + h * 256 + dk]);
                        aC += wsv * kk * bf2f(VA[ts * 1024 + h * 256 + dv]); an += wsv * kk; }
                    Cd[(size_t)dk * 256 + dv] = (zero ? 0.f : decay * Cs[(size_t)dk * 256 + dv]) + aC;
                    if (dv == 0) nd[dk] = (zero ? 0.f : decay * ns[dk]) + an;
                }
            }
            GBAR();
        }
        for (long t = gw; t < (long)NTOK * 4; t += NGW) { const unsigned long long w8 = *((const GAS unsigned long long*)(HA + t * 256) + lane);
            const float v0 = __uint_as_float((unsigned)w8 << 16), v1 = __uint_as_float((unsigned)w8 & 0xffff0000u), v2 = __uint_as_float((unsigned)(w8 >> 32) << 16), v3 = __uint_as_float((unsigned)(w8 >> 32) & 0xffff0000u);
            const float mean = wave_sum((v0 + v1) + (v2 + v3)) * (1.0f / 256.0f); const float d0 = v0 - mean, d1 = v1 - mean, d2 = v2 - mean, d3 = v3 - mean;
            const float var = wave_sum((d0 * d0 + d1 * d1) + (d2 * d2 + d3 * d3)) * (1.0f / 256.0f);
            if (lane == 0) { HST[t * 2] = mean; HST[t * 2 + 1] = 1.0f / sqrtf(var + HEAD_NORM_EPS); } }
    }
    if (IN(3)) {
        LAS float* sc = (LAS float*)(lds + RING_OFF);
        LAS float* qv = (LAS float*)(lds + RING_OFF + 16384);
        for (int row = vcu; row < NTOK; row += G) {
            const bool samp = row >= NTP; const int b = samp ? (row - NTP) / DEC_SEQ : row / SEQ; const int q = samp ? (row - NTP) % DEC_SEQ : row % SEQ;
            const int S = samp ? PAST_LEN + DEC_SEQ : ((q >> 6) + 1) * 64;
            unsigned long long* mrow = samp ? MASKS + (size_t)(row - NTP) * 40 : MASK + (size_t)row * 32;
            if (S <= TOPK_MAX) { if (tid < 32) mrow[tid] = (tid < (S >> 6)) ? ~0ull : 0ull; continue; }
            qv[tid] = bf2f(QI[(size_t)row * 512 + tid]); if (tid < 8) qv[512 + tid] = SM[(size_t)row * 16 + tid] * 0.35355339059327373f;
            __syncthreads();
            const int nIt = (S + 511) / 512;
            for (int i = 0; i < nIt; ++i) { const int s = tid + 512 * i;
                if (s < S) { float kf[64];
                    if (samp && s < PAST_LEN) { const float* kr = cache_ik + ((size_t)b * PAST_LEN + s) * 64;
#pragma unroll
                        for (int j = 0; j < 64; ++j) kf[j] = kr[j]; }
                    else { const bf16* kr = KI + (samp ? (size_t)NTP + (size_t)b * DEC_SEQ + (s - PAST_LEN) : (size_t)b * SEQ + s) * 64;
#pragma unroll
                        for (int j = 0; j < 64; ++j) kf[j] = bf2f(kr[j]); }
                    float a = 0.f;
#pragma unroll
                    for (int h = 0; h < 8; ++h) { float d = 0.f;
#pragma unroll
                        for (int j = 0; j < 64; ++j) d += qv[h * 64 + j] * kf[j];
                        a += qv[512 + h] * fmaxf(d, 0.f); }
                    sc[s] = a; } }
            __syncthreads();
            for (int i = 0; i < nIt; ++i) { const int s = tid + 512 * i; bool keep = false;
                if (s < S) { const float v = sc[s]; int rank = 0; for (int j = 0; j < S; ++j) { const float u = sc[j]; rank += (u > v) || (u == v && j < s); } keep = rank < TOPK_MAX; }
                const unsigned long long bm = __ballot(keep);
                if (lane == 0 && (wave + 8 * i) * 64 < S) mrow[wave + 8 * i] = bm; }
            if (!samp) { const int nw = S >> 6; if (tid >= nw && tid < 32) mrow[tid] = 0ull; }
            __syncthreads();
        }
        GBAR();
    }
    if (IN(4)) {
        for (long t = gtid; t < (long)NTOK * 64; t += GT) {
            const int dc = (int)(t & 7), h = (int)((t >> 3) & 7); const int row = (int)(t >> 6);
            const bool samp = row >= NTP; const int b = samp ? (row - NTP) / DEC_SEQ : row / SEQ; const int q = samp ? (row - NTP) % DEC_SEQ : row % SEQ;
            const int S = samp ? PAST_LEN + DEC_SEQ : ((q >> 6) + 1) * 64; const int qpos = samp ? PAST_LEN + q : q;
            const unsigned long long* mrow = samp ? MASKS + (size_t)(row - NTP) * 40 : MASK + (size_t)row * 32;
            const bf16* qr = QB + (size_t)row * 1024 + h * 128;
            float mx = -INFINITY, sum = 0.f, o[16];
#pragma unroll
            for (int i = 0; i < 16; ++i) o[i] = 0.f;
            for (int w = 0; w * 64 < S; ++w) { unsigned long long bits = mrow[w];
                while (bits) { const int s = w * 64 + __builtin_ctzll(bits); bits &= bits - 1;
                    float d = 0.f; float vv[16];
                    if (samp) { const float* kr = (s < PAST_LEN) ? cache_k + ((size_t)b * PAST_LEN + s) * 1024 + h * 128 : k_sample + ((size_t)b * DEC_SEQ + (s - PAST_LEN)) * 1024 + h * 128;
                        const float* vr = (s < PAST_LEN) ? cache_v + ((size_t)b * PAST_LEN + s) * 1024 + h * 128 + dc * 16 : v_sample + ((size_t)b * DEC_SEQ + (s - PAST_LEN)) * 1024 + h * 128 + dc * 16;
#pragma unroll
                        for (int j = 0; j < 128; ++j) d += bf2f(qr[j]) * kr[j];
#pragma unroll
                        for (int i = 0; i < 16; ++i) vv[i] = vr[i]; }
                    else { const bf16* kr = KBc + ((size_t)b * SEQ + s) * 1024 + h * 128; const bf16* vr = VBc + ((size_t)b * SEQ + s) * 1024 + h * 128 + dc * 16;
#pragma unroll
                        for (int j = 0; j < 128; ++j) d += bf2f(qr[j]) * bf2f(kr[j]);
#pragma unroll
                        for (int i = 0; i < 16; ++i) vv[i] = bf2f(vr[i]); }
                    const float lg = d * 0.08838834764831845f + rel_bias[t5b(s - qpos) * 8 + h];
                    if (lg > mx) { const float f = __expf(mx - lg); sum *= f;
#pragma unroll
                        for (int i = 0; i < 16; ++i) o[i] *= f; mx = lg; }
                    const float p = __expf(lg - mx); sum += p;
#pragma unroll
                    for (int i = 0; i < 16; ++i) o[i] += p * vv[i]; } }
            const float inv = 1.0f / sum; bf16* orow = OB + (size_t)row * 1024 + h * 128 + dc * 16;
#pragma unroll
            for (int i = 0; i < 16; ++i) orow[i] = (bf16)f2bf(o[i] * inv);
        }
        GBAR();
    }
    if (IN(5)) {
        pg8::Gemm g{XB, WMRG, NTOK, N_M1A, 1024}; pg8::StaticOrder S; S.init(NTOK, N_M1A, G, (int)blockIdx.x);
        pg8::EpiM1a E{HA, OB, HST, a_norm_g, BR};
        pg8::gemm_phase<pg8::EpiM1a, pg8::StaticOrder, true, true>(lds + RING_OFF, g, S, E);
        GBAR();
    }
    if (IN(6)) {
        pg8::Gemm g{XB, WMRG + (size_t)N_M1A * 1024, NTOK, N_M1B, 1024}; pg8::StaticOrder S; S.init(NTOK, N_M1B, G, (int)blockIdx.x);
        pg8::EpiM1b E{SGA, SGB};
        pg8::gemm_phase<pg8::EpiM1b, pg8::StaticOrder, true, true>(lds + RING_OFF, g, S, E);
        GBAR();
    }
    if (IN(7)) {
        pg8::Gemm g{BR, WAB, NTOK, 1024, 2048}; pg8::StaticOrder S; S.init(NTOK, 1024, G, (int)blockIdx.x);
        pg8::EpiM2 E{SGA, SGB, MX};
        pg8::gemm_phase<pg8::EpiM2, pg8::StaticOrder, true, true>(lds + RING_OFF, g, S, E);
        GBAR();
    }
    if (IN(8)) {
        pg8::Gemm g{MX, WO, NTOK, 1024, 1024}; pg8::StaticOrder S; S.init(NTOK, 1024, G, (int)blockIdx.x);
        pg8::EpiM3 E{args.in[0], args.in[1], y_prompt, y_sample};
        pg8::gemm_phase<pg8::EpiM3, pg8::StaticOrder, true, true>(lds + RING_OFF, g, S, E);
        GBAR();
    }
    if (IN(9)) {
        for (int m = gw; m < NTOK; m += NGW) {
            float* yr = m < NTP ? y_prompt + (size_t)m * 1024 : y_sample + (size_t)(m - NTP) * 1024;
            GAS f32x4* yv = (GAS f32x4*)yr + lane; f32x4 v[4]; float s = 0.f;
#pragma unroll
            for (int j = 0; j < 4; ++j) { v[j] = yv[64 * j]; s += (v[j].x + v[j].y) + (v[j].z + v[j].w); }
            const float mean = wave_sum(s) * (1.f / 1024.f); float s2 = 0.f;
#pragma unroll
            for (int j = 0; j < 4; ++j) { v[j] = v[j] - mean; s2 += (v[j].x * v[j].x + v[j].y * v[j].y) + (v[j].z * v[j].z + v[j].w * v[j].w); }
            const float rstd = 1.f / sqrtf(wave_sum(s2) * (1.f / 1024.f) + LN_EPS);
#pragma unroll
            for (int j = 0; j < 4; ++j) { const f32x4 gg = *((const GAS f32x4*)ln_g + lane + 64 * j), bb = *((const GAS f32x4*)ln_b + lane + 64 * j); yv[64 * j] = v[j] * rstd * gg + bb; }
        }
    }
#undef IN
#undef GBAR
#undef gtid
#undef GT
#undef gw
#undef NGW
#undef tid
#undef lane
#undef wave
#undef G
#undef vcu
}

extern "C" void kernel_launch(void* const* d_in, const int* in_sizes, int n_in, void* d_out, int out_size, void* d_ws, size_t ws_size, hipStream_t stream) {
    static int grid = 0;
    if (grid == 0) {
        int dev = 0, cus = 0;
        if (hipGetDevice(&dev) != hipSuccess || hipDeviceGetAttribute(&cus, hipDeviceAttributeMultiprocessorCount, dev) != hipSuccess) { grid = -1; return; }
        if (hipFuncSetAttribute((const void*)mk_fwd, hipFuncAttributeMaxDynamicSharedMemorySize, LDS_BYTES) != hipSuccess) { grid = -1; return; }
        (void)hipGetLastError();
        if (n_in != 17 || ws_size < WS_END) { fprintf(stderr, "kernel_launch: needs 17 inputs and %zu bytes of workspace (got %d, %zu)\n", (size_t)WS_END, n_in, ws_size); grid = -1; return; }
        grid = cus;
    }
    if (grid < 0) return;
    if (hipMemsetAsync((unsigned char*)d_ws + WS_CTL, 0, CTL_ZERO_BYTES, stream) != hipSuccess) return;
    Args a{};
    for (int i = 0; i < 17; ++i) a.in[i] = (const float*)d_in[i];
    a.out = (float*)d_out; a.ws = (unsigned char*)d_ws; a.ph_lo = 0; a.ph_hi = 10;
    hipLaunchKernelGGL(mk_fwd, dim3(grid), dim3(NWAVES * 64), LDS_BYTES, stream, a);
}
```

```cpp
#include <hip/hip_runtime.h>
#include <cstdio>
#include <cstdint>
#include <math.h>
#ifndef D_MODEL
#define D_MODEL 1024
#define BATCH 32
#define SEQ 2048
#define DEC_BATCH 16
#define DEC_SEQ 32
#define PAST_LEN 2048
#define CHUNK 64
#define A_HEADS 4
#define A_HEAD_DIM 256
#define B_HEADS 8
#define B_HEAD_DIM 128
#define IDX_HEADS 8
#define IDX_DIM 64
#define TOPK_MAX 256
#define GROUP_B 4
#endif
#define A_WIDTH (A_HEADS * A_HEAD_DIM)
#define B_WIDTH (B_HEADS * B_HEAD_DIM)
#define C_QA 0
#define C_KA (C_QA + A_WIDTH)
#define C_VA (C_KA + A_WIDTH)
#define C_OA (C_VA + A_WIDTH)
#define C_ZA (C_OA + A_WIDTH)
#define C_IA (C_ZA + A_WIDTH)
#define C_FA (C_IA + A_HEADS)
#define C_QB (C_FA + A_HEADS)
#define C_KB (C_QB + B_WIDTH)
#define C_VB (C_KB + B_WIDTH)
#define C_ZB (C_VB + B_WIDTH)
#define C_QI (C_ZB + B_WIDTH)
#define C_KI (C_QI + IDX_HEADS * IDX_DIM)
#define C_WI (C_KI + IDX_DIM)
#define C_GA (C_WI + IDX_HEADS)
#define C_GB (C_GA + D_MODEL)
#define IN_COLS (C_GB + D_MODEL)
#define LN_EPS 1e-5f
#define HEAD_NORM_EPS 1e-6f
#define DN_ALPHA 1.189207115002721f


#define GAS __attribute__((address_space(1)))
#define LAS __attribute__((address_space(3)))
typedef unsigned short bf16;
typedef unsigned v4u __attribute__((ext_vector_type(4)));
typedef float f32x4 __attribute__((ext_vector_type(4)));
typedef short bf16x8 __attribute__((ext_vector_type(8)));
typedef GAS unsigned gu32;
typedef GAS unsigned long long gu64;
#define RLX_AGENT __ATOMIC_RELAXED, __HIP_MEMORY_SCOPE_AGENT
#define LDS_WAIT() asm volatile("s_waitcnt lgkmcnt(0)" ::: "memory")
#define VM_WAIT() asm volatile("s_waitcnt vmcnt(0)" ::: "memory")
__device__ __forceinline__ unsigned long long rt() { return __builtin_amdgcn_s_memrealtime(); }
__device__ __forceinline__ unsigned f2bf(float f) { unsigned u = __builtin_bit_cast(unsigned, f); return (u + 0x7fffu + ((u >> 16) & 1u)) >> 16; }
__device__ __forceinline__ unsigned pk2(float lo, float hi) { return f2bf(lo) | (f2bf(hi) << 16); }

#define XB_TMO      128
#define XB_XCNT(j)  (256  + 64 * (j))
#define XB_XSUB(j)  (1280 + 64 * (j))
#define XB_XGEN(j)  (2304 + 64 * (j))
#define XB_TOP      3328
#define XB_TOPGEN   3392
#define XCD_BAR_WORDS 3456
#define XB_SPIN_CAP (1u << 18)

__device__ __forceinline__ unsigned xb_ld(unsigned* p)              { return __hip_atomic_load(p, __ATOMIC_RELAXED, __HIP_MEMORY_SCOPE_AGENT); }
__device__ __forceinline__ unsigned xb_add(unsigned* p, unsigned v) { return __hip_atomic_fetch_add(p, v, __ATOMIC_RELAXED, __HIP_MEMORY_SCOPE_AGENT); }
__device__ __forceinline__ unsigned xb_xcc_id() { return (unsigned)__builtin_amdgcn_s_getreg((3 << 11) | 20) & 0xFu; }
#define XB_SPIN(cond, bar) do { unsigned _sp = 0; while (cond) { __builtin_amdgcn_s_sleep(1); \
    if ((++_sp & 255u) == 0u) { if (xb_ld(&(bar)[XB_TMO])) break; if (_sp > XB_SPIN_CAP) { atomicAdd(&(bar)[XB_TMO], 1u); break; } } } } while (0)

struct XcdBarrier {
    unsigned* bar; unsigned x;
    volatile LAS unsigned* st;
};

__device__ __forceinline__ XcdBarrier xcd_barrier_post(unsigned* bar, volatile LAS unsigned* st) {
    XcdBarrier b; b.bar = bar; b.x = xb_xcc_id(); b.st = st;
    if (threadIdx.x == 0) (void)xb_add(&bar[XB_XCNT(b.x)], 1u);
    return b;
}
__device__ __forceinline__ void xcd_barrier_complete(unsigned* bar, unsigned x, unsigned& nloc, unsigned& nx) {
    const unsigned G = gridDim.x * gridDim.y * gridDim.z;
    unsigned sum, cnt, mine, sp = 0u;
    for (;;) {
        sum = 0u; cnt = 0u; mine = 0u;
#pragma unroll
        for (unsigned j = 0; j < 16; ++j) { const unsigned c = xb_ld(&bar[XB_XCNT(j)]); sum += c; cnt += (c > 0u) ? 1u : 0u; mine = (j == x) ? c : mine; }
        if (sum == G) break;
        __builtin_amdgcn_s_sleep(1);
        if ((++sp & 255u) == 0u) { if (xb_ld(&bar[XB_TMO])) break; if (sp > XB_SPIN_CAP) { atomicAdd(&bar[XB_TMO], 1u); break; } }
    }
    nloc = mine > 0u ? mine : 1u; nx = cnt > 0u ? cnt : 1u;
}

__device__ __forceinline__ void xcd_barrier(const XcdBarrier& b) {
    asm volatile("s_waitcnt vmcnt(0)" ::: "memory");
    __syncthreads();
    if (threadIdx.x == 0) {
        unsigned* bar = b.bar;
        __builtin_amdgcn_s_waitcnt(0);
        unsigned nloc = b.st[0], nx = b.st[1];
        if (nloc == 0u) { xcd_barrier_complete(bar, b.x, nloc, nx); b.st[0] = nloc; b.st[1] = nx; }
        const unsigned old = xb_add(&bar[XB_XSUB(b.x)], 1u);
        const unsigned gen = old / nloc;
        if (old + 1u == (gen + 1u) * nloc) {
            __builtin_amdgcn_fence(__ATOMIC_RELEASE, "agent");
            asm volatile("s_waitcnt vmcnt(0)" ::: "memory");
            const unsigned og = xb_add(&bar[XB_TOP], 1u);
            const unsigned tg = og / nx;
            if (og + 1u == (tg + 1u) * nx) xb_add(&bar[XB_TOPGEN], 1u);
            else XB_SPIN(xb_ld(&bar[XB_TOPGEN]) == tg, bar);
            __builtin_amdgcn_fence(__ATOMIC_ACQUIRE, "agent");
            xb_add(&bar[XB_XGEN(b.x)], 1u);
            asm volatile("s_waitcnt vmcnt(0)" ::: "memory");
        } else {
            XB_SPIN(xb_ld(&bar[XB_XGEN(b.x)]) == gen, bar);
            __builtin_amdgcn_fence(__ATOMIC_ACQUIRE, "agent");
            asm volatile("s_waitcnt vmcnt(0)" ::: "memory");
        }
    }
    __syncthreads();
}

namespace pg8 {
#define PG8_LAS __attribute__((address_space(3)))
typedef unsigned short bf16_t;
typedef short bf16x8 __attribute__((ext_vector_type(8)));
typedef float f32x4 __attribute__((ext_vector_type(4)));
typedef unsigned u32x4 __attribute__((ext_vector_type(4)));
constexpr int BM = 256, BK = 64, HALF = 128, HTB = HALF * BK * 2  , STAGE_BYTES = 8 * HTB, NXCD = 8, WGM = 8;

__host__ __device__ __forceinline__ int lds_byte(int r, int c) { const int st = (r >> 4) * 2 + (c >> 5), rr = r & 15, cc = c & 31, ob = rr * 64 + cc * 2; return st * 1024 + (ob ^ (((ob >> 9) & 1) << 5)); }
__host__ __device__ __forceinline__ void stage_rc(int b, int& R, int& C) { const int st = b / 1024, sb = b % 1024, swz = sb ^ (((sb >> 9) & 1) << 5); R = (st >> 1) * 16 + swz / 64; C = (st & 1) * 32 + (swz % 64) / 2; }
__host__ __device__ __forceinline__ int perm32(int rho) { const int n = rho >> 4, i = rho & 15; return 8 * (i >> 2) + 4 * n + (i & 3); }

struct Unit { int pm, pn; };
struct Gemm { const bf16_t* A; const bf16_t* Bt; int M, N, K; };

struct StaticOrder {
    int nM, nN, nwg, G, c;
    __host__ __device__ void init(int M, int N, int G_, int c_) { nM = M / BM; nN = N / BM; nwg = nM * nN; G = G_; c = c_; }
    __host__ __device__ bool next(int i, Unit& u) const {
        const long L = (long)i * G + c; if (L >= nwg) return false;
        int wgid = (int)L; { const int q = nwg / NXCD, r = nwg % NXCD, xcd = wgid % NXCD, off = wgid / NXCD; wgid = (xcd < r ? xcd * (q + 1) : r * (q + 1) + (xcd - r) * q) + off; }
        const int nig = WGM * nN, gid = wgid / nig, fm = gid * WGM, gsz = (nM - fm) < WGM ? (nM - fm) : WGM;
        u.pm = fm + ((wgid % nig) % gsz); u.pn = (wgid % nig) / gsz; return true;
    }
    __device__ __forceinline__ void a_ready(const Unit&) const {}
    __device__ __forceinline__ void done(const Unit&) const {}
};
__device__ __forceinline__ unsigned cvt_pk_bf16(float lo, float hi) { unsigned r; asm volatile("v_cvt_pk_bf16_f32 %0, %1, %2" : "=v"(r) : "v"(lo), "v"(hi)); return r; }
typedef float f32x2 __attribute__((ext_vector_type(2)));
template <class Epi, class Sched, bool ALIGN_EPI = false, bool SP2 = false>
__device__ __forceinline__ void gemm_phase(PG8_LAS unsigned char* lds, const Gemm g, const Sched& S, const Epi& E) {
    const int tid = threadIdx.x, wid = __builtin_amdgcn_readfirstlane(tid >> 6), lane = tid & 63, wr = wid >> 2, wc = wid & 3, fr = lane & 15, fq = lane >> 4;
    const int K = g.K, nt = K / BK;
    unsigned voffA[2], voffB[2];
#pragma unroll
    for (int i = 0; i < 2; ++i) { int R, C; stage_rc(tid * 16 + i * 8192, R, C); const int Rb = Epi::PERM ? ((R & ~31) + perm32(R & 31)) : R;
        voffA[i] = (unsigned)(R * K + C) * 2u; voffB[i] = (unsigned)(Rb * K + C) * 2u; }
    const size_t kstep = (size_t)(BK * 2);
    const size_t hstep = (size_t)HALF * K * 2;
    const size_t tstep = 2 * hstep;
    const unsigned ldsw = (unsigned)wid * 1024u;
    const int aoff = lds_byte(wr * 64 + fr, fq * 8), boff = lds_byte(wc * 32 + fr, fq * 8);
#define PG8_SA(b, h) (((b) * 2 + (h)) * HTB)
#define PG8_SB(b, h) ((4 + (b) * 2 + (h)) * HTB)
#define PG8_STAGE(bufoff, gbase, voff) do { _Pragma("unroll") for (int _i = 0; _i < 2; ++_i) \
        __builtin_amdgcn_global_load_lds((const unsigned*)((const char*)(gbase) + (voff)[_i]), (PG8_LAS unsigned*)(lds + (bufoff) + ldsw + _i * 8192), 16, 0, 0); } while (0)
#define PG8_LDA(dst, b, h) do { _Pragma("unroll") for (int m = 0; m < 4; ++m) _Pragma("unroll") for (int k = 0; k < 2; ++k) dst[m][k] = *(const PG8_LAS bf16x8*)(lds + PG8_SA(b, h) + aoff + m * 2048 + k * 1024); } while (0)
#define PG8_LDB(dst, b, h) do { _Pragma("unroll") for (int n = 0; n < 2; ++n) _Pragma("unroll") for (int k = 0; k < 2; ++k) dst[n][k] = *(const PG8_LAS bf16x8*)(lds + PG8_SB(b, h) + boff + n * 2048 + k * 1024); } while (0)
#define PG8_MMA(ai, bj, At, Bt) do { __builtin_amdgcn_s_setprio(1); _Pragma("unroll") for (int m = 0; m < 4; ++m) _Pragma("unroll") for (int n = 0; n < 2; ++n) _Pragma("unroll") for (int k = 0; k < 2; ++k) \
        acc[ai][bj][m][n] = __builtin_amdgcn_mfma_f32_16x16x32_bf16(Bt[n][k], At[m][k], acc[ai][bj][m][n], 0, 0, 0); __builtin_amdgcn_s_setprio(0); } while (0)
#define PG8_WAIT_V(n) asm volatile("s_waitcnt vmcnt(" #n ")" ::: "memory")
#define PG8_WAIT_L(n) asm volatile("s_waitcnt lgkmcnt(" #n ")" ::: "memory")
#define PG8_BAR __builtin_amdgcn_s_barrier()
#define PG8_SCHED __builtin_amdgcn_sched_barrier(0)
    Unit cur, nxt; int ui = 0;
    if (!S.next(0, cur)) return;
    f32x4 acc[2][2][4][2];
#pragma unroll
    for (int a = 0; a < 2; ++a)
#pragma unroll
        for (int b = 0; b < 2; ++b)
#pragma unroll
            for (int m = 0; m < 4; ++m)
#pragma unroll
                for (int n = 0; n < 2; ++n) acc[a][b][m][n] = (f32x4){0.f, 0.f, 0.f, 0.f};
    bf16x8 At[4][2], B0[2][2], B1[2][2];
    const char* cA = (const char*)g.A + (size_t)cur.pm * tstep; const char* cB = (const char*)g.Bt + (size_t)cur.pn * tstep;
    S.a_ready(cur);
    if constexpr (SP2) {
        PG8_STAGE(PG8_SB(0, 0), cB, voffB); PG8_STAGE(PG8_SB(0, 1), cB + hstep, voffB); PG8_STAGE(PG8_SA(0, 0), cA, voffA); PG8_STAGE(PG8_SA(0, 1), cA + hstep, voffA);
        if (wr == 1) PG8_BAR;
        PG8_WAIT_V(2); PG8_BAR;
        PG8_STAGE(PG8_SB(1, 0), cB + kstep, voffB); PG8_STAGE(PG8_SA(1, 0), cA + kstep, voffA); PG8_STAGE(PG8_SB(1, 1), cB + hstep + kstep, voffB);
        PG8_WAIT_V(6); PG8_BAR;
    } else {
        PG8_STAGE(PG8_SB(0, 0), cB, voffB); PG8_STAGE(PG8_SA(0, 0), cA, voffA); PG8_STAGE(PG8_SB(0, 1), cB + hstep, voffB); PG8_STAGE(PG8_SA(0, 1), cA + hstep, voffA);
        if (wr == 1) PG8_BAR;
        PG8_WAIT_V(4); PG8_BAR;
        PG8_STAGE(PG8_SB(1, 0), cB + kstep, voffB); PG8_STAGE(PG8_SA(1, 0), cA + kstep, voffA); PG8_STAGE(PG8_SB(1, 1), cB + hstep + kstep, voffB);
        PG8_WAIT_V(6); PG8_BAR;
    }
    for (;;) {
        const bool has_next = S.next(ui + 1, nxt);
        const char* nA = has_next ? (const char*)g.A + (size_t)nxt.pm * tstep : cA; const char* nB = has_next ? (const char*)g.Bt + (size_t)nxt.pn * tstep : cB;
        for (int t = 0; t < nt; t += 2) {
            const bool last = (t == nt - 2);
            const char* a1 = cA + (size_t)(t + 1) * kstep;
            const char* a2 = last ? nA : cA + (size_t)(t + 2) * kstep; const char* b2 = last ? nB : cB + (size_t)(t + 2) * kstep;
            const char* a3 = a2 + kstep; const char* b3 = b2 + kstep;
            if (last && has_next) S.a_ready(nxt);
            if constexpr (Epi::MIDK) { if (t == nt / 2) E.mid(acc, cur, wr, wc, fr, fq); }
            if constexpr (SP2) {
            PG8_LDB(B0, 0, 0); PG8_LDB(B1, 0, 1); PG8_SCHED; PG8_LDA(At, 0, 0); PG8_STAGE(PG8_SA(1, 1), a1 + hstep, voffA);
            PG8_WAIT_V(8); PG8_WAIT_L(0); PG8_BAR; PG8_MMA(0, 0, At, B0); PG8_MMA(0, 1, At, B1); PG8_BAR; PG8_SCHED;
            PG8_LDA(At, 0, 1); PG8_STAGE(PG8_SB(0, 0), b2, voffB); PG8_STAGE(PG8_SB(0, 1), b2 + hstep, voffB); PG8_STAGE(PG8_SA(0, 0), a2, voffA);
            PG8_WAIT_V(8); PG8_WAIT_L(0); PG8_BAR; PG8_MMA(1, 0, At, B0); PG8_MMA(1, 1, At, B1); PG8_BAR; PG8_SCHED;
            PG8_LDB(B0, 1, 0); PG8_LDB(B1, 1, 1); PG8_SCHED; PG8_LDA(At, 1, 0); PG8_STAGE(PG8_SA(0, 1), a2 + hstep, voffA);
            PG8_WAIT_V(8); PG8_WAIT_L(0); PG8_BAR; PG8_MMA(0, 0, At, B0); PG8_MMA(0, 1, At, B1); PG8_BAR; PG8_SCHED;
            PG8_LDA(At, 1, 1); PG8_STAGE(PG8_SB(1, 0), b3, voffB); PG8_STAGE(PG8_SB(1, 1), b3 + hstep, voffB); PG8_STAGE(PG8_SA(1, 0), a3, voffA);
            PG8_WAIT_V(8); PG8_WAIT_L(0); PG8_BAR; PG8_MMA(1, 0, At, B0); PG8_MMA(1, 1, At, B1); PG8_BAR; PG8_SCHED;
            } else {
            PG8_LDB(B0, 0, 0); PG8_SCHED; PG8_LDA(At, 0, 0); PG8_STAGE(PG8_SA(1, 1), a1 + hstep, voffA);
            PG8_WAIT_L(8); PG8_BAR; PG8_WAIT_L(0); PG8_MMA(0, 0, At, B0); PG8_BAR; PG8_SCHED;
            PG8_LDB(B1, 0, 1); PG8_STAGE(PG8_SB(0, 0), b2, voffB);
            PG8_BAR; PG8_WAIT_L(0); PG8_MMA(0, 1, At, B1); PG8_BAR;
            PG8_LDA(At, 0, 1); PG8_STAGE(PG8_SA(0, 0), a2, voffA);
            PG8_BAR; PG8_WAIT_L(0); PG8_MMA(1, 0, At, B0); PG8_BAR; PG8_SCHED;
            PG8_STAGE(PG8_SB(0, 1), b2 + hstep, voffB);
            PG8_WAIT_V(6); PG8_BAR; PG8_MMA(1, 1, At, B1); PG8_BAR;
            PG8_LDB(B0, 1, 0); PG8_SCHED; PG8_LDA(At, 1, 0); PG8_STAGE(PG8_SA(0, 1), a2 + hstep, voffA);
            PG8_WAIT_L(8); PG8_BAR; PG8_WAIT_L(0); PG8_MMA(0, 0, At, B0); PG8_BAR; PG8_SCHED;
            PG8_LDB(B1, 1, 1); PG8_STAGE(PG8_SB(1, 0), b3, voffB);
            PG8_BAR; PG8_WAIT_L(0); PG8_MMA(0, 1, At, B1); PG8_BAR;
            PG8_LDA(At, 1, 1); PG8_STAGE(PG8_SA(1, 0), a3, voffA);
            PG8_BAR; PG8_WAIT_L(0); PG8_MMA(1, 0, At, B0); PG8_BAR; PG8_SCHED;
            PG8_STAGE(PG8_SB(1, 1), b3 + hstep, voffB);
            PG8_WAIT_V(6); PG8_BAR; PG8_MMA(1, 1, At, B1); PG8_BAR;
            }
        }
        if constexpr (ALIGN_EPI) { if (wr == 0) PG8_BAR; }
        if constexpr (!Epi::AFTER_DRAIN) { E(acc, cur, wr, wc, fr, fq); S.done(cur); }
        if (!has_next) break;
#pragma unroll
        for (int a = 0; a < 2; ++a)
#pragma unroll
            for (int b = 0; b < 2; ++b)
#pragma unroll
                for (int m = 0; m < 4; ++m)
#pragma unroll
                    for (int n = 0; n < 2; ++n) acc[a][b][m][n] = (f32x4){0.f, 0.f, 0.f, 0.f};
        cur = nxt; cA = nA; cB = nB; ++ui;
        if constexpr (ALIGN_EPI) { if (wr == 1) PG8_BAR; }
    }
    PG8_WAIT_V(0);
    if constexpr (!ALIGN_EPI) { if (wr == 0) PG8_BAR; }
    PG8_BAR;
    if constexpr (Epi::AFTER_DRAIN) { E.fused(acc, cur, wr, wc, fr, fq, lds, wid, lane); S.done(cur); }
#undef PG8_SA
#undef PG8_SB
#undef PG8_STAGE
#undef PG8_LDA
#undef PG8_LDB
#undef PG8_MMA
#undef PG8_WAIT_V
#undef PG8_WAIT_L
#undef PG8_BAR
#undef PG8_SCHED
}
}

namespace at2 {
constexpr float SCALE = 0.08838834764831845f;
constexpr float THR = 8.f;
constexpr int NW = 8, QBLK = 32, KVBLK = 64, QB = NW * QBLK, D = 128, PITCH = 1024;
constexpr int SHM_V = KVBLK * D * 2, SHM_K = KVBLK * D * 2;
constexpr int BT_OFF = 2 * SHM_V + 2 * SHM_K + NW * 64 * 4;
constexpr int LDS_BYTES = BT_OFF + 320 * 4;
typedef short bf16x8 __attribute__((ext_vector_type(8)));
typedef short s16x4 __attribute__((ext_vector_type(4)));
typedef float f32x16 __attribute__((ext_vector_type(16)));
typedef float f32x4 __attribute__((ext_vector_type(4)));
typedef unsigned u32x4 __attribute__((ext_vector_type(4)));
typedef unsigned short bf16;

#define KSWZ(row, colB) ((row) * 256 + ((colB) ^ (((row) & 7) << 4)))
#define SBAR() __builtin_amdgcn_sched_barrier(0)
__device__ __forceinline__ int v_st(int k, int c) { const int kk = (k & ~0xC) | ((k & 4) << 1) | ((k & 8) >> 1); return ((kk >> 3) * 4 + (c >> 5)) * 512 + ((kk & 7) * 32 + (c & 31)) * 2; }
__device__ __forceinline__ int v_rd_base(int lane) { return ((lane & 3) << 3) | (((lane >> 2) & 3) << 6) | (((lane >> 4) & 1) << 5) | (((lane >> 5) & 1) << 8); }
constexpr int v_rd_off(int d0, int ks, int half) { return d0 * 512 + ks * 4096 + half * 2048; }
__device__ __forceinline__ int crow(int r, int hi) { return (r & 3) + 8 * (r >> 2) + 4 * hi; }
__device__ __forceinline__ unsigned cvtpk(float lo, float hi) { unsigned r; asm volatile("v_cvt_pk_bf16_f32 %0, %1, %2" : "=v"(r) : "v"(lo), "v"(hi)); return r; }
__device__ __forceinline__ bf16x8 load8(const bf16* p) { return *reinterpret_cast<const bf16x8*>(p); }

typedef __attribute__((address_space(3))) const float* lds_cf32;
__device__ __forceinline__ unsigned mask_compact(unsigned long long mw, int hi) { return ((unsigned)(mw >> (4 * hi)) & 0x0f0f0f0fu) | (((unsigned)(mw >> (32 + 4 * hi)) & 0x0f0f0f0fu) << 4); }
__device__ __forceinline__ void mask_bias(f32x16& p0, f32x16& p1, unsigned mwc, lds_cf32 bt, int idx0, bool far, float cfar, int hi) {
    const float NEG = -__builtin_inff();
    const unsigned w0 = mwc, w1 = mwc >> 4;
    if (far) {
#pragma unroll
        for (int r = 0; r < 16; ++r) { const int c = (r & 3) + 8 * (r >> 2);
            p0[r] = ((w0 >> c) & 1u) ? p0[r] + cfar : NEG; p1[r] = ((w1 >> c) & 1u) ? p1[r] + cfar : NEG; }
    } else { lds_cf32 b = bt + idx0;
#pragma unroll
        for (int r = 0; r < 16; ++r) { const int c = (r & 3) + 8 * (r >> 2);
            p0[r] = ((w0 >> c) & 1u) ? p0[r] + b[c] : NEG; p1[r] = ((w1 >> c) & 1u) ? p1[r] + b[c + 32] : NEG;
            if ((r & 3) == 3) asm volatile("" ::: "memory"); }
    }
}
__device__ __forceinline__ void partialSM(f32x16& p0, f32x16& p1, float& m_reg, float& mn, float& alpha) {
    float pmax = p0[0]; for (int r = 1; r < 16; ++r) pmax = fmaxf(pmax, p0[r]); for (int r = 0; r < 16; ++r) pmax = fmaxf(pmax, p1[r]);
    { auto rr = __builtin_amdgcn_permlane32_swap(__float_as_uint(pmax), __float_as_uint(pmax), false, false);
      pmax = fmaxf(__uint_as_float(rr[0]), __uint_as_float(rr[1])); }
    constexpr float C2 = 1.4426950408889634f * SCALE;
    if (__builtin_expect(__all((pmax - m_reg) * SCALE <= THR), 1)) { mn = m_reg; alpha = 1.f; }
    else { mn = fmaxf(m_reg, pmax); alpha = __builtin_amdgcn_exp2f((m_reg - mn) * C2); m_reg = mn; }
    const float mnL = -mn * C2;
    for (int r = 0; r < 16; ++r) p0[r] = fmaf(p0[r], C2, mnL); for (int r = 0; r < 16; ++r) p1[r] = fmaf(p1[r], C2, mnL);
    for (int r = 0; r < 16; ++r) p0[r] = __builtin_amdgcn_exp2f(p0[r]);
}
__device__ __forceinline__ void finishSM(f32x16& p0, f32x16& p1, float alpha, float& l_reg, bf16x8& pa0, bf16x8& pa1, bf16x8& pa2, bf16x8& pa3) {
    for (int r = 0; r < 16; ++r) p1[r] = __builtin_amdgcn_exp2f(p1[r]);
    float ps = 0; for (int r = 0; r < 16; ++r) ps += p0[r]; for (int r = 0; r < 16; ++r) ps += p1[r];
    { auto rr = __builtin_amdgcn_permlane32_swap(__float_as_uint(ps), __float_as_uint(ps), false, false);
      ps = __uint_as_float(rr[0]) + __uint_as_float(rr[1]); }
    l_reg = l_reg * alpha + ps;
#define PK4(P, B_, OUT) do { unsigned a0 = cvtpk(P[B_+0], P[B_+1]), a1 = cvtpk(P[B_+2], P[B_+3]);                          \
        unsigned b0 = cvtpk(P[B_+4], P[B_+5]), b1 = cvtpk(P[B_+6], P[B_+7]);                                             \
        auto r0 = __builtin_amdgcn_permlane32_swap(a0, b0, false, false); auto r1 = __builtin_amdgcn_permlane32_swap(a1, b1, false, false); \
        u32x4 w = {r0[0], r1[0], r0[1], r1[1]}; OUT = *reinterpret_cast<bf16x8*>(&w); } while (0)
    PK4(p0, 0, pa0); PK4(p0, 8, pa1); PK4(p1, 0, pa2); PK4(p1, 8, pa3);
#undef PK4
}
template <int KB, bool SK>
__device__ __forceinline__ void qkt(f32x16& p0, f32x16& p1, const char* K_lds, int r32, int hi, const bf16x8* qr, bool act) {
    if (SK && !act) { const float NEG = -__builtin_inff();
#pragma unroll
        for (int r = 0; r < 16; ++r) { p0[r] = NEG; p1[r] = NEG; } return; }
    p0 = f32x16{}; p1 = f32x16{};
    const char* kb[4];
#pragma unroll
    for (int dd = 0; dd < 4; ++dd) kb[dd] = K_lds + KB * SHM_K + KSWZ(r32, (dd * 16 + hi * 8) * 2);
#pragma unroll
    for (int d0 = 0; d0 < 8; ++d0) { const char* a = kb[d0 & 3] + (d0 >> 2) * 128;
        bf16x8 b0 = *reinterpret_cast<const bf16x8*>(a);
        bf16x8 b1 = *reinterpret_cast<const bf16x8*>(a + 32 * 256);
        p0 = __builtin_amdgcn_mfma_f32_32x32x16_bf16(b0, qr[d0], p0, 0, 0, 0);
        p1 = __builtin_amdgcn_mfma_f32_32x32x16_bf16(b1, qr[d0], p1, 0, 0, 0); }
}
template <int VB, bool SK>
__device__ __forceinline__ void pv_tile(f32x16* o, int vb0, bf16x8 pa0, bf16x8 pa1, bf16x8 pa2, bf16x8 pa3, bool act) {
    if (SK && !act) return;
#define TRRD(dst, off) asm volatile("ds_read_b64_tr_b16 %0, %1 offset:%2" : "=&v"(dst) : "v"(vb0), "i"(off) : "memory")
#define PV_D0(d0) do { s16x4 l0, l1, l2, l3, h0, h1, h2, h3; constexpr int b_ = VB * SHM_V + v_rd_off(d0, 0, 0); \
        TRRD(l0, b_); TRRD(h0, b_ + 2048); TRRD(l1, b_ + 4096); TRRD(h1, b_ + 6144); TRRD(l2, b_ + 8192); TRRD(h2, b_ + 10240); TRRD(l3, b_ + 12288); TRRD(h3, b_ + 14336); \
        asm volatile("s_waitcnt lgkmcnt(0)" ::: "memory"); SBAR();   \
        o[d0] = __builtin_amdgcn_mfma_f32_32x32x16_bf16(pa0, (bf16x8){l0[0], l0[1], l0[2], l0[3], h0[0], h0[1], h0[2], h0[3]}, o[d0], 0, 0, 0);   \
        o[d0] = __builtin_amdgcn_mfma_f32_32x32x16_bf16(pa1, (bf16x8){l1[0], l1[1], l1[2], l1[3], h1[0], h1[1], h1[2], h1[3]}, o[d0], 0, 0, 0);   \
        o[d0] = __builtin_amdgcn_mfma_f32_32x32x16_bf16(pa2, (bf16x8){l2[0], l2[1], l2[2], l2[3], h2[0], h2[1], h2[2], h2[3]}, o[d0], 0, 0, 0);   \
        o[d0] = __builtin_amdgcn_mfma_f32_32x32x16_bf16(pa3, (bf16x8){l3[0], l3[1], l3[2], l3[3], h3[0], h3[1], h3[2], h3[3]}, o[d0], 0, 0, 0); } while (0)
    PV_D0(0); PV_D0(1); PV_D0(2); PV_D0(3);
#undef PV_D0
#undef TRRD
}

struct Ctx { __amdgpu_buffer_rsrc_t Q, K, V, M; };
typedef unsigned v4u32 __attribute__((ext_vector_type(4))); typedef unsigned v2u32 __attribute__((ext_vector_type(2)));
#define LD16(rs, vo, so) __builtin_bit_cast(bf16x8, __builtin_amdgcn_raw_buffer_load_b128((rs), (int)(vo), (int)(so), 0))
struct Seam { bf16x8 qr[8]; bf16x8 st_v0, st_v1, st_k0, st_k1; };
#define VMW() asm volatile("s_waitcnt vmcnt(0)" ::: "memory")
#define VMWN(n) asm volatile("s_waitcnt vmcnt(%0)" :: "i"(n) : "memory")
#define SLOAD_H(k0) do { S.st_v0 = LD16(C.V, kvoff, (k0) * (PITCH * 2)); S.st_v1 = LD16(C.V, kvoff, ((k0) + 32) * (PITCH * 2));              \
                         S.st_k0 = LD16(C.K, kvoff, (k0) * (PITCH * 2)); S.st_k1 = LD16(C.K, kvoff, ((k0) + 32) * (PITCH * 2)); } while (0)
#define SWRITE_HK(bf) do { *(bf16x8*)(K_lds + (bf) * SHM_K + kws) = S.st_k0; *(bf16x8*)(K_lds + (bf) * SHM_K + kws + 32 * 256) = S.st_k1; } while (0)
#define SWRITE_HV(bf) do { *(bf16x8*)(V_lds + (bf) * SHM_V + vst0) = S.st_v0; *(bf16x8*)(V_lds + (bf) * SHM_V + vst1) = S.st_v1; } while (0)
#define SWRITE_H(bf) do { SWRITE_HV(bf); SWRITE_HK(bf); } while (0)
__device__ __forceinline__ void dsa_prime(const Ctx& C, int P0, char* lds, Seam& S) {
    int tid = threadIdx.x; asm volatile("" : "+v"(tid));
    const int wid = __builtin_amdgcn_readfirstlane(tid >> 6), lane = tid & 63, r32 = lane & 31, hi = lane >> 5;
    const int sr = tid >> 4, sc = (tid & 15) * 8, kws = KSWZ(sr, sc * 2); char* K_lds = lds + 2 * SHM_V;
    const unsigned kvoff = (unsigned)(sr * PITCH + sc) * 2u, qoff = (unsigned)((wid * QBLK + r32) * PITCH + hi * 8) * 2u;
    for (int d0 = 0; d0 < 8; ++d0) S.qr[d0] = LD16(C.Q, qoff + d0 * 32, P0 * (PITCH * 2));
    SLOAD_H(0); VMW(); SWRITE_HK(0);
    __syncthreads();
}
__device__ __forceinline__ void dsa_block(const Ctx& C, int P0, int P0n, char* lds, Seam& S, float cfar) {
    int tid = threadIdx.x; asm volatile("" : "+v"(tid));
    const int wid = __builtin_amdgcn_readfirstlane(tid >> 6), lane = tid & 63, r32 = lane & 31, hi = lane >> 5;
    const int NT = P0 / KVBLK + QB / KVBLK;
    const int qlo = P0 + wid * QBLK;
    const int limw = ((qlo >> 6) + 1) * 64;
    char* V_lds = lds; char* K_lds = lds + 2 * SHM_V;
    float* wsc = (float*)(lds + 2 * SHM_V + 2 * SHM_K) + wid * 64; float* li_l = wsc, * al_l = wsc + 32;
    lds_cf32 bt = (lds_cf32)((__attribute__((address_space(3))) char*)lds + BT_OFF);
    float m_reg = -1e30f, l_reg = 0; f32x16 o[4] = {};
    const int sr = tid >> 4, sc = (tid & 15) * 8, vst0 = v_st(sr, sc), vst1 = v_st(32 + sr, sc), kws = KSWZ(sr, sc * 2);
    const int vb0 = (int)(uintptr_t)V_lds + v_rd_base(lane);
    const unsigned kvoff = (unsigned)(sr * PITCH + sc) * 2u, qoff = (unsigned)((wid * QBLK + r32) * PITCH + hi * 8) * 2u, moff = (unsigned)((wid * QBLK + r32) * 32) * 8u;
#define MROW(t) mask_compact(__builtin_bit_cast(unsigned long long, __builtin_amdgcn_raw_buffer_load_b64(C.M, (int)moff, (P0 * 32 + (t)) * 8, 0)), hi)
    const int rel0 = 256 + 4 * hi - (qlo + r32);
#define RESC(a) do { if (__any((a) < 1.f)) { if (hi == 0) al_l[r32] = (a); asm volatile("s_waitcnt lgkmcnt(0)" ::: "memory");              \
                     for (int d_ = 0; d_ < 4; ++d_) for (int r = 0; r < 16; ++r) o[d_][r] *= al_l[crow(r, hi)]; } } while (0)
#define KBASE(t) ((t) * KVBLK)
#define ACT(t) (KBASE(t) < limw)
#define MASKT(P0_, P1_, mw_, t) do { const int kb_ = KBASE(t); if (ACT(t)) mask_bias(P0_, P1_, mw_, bt, kb_ + rel0, kb_ + KVBLK - 1 - qlo <= -128, cfar, hi); } while (0)
    constexpr int NQL = 8; constexpr bool SK = true;
#define SEAM_K0() do { VMWN(NQL); SWRITE_HK(0); SBAR(); } while (0)
    f32x16 pA0, pA1, pB0, pB1; float mnA, mnB, alA, alB; bf16x8 pa0, pa1, pa2, pa3; unsigned mw;
    SWRITE_HV(0); SBAR();
    if (NT > 1) SLOAD_H(KBASE(1));
    mw = MROW(0);
    SBAR(); qkt<0, SK>(pA0, pA1, K_lds, r32, hi, S.qr, ACT(0));
    MASKT(pA0, pA1, mw, 0); partialSM(pA0, pA1, m_reg, mnA, alA);
    if (NT > 1) { VMW(); SWRITE_H(1); }
    __syncthreads();
#define HALF_STEP(PX0, PX1, mnX, alX, PY0, PY1, alY, t, KB, VB, SB) do {                                                      \
        SBAR(); mw = MROW(t); qkt<KB, SK>(PX0, PX1, K_lds, r32, hi, S.qr, ACT(t));                                          \
        finishSM(PY0, PY1, alY, l_reg, pa0, pa1, pa2, pa3); SBAR();                                                           \
        if ((t) + 1 < NT) { SLOAD_H(KBASE((t) + 1)); SBAR(); }                                                        \
        pv_tile<VB, SK>(o, vb0, pa0, pa1, pa2, pa3, ACT((t) - 1)); MASKT(PX0, PX1, mw, (t)); partialSM(PX0, PX1, m_reg, mnX, alX); \
        __syncthreads();                                                                                                      \
        if ((t) + 1 < NT) { VMW(); SWRITE_H(SB); }                                                                            \
        RESC(alX); __syncthreads(); } while (0)
    for (int t = 1; t + 1 < NT; t += 2) {
        HALF_STEP(pB0, pB1, mnB, alB, pA0, pA1, alA, t, 1, 0, 0);
        HALF_STEP(pA0, pA1, mnA, alA, pB0, pB1, alB, t + 1, 0, 1, 1);
    }
    const bool even = (NT & 1) == 0;
    if (even) { SBAR(); mw = MROW(NT - 1); qkt<1, SK>(pB0, pB1, K_lds, r32, hi, S.qr, ACT(NT - 1)); SBAR(); }
    SLOAD_H(0); SBAR();
#pragma unroll
    for (int d0 = 0; d0 < 8; ++d0) S.qr[d0] = LD16(C.Q, qoff + d0 * 32, P0n * (PITCH * 2));
    SBAR();
    finishSM(pA0, pA1, alA, l_reg, pa0, pa1, pa2, pa3); SBAR();
    pv_tile<0, SK>(o, vb0, pa0, pa1, pa2, pa3, ACT(even ? NT - 2 : NT - 1));
    if (even) { MASKT(pB0, pB1, mw, NT - 1); partialSM(pB0, pB1, m_reg, mnB, alB); __syncthreads(); RESC(alB);
        finishSM(pB0, pB1, alB, l_reg, pa0, pa1, pa2, pa3); SBAR(); pv_tile<1, SK>(o, vb0, pa0, pa1, pa2, pa3, ACT(NT - 1)); }
    SBAR(); SEAM_K0();
    if (hi == 0) li_l[r32] = l_reg; asm volatile("s_waitcnt lgkmcnt(0)" ::: "memory");
    float rli[16];
#pragma unroll
    for (int r = 0; r < 16; ++r) rli[r] = __builtin_amdgcn_rcpf(li_l[crow(r, hi)]);
    const unsigned ooff = (unsigned)((wid * QBLK + 4 * hi) * PITCH + r32) * 2u;
#pragma unroll
    for (int r = 0; r < 16; ++r) { const int so = (P0 + (r & 3) + 8 * (r >> 2)) * (PITCH * 2);
#pragma unroll
        for (int d0 = 0; d0 < 4; ++d0) { const float v = o[d0][r] * rli[r];
            const float vn = __shfl_xor(v, 1);
            if ((r32 & 1) == 0) __builtin_amdgcn_raw_buffer_store_b32(cvtpk(v, vn), C.Q, (int)(ooff + d0 * 64), so, 0); } }
    __syncthreads();
#undef RESC
#undef MROW
#undef KBASE
#undef ACT
#undef MASKT
#undef SEAM_K0
#undef HALF_STEP
}
#undef VMW
#undef VMWN
#undef SLOAD_H
#undef SWRITE_HK
#undef SWRITE_HV
#undef SWRITE_H
#undef KSWZ
#undef SBAR
}

constexpr int NWAVES = 8;
constexpr int NTP = BATCH * SEQ, NTS = DEC_BATCH * DEC_SEQ, NTOK = NTP + NTS;
constexpr int NPM = NTOK / 256;
constexpr int N_MIX = 27 * 256, N_M1A = 12 * 256, N_M1B = 8 * 256;
static_assert(NTP % 256 == 0 && NTS % 256 == 0 && D_MODEL == 1024 && A_WIDTH == 1024 && B_WIDTH == 1024, "geometry");

constexpr size_t MiB = 1u << 20;
constexpr size_t WS_CTL = 0, CTL_ZERO_BYTES = 1 * MiB;
constexpr size_t WS_WMIX = 1 * MiB;
constexpr size_t WS_WMRG = WS_WMIX + 14 * MiB;
constexpr size_t WS_WAB  = WS_WMRG + 10 * MiB;
constexpr size_t WS_WO   = WS_WAB + 4 * MiB;
constexpr size_t WS_XB   = WS_WO + 2 * MiB;
constexpr size_t ROWBUF  = (size_t)NTOK * 1024 * 2;
constexpr size_t WS_QA   = WS_XB + ROWBUF;
constexpr size_t WS_KA   = WS_QA + ROWBUF;
constexpr size_t WS_VA   = WS_KA + ROWBUF;
constexpr size_t WS_QB   = WS_VA + ROWBUF;
constexpr size_t WS_QI   = WS_QB + ROWBUF;
constexpr size_t WS_KI   = WS_QI + 65 * MiB;
constexpr size_t WS_SM   = WS_KI + 9 * MiB;
constexpr size_t WS_MASK = WS_SM + 5 * MiB;
constexpr size_t WS_HST  = WS_MASK + 16 * MiB;
constexpr size_t WS_NAIVE = WS_HST + 3 * MiB;
constexpr size_t WS_NEED = WS_NAIVE;
static_assert(WS_WMIX + (size_t)N_MIX * 1024 * 2 <= WS_WMRG && WS_QI + (size_t)NTOK * 512 * 2 <= WS_KI && WS_KI + (size_t)NTOK * 64 * 2 <= WS_SM && WS_SM + (size_t)NTOK * 64 <= WS_MASK
              && WS_HST + (size_t)NTOK * 32 <= WS_NAIVE, "d_ws map");
constexpr int CW_BAR = 4096;
constexpr int RING_OFF = 0, RING_BYTES = 131072;
constexpr int LDSCTL_OFF = RING_BYTES, MISC_OFF = LDSCTL_OFF + 320;
constexpr int LDS_BYTES = 147456;

struct Args { const float* in[17]; float* out; unsigned char* ws; int ph_lo, ph_hi; };

__device__ __forceinline__ float bf2f(bf16 v) { return __uint_as_float((unsigned)v << 16); }
__device__ __forceinline__ float sigm(float x) { return 1.0f / (1.0f + __expf(-x)); }

__device__ __forceinline__ void tr_item(const float* W, int ldw, int c0, int nv, int k0, bf16* WT, int ldt, int r0, int kofs, LAS float* scr, int lane) {
    const int n_ = lane & 31;
#pragma unroll 8
    for (int i = 0; i < 32; ++i) { const int kk = 2 * i + (lane >> 5); scr[kk * 33 + n_] = (n_ < nv) ? W[(size_t)(k0 + kk) * ldw + c0 + n_] : 0.f; }
    LDS_WAIT(); asm volatile("" ::: "memory");
    const int c = lane & 7;
#pragma unroll
    for (int j = 0; j < 4; ++j) { const int n = (lane >> 3) + 8 * j; const LAS float* s = scr + (8 * c) * 33 + n;
        v4u o; o.x = pk2(s[0 * 33], s[1 * 33]); o.y = pk2(s[2 * 33], s[3 * 33]); o.z = pk2(s[4 * 33], s[5 * 33]); o.w = pk2(s[6 * 33], s[7 * 33]);
        if (n < nv) *(GAS v4u*)(WT + (size_t)(r0 + n) * ldt + kofs + k0 + 8 * c) = o; }
    LDS_WAIT(); asm volatile("" ::: "memory");
}
struct Seg { int src, n, dst; };
__device__ __forceinline__ Seg win_seg(int s) {
    switch (s) {
        case 0: return Seg{C_QA, 1024, 0};      case 1: return Seg{C_KA, 1024, 1024};  case 2: return Seg{C_VA, 1024, 2048};
        case 3: return Seg{C_QB, 1024, 3072};   case 4: return Seg{C_KB, 1024, 4096};  case 5: return Seg{C_VB, 1024, 5120};
        case 6: return Seg{C_QI, 512, 6144};    case 7: return Seg{C_KI, 64, 6656};    case 8: return Seg{C_WI, 8, 6720};
        case 9: return Seg{C_IA, 4, 6728};      case 10: return Seg{C_FA, 4, 6732};
        case 27: return Seg{C_ZB, 1024, 2048};  case 28: return Seg{C_GA, 1024, 3072}; case 29: return Seg{C_GB, 1024, 4096};
        default: { const int j = (s - 11) >> 1; return (s & 1) ? Seg{C_OA + 128 * j, 128, 256 * j} : Seg{C_ZA + 128 * j, 128, 256 * j + 128}; }
    }
}
struct P0Args { const float *xp, *xs, *w_in, *w_out_a, *w_out_b, *w_o; bf16 *XB, *WMIX, *WMRG, *WAB, *WO; };
__device__ __forceinline__ void p0_prologue(const P0Args& a, LAS unsigned char* lds, int vcu, int G, int wave, int lane) {
    LAS float* scr = (LAS float*)(lds + RING_OFF + wave * 16384);
    const int gw = vcu * NWAVES + wave, NGW = G * NWAVES;
    int base = 0;
    for (int s = 0; s < 30; ++s) {
        const Seg sg = win_seg(s); const int nblk = (sg.n + 31) / 32, nit = nblk * 16;
        bf16* WT = s < 11 ? a.WMIX : a.WMRG;
        for (int it = gw - (base % NGW); it < nit; it += NGW) { if (it < 0) continue; const int kb = it / nblk, nb = it % nblk; const int nv = sg.n - 32 * nb < 32 ? sg.n - 32 * nb : 32;
            tr_item(a.w_in, IN_COLS, sg.src + 32 * nb, nv, 64 * kb, WT, 1024, sg.dst + 32 * nb, 0, scr, lane); }
        base += nit;
    }
    for (int i = gw * 64 + lane; i < 176 * 128; i += NGW * 64) ((GAS v4u*)(a.WMIX + (size_t)6736 * 1024))[i] = (v4u){0u, 0u, 0u, 0u};
    for (int it = gw; it < 3 * 512; it += NGW) { const int w = it / 512, r = it % 512, kb = r / 32, nb = r % 32;
        if (w == 0) tr_item(a.w_out_a, 1024, 32 * nb, 32, 64 * kb, a.WAB, 2048, 32 * nb, 0, scr, lane);
        else if (w == 1) tr_item(a.w_out_b, 1024, 32 * nb, 32, 64 * kb, a.WAB, 2048, 32 * nb, 1024, scr, lane);
        else tr_item(a.w_o, 1024, 32 * nb, 32, 64 * kb, a.WO, 1024, 32 * nb, 0, scr, lane); }
    for (int m = gw; m < NTOK; m += NGW) {
        const float* xr = m < NTP ? a.xp + (size_t)m * 1024 : a.xs + (size_t)(m - NTP) * 1024;
        const GAS f32x4* xv = (const GAS f32x4*)xr + lane; GAS unsigned long long* o8 = (GAS unsigned long long*)(a.XB + (size_t)m * 1024) + lane;
#pragma unroll
        for (int j = 0; j < 4; ++j) { const f32x4 v = xv[64 * j]; o8[64 * j] = (unsigned long long)pk2(v.x, v.y) | ((unsigned long long)pk2(v.z, v.w) << 32); }
    }
}

namespace pg8 {
struct EpiMix {
    static constexpr bool PERM = true, AFTER_DRAIN = false, MIDK = false;
    bf16_t* QA4;
    bf16_t* KVc;
    bf16_t *QI, *KI; float* SM;
    float *okvp, *okvs;
    float *oikp, *oiks;
    __device__ __forceinline__ void mid(f32x4 (&)[2][2][4][2], const Unit&, int, int, int, int) const {}
    __device__ __forceinline__ void operator()(const f32x4 (&acc)[2][2][4][2], const Unit& u, int wr, int wc, int fr, int fq) const {
        const int pn = u.pn; const bool samp = u.pm >= NTP / 256;
        const int row0 = u.pm * BM + wr * 64 + fr, cl = wc * 32 + 8 * fq;
        if (pn < 16) {
            bf16_t* base = QA4 + (size_t)(pn >> 2) * ((size_t)NTOK * 1024); const float sc = (pn >= 4 && pn < 8) ? 0.0625f : 1.0f;
            const int col0 = (pn & 3) * 256 + cl;
#pragma unroll
            for (int ai = 0; ai < 2; ++ai)
#pragma unroll
                for (int m = 0; m < 4; ++m) { bf16_t* rowp = base + (size_t)(row0 + ai * HALF + m * 16) * 1024 + col0;
#pragma unroll
                    for (int bj = 0; bj < 2; ++bj) { const f32x4 v0 = acc[ai][bj][m][0] * sc, v1 = acc[ai][bj][m][1] * sc;
                        u32x4 w; w.x = cvt_pk_bf16(v0[0], v0[1]); w.y = cvt_pk_bf16(v0[2], v0[3]); w.z = cvt_pk_bf16(v1[0], v1[1]); w.w = cvt_pk_bf16(v1[2], v1[3]);
                        *(u32x4*)(rowp + bj * HALF) = w; } }
        } else if (pn < 24) {
            const int isV = pn >= 20 ? 1 : 0; const int col0 = (pn & 3) * 256 + cl;
            float* of = samp ? okvs + (size_t)isV * ((size_t)NTS * 1024) : okvp + (size_t)isV * ((size_t)NTP * 1024);
            bf16_t* cb = KVc + (size_t)isV * ((size_t)NTP * 1024);
#pragma unroll
            for (int ai = 0; ai < 2; ++ai)
#pragma unroll
                for (int m = 0; m < 4; ++m) { const int r = row0 + ai * HALF + m * 16; const int rr = samp ? r - NTP : r;
#pragma unroll
                    for (int bj = 0; bj < 2; ++bj) { const f32x4 v0 = acc[ai][bj][m][0], v1 = acc[ai][bj][m][1];
                        float* fp = of + (size_t)rr * 1024 + col0 + bj * HALF; *(f32x4*)fp = v0; *(f32x4*)(fp + 4) = v1;
                        if (!samp) { u32x4 w; w.x = cvt_pk_bf16(v0[0], v0[1]); w.y = cvt_pk_bf16(v0[2], v0[3]); w.z = cvt_pk_bf16(v1[0], v1[1]); w.w = cvt_pk_bf16(v1[2], v1[3]);
                            *(u32x4*)(cb + (size_t)r * 1024 + col0 + bj * HALF) = w; } } }
        } else if (pn < 26) {
            const int col0 = (pn - 24) * 256 + cl;
#pragma unroll
            for (int ai = 0; ai < 2; ++ai)
#pragma unroll
                for (int m = 0; m < 4; ++m) { bf16_t* rowp = QI + (size_t)(row0 + ai * HALF + m * 16) * 512 + col0;
#pragma unroll
                    for (int bj = 0; bj < 2; ++bj) { const f32x4 v0 = acc[ai][bj][m][0] * 0.125f, v1 = acc[ai][bj][m][1] * 0.125f;
                        u32x4 w; w.x = cvt_pk_bf16(v0[0], v0[1]); w.y = cvt_pk_bf16(v0[2], v0[3]); w.z = cvt_pk_bf16(v1[0], v1[1]); w.w = cvt_pk_bf16(v1[2], v1[3]);
                        *(u32x4*)(rowp + bj * HALF) = w; } }
        } else {
            float* oik = samp ? oiks : oikp;
#pragma unroll
            for (int ai = 0; ai < 2; ++ai)
#pragma unroll
                for (int m = 0; m < 4; ++m) { const int r = row0 + ai * HALF + m * 16; const int rr = samp ? r - NTP : r; const f32x4 v0 = acc[ai][0][m][0], v1 = acc[ai][0][m][1];
                    if (wc < 2) { float* fp = oik + (size_t)rr * 64 + cl; *(f32x4*)fp = v0; *(f32x4*)(fp + 4) = v1;
                        u32x4 w; w.x = cvt_pk_bf16(v0[0], v0[1]); w.y = cvt_pk_bf16(v0[2], v0[3]); w.z = cvt_pk_bf16(v1[0], v1[1]); w.w = cvt_pk_bf16(v1[2], v1[3]);
                        *(u32x4*)(KI + (size_t)r * 64 + cl) = w; }
                    else if (wc == 2 && fq < 2) { float* fp = SM + (size_t)r * 16 + 8 * fq; *(f32x4*)fp = v0; *(f32x4*)(fp + 4) = v1; } }
        }
    }
};
}


constexpr size_t WS_BC = WS_NAIVE, WS_WV = WS_BC + 2 * MiB, WS_CMX = WS_WV + 2 * MiB;
constexpr size_t WS_CHS = WS_CMX + 2 * MiB;
constexpr size_t WS_SMAT = WS_CHS + 1 * MiB;
constexpr size_t WS_CB = WS_SMAT + 3 * MiB;
constexpr size_t WS_NB = WS_CB + 64 * MiB;
constexpr size_t WS_MASKS = WS_NB + 1 * MiB;
constexpr size_t WS_HA = WS_MASKS + 1 * MiB;
constexpr size_t WS_END = WS_HA + ROWBUF;
constexpr int NCHK = BATCH * 4 * 32 + DEC_BATCH * 4;

__device__ __forceinline__ float logsig(float x) { return fminf(x, 0.0f) - log1pf(__expf(-fabsf(x))); }
__device__ __forceinline__ float siluf(float x) { return x / (1.0f + __expf(-x)); }
__device__ __forceinline__ int t5b(int rel) { const int n = rel < 0 ? -rel : rel; const int v = n < 8 ? n : 8 + (n >= 12) + (n >= 16) + (n >= 23) + (n >= 32) + (n >= 46) + (n >= 64) + (n >= 91); return (rel > 0 ? 16 : 0) + v; }

namespace pg8 {
__device__ __forceinline__ void unpack8(u32x4 w, float (&f)[8]) {
    f[0] = __uint_as_float(w.x << 16); f[1] = __uint_as_float(w.x & 0xffff0000u); f[2] = __uint_as_float(w.y << 16); f[3] = __uint_as_float(w.y & 0xffff0000u);
    f[4] = __uint_as_float(w.z << 16); f[5] = __uint_as_float(w.z & 0xffff0000u); f[6] = __uint_as_float(w.w << 16); f[7] = __uint_as_float(w.w & 0xffff0000u);
}
__device__ __forceinline__ u32x4 pack8f(const float (&f)[8]) { u32x4 w; w.x = cvt_pk_bf16(f[0], f[1]); w.y = cvt_pk_bf16(f[2], f[3]); w.z = cvt_pk_bf16(f[4], f[5]); w.w = cvt_pk_bf16(f[6], f[7]); return w; }
__device__ __forceinline__ float sg_(float x) { return 1.0f / (1.0f + __expf(-x)); }
struct EpiM1a {
    static constexpr bool PERM = true, AFTER_DRAIN = false, MIDK = false;
    const bf16_t* HA; const bf16_t* OB; const float* HST; const float* ang; bf16_t* BR;
    __device__ __forceinline__ void mid(f32x4 (&)[2][2][4][2], const Unit&, int, int, int, int) const {}
    __device__ __forceinline__ void operator()(const f32x4 (&acc)[2][2][4][2], const Unit& u, int wr, int wc, int fr, int fq) const {
        const int pn = u.pn; const int row0 = u.pm * BM + wr * 64 + fr, cl = wc * 32 + 8 * fq;
        if (pn < 8) {
            const int ch0 = 128 * pn + cl, head = pn >> 1;
            const f32x4 g0 = *(const f32x4*)(ang + ch0), g1 = *(const f32x4*)(ang + ch0 + 4);
            const float g[8] = {g0[0], g0[1], g0[2], g0[3], g1[0], g1[1], g1[2], g1[3]};
#pragma unroll
            for (int ai = 0; ai < 2; ++ai)
#pragma unroll
                for (int m = 0; m < 4; ++m) { const int r = row0 + ai * HALF + m * 16;
                    float h[8]; unpack8(*(const u32x4*)(HA + (size_t)r * 1024 + ch0), h);
                    const float mean = HST[((size_t)r * 4 + head) * 2], rstd = HST[((size_t)r * 4 + head) * 2 + 1];
                    const f32x4 o0 = acc[ai][0][m][0], o1 = acc[ai][0][m][1], z0 = acc[ai][1][m][0], z1 = acc[ai][1][m][1];
                    const float oa[8] = {o0[0], o0[1], o0[2], o0[3], o1[0], o1[1], o1[2], o1[3]}, za[8] = {z0[0], z0[1], z0[2], z0[3], z1[0], z1[1], z1[2], z1[3]};
                    float o[8];
#pragma unroll
                    for (int i = 0; i < 8; ++i) o[i] = ((h[i] - mean) * rstd * g[i] * sg_(oa[i])) * (za[i] * sg_(za[i]));
                    *(u32x4*)(BR + (size_t)r * 2048 + ch0) = pack8f(o); }
        } else {
#pragma unroll
            for (int ai = 0; ai < 2; ++ai)
#pragma unroll
                for (int m = 0; m < 4; ++m) { const int r = row0 + ai * HALF + m * 16;
#pragma unroll
                    for (int bj = 0; bj < 2; ++bj) { const int ch0 = 256 * (pn - 8) + 128 * bj + cl;
                        float ob[8]; unpack8(*(const u32x4*)(OB + (size_t)r * 1024 + ch0), ob);
                        const f32x4 z0 = acc[ai][bj][m][0], z1 = acc[ai][bj][m][1]; const float zb[8] = {z0[0], z0[1], z0[2], z0[3], z1[0], z1[1], z1[2], z1[3]};
                        float o[8];
#pragma unroll
                        for (int i = 0; i < 8; ++i) o[i] = ob[i] * (zb[i] * sg_(zb[i]));
                        *(u32x4*)(BR + (size_t)r * 2048 + 1024 + ch0) = pack8f(o); } }
        }
    }
};
struct EpiM1b {
    static constexpr bool PERM = true, AFTER_DRAIN = false, MIDK = false;
    bf16_t* SGA; bf16_t* SGB;
    __device__ __forceinline__ void mid(f32x4 (&)[2][2][4][2], const Unit&, int, int, int, int) const {}
    __device__ __forceinline__ void operator()(const f32x4 (&acc)[2][2][4][2], const Unit& u, int wr, int wc, int fr, int fq) const {
        const int pn = u.pn; const int row0 = u.pm * BM + wr * 64 + fr, cl = wc * 32 + 8 * fq;
        bf16_t* base = pn < 4 ? SGA : SGB; const int col0 = (pn & 3) * 256 + cl;
#pragma unroll
        for (int ai = 0; ai < 2; ++ai)
#pragma unroll
            for (int m = 0; m < 4; ++m) { bf16_t* rowp = base + (size_t)(row0 + ai * HALF + m * 16) * 1024 + col0;
#pragma unroll
                for (int bj = 0; bj < 2; ++bj) { const f32x4 v0 = acc[ai][bj][m][0], v1 = acc[ai][bj][m][1];
                    const float o[8] = {sg_(v0[0]), sg_(v0[1]), sg_(v0[2]), sg_(v0[3]), sg_(v1[0]), sg_(v1[1]), sg_(v1[2]), sg_(v1[3])};
                    *(u32x4*)(rowp + bj * HALF) = pack8f(o); } }
    }
};
struct EpiM2 {
    static constexpr bool PERM = true, AFTER_DRAIN = false, MIDK = true;
    const bf16_t* SGA; const bf16_t* SGB; bf16_t* MX;
    __device__ __forceinline__ void mid(f32x4 (&acc)[2][2][4][2], const Unit& u, int wr, int wc, int fr, int fq) const {
        int fr_ = fr, fq_ = fq; asm volatile("" : "+v"(fr_), "+v"(fq_));
        const int row0 = u.pm * BM + wr * 64 + fr_, col0 = u.pn * BM + wc * 32 + 8 * fq_;
#pragma unroll
        for (int ai = 0; ai < 2; ++ai)
#pragma unroll
            for (int m = 0; m < 4; ++m) { const size_t ro = (size_t)(row0 + ai * HALF + m * 16) * 1024 + col0;
#pragma unroll
                for (int bj = 0; bj < 2; ++bj) { float a[8], b[8]; unpack8(*(const u32x4*)(SGA + ro + bj * HALF), a); unpack8(*(const u32x4*)(SGB + ro + bj * HALF), b);
#pragma unroll
                    for (int i = 0; i < 4; ++i) { acc[ai][bj][m][0][i] *= a[i] * __builtin_amdgcn_rcpf(b[i]); acc[ai][bj][m][1][i] *= a[4 + i] * __builtin_amdgcn_rcpf(b[4 + i]); } }
                asm volatile("" ::: "memory"); }
    }
    __device__ __forceinline__ void operator()(const f32x4 (&acc)[2][2][4][2], const Unit& u, int wr, int wc, int fr, int fq) const {
        int fr_ = fr, fq_ = fq; asm volatile("" : "+v"(fr_), "+v"(fq_));
        const int row0 = u.pm * BM + wr * 64 + fr_, col0 = u.pn * BM + wc * 32 + 8 * fq_;
#pragma unroll
        for (int ai = 0; ai < 2; ++ai)
#pragma unroll
            for (int m = 0; m < 4; ++m) { const size_t ro = (size_t)(row0 + ai * HALF + m * 16) * 1024 + col0;
#pragma unroll
                for (int bj = 0; bj < 2; ++bj) { float b[8]; unpack8(*(const u32x4*)(SGB + ro + bj * HALF), b);
                    const f32x4 v0 = acc[ai][bj][m][0], v1 = acc[ai][bj][m][1];
                    const float o[8] = {v0[0] * b[0], v0[1] * b[1], v0[2] * b[2], v0[3] * b[3], v1[0] * b[4], v1[1] * b[5], v1[2] * b[6], v1[3] * b[7]};
                    *(u32x4*)(MX + ro + bj * HALF) = pack8f(o); }
                asm volatile("" ::: "memory"); }
    }
};
struct EpiM3 {
    static constexpr bool PERM = true, AFTER_DRAIN = false, MIDK = false;
    const float* xp; const float* xs; float* yp; float* ys;
    __device__ __forceinline__ void mid(f32x4 (&)[2][2][4][2], const Unit&, int, int, int, int) const {}
    __device__ __forceinline__ void operator()(const f32x4 (&acc)[2][2][4][2], const Unit& u, int wr, int wc, int fr, int fq) const {
        const bool samp = u.pm >= NTP / 256; const int row0 = (samp ? u.pm - NTP / 256 : u.pm) * BM + wr * 64 + fr, col0 = u.pn * BM + wc * 32 + 8 * fq;
        const float* xb = samp ? xs : xp; float* yb = samp ? ys : yp;
#pragma unroll
        for (int ai = 0; ai < 2; ++ai)
#pragma unroll
            for (int m = 0; m < 4; ++m) { const size_t ro = (size_t)(row0 + ai * HALF + m * 16) * 1024 + col0;
#pragma unroll
                for (int bj = 0; bj < 2; ++bj) { const f32x4 x0 = *(const f32x4*)(xb + ro + bj * HALF), x1 = *(const f32x4*)(xb + ro + bj * HALF + 4);
                    *(f32x4*)(yb + ro + bj * HALF) = x0 * DN_ALPHA + acc[ai][bj][m][0]; *(f32x4*)(yb + ro + bj * HALF + 4) = x1 * DN_ALPHA + acc[ai][bj][m][1]; } }
    }
};
}

__device__ __forceinline__ float wave_sum(float v) {
#pragma unroll
    for (int o = 1; o < 64; o <<= 1) v += __shfl_xor(v, o);
    return v;
}

typedef const __attribute__((address_space(4))) Args* kargp_t;
#define MK_ARGS kargp_t ap_ = (kargp_t)__builtin_amdgcn_kernarg_segment_ptr(); asm volatile("" : "+s"(ap_))
#define args (*ap_)
__global__ void __launch_bounds__(NWAVES * 64, 2) mk_fwd(Args kargs_by_value) {
    extern __shared__ __attribute__((aligned(16))) unsigned char lds_raw[];
    LAS unsigned char* lds = (LAS unsigned char*)lds_raw;
    int lo, hi; unsigned* barw;
    { MK_ARGS; lo = args.ph_lo; hi = args.ph_hi; barw = (unsigned*)((gu32*)(args.ws + WS_CTL) + CW_BAR); }
    volatile LAS unsigned* MISC = (volatile LAS unsigned*)(lds + MISC_OFF);
    for (int u = threadIdx.x; u < (LDS_BYTES - LDSCTL_OFF) / 4; u += NWAVES * 64) ((LAS unsigned*)(lds + LDSCTL_OFF))[u] = 0u;
    __syncthreads();
    XcdBarrier bar = xcd_barrier_post(barw, MISC + 8);
#ifndef PHMASK
#define PHMASK 0x3ff
#endif
#define IN(k) (((PHMASK >> (k)) & 1) && lo <= (k) && (k) < hi)
#define GBAR() xcd_barrier(bar)
#define WMIX ((bf16*)(args.ws + WS_WMIX))
#define WMRG ((bf16*)(args.ws + WS_WMRG))
#define WAB ((bf16*)(args.ws + WS_WAB))
#define WO ((bf16*)(args.ws + WS_WO))
#define XB ((bf16*)(args.ws + WS_XB))
#define QA ((bf16*)(args.ws + WS_QA))
#define KA ((bf16*)(args.ws + WS_KA))
#define VA ((bf16*)(args.ws + WS_VA))
#define QB ((bf16*)(args.ws + WS_QB))
#define QI ((bf16*)(args.ws + WS_QI))
#define KI ((bf16*)(args.ws + WS_KI))
#define SM ((float*)(args.ws + WS_SM))
#define MASK ((unsigned long long*)(args.ws + WS_MASK))
#define MASKS ((unsigned long long*)(args.ws + WS_MASKS))
#define HST ((float*)(args.ws + WS_HST))
#define BC ((float*)(args.ws + WS_BC))
#define WV ((float*)(args.ws + WS_WV))
#define CMX ((float*)(args.ws + WS_CMX))
#define CHS ((float*)(args.ws + WS_CHS))
#define MCH (CHS + 2 * NCHK)
#define SMATP ((float*)(args.ws + WS_SMAT))
#define SMATS (SMATP + 128 * 4096)
#define CB ((float*)(args.ws + WS_CB))
#define NBf ((float*)(args.ws + WS_NB))
#define HA ((bf16*)(args.ws + WS_HA))
#define OB QB
#define BR KA
#define SGA QA
#define SGB QB
#define MX XB
#define y_prompt (args.out)
#define y_sample (y_prompt + (size_t)NTP * 1024)
#define k_prompt (y_sample + (size_t)NTS * 1024)
#define v_prompt (k_prompt + (size_t)NTP * 1024)
#define ik_prompt (v_prompt + (size_t)NTP * 1024)
#define C_prompt (ik_prompt + (size_t)NTP * 64)
#define n_prompt (C_prompt + (size_t)BATCH * 4 * 65536)
#define m_prompt (n_prompt + (size_t)BATCH * 1024)
#define k_sample (m_prompt + BATCH * 4)
#define v_sample (k_sample + (size_t)NTS * 1024)
#define ik_sample (v_sample + (size_t)NTS * 1024)
#define C_sample (ik_sample + (size_t)NTS * 64)
#define n_sample (C_sample + (size_t)DEC_BATCH * 4 * 65536)
#define m_sample (n_sample + (size_t)DEC_BATCH * 1024)
#define KBc ((bf16*)y_prompt)
#define VBc (KBc + (size_t)NTP * 1024)
#define cache_k (args.in[2])
#define cache_v (args.in[3])
#define cache_ik (args.in[4])
#define state_C (args.in[5])
#define state_n (args.in[6])
#define state_m (args.in[7])
#define b_gates (args.in[9])
#define a_norm_g (args.in[10])
#define rel_bias (args.in[14])
#define ln_g (args.in[15])
#define ln_b (args.in[16])
#define gtid ({ int t__ = (int)threadIdx.x; asm volatile("" : "+v"(t__)); (long)blockIdx.x * (NWAVES * 64) + (long)t__; })
#define GT ((long)gridDim.x * (NWAVES * 64))
#define gw (vcu * NWAVES + wave)
#define NGW ((int)gridDim.x * NWAVES)
#define tid ((int)threadIdx.x)
#define lane ((int)(threadIdx.x & 63))
#define wave (__builtin_amdgcn_readfirstlane((int)(threadIdx.x >> 6)))
#define G ((int)gridDim.x)
#define vcu ((G % 8 == 0) ? ((int)blockIdx.x % 8) * (G / 8) + (int)blockIdx.x / 8 : (int)blockIdx.x)

    if (IN(0)) { MK_ARGS;
        P0Args a{args.in[0], args.in[1], args.in[8], args.in[11], args.in[12], args.in[13], XB, WMIX, WMRG, WAB, WO};
        p0_prologue(a, lds, vcu, G, wave, lane);
        GBAR();
    }
    if (IN(1)) { MK_ARGS;
        pg8::Gemm g{XB, WMIX, NTOK, N_MIX, 1024}; pg8::StaticOrder S; S.init(NTOK, N_MIX, G, (int)blockIdx.x);
        pg8::EpiMix E{QA, KBc, QI, KI, SM, k_prompt, k_sample, ik_prompt, ik_sample};
        pg8::gemm_phase<pg8::EpiMix, pg8::StaticOrder, true, true>(lds + RING_OFF, g, S, E);
        GBAR();
    }
    if (IN(2)) { MK_ARGS;
        for (long t = gtid; t < NCHK; t += GT) {
            int h, L; long tok0;
            if (t < 4096) { const int b = (int)(t >> 7); h = (int)((t >> 5) & 3); const int c = (int)(t & 31); tok0 = (long)b * SEQ + c * 64; L = 64; }
            else { const int b = (int)((t - 4096) >> 2); h = (int)((t - 4096) & 3); tok0 = NTP + (long)b * DEC_SEQ; L = DEC_SEQ; }
            const float bi = b_gates[h], bfg = b_gates[4 + h]; float cum = 0.f, cmax = -INFINITY;
            for (int l = 0; l < L; ++l) { const long tok = tok0 + l; const float ig = SM[tok * 16 + 8 + h] + bi; const float lf = logsig(SM[tok * 16 + 12 + h] + bfg);
                cum += lf; const float w = ig - cum; cmax = fmaxf(cmax, w); BC[tok * 4 + h] = cum; WV[tok * 4 + h] = w; CMX[tok * 4 + h] = cmax; }
            CHS[2 * t] = cum; CHS[2 * t + 1] = cmax;
        }
        GBAR();
        for (long t = gtid; t < BATCH * 4 + DEC_BATCH * 4; t += GT) {
            if (t < BATCH * 4) { float m = 0.f; for (int c = 0; c < 32; ++c) { const long i = t * 32 + c; MCH[i] = m; m = CHS[2 * i] + fmaxf(m, CHS[2 * i + 1]); } m_prompt[t] = m; }
            else { const long j = t - BATCH * 4; const long i = 4096 + j; float m = state_m[j]; MCH[i] = m; m = CHS[2 * i] + fmaxf(m, CHS[2 * i + 1]); m_sample[j] = m; }
        }
        GBAR();
        for (int c = 0; c < 32; ++c) {
            const long nSp = 128L * 4096, nSs = (c == 0) ? 64L * 1024 : 0;
            for (long t = gtid; t < nSp + nSs; t += GT) {
                int bh, l, s, L; long tok0; float* dst;
                if (t < nSp) { bh = (int)(t >> 12); l = (int)((t >> 6) & 63); s = (int)(t & 63); L = 64; tok0 = (long)(bh >> 2) * SEQ + c * 64; dst = SMATP + t; }
                else { const long u = t - nSp; bh = (int)(u >> 10); l = (int)((u >> 5) & 31); s = (int)(u & 31); L = 32; tok0 = NTP + (long)(bh >> 2) * DEC_SEQ; dst = SMATS + u; }
                const int h = bh & 3; float val = 0.f;
                if (s <= l) { const long tl = tok0 + l, ts = tok0 + s; const bf16* q = QA + tl * 1024 + h * 256; const bf16* k = KA + ts * 1024 + h * 256;
                    float d = 0.f; for (int i = 0; i < 256; ++i) d += bf2f(q[i]) * bf2f(k[i]);
                    const long ci = (t < nSp) ? (long)bh * 32 + c : 4096 + bh;
                    val = d * __expf(WV[ts * 4 + h] - fmaxf(MCH[ci], CMX[tl * 4 + h])); }
                *dst = val;
            }
            GBAR();
            const long nHp = 32L * 64 * 1024, nHs = (c == 0) ? 16L * 32 * 1024 : 0, nCp = 128L * 65536, nCs = (c == 0) ? 64L * 65536 : 0;
            for (long t = gtid; t < nHp + nHs + nCp + nCs; t += GT) {
                if (t < nHp + nHs) {
                    int b, l, h, dv, L; long tok0, ci; const float* Sr; const float* Cm; const float* nv; bool zero = false;
                    if (t < nHp) { b = (int)(t >> 16); l = (int)((t >> 10) & 63); h = (int)((t >> 8) & 3); dv = (int)(t & 255); L = 64; tok0 = (long)b * SEQ + c * 64; ci = (long)(b * 4 + h) * 32 + c;
                        Sr = SMATP + ((long)(b * 4 + h) * 64 + l) * 64; Cm = CB + (size_t)(c & 1) * 128 * 65536 + (size_t)(b * 4 + h) * 65536; nv = NBf + (c & 1) * 128 * 256 + (b * 4 + h) * 256; zero = (c == 0); }
                    else { const long u = t - nHp; b = (int)(u >> 15); l = (int)((u >> 10) & 31); h = (int)((u >> 8) & 3); dv = (int)(u & 255); L = 32; tok0 = NTP + (long)b * DEC_SEQ; ci = 4096 + b * 4 + h;
                        Sr = SMATS + ((long)(b * 4 + h) * 32 + l) * 32; Cm = state_C + (size_t)(b * 4 + h) * 65536; nv = state_n + (b * 4 + h) * 256; }
                    const long tl = tok0 + l; const bf16* q = QA + tl * 1024 + h * 256;
                    const float mc = MCH[ci], Ml = fmaxf(mc, CMX[tl * 4 + h]), bl = BC[tl * 4 + h]; const float inter = __expf(mc - Ml);
                    float num = 0.f, den = 0.f;
                    for (int s = 0; s <= l; ++s) { const float sv = Sr[s]; num += sv * bf2f(VA[(tok0 + s) * 1024 + h * 256 + dv]); den += sv; }
                    if (!zero) { float qc = 0.f, qn = 0.f; for (int i = 0; i < 256; ++i) { const float qi_ = bf2f(q[i]); qc += qi_ * Cm[(size_t)i * 256 + dv]; qn += qi_ * nv[i]; } num += inter * qc; den += inter * qn; }
                    const float hv = num / fmaxf(fabsf(den), __expf(-(bl + Ml)));
                    HA[tl * 1024 + h * 256 + dv] = (bf16)f2bf(hv);
                } else {
                    const long u0 = t - (nHp + nHs); int bh, dk, dv, L; long tok0, ci; const float* Cs; const float* ns; float* Cd; float* nd; bool zero = false;
                    if (u0 < nCp) { bh = (int)(u0 >> 16); dk = (int)((u0 >> 8) & 255); dv = (int)(u0 & 255); L = 64; tok0 = (long)(bh >> 2) * SEQ + c * 64; ci = (long)bh * 32 + c; zero = (c == 0);
                        Cs = CB + (size_t)(c & 1) * 128 * 65536 + (size_t)bh * 65536; ns = NBf + (c & 1) * 128 * 256 + bh * 256;
                        Cd = (c == 31) ? C_prompt + (size_t)bh * 65536 : CB + (size_t)((c + 1) & 1) * 128 * 65536 + (size_t)bh * 65536; nd = (c == 31) ? n_prompt + bh * 256 : NBf + ((c + 1) & 1) * 128 * 256 + bh * 256; }
                    else { const long u = u0 - nCp; bh = (int)(u >> 16); dk = (int)((u >> 8) & 255); dv = (int)(u & 255); L = 32; tok0 = NTP + (long)(bh >> 2) * DEC_SEQ; ci = 4096 + bh;
                        Cs = state_C + (size_t)bh * 65536; ns = state_n + bh * 256; Cd = C_sample + (size_t)bh * 65536; nd = n_sample + bh * 256; }
                    const int h = bh & 3; const float mc = MCH[ci]; const float Mlast = fmaxf(mc, CMX[(tok0 + L - 1) * 4 + h]); const float decay = __expf(mc - Mlast);
                    float aC = 0.f, an = 0.f;
                    for (int s = 0; s < L; ++s) { const long ts = tok0 + s; const float wsv = __expf(WV[ts * 4 + h] - Mlast); const float kk = bf2f(KA[ts * 1024 + h * 256 + dk]);
                        aC += wsv * kk * bf2f(VA[ts * 1024 + h * 256 + dv]); an += wsv * kk; }
                    Cd[(size_t)dk * 256 + dv] = (zero ? 0.f : decay * Cs[(size_t)dk * 256 + dv]) + aC;
                    if (dv == 0) nd[dk] = (zero ? 0.f : decay * ns[dk]) + an;
                }
            }
            GBAR();
        }
        for (long t = gw; t < (long)NTOK * 4; t += NGW) { const unsigned long long w8 = *((const GAS unsigned long long*)(HA + t * 256) + lane);
            const float v0 = __uint_as_float((unsigned)w8 << 16), v1 = __uint_as_float((unsigned)w8 & 0xffff0000u), v2 = __uint_as_float((unsigned)(w8 >> 32) << 16), v3 = __uint_as_float((unsigned)(w8 >> 32) & 0xffff0000u);
            const float mean = wave_sum((v0 + v1) + (v2 + v3)) * (1.0f / 256.0f); const float d0 = v0 - mean, d1 = v1 - mean, d2 = v2 - mean, d3 = v3 - mean;
            const float var = wave_sum((d0 * d0 + d1 * d1) + (d2 * d2 + d3 * d3)) * (1.0f / 256.0f);
            if (lane == 0) { HST[t * 2] = mean; HST[t * 2 + 1] = 1.0f / sqrtf(var + HEAD_NORM_EPS); } }
    }
    if (IN(3)) { MK_ARGS;
        {
            typedef short bfx8 __attribute__((ext_vector_type(8))); typedef float f16v __attribute__((ext_vector_type(16)));
            LAS int* sck = (LAS int*)(lds + RING_OFF);
            const int hi = lane >> 5, r32 = lane & 31;
            for (int w4 = 0; w4 < 4; ++w4) {
                const int bW = vcu >> 3, jW = vcu & 7; const int cW = (w4 == 0) ? jW : (w4 == 1) ? 15 - jW : (w4 == 2) ? 16 + jW : 31 - jW;
                if (vcu >= BATCH * 8) break;
                const int S = 64 * (cW + 1), nW = cW + 1; const long tok0 = (long)bW * SEQ + 64 * cW;
                if (S <= TOPK_MAX) {
                    for (int k = 0; k < 8; ++k) { if (lane < 32) MASK[(size_t)(tok0 + wave * 8 + k) * 32 + lane] = (lane < nW) ? ~0ull : 0ull; }
                    continue; }
                for (int rd = 0; rd < 8; ++rd) {
                    bfx8 afr[2][4]; float wgt[2][16];
                    { const int blk = r32 >> 2; const int qa_ = 2 * (blk & 1) + (blk >> 2), ha_ = 4 * ((blk >> 1) & 1) + (r32 & 3);
#pragma unroll
                      for (int rt = 0; rt < 2; ++rt) { const bf16* qp = QI + (size_t)(tok0 + 8 * rd + 4 * rt + qa_) * 512 + ha_ * 64 + hi * 8;
#pragma unroll
                          for (int ks = 0; ks < 4; ++ks) afr[rt][ks] = *(const bfx8*)(qp + ks * 16);
#pragma unroll
                          for (int qq = 0; qq < 2; ++qq) { const float* wp = SM + (size_t)(tok0 + 8 * rd + 4 * rt + 2 * hi + qq) * 16;
                              const f32x4 w0 = *(const f32x4*)wp, w1 = *(const f32x4*)(wp + 4);
                              wgt[rt][8 * qq + 0] = w0[0] * 0.35355339059327373f; wgt[rt][8 * qq + 1] = w0[1] * 0.35355339059327373f; wgt[rt][8 * qq + 2] = w0[2] * 0.35355339059327373f; wgt[rt][8 * qq + 3] = w0[3] * 0.35355339059327373f;
                              wgt[rt][8 * qq + 4] = w1[0] * 0.35355339059327373f; wgt[rt][8 * qq + 5] = w1[1] * 0.35355339059327373f; wgt[rt][8 * qq + 6] = w1[2] * 0.35355339059327373f; wgt[rt][8 * qq + 7] = w1[3] * 0.35355339059327373f; } } }
                    for (int kt = wave; kt < 2 * nW; kt += 8) {
                        const bf16* kp = KI + ((size_t)bW * SEQ + 32 * kt + r32) * 64 + hi * 8;
                        bfx8 bfr[4];
#pragma unroll
                        for (int ks = 0; ks < 4; ++ks) bfr[ks] = *(const bfx8*)(kp + ks * 16);
#pragma unroll
                        for (int rt = 0; rt < 2; ++rt) { f16v acc = {};
#pragma unroll
                            for (int ks = 0; ks < 4; ++ks) acc = __builtin_amdgcn_mfma_f32_32x32x16_bf16(afr[rt][ks], bfr[ks], acc, 0, 0, 0);
                            float sA = 0.f, sB = 0.f;
#pragma unroll
                            for (int i = 0; i < 8; ++i) { sA += wgt[rt][i] * fmaxf(acc[i], 0.f); sB += wgt[rt][8 + i] * fmaxf(acc[8 + i], 0.f); }
                            const int kA = __float_as_int(sA), kB = __float_as_int(sB);
                            sck[(4 * rt + 2 * hi) * 2048 + 32 * kt + r32] = kA ^ ((kA >> 31) & 0x7fffffff);
                            sck[(4 * rt + 2 * hi + 1) * 2048 + 32 * kt + r32] = kB ^ ((kB >> 31) & 0x7fffffff); }
                    }
                    __syncthreads();
                    { int v[32]; int vmx = (int)0x80000000, vmn = 0x7fffffff;
#pragma unroll
                      for (int i = 0; i < 32; ++i) { v[i] = (i < nW) ? sck[wave * 2048 + lane + 64 * i] : (int)0x80000000; if (i < nW) { vmx = max(vmx, v[i]); vmn = min(vmn, v[i]); } }
#pragma unroll
                      for (int o_ = 1; o_ < 64; o_ <<= 1) { vmx = max(vmx, __shfl_xor(vmx, o_)); vmn = min(vmn, __shfl_xor(vmn, o_)); }
                      long lo_ = vmn, hi_ = vmx; bool exact = false; int T = vmn;
                      while (lo_ < hi_) { const int mid = (int)(lo_ + ((hi_ - lo_ + 1) >> 1)); int cnt = 0;
#pragma unroll
                          for (int i = 0; i < 32; ++i) { if (i < nW) cnt += __builtin_popcountll(__ballot(v[i] >= mid)); if ((i & 3) == 3) __builtin_amdgcn_sched_barrier(0); }
                          if (cnt == TOPK_MAX) { exact = true; T = mid; break; }
                          if (cnt > TOPK_MAX) lo_ = mid; else hi_ = (long)mid - 1; }
                      if (!exact) T = (int)lo_;
                      int need = TOPK_MAX;
                      if (!exact) { int cgt = 0;
#pragma unroll
                          for (int i = 0; i < 32; ++i) { if (i < nW) cgt += __builtin_popcountll(__ballot(v[i] > T)); if ((i & 3) == 3) __builtin_amdgcn_sched_barrier(0); }
                          need = TOPK_MAX - cgt; }
                      unsigned long long myw = 0ull; int running = 0; const unsigned long long lt = (1ull << lane) - 1ull;
#pragma unroll
                      for (int i = 0; i < 32; ++i) if (i < nW) { bool sel;
                          if (exact) sel = v[i] >= T;
                          else { const bool eq = v[i] == T; const unsigned long long em = __ballot(eq); sel = (v[i] > T) || (eq && running + __builtin_popcountll(em & lt) < need); running += __builtin_popcountll(em); }
                          const unsigned long long wd = __ballot(sel); if (lane == i) myw = wd; __builtin_amdgcn_sched_barrier(0); }
                      if (lane < 32) MASK[(size_t)(tok0 + 8 * rd + wave) * 32 + lane] = myw; }
                    __syncthreads();
                }
            }
        }
        LAS float* sc = (LAS float*)(lds + RING_OFF);
        LAS float* qv = (LAS float*)(lds + RING_OFF + 16384);
        for (int row = NTP + vcu; row < NTOK; row += G) {
            const bool samp = row >= NTP; const int b = samp ? (row - NTP) / DEC_SEQ : row / SEQ; const int q = samp ? (row - NTP) % DEC_SEQ : row % SEQ;
            const int S = samp ? PAST_LEN + DEC_SEQ : ((q >> 6) + 1) * 64;
            unsigned long long* mrow = samp ? MASKS + (size_t)(row - NTP) * 40 : MASK + (size_t)row * 32;
            if (S <= TOPK_MAX) { if (tid < 32) mrow[tid] = (tid < (S >> 6)) ? ~0ull : 0ull; continue; }
            qv[tid] = bf2f(QI[(size_t)row * 512 + tid]); if (tid < 8) qv[512 + tid] = SM[(size_t)row * 16 + tid] * 0.35355339059327373f;
            __syncthreads();
            const int nIt = (S + 511) / 512;
            for (int i = 0; i < nIt; ++i) { const int s = tid + 512 * i;
                if (s < S) { float kf[64];
                    if (samp && s < PAST_LEN) { const float* kr = cache_ik + ((size_t)b * PAST_LEN + s) * 64;
#pragma unroll
                        for (int j = 0; j < 64; ++j) kf[j] = kr[j]; }
                    else { const bf16* kr = KI + (samp ? (size_t)NTP + (size_t)b * DEC_SEQ + (s - PAST_LEN) : (size_t)b * SEQ + s) * 64;
#pragma unroll
                        for (int j = 0; j < 64; ++j) kf[j] = bf2f(kr[j]); }
                    float a = 0.f;
#pragma unroll
                    for (int h = 0; h < 8; ++h) { float d = 0.f;
#pragma unroll
                        for (int j = 0; j < 64; ++j) d += qv[h * 64 + j] * kf[j];
                        a += qv[512 + h] * fmaxf(d, 0.f); }
                    sc[s] = a; } }
            __syncthreads();
            for (int i = 0; i < nIt; ++i) { const int s = tid + 512 * i; bool keep = false;
                if (s < S) { const float v = sc[s]; int rank = 0; for (int j = 0; j < S; ++j) { const float u = sc[j]; rank += (u > v) || (u == v && j < s); } keep = rank < TOPK_MAX; }
                const unsigned long long bm = __ballot(keep);
                if (lane == 0 && (wave + 8 * i) * 64 < S) mrow[wave + 8 * i] = bm; }
            if (!samp) { const int nw = S >> 6; if (tid >= nw && tid < 32) mrow[tid] = 0ull; }
            __syncthreads();
        }
        GBAR();
    }
    if (IN(4)) { MK_ARGS;
        {
            char* alds = (char*)lds_raw;
            for (int bh = vcu; bh < BATCH * 8; bh += G) {
                const int b = bh >> 3, h = bh & 7;
                if (tid < 320) ((float*)(alds + at2::BT_OFF))[tid] = rel_bias[t5b(tid - 256) * 8 + h] * (1.0f / at2::SCALE);
                const float cfar = __int_as_float(__builtin_amdgcn_readfirstlane(__float_as_int(rel_bias[15 * 8 + h] * (1.0f / at2::SCALE))));
                at2::Ctx C;
                C.Q = __builtin_amdgcn_make_buffer_rsrc((void*)(QB + (size_t)b * SEQ * 1024 + h * 128), (short)0, SEQ * 1024 * 2, 0x00020000);
                C.K = __builtin_amdgcn_make_buffer_rsrc((void*)(KBc + (size_t)b * SEQ * 1024 + h * 128), (short)0, SEQ * 1024 * 2, 0x00020000);
                C.V = __builtin_amdgcn_make_buffer_rsrc((void*)(VBc + (size_t)b * SEQ * 1024 + h * 128), (short)0, SEQ * 1024 * 2, 0x00020000);
                C.M = __builtin_amdgcn_make_buffer_rsrc((void*)(MASK + (size_t)b * SEQ * 32), (short)0, SEQ * 32 * 8, 0x00020000);
                at2::Seam S; at2::dsa_prime(C, 0, alds, S);
                for (int u = 0; u < 8; ++u) at2::dsa_block(C, u * 256, (u < 7 ? u + 1 : u) * 256, alds, S, cfar);
            }
        }
        for (long t = gtid; t < (long)NTS * 64; t += GT) {
            const int dc = (int)(t & 7), h = (int)((t >> 3) & 7); const int row = NTP + (int)(t >> 6);
            const bool samp = row >= NTP; const int b = samp ? (row - NTP) / DEC_SEQ : row / SEQ; const int q = samp ? (row - NTP) % DEC_SEQ : row % SEQ;
            const int S = samp ? PAST_LEN + DEC_SEQ : ((q >> 6) + 1) * 64; const int qpos = samp ? PAST_LEN + q : q;
            const unsigned long long* mrow = samp ? MASKS + (size_t)(row - NTP) * 40 : MASK + (size_t)row * 32;
            const bf16* qr = QB + (size_t)row * 1024 + h * 128;
            float mx = -INFINITY, sum = 0.f, o[16];
#pragma unroll
            for (int i = 0; i < 16; ++i) o[i] = 0.f;
            for (int w = 0; w * 64 < S; ++w) { unsigned long long bits = mrow[w];
                while (bits) { const int s = w * 64 + __builtin_ctzll(bits); bits &= bits - 1;
                    float d = 0.f; float vv[16];
                    if (samp) { const float* kr = (s < PAST_LEN) ? cache_k + ((size_t)b * PAST_LEN + s) * 1024 + h * 128 : k_sample + ((size_t)b * DEC_SEQ + (s - PAST_LEN)) * 1024 + h * 128;
                        const float* vr = (s < PAST_LEN) ? cache_v + ((size_t)b * PAST_LEN + s) * 1024 + h * 128 + dc * 16 : v_sample + ((size_t)b * DEC_SEQ + (s - PAST_LEN)) * 1024 + h * 128 + dc * 16;
#pragma unroll 8
                        for (int j = 0; j < 128; ++j) d += bf2f(qr[j]) * kr[j];
#pragma unroll
                        for (int i = 0; i < 16; ++i) vv[i] = vr[i]; }
                    else { const bf16* kr = KBc + ((size_t)b * SEQ + s) * 1024 + h * 128; const bf16* vr = VBc + ((size_t)b * SEQ + s) * 1024 + h * 128 + dc * 16;
#pragma unroll 8
                        for (int j = 0; j < 128; ++j) d += bf2f(qr[j]) * bf2f(kr[j]);
#pragma unroll
                        for (int i = 0; i < 16; ++i) vv[i] = bf2f(vr[i]); }
                    const float lg = d * 0.08838834764831845f + rel_bias[t5b(s - qpos) * 8 + h];
                    if (lg > mx) { const float f = __expf(mx - lg); sum *= f;
#pragma unroll
                        for (int i = 0; i < 16; ++i) o[i] *= f; mx = lg; }
                    const float p = __expf(lg - mx); sum += p;
#pragma unroll
                    for (int i = 0; i < 16; ++i) o[i] += p * vv[i]; } }
            const float inv = 1.0f / sum; bf16* orow = OB + (size_t)row * 1024 + h * 128 + dc * 16;
#pragma unroll
            for (int i = 0; i < 16; ++i) orow[i] = (bf16)f2bf(o[i] * inv);
        }
        GBAR();
    }
    if (IN(5)) { MK_ARGS;
        pg8::Gemm g{XB, WMRG, NTOK, N_M1A, 1024}; pg8::StaticOrder S; S.init(NTOK, N_M1A, G, (int)blockIdx.x);
        pg8::EpiM1a E{HA, OB, HST, a_norm_g, BR};
        pg8::gemm_phase<pg8::EpiM1a, pg8::StaticOrder, true, true>(lds + RING_OFF, g, S, E);
        GBAR();
    }
    if (IN(6)) { MK_ARGS;
        pg8::Gemm g{XB, WMRG + (size_t)N_M1A * 1024, NTOK, N_M1B, 1024}; pg8::StaticOrder S; S.init(NTOK, N_M1B, G, (int)blockIdx.x);
        pg8::EpiM1b E{SGA, SGB};
        pg8::gemm_phase<pg8::EpiM1b, pg8::StaticOrder, true, true>(lds + RING_OFF, g, S, E);
        GBAR();
    }
    if (IN(7)) { MK_ARGS;
        pg8::Gemm g{BR, WAB, NTOK, 1024, 2048}; pg8::StaticOrder S; S.init(NTOK, 1024, G, (int)blockIdx.x);
        pg8::EpiM2 E{SGA, SGB, MX};
        pg8::gemm_phase<pg8::EpiM2, pg8::StaticOrder, true, true>(lds + RING_OFF, g, S, E);
        GBAR();
    }
    if (IN(8)) { MK_ARGS;
        pg8::Gemm g{MX, WO, NTOK, 1024, 1024}; pg8::StaticOrder S; S.init(NTOK, 1024, G, (int)blockIdx.x);
        pg8::EpiM3 E{args.in[0], args.in[1], y_prompt, y_sample};
        pg8::gemm_phase<pg8::EpiM3, pg8::StaticOrder, true, true>(lds + RING_OFF, g, S, E);
        GBAR();
    }
    if (IN(9)) { MK_ARGS;
        for (int m = gw; m < NTOK; m += NGW) {
            float* yr = m < NTP ? y_prompt + (size_t)m * 1024 : y_sample + (size_t)(m - NTP) * 1024;
            GAS f32x4* yv = (GAS f32x4*)yr + lane; f32x4 v[4]; float s = 0.f;
#pragma unroll
            for (int j = 0; j < 4; ++j) { v[j] = yv[64 * j]; s += (v[j].x + v[j].y) + (v[j].z + v[j].w); }
            const float mean = wave_sum(s) * (1.f / 1024.f); float s2 = 0.f;
#pragma unroll
            for (int j = 0; j < 4; ++j) { v[j] = v[j] - mean; s2 += (v[j].x * v[j].x + v[j].y * v[j].y) + (v[j].z * v[j].z + v[j].w * v[j].w); }
            const float rstd = 1.f / sqrtf(wave_sum(s2) * (1.f / 1024.f) + LN_EPS);
#pragma unroll
            for (int j = 0; j < 4; ++j) { const f32x4 gg = *((const GAS f32x4*)ln_g + lane + 64 * j), bb = *((const GAS f32x4*)ln_b + lane + 64 * j); yv[64 * j] = v[j] * rstd * gg + bb; }
        }
    }
#undef IN
#undef GBAR
#undef args
#undef gtid
#undef GT
#undef gw
#undef NGW
#undef tid
#undef lane
#undef wave
#undef G
#undef vcu
}

extern "C" void kernel_launch(void* const* d_in, const int* in_sizes, int n_in, void* d_out, int out_size, void* d_ws, size_t ws_size, hipStream_t stream) {
    static int grid = 0;
    if (grid == 0) {
        int dev = 0, cus = 0;
        if (hipGetDevice(&dev) != hipSuccess || hipDeviceGetAttribute(&cus, hipDeviceAttributeMultiprocessorCount, dev) != hipSuccess) { grid = -1; return; }
        if (hipFuncSetAttribute((const void*)mk_fwd, hipFuncAttributeMaxDynamicSharedMemorySize, LDS_BYTES) != hipSuccess) { grid = -1; return; }
        (void)hipGetLastError();
        if (n_in != 17 || ws_size < WS_END) { fprintf(stderr, "kernel_launch: needs 17 inputs and %zu bytes of workspace (got %d, %zu)\n", (size_t)WS_END, n_in, ws_size); grid = -1; return; }
        grid = cus;
    }
    if (grid < 0) return;
    if (hipMemsetAsync((unsigned char*)d_ws + WS_CTL, 0, CTL_ZERO_BYTES, stream) != hipSuccess) return;
    Args a{};
    for (int i = 0; i < 17; ++i) a.in[i] = (const float*)d_in[i];
    a.out = (float*)d_out; a.ws = (unsigned char*)d_ws; a.ph_lo = 0; a.ph_hi = 10;
    hipLaunchKernelGGL(mk_fwd, dim3(grid), dim3(NWAVES * 64), LDS_BYTES, stream, a);
}
```

```cpp
#include <hip/hip_runtime.h>
#include <cstdio>
#include <cstdint>
#include <math.h>
#ifndef D_MODEL
#define D_MODEL 1024
#define BATCH 32
#define SEQ 2048
#define DEC_BATCH 16
#define DEC_SEQ 32
#define PAST_LEN 2048
#define CHUNK 64
#define A_HEADS 4
#define A_HEAD_DIM 256
#define B_HEADS 8
#define B_HEAD_DIM 128
#define IDX_HEADS 8
#define IDX_DIM 64
#define TOPK_MAX 256
#define GROUP_B 4
#endif
#define A_WIDTH (A_HEADS * A_HEAD_DIM)
#define B_WIDTH (B_HEADS * B_HEAD_DIM)
#define C_QA 0
#define C_KA (C_QA + A_WIDTH)
#define C_VA (C_KA + A_WIDTH)
#define C_OA (C_VA + A_WIDTH)
#define C_ZA (C_OA + A_WIDTH)
#define C_IA (C_ZA + A_WIDTH)
#define C_FA (C_IA + A_HEADS)
#define C_QB (C_FA + A_HEADS)
#define C_KB (C_QB + B_WIDTH)
#define C_VB (C_KB + B_WIDTH)
#define C_ZB (C_VB + B_WIDTH)
#define C_QI (C_ZB + B_WIDTH)
#define C_KI (C_QI + IDX_HEADS * IDX_DIM)
#define C_WI (C_KI + IDX_DIM)
#define C_GA (C_WI + IDX_HEADS)
#define C_GB (C_GA + D_MODEL)
#define IN_COLS (C_GB + D_MODEL)
#define LN_EPS 1e-5f
#define HEAD_NORM_EPS 1e-6f
#define DN_ALPHA 1.189207115002721f


#define GAS __attribute__((address_space(1)))
#define LAS __attribute__((address_space(3)))
typedef unsigned short bf16;
typedef unsigned v4u __attribute__((ext_vector_type(4)));
typedef float f32x4 __attribute__((ext_vector_type(4)));
typedef short bf16x8 __attribute__((ext_vector_type(8)));
typedef GAS unsigned gu32;
typedef GAS unsigned long long gu64;
#define RLX_AGENT __ATOMIC_RELAXED, __HIP_MEMORY_SCOPE_AGENT
#define LDS_WAIT() asm volatile("s_waitcnt lgkmcnt(0)" ::: "memory")
#define VM_WAIT() asm volatile("s_waitcnt vmcnt(0)" ::: "memory")
__device__ __forceinline__ unsigned long long rt() { return __builtin_amdgcn_s_memrealtime(); }
__device__ __forceinline__ unsigned f2bf(float f) { unsigned u = __builtin_bit_cast(unsigned, f); return (u + 0x7fffu + ((u >> 16) & 1u)) >> 16; }
__device__ __forceinline__ unsigned pk2(float lo, float hi) { return f2bf(lo) | (f2bf(hi) << 16); }

#define XB_TMO      128
#define XB_XCNT(j)  (256  + 64 * (j))
#define XB_XSUB(j)  (1280 + 64 * (j))
#define XB_XGEN(j)  (2304 + 64 * (j))
#define XB_TOP      3328
#define XB_TOPGEN   3392
#define XCD_BAR_WORDS 3456
#define XB_SPIN_CAP (1u << 18)

__device__ __forceinline__ unsigned xb_ld(unsigned* p)              { return __hip_atomic_load(p, __ATOMIC_RELAXED, __HIP_MEMORY_SCOPE_AGENT); }
__device__ __forceinline__ unsigned xb_add(unsigned* p, unsigned v) { return __hip_atomic_fetch_add(p, v, __ATOMIC_RELAXED, __HIP_MEMORY_SCOPE_AGENT); }
__device__ __forceinline__ unsigned xb_xcc_id() { return (unsigned)__builtin_amdgcn_s_getreg((3 << 11) | 20) & 0xFu; }
#define XB_SPIN(cond, bar) do { unsigned _sp = 0; while (cond) { __builtin_amdgcn_s_sleep(1); \
    if ((++_sp & 255u) == 0u) { if (xb_ld(&(bar)[XB_TMO])) break; if (_sp > XB_SPIN_CAP) { atomicAdd(&(bar)[XB_TMO], 1u); break; } } } } while (0)

struct XcdBarrier {
    unsigned* bar; unsigned x;
    volatile LAS unsigned* st;
};

__device__ __forceinline__ XcdBarrier xcd_barrier_post(unsigned* bar, volatile LAS unsigned* st) {
    XcdBarrier b; b.bar = bar; b.x = xb_xcc_id(); b.st = st;
    if (threadIdx.x == 0) (void)xb_add(&bar[XB_XCNT(b.x)], 1u);
    return b;
}
__device__ __forceinline__ void xcd_barrier_complete(unsigned* bar, unsigned x, unsigned& nloc, unsigned& nx) {
    const unsigned G = gridDim.x * gridDim.y * gridDim.z;
    unsigned sum, cnt, mine, sp = 0u;
    for (;;) {
        sum = 0u; cnt = 0u; mine = 0u;
#pragma unroll
        for (unsigned j = 0; j < 16; ++j) { const unsigned c = xb_ld(&bar[XB_XCNT(j)]); sum += c; cnt += (c > 0u) ? 1u : 0u; mine = (j == x) ? c : mine; }
        if (sum == G) break;
        __builtin_amdgcn_s_sleep(1);
        if ((++sp & 255u) == 0u) { if (xb_ld(&bar[XB_TMO])) break; if (sp > XB_SPIN_CAP) { atomicAdd(&bar[XB_TMO], 1u); break; } }
    }
    nloc = mine > 0u ? mine : 1u; nx = cnt > 0u ? cnt : 1u;
}

__device__ __forceinline__ void xcd_barrier(const XcdBarrier& b) {
    asm volatile("s_waitcnt vmcnt(0)" ::: "memory");
    __syncthreads();
    if (threadIdx.x == 0) {
        unsigned* bar = b.bar;
        __builtin_amdgcn_s_waitcnt(0);
        unsigned nloc = b.st[0], nx = b.st[1];
        if (nloc == 0u) { xcd_barrier_complete(bar, b.x, nloc, nx); b.st[0] = nloc; b.st[1] = nx; }
        const unsigned old = xb_add(&bar[XB_XSUB(b.x)], 1u);
        const unsigned gen = old / nloc;
        if (old + 1u == (gen + 1u) * nloc) {
            __builtin_amdgcn_fence(__ATOMIC_RELEASE, "agent");
            asm volatile("s_waitcnt vmcnt(0)" ::: "memory");
            const unsigned og = xb_add(&bar[XB_TOP], 1u);
            const unsigned tg = og / nx;
            if (og + 1u == (tg + 1u) * nx) xb_add(&bar[XB_TOPGEN], 1u);
            else XB_SPIN(xb_ld(&bar[XB_TOPGEN]) == tg, bar);
            __builtin_amdgcn_fence(__ATOMIC_ACQUIRE, "agent");
            xb_add(&bar[XB_XGEN(b.x)], 1u);
            asm volatile("s_waitcnt vmcnt(0)" ::: "memory");
        } else {
            XB_SPIN(xb_ld(&bar[XB_XGEN(b.x)]) == gen, bar);
            __builtin_amdgcn_fence(__ATOMIC_ACQUIRE, "agent");
            asm volatile("s_waitcnt vmcnt(0)" ::: "memory");
        }
    }
    __syncthreads();
}

namespace pg8 {
#define PG8_LAS __attribute__((address_space(3)))
typedef unsigned short bf16_t;
typedef short bf16x8 __attribute__((ext_vector_type(8)));
typedef float f32x4 __attribute__((ext_vector_type(4)));
typedef unsigned u32x4 __attribute__((ext_vector_type(4)));
constexpr int BM = 256, BK = 64, HALF = 128, HTB = HALF * BK * 2  , STAGE_BYTES = 8 * HTB, NXCD = 8, WGM = 8;

__host__ __device__ __forceinline__ int lds_byte(int r, int c) { const int st = (r >> 4) * 2 + (c >> 5), rr = r & 15, cc = c & 31, ob = rr * 64 + cc * 2; return st * 1024 + (ob ^ (((ob >> 9) & 1) << 5)); }
__host__ __device__ __forceinline__ void stage_rc(int b, int& R, int& C) { const int st = b / 1024, sb = b % 1024, swz = sb ^ (((sb >> 9) & 1) << 5); R = (st >> 1) * 16 + swz / 64; C = (st & 1) * 32 + (swz % 64) / 2; }
__host__ __device__ __forceinline__ int perm32(int rho) { const int n = rho >> 4, i = rho & 15; return 8 * (i >> 2) + 4 * n + (i & 3); }

struct Unit { int pm, pn; };
struct Gemm { const bf16_t* A; const bf16_t* Bt; int M, N, K; };

struct StaticOrder {
    int nM, nN, nwg, G, c;
    __host__ __device__ void init(int M, int N, int G_, int c_) { nM = M / BM; nN = N / BM; nwg = nM * nN; G = G_; c = c_; }
    __host__ __device__ bool next(int i, Unit& u) const {
        const long L = (long)i * G + c; if (L >= nwg) return false;
        int wgid = (int)L; { const int q = nwg / NXCD, r = nwg % NXCD, xcd = wgid % NXCD, off = wgid / NXCD; wgid = (xcd < r ? xcd * (q + 1) : r * (q + 1) + (xcd - r) * q) + off; }
        const int nig = WGM * nN, gid = wgid / nig, fm = gid * WGM, gsz = (nM - fm) < WGM ? (nM - fm) : WGM;
        u.pm = fm + ((wgid % nig) % gsz); u.pn = (wgid % nig) / gsz; return true;
    }
    __device__ __forceinline__ void a_ready(const Unit&) const {}
    __device__ __forceinline__ void done(const Unit&) const {}
};
__device__ __forceinline__ unsigned cvt_pk_bf16(float lo, float hi) { unsigned r; asm volatile("v_cvt_pk_bf16_f32 %0, %1, %2" : "=v"(r) : "v"(lo), "v"(hi)); return r; }
typedef float f32x2 __attribute__((ext_vector_type(2)));
template <class Epi, class Sched, bool ALIGN_EPI = false, bool SP2 = false>
__device__ __forceinline__ void gemm_phase(PG8_LAS unsigned char* lds, const Gemm g, const Sched& S, const Epi& E) {
    const int tid = threadIdx.x, wid = __builtin_amdgcn_readfirstlane(tid >> 6), lane = tid & 63, wr = wid >> 2, wc = wid & 3, fr = lane & 15, fq = lane >> 4;
    const int K = g.K, nt = K / BK;
    unsigned voffA[2], voffB[2];
#pragma unroll
    for (int i = 0; i < 2; ++i) { int R, C; stage_rc(tid * 16 + i * 8192, R, C); const int Rb = Epi::PERM ? ((R & ~31) + perm32(R & 31)) : R;
        voffA[i] = (unsigned)(R * K + C) * 2u; voffB[i] = (unsigned)(Rb * K + C) * 2u; }
    const size_t kstep = (size_t)(BK * 2);
    const size_t hstep = (size_t)HALF * K * 2;
    const size_t tstep = 2 * hstep;
    const unsigned ldsw = (unsigned)wid * 1024u;
    const int aoff = lds_byte(wr * 64 + fr, fq * 8), boff = lds_byte(wc * 32 + fr, fq * 8);
#define PG8_SA(b, h) (((b) * 2 + (h)) * HTB)
#define PG8_SB(b, h) ((4 + (b) * 2 + (h)) * HTB)
#define PG8_STAGE(bufoff, gbase, voff) do { _Pragma("unroll") for (int _i = 0; _i < 2; ++_i) \
        __builtin_amdgcn_global_load_lds((const unsigned*)((const char*)(gbase) + (voff)[_i]), (PG8_LAS unsigned*)(lds + (bufoff) + ldsw + _i * 8192), 16, 0, 0); } while (0)
#define PG8_LDA(dst, b, h) do { _Pragma("unroll") for (int m = 0; m < 4; ++m) _Pragma("unroll") for (int k = 0; k < 2; ++k) dst[m][k] = *(const PG8_LAS bf16x8*)(lds + PG8_SA(b, h) + aoff + m * 2048 + k * 1024); } while (0)
#define PG8_LDB(dst, b, h) do { _Pragma("unroll") for (int n = 0; n < 2; ++n) _Pragma("unroll") for (int k = 0; k < 2; ++k) dst[n][k] = *(const PG8_LAS bf16x8*)(lds + PG8_SB(b, h) + boff + n * 2048 + k * 1024); } while (0)
#define PG8_MMA(ai, bj, At, Bt) do { __builtin_amdgcn_s_setprio(1); _Pragma("unroll") for (int m = 0; m < 4; ++m) _Pragma("unroll") for (int n = 0; n < 2; ++n) _Pragma("unroll") for (int k = 0; k < 2; ++k) \
        acc[ai][bj][m][n] = __builtin_amdgcn_mfma_f32_16x16x32_bf16(Bt[n][k], At[m][k], acc[ai][bj][m][n], 0, 0, 0); __builtin_amdgcn_s_setprio(0); } while (0)
#define PG8_WAIT_V(n) asm volatile("s_waitcnt vmcnt(" #n ")" ::: "memory")
#define PG8_WAIT_L(n) asm volatile("s_waitcnt lgkmcnt(" #n ")" ::: "memory")
#define PG8_BAR __builtin_amdgcn_s_barrier()
#define PG8_SCHED __builtin_amdgcn_sched_barrier(0)
    Unit cur, nxt; int ui = 0;
    if (!S.next(0, cur)) return;
    f32x4 acc[2][2][4][2];
#pragma unroll
    for (int a = 0; a < 2; ++a)
#pragma unroll
        for (int b = 0; b < 2; ++b)
#pragma unroll
            for (int m = 0; m < 4; ++m)
#pragma unroll
                for (int n = 0; n < 2; ++n) acc[a][b][m][n] = (f32x4){0.f, 0.f, 0.f, 0.f};
    bf16x8 At[4][2], B0[2][2], B1[2][2];
    const char* cA = (const char*)g.A + (size_t)cur.pm * tstep; const char* cB = (const char*)g.Bt + (size_t)cur.pn * tstep;
    S.a_ready(cur);
    if constexpr (SP2) {
        PG8_STAGE(PG8_SB(0, 0), cB, voffB); PG8_STAGE(PG8_SB(0, 1), cB + hstep, voffB); PG8_STAGE(PG8_SA(0, 0), cA, voffA); PG8_STAGE(PG8_SA(0, 1), cA + hstep, voffA);
        if (wr == 1) PG8_BAR;
        PG8_WAIT_V(2); PG8_BAR;
        PG8_STAGE(PG8_SB(1, 0), cB + kstep, voffB); PG8_STAGE(PG8_SA(1, 0), cA + kstep, voffA); PG8_STAGE(PG8_SB(1, 1), cB + hstep + kstep, voffB);
        PG8_WAIT_V(6); PG8_BAR;
    } else {
        PG8_STAGE(PG8_SB(0, 0), cB, voffB); PG8_STAGE(PG8_SA(0, 0), cA, voffA); PG8_STAGE(PG8_SB(0, 1), cB + hstep, voffB); PG8_STAGE(PG8_SA(0, 1), cA + hstep, voffA);
        if (wr == 1) PG8_BAR;
        PG8_WAIT_V(4); PG8_BAR;
        PG8_STAGE(PG8_SB(1, 0), cB + kstep, voffB); PG8_STAGE(PG8_SA(1, 0), cA + kstep, voffA); PG8_STAGE(PG8_SB(1, 1), cB + hstep + kstep, voffB);
        PG8_WAIT_V(6); PG8_BAR;
    }
    for (;;) {
        const bool has_next = S.next(ui + 1, nxt);
        const char* nA = has_next ? (const char*)g.A + (size_t)nxt.pm * tstep : cA; const char* nB = has_next ? (const char*)g.Bt + (size_t)nxt.pn * tstep : cB;
        for (int t = 0; t < nt; t += 2) {
            const bool last = (t == nt - 2);
            const char* a1 = cA + (size_t)(t + 1) * kstep;
            const char* a2 = last ? nA : cA + (size_t)(t + 2) * kstep; const char* b2 = last ? nB : cB + (size_t)(t + 2) * kstep;
            const char* a3 = a2 + kstep; const char* b3 = b2 + kstep;
            if (last && has_next) S.a_ready(nxt);
            if constexpr (Epi::MIDK) { if (t == nt / 2) E.mid(acc, cur, wr, wc, fr, fq); }
            if constexpr (SP2) {
            PG8_LDB(B0, 0, 0); PG8_LDB(B1, 0, 1); PG8_SCHED; PG8_LDA(At, 0, 0); PG8_STAGE(PG8_SA(1, 1), a1 + hstep, voffA);
            PG8_WAIT_V(8); PG8_WAIT_L(0); PG8_BAR; PG8_MMA(0, 0, At, B0); PG8_MMA(0, 1, At, B1); PG8_BAR; PG8_SCHED;
            PG8_LDA(At, 0, 1); PG8_STAGE(PG8_SB(0, 0), b2, voffB); PG8_STAGE(PG8_SB(0, 1), b2 + hstep, voffB); PG8_STAGE(PG8_SA(0, 0), a2, voffA);
            PG8_WAIT_V(8); PG8_WAIT_L(0); PG8_BAR; PG8_MMA(1, 0, At, B0); PG8_MMA(1, 1, At, B1); PG8_BAR; PG8_SCHED;
            PG8_LDB(B0, 1, 0); PG8_LDB(B1, 1, 1); PG8_SCHED; PG8_LDA(At, 1, 0); PG8_STAGE(PG8_SA(0, 1), a2 + hstep, voffA);
            PG8_WAIT_V(8); PG8_WAIT_L(0); PG8_BAR; PG8_MMA(0, 0, At, B0); PG8_MMA(0, 1, At, B1); PG8_BAR; PG8_SCHED;
            PG8_LDA(At, 1, 1); PG8_STAGE(PG8_SB(1, 0), b3, voffB); PG8_STAGE(PG8_SB(1, 1), b3 + hstep, voffB); PG8_STAGE(PG8_SA(1, 0), a3, voffA);
            PG8_WAIT_V(8); PG8_WAIT_L(0); PG8_BAR; PG8_MMA(1, 0, At, B0); PG8_MMA(1, 1, At, B1); PG8_BAR; PG8_SCHED;
            } else {
            PG8_LDB(B0, 0, 0); PG8_SCHED; PG8_LDA(At, 0, 0); PG8_STAGE(PG8_SA(1, 1), a1 + hstep, voffA);
            PG8_WAIT_L(8); PG8_BAR; PG8_WAIT_L(0); PG8_MMA(0, 0, At, B0); PG8_BAR; PG8_SCHED;
            PG8_LDB(B1, 0, 1); PG8_STAGE(PG8_SB(0, 0), b2, voffB);
            PG8_BAR; PG8_WAIT_L(0); PG8_MMA(0, 1, At, B1); PG8_BAR;
            PG8_LDA(At, 0, 1); PG8_STAGE(PG8_SA(0, 0), a2, voffA);
            PG8_BAR; PG8_WAIT_L(0); PG8_MMA(1, 0, At, B0); PG8_BAR; PG8_SCHED;
            PG8_STAGE(PG8_SB(0, 1), b2 + hstep, voffB);
            PG8_WAIT_V(6); PG8_BAR; PG8_MMA(1, 1, At, B1); PG8_BAR;
            PG8_LDB(B0, 1, 0); PG8_SCHED; PG8_LDA(At, 1, 0); PG8_STAGE(PG8_SA(0, 1), a2 + hstep, voffA);
            PG8_WAIT_L(8); PG8_BAR; PG8_WAIT_L(0); PG8_MMA(0, 0, At, B0); PG8_BAR; PG8_SCHED;
            PG8_LDB(B1, 1, 1); PG8_STAGE(PG8_SB(1, 0), b3, voffB);
            PG8_BAR; PG8_WAIT_L(0); PG8_MMA(0, 1, At, B1); PG8_BAR;
            PG8_LDA(At, 1, 1); PG8_STAGE(PG8_SA(1, 0), a3, voffA);
            PG8_BAR; PG8_WAIT_L(0); PG8_MMA(1, 0, At, B0); PG8_BAR; PG8_SCHED;
            PG8_STAGE(PG8_SB(1, 1), b3 + hstep, voffB);
            PG8_WAIT_V(6); PG8_BAR; PG8_MMA(1, 1, At, B1); PG8_BAR;
            }
        }
        if constexpr (ALIGN_EPI) { if (wr == 0) PG8_BAR; }
        if constexpr (!Epi::AFTER_DRAIN) { E(acc, cur, wr, wc, fr, fq); S.done(cur); }
        if (!has_next) break;
#pragma unroll
        for (int a = 0; a < 2; ++a)
#pragma unroll
            for (int b = 0; b < 2; ++b)
#pragma unroll
                for (int m = 0; m < 4; ++m)
#pragma unroll
                    for (int n = 0; n < 2; ++n) acc[a][b][m][n] = (f32x4){0.f, 0.f, 0.f, 0.f};
        cur = nxt; cA = nA; cB = nB; ++ui;
        if constexpr (ALIGN_EPI) { if (wr == 1) PG8_BAR; }
    }
    PG8_WAIT_V(0);
    if constexpr (!ALIGN_EPI) { if (wr == 0) PG8_BAR; }
    PG8_BAR;
    if constexpr (Epi::AFTER_DRAIN) { E.fused(acc, cur, wr, wc, fr, fq, lds, wid, lane); S.done(cur); }
#undef PG8_SA
#undef PG8_SB
#undef PG8_STAGE
#undef PG8_LDA
#undef PG8_LDB
#undef PG8_MMA
#undef PG8_WAIT_V
#undef PG8_WAIT_L
#undef PG8_BAR
#undef PG8_SCHED
}
}

namespace at2 {
constexpr float SCALE = 0.08838834764831845f;
constexpr float THR = 8.f;
constexpr int NW = 8, QBLK = 32, KVBLK = 64, QB = NW * QBLK, D = 128, PITCH = 1024;
constexpr int SHM_V = KVBLK * D * 2, SHM_K = KVBLK * D * 2;
constexpr int BT_OFF = 2 * SHM_V + 2 * SHM_K + NW * 64 * 4;
constexpr int LDS_BYTES = BT_OFF + 320 * 4;
typedef short bf16x8 __attribute__((ext_vector_type(8)));
typedef short s16x4 __attribute__((ext_vector_type(4)));
typedef float f32x16 __attribute__((ext_vector_type(16)));
typedef float f32x4 __attribute__((ext_vector_type(4)));
typedef unsigned u32x4 __attribute__((ext_vector_type(4)));
typedef unsigned short bf16;

#define KSWZ(row, colB) ((row) * 256 + ((colB) ^ (((row) & 7) << 4)))
#define SBAR() __builtin_amdgcn_sched_barrier(0)
__device__ __forceinline__ int v_st(int k, int c) { const int kk = (k & ~0xC) | ((k & 4) << 1) | ((k & 8) >> 1); return ((kk >> 3) * 4 + (c >> 5)) * 512 + ((kk & 7) * 32 + (c & 31)) * 2; }
__device__ __forceinline__ int v_rd_base(int lane) { return ((lane & 3) << 3) | (((lane >> 2) & 3) << 6) | (((lane >> 4) & 1) << 5) | (((lane >> 5) & 1) << 8); }
constexpr int v_rd_off(int d0, int ks, int half) { return d0 * 512 + ks * 4096 + half * 2048; }
__device__ __forceinline__ int crow(int r, int hi) { return (r & 3) + 8 * (r >> 2) + 4 * hi; }
__device__ __forceinline__ unsigned cvtpk(float lo, float hi) { unsigned r; asm volatile("v_cvt_pk_bf16_f32 %0, %1, %2" : "=v"(r) : "v"(lo), "v"(hi)); return r; }
__device__ __forceinline__ bf16x8 load8(const bf16* p) { return *reinterpret_cast<const bf16x8*>(p); }

typedef __attribute__((address_space(3))) const float* lds_cf32;
__device__ __forceinline__ unsigned mask_compact(unsigned long long mw, int hi) { return ((unsigned)(mw >> (4 * hi)) & 0x0f0f0f0fu) | (((unsigned)(mw >> (32 + 4 * hi)) & 0x0f0f0f0fu) << 4); }
__device__ __forceinline__ void mask_bias(f32x16& p0, f32x16& p1, unsigned mwc, lds_cf32 bt, int idx0, bool far, float cfar, int hi) {
    const float NEG = -__builtin_inff();
    const unsigned w0 = mwc, w1 = mwc >> 4;
    if (far) {
#pragma unroll
        for (int r = 0; r < 16; ++r) { const int c = (r & 3) + 8 * (r >> 2);
            p0[r] = ((w0 >> c) & 1u) ? p0[r] + cfar : NEG; p1[r] = ((w1 >> c) & 1u) ? p1[r] + cfar : NEG; }
    } else { lds_cf32 b = bt + idx0;
#pragma unroll
        for (int r = 0; r < 16; ++r) { const int c = (r & 3) + 8 * (r >> 2);
            p0[r] = ((w0 >> c) & 1u) ? p0[r] + b[c] : NEG; p1[r] = ((w1 >> c) & 1u) ? p1[r] + b[c + 32] : NEG;
            if ((r & 3) == 3) asm volatile("" ::: "memory"); }
    }
}
__device__ __forceinline__ void partialSM(f32x16& p0, f32x16& p1, float& m_reg, float& mn, float& alpha) {
    float pmax = p0[0]; for (int r = 1; r < 16; ++r) pmax = fmaxf(pmax, p0[r]); for (int r = 0; r < 16; ++r) pmax = fmaxf(pmax, p1[r]);
    { auto rr = __builtin_amdgcn_permlane32_swap(__float_as_uint(pmax), __float_as_uint(pmax), false, false);
      pmax = fmaxf(__uint_as_float(rr[0]), __uint_as_float(rr[1])); }
    constexpr float C2 = 1.4426950408889634f * SCALE;
    if (__builtin_expect(__all((pmax - m_reg) * SCALE <= THR), 1)) { mn = m_reg; alpha = 1.f; }
    else { mn = fmaxf(m_reg, pmax); alpha = __builtin_amdgcn_exp2f((m_reg - mn) * C2); m_reg = mn; }
    const float mnL = -mn * C2;
    for (int r = 0; r < 16; ++r) p0[r] = fmaf(p0[r], C2, mnL); for (int r = 0; r < 16; ++r) p1[r] = fmaf(p1[r], C2, mnL);
    for (int r = 0; r < 16; ++r) p0[r] = __builtin_amdgcn_exp2f(p0[r]);
}
__device__ __forceinline__ void finishSM(f32x16& p0, f32x16& p1, float alpha, float& l_reg, bf16x8& pa0, bf16x8& pa1, bf16x8& pa2, bf16x8& pa3) {
    for (int r = 0; r < 16; ++r) p1[r] = __builtin_amdgcn_exp2f(p1[r]);
    float ps = 0; for (int r = 0; r < 16; ++r) ps += p0[r]; for (int r = 0; r < 16; ++r) ps += p1[r];
    { auto rr = __builtin_amdgcn_permlane32_swap(__float_as_uint(ps), __float_as_uint(ps), false, false);
      ps = __uint_as_float(rr[0]) + __uint_as_float(rr[1]); }
    l_reg = l_reg * alpha + ps;
#define PK4(P, B_, OUT) do { unsigned a0 = cvtpk(P[B_+0], P[B_+1]), a1 = cvtpk(P[B_+2], P[B_+3]);                          \
        unsigned b0 = cvtpk(P[B_+4], P[B_+5]), b1 = cvtpk(P[B_+6], P[B_+7]);                                             \
        auto r0 = __builtin_amdgcn_permlane32_swap(a0, b0, false, false); auto r1 = __builtin_amdgcn_permlane32_swap(a1, b1, false, false); \
        u32x4 w = {r0[0], r1[0], r0[1], r1[1]}; OUT = *reinterpret_cast<bf16x8*>(&w); } while (0)
    PK4(p0, 0, pa0); PK4(p0, 8, pa1); PK4(p1, 0, pa2); PK4(p1, 8, pa3);
#undef PK4
}
template <int KB, bool SK>
__device__ __forceinline__ void qkt(f32x16& p0, f32x16& p1, const char* K_lds, int r32, int hi, const bf16x8* qr, bool act) {
    if (SK && !act) { const float NEG = -__builtin_inff();
#pragma unroll
        for (int r = 0; r < 16; ++r) { p0[r] = NEG; p1[r] = NEG; } return; }
    p0 = f32x16{}; p1 = f32x16{};
    const char* kb[4];
#pragma unroll
    for (int dd = 0; dd < 4; ++dd) kb[dd] = K_lds + KB * SHM_K + KSWZ(r32, (dd * 16 + hi * 8) * 2);
#pragma unroll
    for (int d0 = 0; d0 < 8; ++d0) { const char* a = kb[d0 & 3] + (d0 >> 2) * 128;
        bf16x8 b0 = *reinterpret_cast<const bf16x8*>(a);
        bf16x8 b1 = *reinterpret_cast<const bf16x8*>(a + 32 * 256);
        p0 = __builtin_amdgcn_mfma_f32_32x32x16_bf16(b0, qr[d0], p0, 0, 0, 0);
        p1 = __builtin_amdgcn_mfma_f32_32x32x16_bf16(b1, qr[d0], p1, 0, 0, 0); }
}
template <int VB, bool SK>
__device__ __forceinline__ void pv_tile(f32x16* o, int vb0, bf16x8 pa0, bf16x8 pa1, bf16x8 pa2, bf16x8 pa3, bool act) {
    if (SK && !act) return;
#define TRRD(dst, off) asm volatile("ds_read_b64_tr_b16 %0, %1 offset:%2" : "=&v"(dst) : "v"(vb0), "i"(off) : "memory")
#define PV_D0(d0) do { s16x4 l0, l1, l2, l3, h0, h1, h2, h3; constexpr int b_ = VB * SHM_V + v_rd_off(d0, 0, 0); \
        TRRD(l0, b_); TRRD(h0, b_ + 2048); TRRD(l1, b_ + 4096); TRRD(h1, b_ + 6144); TRRD(l2, b_ + 8192); TRRD(h2, b_ + 10240); TRRD(l3, b_ + 12288); TRRD(h3, b_ + 14336); \
        asm volatile("s_waitcnt lgkmcnt(0)" ::: "memory"); SBAR();   \
        o[d0] = __builtin_amdgcn_mfma_f32_32x32x16_bf16(pa0, (bf16x8){l0[0], l0[1], l0[2], l0[3], h0[0], h0[1], h0[2], h0[3]}, o[d0], 0, 0, 0);   \
        o[d0] = __builtin_amdgcn_mfma_f32_32x32x16_bf16(pa1, (bf16x8){l1[0], l1[1], l1[2], l1[3], h1[0], h1[1], h1[2], h1[3]}, o[d0], 0, 0, 0);   \
        o[d0] = __builtin_amdgcn_mfma_f32_32x32x16_bf16(pa2, (bf16x8){l2[0], l2[1], l2[2], l2[3], h2[0], h2[1], h2[2], h2[3]}, o[d0], 0, 0, 0);   \
        o[d0] = __builtin_amdgcn_mfma_f32_32x32x16_bf16(pa3, (bf16x8){l3[0], l3[1], l3[2], l3[3], h3[0], h3[1], h3[2], h3[3]}, o[d0], 0, 0, 0); } while (0)
    PV_D0(0); PV_D0(1); PV_D0(2); PV_D0(3);
#undef PV_D0
#undef TRRD
}

struct Ctx { __amdgpu_buffer_rsrc_t Q, K, V, M; };
typedef unsigned v4u32 __attribute__((ext_vector_type(4))); typedef unsigned v2u32 __attribute__((ext_vector_type(2)));
#define LD16(rs, vo, so) __builtin_bit_cast(bf16x8, __builtin_amdgcn_raw_buffer_load_b128((rs), (int)(vo), (int)(so), 0))
struct Seam { bf16x8 qr[8]; bf16x8 st_v0, st_v1, st_k0, st_k1; };
#define VMW() asm volatile("s_waitcnt vmcnt(0)" ::: "memory")
#define VMWN(n) asm volatile("s_waitcnt vmcnt(%0)" :: "i"(n) : "memory")
#define SLOAD_H(k0) do { S.st_v0 = LD16(C.V, kvoff, (k0) * (PITCH * 2)); S.st_v1 = LD16(C.V, kvoff, ((k0) + 32) * (PITCH * 2));              \
                         S.st_k0 = LD16(C.K, kvoff, (k0) * (PITCH * 2)); S.st_k1 = LD16(C.K, kvoff, ((k0) + 32) * (PITCH * 2)); } while (0)
#define SWRITE_HK(bf) do { *(bf16x8*)(K_lds + (bf) * SHM_K + kws) = S.st_k0; *(bf16x8*)(K_lds + (bf) * SHM_K + kws + 32 * 256) = S.st_k1; } while (0)
#define SWRITE_HV(bf) do { *(bf16x8*)(V_lds + (bf) * SHM_V + vst0) = S.st_v0; *(bf16x8*)(V_lds + (bf) * SHM_V + vst1) = S.st_v1; } while (0)
#define SWRITE_H(bf) do { SWRITE_HV(bf); SWRITE_HK(bf); } while (0)
__device__ __forceinline__ void dsa_prime(const Ctx& C, int P0, char* lds, Seam& S) {
    int tid = threadIdx.x; asm volatile("" : "+v"(tid));
    const int wid = __builtin_amdgcn_readfirstlane(tid >> 6), lane = tid & 63, r32 = lane & 31, hi = lane >> 5;
    const int sr = tid >> 4, sc = (tid & 15) * 8, kws = KSWZ(sr, sc * 2); char* K_lds = lds + 2 * SHM_V;
    const unsigned kvoff = (unsigned)(sr * PITCH + sc) * 2u, qoff = (unsigned)((wid * QBLK + r32) * PITCH + hi * 8) * 2u;
    for (int d0 = 0; d0 < 8; ++d0) S.qr[d0] = LD16(C.Q, qoff + d0 * 32, P0 * (PITCH * 2));
    SLOAD_H(0); VMW(); SWRITE_HK(0);
    __syncthreads();
}
__device__ __forceinline__ void dsa_block(const Ctx& C, int P0, int P0n, char* lds, Seam& S, float cfar) {
    int tid = threadIdx.x; asm volatile("" : "+v"(tid));
    const int wid = __builtin_amdgcn_readfirstlane(tid >> 6), lane = tid & 63, r32 = lane & 31, hi = lane >> 5;
    const int NT = P0 / KVBLK + QB / KVBLK;
    const int qlo = P0 + wid * QBLK;
    const int limw = ((qlo >> 6) + 1) * 64;
    char* V_lds = lds; char* K_lds = lds + 2 * SHM_V;
    float* wsc = (float*)(lds + 2 * SHM_V + 2 * SHM_K) + wid * 64; float* li_l = wsc, * al_l = wsc + 32;
    lds_cf32 bt = (lds_cf32)((__attribute__((address_space(3))) char*)lds + BT_OFF);
    float m_reg = -1e30f, l_reg = 0; f32x16 o[4] = {};
    const int sr = tid >> 4, sc = (tid & 15) * 8, vst0 = v_st(sr, sc), vst1 = v_st(32 + sr, sc), kws = KSWZ(sr, sc * 2);
    const int vb0 = (int)(uintptr_t)V_lds + v_rd_base(lane);
    const unsigned kvoff = (unsigned)(sr * PITCH + sc) * 2u, qoff = (unsigned)((wid * QBLK + r32) * PITCH + hi * 8) * 2u, moff = (unsigned)((wid * QBLK + r32) * 32) * 8u;
#define MROW(t) mask_compact(__builtin_bit_cast(unsigned long long, __builtin_amdgcn_raw_buffer_load_b64(C.M, (int)moff, (P0 * 32 + (t)) * 8, 0)), hi)
    const int rel0 = 256 + 4 * hi - (qlo + r32);
#define RESC(a) do { if (__any((a) < 1.f)) { if (hi == 0) al_l[r32] = (a); asm volatile("s_waitcnt lgkmcnt(0)" ::: "memory");              \
                     for (int d_ = 0; d_ < 4; ++d_) for (int r = 0; r < 16; ++r) o[d_][r] *= al_l[crow(r, hi)]; } } while (0)
#define KBASE(t) ((t) * KVBLK)
#define ACT(t) (KBASE(t) < limw)
#define MASKT(P0_, P1_, mw_, t) do { const int kb_ = KBASE(t); if (ACT(t)) mask_bias(P0_, P1_, mw_, bt, kb_ + rel0, kb_ + KVBLK - 1 - qlo <= -128, cfar, hi); } while (0)
    constexpr int NQL = 8; constexpr bool SK = true;
#define SEAM_K0() do { VMWN(NQL); SWRITE_HK(0); SBAR(); } while (0)
    f32x16 pA0, pA1, pB0, pB1; float mnA, mnB, alA, alB; bf16x8 pa0, pa1, pa2, pa3; unsigned mw;
    SWRITE_HV(0); SBAR();
    if (NT > 1) SLOAD_H(KBASE(1));
    mw = MROW(0);
    SBAR(); qkt<0, SK>(pA0, pA1, K_lds, r32, hi, S.qr, ACT(0));
    MASKT(pA0, pA1, mw, 0); partialSM(pA0, pA1, m_reg, mnA, alA);
    if (NT > 1) { VMW(); SWRITE_H(1); }
    __syncthreads();
#define HALF_STEP(PX0, PX1, mnX, alX, PY0, PY1, alY, t, KB, VB, SB) do {                                                      \
        SBAR(); mw = MROW(t); qkt<KB, SK>(PX0, PX1, K_lds, r32, hi, S.qr, ACT(t));                                          \
        finishSM(PY0, PY1, alY, l_reg, pa0, pa1, pa2, pa3); SBAR();                                                           \
        if ((t) + 1 < NT) { SLOAD_H(KBASE((t) + 1)); SBAR(); }                                                        \
        pv_tile<VB, SK>(o, vb0, pa0, pa1, pa2, pa3, ACT((t) - 1)); MASKT(PX0, PX1, mw, (t)); partialSM(PX0, PX1, m_reg, mnX, alX); \
        __syncthreads();                                                                                                      \
        if ((t) + 1 < NT) { VMW(); SWRITE_H(SB); }                                                                            \
        RESC(alX); __syncthreads(); } while (0)
    for (int t = 1; t + 1 < NT; t += 2) {
        HALF_STEP(pB0, pB1, mnB, alB, pA0, pA1, alA, t, 1, 0, 0);
        HALF_STEP(pA0, pA1, mnA, alA, pB0, pB1, alB, t + 1, 0, 1, 1);
    }
    const bool even = (NT & 1) == 0;
    if (even) { SBAR(); mw = MROW(NT - 1); qkt<1, SK>(pB0, pB1, K_lds, r32, hi, S.qr, ACT(NT - 1)); SBAR(); }
    SLOAD_H(0); SBAR();
#pragma unroll
    for (int d0 = 0; d0 < 8; ++d0) S.qr[d0] = LD16(C.Q, qoff + d0 * 32, P0n * (PITCH * 2));
    SBAR();
    finishSM(pA0, pA1, alA, l_reg, pa0, pa1, pa2, pa3); SBAR();
    pv_tile<0, SK>(o, vb0, pa0, pa1, pa2, pa3, ACT(even ? NT - 2 : NT - 1));
    if (even) { MASKT(pB0, pB1, mw, NT - 1); partialSM(pB0, pB1, m_reg, mnB, alB); __syncthreads(); RESC(alB);
        finishSM(pB0, pB1, alB, l_reg, pa0, pa1, pa2, pa3); SBAR(); pv_tile<1, SK>(o, vb0, pa0, pa1, pa2, pa3, ACT(NT - 1)); }
    SBAR(); SEAM_K0();
    if (hi == 0) li_l[r32] = l_reg; asm volatile("s_waitcnt lgkmcnt(0)" ::: "memory");
    float rli[16];
#pragma unroll
    for (int r = 0; r < 16; ++r) rli[r] = __builtin_amdgcn_rcpf(li_l[crow(r, hi)]);
    const unsigned ooff = (unsigned)((wid * QBLK + 4 * hi) * PITCH + r32) * 2u;
#pragma unroll
    for (int r = 0; r < 16; ++r) { const int so = (P0 + (r & 3) + 8 * (r >> 2)) * (PITCH * 2);
#pragma unroll
        for (int d0 = 0; d0 < 4; ++d0) { const float v = o[d0][r] * rli[r];
            const float vn = __shfl_xor(v, 1);
            if ((r32 & 1) == 0) __builtin_amdgcn_raw_buffer_store_b32(cvtpk(v, vn), C.Q, (int)(ooff + d0 * 64), so, 0); } }
    __syncthreads();
#undef RESC
#undef MROW
#undef KBASE
#undef ACT
#undef MASKT
#undef SEAM_K0
#undef HALF_STEP
}
#undef VMW
#undef VMWN
#undef SLOAD_H
#undef SWRITE_HK
#undef SWRITE_HV
#undef SWRITE_H
#undef KSWZ
#undef SBAR
}

constexpr int NWAVES = 8;
constexpr int NTP = BATCH * SEQ, NTS = DEC_BATCH * DEC_SEQ, NTOK = NTP + NTS;
constexpr int NPM = NTOK / 256;
constexpr int N_MIX = 27 * 256, N_M1A = 12 * 256, N_M1B = 8 * 256;
static_assert(NTP % 256 == 0 && NTS % 256 == 0 && D_MODEL == 1024 && A_WIDTH == 1024 && B_WIDTH == 1024, "geometry");

constexpr size_t MiB = 1u << 20;
constexpr size_t WS_CTL = 0, CTL_ZERO_BYTES = 1 * MiB;
constexpr size_t WS_WMIX = 1 * MiB;
constexpr size_t WS_WMRG = WS_WMIX + 14 * MiB;
constexpr size_t WS_WAB  = WS_WMRG + 10 * MiB;
constexpr size_t WS_WO   = WS_WAB + 4 * MiB;
constexpr size_t WS_XB   = WS_WO + 2 * MiB;
constexpr size_t ROWBUF  = (size_t)NTOK * 1024 * 2;
constexpr size_t WS_QA   = WS_XB + ROWBUF;
constexpr size_t WS_KA   = WS_QA + ROWBUF;
constexpr size_t WS_VA   = WS_KA + ROWBUF;
constexpr size_t WS_QB   = WS_VA + ROWBUF;
constexpr size_t WS_QI   = WS_QB + ROWBUF;
constexpr size_t WS_KI   = WS_QI + 65 * MiB;
constexpr size_t WS_SM   = WS_KI + 9 * MiB;
constexpr size_t WS_MASK = WS_SM + 5 * MiB;
constexpr size_t WS_HST  = WS_MASK + 16 * MiB;
constexpr size_t WS_NAIVE = WS_HST + 3 * MiB;
constexpr size_t WS_NEED = WS_NAIVE;
static_assert(WS_WMIX + (size_t)N_MIX * 1024 * 2 <= WS_WMRG && WS_QI + (size_t)NTOK * 512 * 2 <= WS_KI && WS_KI + (size_t)NTOK * 64 * 2 <= WS_SM && WS_SM + (size_t)NTOK * 64 <= WS_MASK
              && WS_HST + (size_t)NTOK * 32 <= WS_NAIVE, "d_ws map");
constexpr int CW_BAR = 4096;
constexpr int RING_OFF = 0, RING_BYTES = 131072;
constexpr int LDS_BYTES = 147456;
constexpr int LDSCTL_OFF = LDS_BYTES - 512, MISC_OFF = LDSCTL_OFF + 320;

struct Args { const float* in[17]; float* out; unsigned char* ws; int ph_lo, ph_hi; };

__device__ __forceinline__ float bf2f(bf16 v) { return __uint_as_float((unsigned)v << 16); }
__device__ __forceinline__ float sigm(float x) { return 1.0f / (1.0f + __expf(-x)); }

__device__ __forceinline__ void tr_item(const float* W, int ldw, int c0, int nv, int k0, bf16* WT, int ldt, int r0, int kofs, LAS float* scr, int lane) {
    const int n_ = lane & 31;
#pragma unroll 8
    for (int i = 0; i < 32; ++i) { const int kk = 2 * i + (lane >> 5); scr[kk * 33 + n_] = (n_ < nv) ? W[(size_t)(k0 + kk) * ldw + c0 + n_] : 0.f; }
    LDS_WAIT(); asm volatile("" ::: "memory");
    const int c = lane & 7;
#pragma unroll
    for (int j = 0; j < 4; ++j) { const int n = (lane >> 3) + 8 * j; const LAS float* s = scr + (8 * c) * 33 + n;
        v4u o; o.x = pk2(s[0 * 33], s[1 * 33]); o.y = pk2(s[2 * 33], s[3 * 33]); o.z = pk2(s[4 * 33], s[5 * 33]); o.w = pk2(s[6 * 33], s[7 * 33]);
        if (n < nv) *(GAS v4u*)(WT + (size_t)(r0 + n) * ldt + kofs + k0 + 8 * c) = o; }
    LDS_WAIT(); asm volatile("" ::: "memory");
}
struct Seg { int src, n, dst; };
__device__ __forceinline__ Seg win_seg(int s) {
    switch (s) {
        case 0: return Seg{C_QA, 1024, 0};      case 1: return Seg{C_KA, 1024, 1024};  case 2: return Seg{C_VA, 1024, 2048};
        case 3: return Seg{C_QB, 1024, 3072};   case 4: return Seg{C_KB, 1024, 4096};  case 5: return Seg{C_VB, 1024, 5120};
        case 6: return Seg{C_QI, 512, 6144};    case 7: return Seg{C_KI, 64, 6656};    case 8: return Seg{C_WI, 8, 6720};
        case 9: return Seg{C_IA, 4, 6728};      case 10: return Seg{C_FA, 4, 6732};
        case 27: return Seg{C_ZB, 1024, 2048};  case 28: return Seg{C_GA, 1024, 3072}; case 29: return Seg{C_GB, 1024, 4096};
        default: { const int j = (s - 11) >> 1; return (s & 1) ? Seg{C_OA + 128 * j, 128, 256 * j} : Seg{C_ZA + 128 * j, 128, 256 * j + 128}; }
    }
}
struct P0Args { const float *xp, *xs, *w_in, *w_out_a, *w_out_b, *w_o; bf16 *XB, *WMIX, *WMRG, *WAB, *WO; };
__device__ __forceinline__ void p0_prologue(const P0Args& a, LAS unsigned char* lds, int vcu, int G, int wave, int lane) {
    LAS float* scr = (LAS float*)(lds + RING_OFF + wave * 16384);
    const int gw = vcu * NWAVES + wave, NGW = G * NWAVES;
    int base = 0;
    for (int s = 0; s < 30; ++s) {
        const Seg sg = win_seg(s); const int nblk = (sg.n + 31) / 32, nit = nblk * 16;
        bf16* WT = s < 11 ? a.WMIX : a.WMRG;
        for (int it = gw - (base % NGW); it < nit; it += NGW) { if (it < 0) continue; const int kb = it / nblk, nb = it % nblk; const int nv = sg.n - 32 * nb < 32 ? sg.n - 32 * nb : 32;
            tr_item(a.w_in, IN_COLS, sg.src + 32 * nb, nv, 64 * kb, WT, 1024, sg.dst + 32 * nb, 0, scr, lane); }
        base += nit;
    }
    for (int i = gw * 64 + lane; i < 176 * 128; i += NGW * 64) ((GAS v4u*)(a.WMIX + (size_t)6736 * 1024))[i] = (v4u){0u, 0u, 0u, 0u};
    for (int it = gw; it < 3 * 512; it += NGW) { const int w = it / 512, r = it % 512, kb = r / 32, nb = r % 32;
        if (w == 0) tr_item(a.w_out_a, 1024, 32 * nb, 32, 64 * kb, a.WAB, 2048, 32 * nb, 0, scr, lane);
        else if (w == 1) tr_item(a.w_out_b, 1024, 32 * nb, 32, 64 * kb, a.WAB, 2048, 32 * nb, 1024, scr, lane);
        else tr_item(a.w_o, 1024, 32 * nb, 32, 64 * kb, a.WO, 1024, 32 * nb, 0, scr, lane); }
    for (int m = gw; m < NTOK; m += NGW) {
        const float* xr = m < NTP ? a.xp + (size_t)m * 1024 : a.xs + (size_t)(m - NTP) * 1024;
        const GAS f32x4* xv = (const GAS f32x4*)xr + lane; GAS unsigned long long* o8 = (GAS unsigned long long*)(a.XB + (size_t)m * 1024) + lane;
#pragma unroll
        for (int j = 0; j < 4; ++j) { const f32x4 v = xv[64 * j]; o8[64 * j] = (unsigned long long)pk2(v.x, v.y) | ((unsigned long long)pk2(v.z, v.w) << 32); }
    }
}

namespace pg8 {
struct EpiMix {
    static constexpr bool PERM = true, AFTER_DRAIN = false, MIDK = false;
    bf16_t* QA4;
    bf16_t* KVc;
    bf16_t *QI, *KI; float* SM;
    float *okvp, *okvs;
    float *oikp, *oiks;
    __device__ __forceinline__ void mid(f32x4 (&)[2][2][4][2], const Unit&, int, int, int, int) const {}
    __device__ __forceinline__ void operator()(const f32x4 (&acc)[2][2][4][2], const Unit& u, int wr, int wc, int fr, int fq) const {
        const int pn = u.pn; const bool samp = u.pm >= NTP / 256;
        const int row0 = u.pm * BM + wr * 64 + fr, cl = wc * 32 + 8 * fq;
        if (pn < 16) {
            bf16_t* base = QA4 + (size_t)(pn >> 2) * ((size_t)NTOK * 1024); const float sc = (pn >= 4 && pn < 8) ? 0.0625f : 1.0f;
            const int col0 = (pn & 3) * 256 + cl;
#pragma unroll
            for (int ai = 0; ai < 2; ++ai)
#pragma unroll
                for (int m = 0; m < 4; ++m) { bf16_t* rowp = base + (size_t)(row0 + ai * HALF + m * 16) * 1024 + col0;
#pragma unroll
                    for (int bj = 0; bj < 2; ++bj) { const f32x4 v0 = acc[ai][bj][m][0] * sc, v1 = acc[ai][bj][m][1] * sc;
                        u32x4 w; w.x = cvt_pk_bf16(v0[0], v0[1]); w.y = cvt_pk_bf16(v0[2], v0[3]); w.z = cvt_pk_bf16(v1[0], v1[1]); w.w = cvt_pk_bf16(v1[2], v1[3]);
                        *(u32x4*)(rowp + bj * HALF) = w; } }
        } else if (pn < 24) {
            const int isV = pn >= 20 ? 1 : 0; const int col0 = (pn & 3) * 256 + cl;
            float* of = samp ? okvs + (size_t)isV * ((size_t)NTS * 1024) : okvp + (size_t)isV * ((size_t)NTP * 1024);
            bf16_t* cb = KVc + (size_t)isV * ((size_t)NTP * 1024);
#pragma unroll
            for (int ai = 0; ai < 2; ++ai)
#pragma unroll
                for (int m = 0; m < 4; ++m) { const int r = row0 + ai * HALF + m * 16; const int rr = samp ? r - NTP : r;
#pragma unroll
                    for (int bj = 0; bj < 2; ++bj) { const f32x4 v0 = acc[ai][bj][m][0], v1 = acc[ai][bj][m][1];
                        float* fp = of + (size_t)rr * 1024 + col0 + bj * HALF; *(f32x4*)fp = v0; *(f32x4*)(fp + 4) = v1;
                        if (!samp) { u32x4 w; w.x = cvt_pk_bf16(v0[0], v0[1]); w.y = cvt_pk_bf16(v0[2], v0[3]); w.z = cvt_pk_bf16(v1[0], v1[1]); w.w = cvt_pk_bf16(v1[2], v1[3]);
                            *(u32x4*)(cb + (size_t)r * 1024 + col0 + bj * HALF) = w; } } }
        } else if (pn < 26) {
            const int col0 = (pn - 24) * 256 + cl;
#pragma unroll
            for (int ai = 0; ai < 2; ++ai)
#pragma unroll
                for (int m = 0; m < 4; ++m) { bf16_t* rowp = QI + (size_t)(row0 + ai * HALF + m * 16) * 512 + col0;
#pragma unroll
                    for (int bj = 0; bj < 2; ++bj) { const f32x4 v0 = acc[ai][bj][m][0] * 0.125f, v1 = acc[ai][bj][m][1] * 0.125f;
                        u32x4 w; w.x = cvt_pk_bf16(v0[0], v0[1]); w.y = cvt_pk_bf16(v0[2], v0[3]); w.z = cvt_pk_bf16(v1[0], v1[1]); w.w = cvt_pk_bf16(v1[2], v1[3]);
                        *(u32x4*)(rowp + bj * HALF) = w; } }
        } else {
            float* oik = samp ? oiks : oikp;
#pragma unroll
            for (int ai = 0; ai < 2; ++ai)
#pragma unroll
                for (int m = 0; m < 4; ++m) { const int r = row0 + ai * HALF + m * 16; const int rr = samp ? r - NTP : r; const f32x4 v0 = acc[ai][0][m][0], v1 = acc[ai][0][m][1];
                    if (wc < 2) { float* fp = oik + (size_t)rr * 64 + cl; *(f32x4*)fp = v0; *(f32x4*)(fp + 4) = v1;
                        u32x4 w; w.x = cvt_pk_bf16(v0[0], v0[1]); w.y = cvt_pk_bf16(v0[2], v0[3]); w.z = cvt_pk_bf16(v1[0], v1[1]); w.w = cvt_pk_bf16(v1[2], v1[3]);
                        *(u32x4*)(KI + (size_t)r * 64 + cl) = w; }
                    else if (wc == 2 && fq < 2) { float* fp = SM + (size_t)r * 16 + 8 * fq; *(f32x4*)fp = v0; *(f32x4*)(fp + 4) = v1; } }
        }
    }
};
}


namespace ml {
typedef short bfx8 __attribute__((ext_vector_type(8)));
typedef short s16x4 __attribute__((ext_vector_type(4)));
typedef float f32x16 __attribute__((ext_vector_type(16)));
typedef float f32x2_t __attribute__((ext_vector_type(2))); typedef __bf16 bf16x2_t __attribute__((ext_vector_type(2)));
typedef short v4i16_t __attribute__((ext_vector_type(4)));
typedef unsigned u32x4 __attribute__((ext_vector_type(4)));
typedef unsigned u32x2 __attribute__((ext_vector_type(2)));
typedef float f32x4 __attribute__((ext_vector_type(4)));
#define MLAS __attribute__((address_space(3)))
constexpr int QP = 528, VP = 272;
constexpr int L_Q = 0, L_K = 64 * QP, L_V = 2 * 64 * QP, L_VW = L_V + 64 * VP, L_EX = L_VW + 64 * VP;
constexpr int L_G = L_EX + 32768;
constexpr int L_GW = L_G, L_GM = L_G + 256, L_GI = L_G + 512, L_GE = L_G + 768, L_GS = L_G + 1024;
constexpr int L_NV = L_G + 1280;
constexpr int L_QN = L_NV + 1024;
constexpr int L_DP = L_QN + 256;
constexpr int L_END = L_DP + 384;
__device__ __forceinline__ unsigned cvtpk(float lo, float hi) { f32x2_t v = {lo, hi}; bf16x2_t b = __builtin_convertvector(v, bf16x2_t); return __builtin_bit_cast(unsigned, b); }
__device__ __forceinline__ bfx8 pack_step(const f32x16& x, int s) {
    u32x4 p; p.x = cvtpk(x[8 * s + 0], x[8 * s + 1]); p.y = cvtpk(x[8 * s + 2], x[8 * s + 3]); p.z = cvtpk(x[8 * s + 4], x[8 * s + 5]); p.w = cvtpk(x[8 * s + 6], x[8 * s + 7]);
    return __builtin_bit_cast(bfx8, p);
}
__device__ __forceinline__ s16x4 vtr(MLAS const unsigned char* p) { return __builtin_bit_cast(s16x4, __builtin_amdgcn_ds_read_tr16_b64_v4i16((MLAS v4i16_t*)p)); }
__device__ __forceinline__ bfx8 cat8(s16x4 lo, s16x4 hi) { return (bfx8){lo[0], lo[1], lo[2], lo[3], hi[0], hi[1], hi[2], hi[3]}; }
__device__ __forceinline__ int crow(int r, int hi) { return (r & 3) + 8 * (r >> 2) + 4 * hi; }
__device__ __forceinline__ float logsig_(float x) { return fminf(x, 0.0f) - log1pf(__expf(-fabsf(x))); }
__device__ __forceinline__ float wsum_(float v) {
#pragma unroll
    for (int o = 1; o < 64; o <<= 1) v += __shfl_xor(v, o);
    return v; }
#define ML_MFMA(a, b, c) __builtin_amdgcn_mfma_f32_32x32x16_bf16((a), (b), (c), 0, 0, 0)

struct Item {
    __amdgpu_buffer_rsrc_t q, k, v;
    __amdgpu_buffer_rsrc_t sm;
    __amdgpu_buffer_rsrc_t C0, Cout;
    const float* n0; float m0; bool has0;
    float* nout; float* mout;
    int head, nchunk, L; float bi, bf;
};
#define ML_LD16(rs, vo, so) __builtin_bit_cast(u32x4, __builtin_amdgcn_raw_buffer_load_b128((rs), (int)(vo), (int)(so), 0))
#define ML_LDF(rs, vo, so) __builtin_bit_cast(float, __builtin_amdgcn_raw_buffer_load_b32((rs), (int)(vo), (int)(so), 0))

__device__ __forceinline__ void run_item(MLAS unsigned char* lds, const Item& it) {
    int tid = threadIdx.x; asm volatile("" : "+v"(tid));
    const int wave = __builtin_amdgcn_readfirstlane(tid >> 6), lane0 = tid & 63, g = wave >> 2, cb = wave & 3;
#define ML_LANE int lane = lane0; asm volatile("" : "+v"(lane)); const int r32 = lane & 31, hi = lane >> 5; (void)r32; (void)hi
    const int L = it.L, h = it.head;
    const unsigned coff = (unsigned)((lane0 >> 5) * 4096 + (lane0 & 31) * 4), qkoff = (unsigned)((tid >> 5) * 2048 + (tid & 31) * 16), voff = (unsigned)((tid >> 4) * 2048 + (tid & 15) * 16), hoff = (unsigned)((4 * (lane0 >> 5) * 1024 + (lane0 & 31)) * 2);
    f32x16 Cacc[4];
#pragma unroll
    for (int j = 0; j < 4; ++j)
#pragma unroll
        for (int i = 0; i < 16; ++i) Cacc[j][i] = it.has0 ? ML_LDF(it.C0, coff, ((128 * g + 32 * j + (i & 3) + 8 * (i >> 2)) * 256 + 32 * cb) * 4) : 0.f;
    if (tid < 256) ((MLAS float*)(lds + L_NV))[tid] = it.has0 ? it.n0[tid] : 0.f;
    float m = it.m0;
    u32x4 pq[4], pk[4], pv[2]; float pia, pfa;
#define ML_PREFETCH(c_) do { const int t0_ = (c_) * L; \
        _Pragma("unroll") for (int i = 0; i < 4; ++i) { const bool ok_ = 16 * i < L;     \
            pq[i] = ok_ ? ML_LD16(it.q, qkoff, (t0_ + 16 * i) * 2048) : (u32x4){0u, 0u, 0u, 0u}; pk[i] = ok_ ? ML_LD16(it.k, qkoff, (t0_ + 16 * i) * 2048) : (u32x4){0u, 0u, 0u, 0u}; } \
        _Pragma("unroll") for (int i = 0; i < 2; ++i) pv[i] = (32 * i < L) ? ML_LD16(it.v, voff, (t0_ + 32 * i) * 2048) : (u32x4){0u, 0u, 0u, 0u}; \
        { const int lane = lane0; const bool ok_ = lane < L; const float a_ = ML_LDF(it.sm, lane * 64, t0_ * 64 + (8 + h) * 4), f_ = ML_LDF(it.sm, lane * 64, t0_ * 64 + (12 + h) * 4); pia = ok_ ? a_ : 0.f; pfa = ok_ ? f_ : 0.f; } } while (0)
    ML_PREFETCH(0);
    for (int c = 0; c < it.nchunk; ++c) {
        float wsl, decay, mnext;
        { ML_LANE;
        float lf = (lane < L) ? logsig_(pfa + it.bf) : 0.f; float cum = lf;
#pragma unroll
        for (int o = 1; o < 64; o <<= 1) { const float t_ = __shfl_up(cum, o); if (lane >= o) cum += t_; }
        const float wv = (lane < L) ? (pia + it.bi) - cum : -INFINITY; float cmx = wv;
#pragma unroll
        for (int o = 1; o < 64; o <<= 1) { const float t_ = __shfl_up(cmx, o); if (lane >= o) cmx = fmaxf(cmx, t_); }
        const float Ml = fmaxf(m, cmx); const float M63 = __shfl(Ml, 63), cum63 = __shfl(cum, 63);
        wsl = __expf(wv - M63); decay = __expf(m - M63); mnext = cum63 + M63;
        if (wave == 0) { ((MLAS float*)(lds + L_GW))[lane] = wv; ((MLAS float*)(lds + L_GM))[lane] = Ml; ((MLAS float*)(lds + L_GI))[lane] = __expf(m - Ml);
                         ((MLAS float*)(lds + L_GE))[lane] = __expf(-(cum + Ml)); ((MLAS float*)(lds + L_GS))[lane] = wsl; } }
#pragma unroll
        for (int i = 0; i < 4; ++i) { const int p_ = tid + 512 * i, row_ = p_ >> 5, cp_ = p_ & 31;
            *(MLAS u32x4*)(lds + L_Q + row_ * QP + cp_ * 16) = pq[i]; *(MLAS u32x4*)(lds + L_K + row_ * QP + cp_ * 16) = pk[i]; }
#pragma unroll
        for (int i = 0; i < 2; ++i) { const int p_ = tid + 512 * i, row_ = p_ >> 4, cp_ = p_ & 15; const float wr_ = __shfl(wsl, row_ & 63);
            *(MLAS u32x4*)(lds + L_V + row_ * VP + cp_ * 16) = pv[i];
            u32x4 o_;
#pragma unroll
            for (int e = 0; e < 4; ++e) o_[e] = cvtpk(__uint_as_float(pv[i][e] << 16) * wr_, __uint_as_float(pv[i][e] & 0xffff0000u) * wr_);
            *(MLAS u32x4*)(lds + L_VW + row_ * VP + cp_ * 16) = o_; }
        __syncthreads();
        const int sb = g; f32x16 S0 = {}, S1 = {};
        { ML_LANE;
            MLAS const unsigned char* kp = lds + L_K + (32 * sb + r32) * QP + hi * 16; MLAS const unsigned char* q0 = lds + L_Q + r32 * QP + hi * 16; MLAS const unsigned char* q1 = q0 + 32 * QP;
#pragma unroll 4
            for (int ks = 0; ks < 16; ++ks) { const bfx8 ka = *(MLAS const bfx8*)(kp + ks * 32); const bfx8 qb1 = *(MLAS const bfx8*)(q1 + ks * 32);
                S1 = ML_MFMA(ka, qb1, S1);
                if (g == 0) { const bfx8 qb0 = *(MLAS const bfx8*)(q0 + ks * 32); S0 = ML_MFMA(ka, qb0, S0); } }
        }
        { ML_LANE;
            const float M1 = ((MLAS const float*)(lds + L_GM))[32 + r32], M0 = ((MLAS const float*)(lds + L_GM))[r32]; float d0 = 0.f, d1 = 0.f;
#pragma unroll
            for (int i = 0; i < 16; ++i) { const int sl = crow(i, hi); const float ws_ = ((MLAS const float*)(lds + L_GW))[32 * sb + sl];
                const int s_ = 32 * sb + sl;
                S1[i] = (s_ <= 32 + r32) ? S1[i] * __expf(ws_ - M1) : 0.f; d1 += S1[i];
                if (g == 0) { S0[i] = (s_ <= r32) ? S0[i] * __expf(ws_ - M0) : 0.f; d0 += S0[i]; } }
            { auto rr = __builtin_amdgcn_permlane32_swap(__float_as_uint(d1), __float_as_uint(d1), false, false); d1 = __uint_as_float(rr[0]) + __uint_as_float(rr[1]); }
            { auto rr = __builtin_amdgcn_permlane32_swap(__float_as_uint(d0), __float_as_uint(d0), false, false); d0 = __uint_as_float(rr[0]) + __uint_as_float(rr[1]); }
            if (cb == 0 && hi == 0) { if (g == 0) { ((MLAS float*)(lds + L_DP))[r32] = d0; ((MLAS float*)(lds + L_DP))[32 + r32] = d1; } else ((MLAS float*)(lds + L_DP))[64 + r32] = d1; }
        }
        f32x16 Y0 = {}, Y1 = {};
        { ML_LANE;
#pragma unroll
        for (int j = 0; j < 4; ++j)
#pragma unroll
            for (int ks = 0; ks < 2; ++ks) { const bfx8 xs = pack_step(Cacc[j], ks);
                MLAS const unsigned char* qa = lds + L_Q + r32 * QP + (128 * g + 32 * j + 16 * ks + 4 * hi) * 2;
                const u32x2 a0l = *(MLAS const u32x2*)(qa), a0h = *(MLAS const u32x2*)(qa + 16), a1l = *(MLAS const u32x2*)(qa + 32 * QP), a1h = *(MLAS const u32x2*)(qa + 32 * QP + 16);
                const bfx8 pa0 = __builtin_bit_cast(bfx8, (u32x4){a0l.x, a0l.y, a0h.x, a0h.y}), pa1 = __builtin_bit_cast(bfx8, (u32x4){a1l.x, a1l.y, a1h.x, a1h.y});
                Y0 = ML_MFMA(pa0, xs, Y0); Y1 = ML_MFMA(pa1, xs, Y1); }
#pragma unroll
        for (int i = 0; i < 16; ++i) { Y0[i] *= ((MLAS const float*)(lds + L_GI))[crow(i, hi)]; Y1[i] *= ((MLAS const float*)(lds + L_GI))[32 + crow(i, hi)]; } }
        { ML_LANE;
            const int i16 = lane & 15, q_ = i16 >> 2, p_ = i16 & 3, gi = lane >> 4;
            MLAS const unsigned char* vb = lds + L_V + (32 * sb + 4 * hi + q_) * VP + (32 * cb + 16 * (gi & 1) + 4 * p_) * 2;
#pragma unroll
            for (int ks = 0; ks < 2; ++ks) { const bfx8 pb = cat8(vtr(vb + (16 * ks) * VP), vtr(vb + (16 * ks + 8) * VP));
                Y1 = ML_MFMA(pack_step(S1, ks), pb, Y1);
                if (g == 0) Y0 = ML_MFMA(pack_step(S0, ks), pb, Y0); }
        }
        { ML_LANE;
            const f32x4 nv = *(MLAS const f32x4*)(lds + L_NV + lane * 16);
#pragma unroll
            for (int rr_ = 0; rr_ < 8; ++rr_) { const int l_ = 8 * wave + rr_; const u32x2 qw = *(MLAS const u32x2*)(lds + L_Q + l_ * QP + lane * 8);
                float d_ = __uint_as_float(qw.x << 16) * nv.x + __uint_as_float(qw.x & 0xffff0000u) * nv.y + __uint_as_float(qw.y << 16) * nv.z + __uint_as_float(qw.y & 0xffff0000u) * nv.w;
                d_ = wsum_(d_); if (lane == 0) ((MLAS float*)(lds + L_QN))[l_] = d_; }
        }
        { ML_LANE;
            MLAS float* ex = (MLAS float*)(lds + L_EX + ((1 - g) * 4 + cb) * 4096) + lane;
#pragma unroll
            for (int i = 0; i < 16; ++i) ex[i * 64] = (g == 0) ? Y1[i] : Y0[i];
        }
        __syncthreads();
        if (c + 1 < it.nchunk) ML_PREFETCH(c + 1);
        { ML_LANE;
            MLAS const float* ex = (MLAS const float*)(lds + L_EX + (g * 4 + cb) * 4096) + lane; f32x16 Y = (g == 0) ? Y0 : Y1;
#pragma unroll
            for (int i = 0; i < 16; ++i) Y[i] += ex[i * 64];
#pragma unroll
            for (int i = 0; i < 16; ++i) { const int l_ = 32 * g + crow(i, hi);
                const float dsum = (g == 0) ? ((MLAS const float*)(lds + L_DP))[l_] : ((MLAS const float*)(lds + L_DP))[l_] + ((MLAS const float*)(lds + L_DP))[32 + l_];
                const float den = dsum + ((MLAS const float*)(lds + L_GI))[l_] * ((MLAS const float*)(lds + L_QN))[l_];
                const float hv = Y[i] / fmaxf(fabsf(den), ((MLAS const float*)(lds + L_GE))[l_]);
                const float hn = __shfl_xor(hv, 1);
                if (32 * g < L && (r32 & 1) == 0) __builtin_amdgcn_raw_buffer_store_b32(cvtpk(hv, hn), it.v, (int)hoff, ((c * L + 32 * g + (i & 3) + 8 * (i >> 2)) * 1024 + 32 * cb) * 2, 0); }
        }
        if (tid < 256) { float a_ = 0.f;
#pragma unroll 8
            for (int s = 0; s < 64; ++s) a_ += ((MLAS const float*)(lds + L_GS))[s] * bf2f(*(MLAS const unsigned short*)(lds + L_K + s * QP + tid * 2));
            ((MLAS float*)(lds + L_NV))[tid] = decay * ((MLAS const float*)(lds + L_NV))[tid] + a_; }
        { ML_LANE;
            const int i16 = lane & 15, q_ = i16 >> 2, p_ = i16 & 3, gi = lane >> 4;
            MLAS const unsigned char* kb_ = lds + L_K + (8 * hi + q_) * QP + (128 * g + 16 * (gi & 1) + 4 * p_) * 2;
            MLAS const unsigned char* vw_ = lds + L_VW + (8 * hi + q_) * VP + (32 * cb + 16 * (gi & 1) + 4 * p_) * 2;
#pragma unroll
            for (int j = 0; j < 4; ++j)
#pragma unroll
                for (int i = 0; i < 16; ++i) Cacc[j][i] *= decay;
#pragma unroll
            for (int ks = 0; ks < 4; ++ks) { const bfx8 vb_ = cat8(vtr(vw_ + (16 * ks) * VP), vtr(vw_ + (16 * ks + 4) * VP));
#pragma unroll
                for (int j = 0; j < 4; ++j) { const bfx8 ka_ = cat8(vtr(kb_ + (16 * ks) * QP + 64 * j), vtr(kb_ + (16 * ks + 4) * QP + 64 * j));
                    Cacc[j] = ML_MFMA(ka_, vb_, Cacc[j]); } }
        }
        m = mnext;
        __syncthreads();
    }
#undef ML_PREFETCH
#undef ML_LANE
#pragma unroll
    for (int j = 0; j < 4; ++j)
#pragma unroll
        for (int i = 0; i < 16; ++i) __builtin_amdgcn_raw_buffer_store_b32(__float_as_uint(Cacc[j][i]), it.Cout, (int)coff, ((128 * g + 32 * j + (i & 3) + 8 * (i >> 2)) * 256 + 32 * cb) * 4, 0);
    if (it.nout && tid < 256) it.nout[tid] = ((MLAS const float*)(lds + L_NV))[tid];
    if (it.mout && tid == 0) *it.mout = m;
    __syncthreads();
}
#undef ML_MFMA
#undef ML_LD16
#undef ML_LDF
#undef MLAS
}

constexpr size_t WS_BC = WS_NAIVE, WS_WV = WS_BC + 2 * MiB, WS_CMX = WS_WV + 2 * MiB;
constexpr size_t WS_CHS = WS_CMX + 2 * MiB;
constexpr size_t WS_SMAT = WS_CHS + 1 * MiB;
constexpr size_t WS_CB = WS_SMAT + 3 * MiB;
constexpr size_t WS_NB = WS_CB + 64 * MiB;
constexpr size_t WS_MASKS = WS_NB + 1 * MiB;
constexpr size_t WS_HA = WS_MASKS + 1 * MiB;
constexpr size_t WS_END = WS_HA + ROWBUF;
constexpr int NCHK = BATCH * 4 * 32 + DEC_BATCH * 4;

__device__ __forceinline__ float logsig(float x) { return fminf(x, 0.0f) - log1pf(__expf(-fabsf(x))); }
__device__ __forceinline__ float siluf(float x) { return x / (1.0f + __expf(-x)); }
__device__ __forceinline__ int t5b(int rel) { const int n = rel < 0 ? -rel : rel; const int v = n < 8 ? n : 8 + (n >= 12) + (n >= 16) + (n >= 23) + (n >= 32) + (n >= 46) + (n >= 64) + (n >= 91); return (rel > 0 ? 16 : 0) + v; }

namespace pg8 {
__device__ __forceinline__ void unpack8(u32x4 w, float (&f)[8]) {
    f[0] = __uint_as_float(w.x << 16); f[1] = __uint_as_float(w.x & 0xffff0000u); f[2] = __uint_as_float(w.y << 16); f[3] = __uint_as_float(w.y & 0xffff0000u);
    f[4] = __uint_as_float(w.z << 16); f[5] = __uint_as_float(w.z & 0xffff0000u); f[6] = __uint_as_float(w.w << 16); f[7] = __uint_as_float(w.w & 0xffff0000u);
}
__device__ __forceinline__ u32x4 pack8f(const float (&f)[8]) { u32x4 w; w.x = cvt_pk_bf16(f[0], f[1]); w.y = cvt_pk_bf16(f[2], f[3]); w.z = cvt_pk_bf16(f[4], f[5]); w.w = cvt_pk_bf16(f[6], f[7]); return w; }
__device__ __forceinline__ float sg_(float x) { return 1.0f / (1.0f + __expf(-x)); }
struct EpiM1a {
    static constexpr bool PERM = true, AFTER_DRAIN = false, MIDK = false;
    const bf16_t* HA; const bf16_t* OB; const float* HST; const float* ang; bf16_t* BR;
    __device__ __forceinline__ void mid(f32x4 (&)[2][2][4][2], const Unit&, int, int, int, int) const {}
    __device__ __forceinline__ void operator()(const f32x4 (&acc)[2][2][4][2], const Unit& u, int wr, int wc, int fr, int fq) const {
        const int pn = u.pn; const int row0 = u.pm * BM + wr * 64 + fr, cl = wc * 32 + 8 * fq;
        if (pn < 8) {
            const int ch0 = 128 * pn + cl, head = pn >> 1;
            const f32x4 g0 = *(const f32x4*)(ang + ch0), g1 = *(const f32x4*)(ang + ch0 + 4);
            const float g[8] = {g0[0], g0[1], g0[2], g0[3], g1[0], g1[1], g1[2], g1[3]};
#pragma unroll
            for (int ai = 0; ai < 2; ++ai)
#pragma unroll
                for (int m = 0; m < 4; ++m) { const int r = row0 + ai * HALF + m * 16;
                    float h[8]; unpack8(*(const u32x4*)(HA + (size_t)r * 1024 + ch0), h);
                    const float mean = HST[((size_t)r * 4 + head) * 2], rstd = HST[((size_t)r * 4 + head) * 2 + 1];
                    const f32x4 o0 = acc[ai][0][m][0], o1 = acc[ai][0][m][1], z0 = acc[ai][1][m][0], z1 = acc[ai][1][m][1];
                    const float oa[8] = {o0[0], o0[1], o0[2], o0[3], o1[0], o1[1], o1[2], o1[3]}, za[8] = {z0[0], z0[1], z0[2], z0[3], z1[0], z1[1], z1[2], z1[3]};
                    float o[8];
#pragma unroll
                    for (int i = 0; i < 8; ++i) o[i] = ((h[i] - mean) * rstd * g[i] * sg_(oa[i])) * (za[i] * sg_(za[i]));
                    *(u32x4*)(BR + (size_t)r * 2048 + ch0) = pack8f(o); }
        } else {
#pragma unroll
            for (int ai = 0; ai < 2; ++ai)
#pragma unroll
                for (int m = 0; m < 4; ++m) { const int r = row0 + ai * HALF + m * 16;
#pragma unroll
                    for (int bj = 0; bj < 2; ++bj) { const int ch0 = 256 * (pn - 8) + 128 * bj + cl;
                        float ob[8]; unpack8(*(const u32x4*)(OB + (size_t)r * 1024 + ch0), ob);
                        const f32x4 z0 = acc[ai][bj][m][0], z1 = acc[ai][bj][m][1]; const float zb[8] = {z0[0], z0[1], z0[2], z0[3], z1[0], z1[1], z1[2], z1[3]};
                        float o[8];
#pragma unroll
                        for (int i = 0; i < 8; ++i) o[i] = ob[i] * (zb[i] * sg_(zb[i]));
                        *(u32x4*)(BR + (size_t)r * 2048 + 1024 + ch0) = pack8f(o); } }
        }
    }
};
struct EpiM1b {
    static constexpr bool PERM = true, AFTER_DRAIN = false, MIDK = false;
    bf16_t* SGA; bf16_t* SGB;
    __device__ __forceinline__ void mid(f32x4 (&)[2][2][4][2], const Unit&, int, int, int, int) const {}
    __device__ __forceinline__ void operator()(const f32x4 (&acc)[2][2][4][2], const Unit& u, int wr, int wc, int fr, int fq) const {
        const int pn = u.pn; const int row0 = u.pm * BM + wr * 64 + fr, cl = wc * 32 + 8 * fq;
        bf16_t* base = pn < 4 ? SGA : SGB; const int col0 = (pn & 3) * 256 + cl;
#pragma unroll
        for (int ai = 0; ai < 2; ++ai)
#pragma unroll
            for (int m = 0; m < 4; ++m) { bf16_t* rowp = base + (size_t)(row0 + ai * HALF + m * 16) * 1024 + col0;
#pragma unroll
                for (int bj = 0; bj < 2; ++bj) { const f32x4 v0 = acc[ai][bj][m][0], v1 = acc[ai][bj][m][1];
                    const float o[8] = {sg_(v0[0]), sg_(v0[1]), sg_(v0[2]), sg_(v0[3]), sg_(v1[0]), sg_(v1[1]), sg_(v1[2]), sg_(v1[3])};
                    *(u32x4*)(rowp + bj * HALF) = pack8f(o); } }
    }
};
struct EpiM2 {
    static constexpr bool PERM = true, AFTER_DRAIN = false, MIDK = true;
    const bf16_t* SGA; const bf16_t* SGB; bf16_t* MX;
    __device__ __forceinline__ void mid(f32x4 (&acc)[2][2][4][2], const Unit& u, int wr, int wc, int fr, int fq) const {
        int fr_ = fr, fq_ = fq; asm volatile("" : "+v"(fr_), "+v"(fq_));
        const int row0 = u.pm * BM + wr * 64 + fr_, col0 = u.pn * BM + wc * 32 + 8 * fq_;
#pragma unroll
        for (int ai = 0; ai < 2; ++ai)
#pragma unroll
            for (int m = 0; m < 4; ++m) { const size_t ro = (size_t)(row0 + ai * HALF + m * 16) * 1024 + col0;
#pragma unroll
                for (int bj = 0; bj < 2; ++bj) { float a[8], b[8]; unpack8(*(const u32x4*)(SGA + ro + bj * HALF), a); unpack8(*(const u32x4*)(SGB + ro + bj * HALF), b);
#pragma unroll
                    for (int i = 0; i < 4; ++i) { acc[ai][bj][m][0][i] *= a[i] * __builtin_amdgcn_rcpf(b[i]); acc[ai][bj][m][1][i] *= a[4 + i] * __builtin_amdgcn_rcpf(b[4 + i]); } }
                asm volatile("" ::: "memory"); }
    }
    __device__ __forceinline__ void operator()(const f32x4 (&acc)[2][2][4][2], const Unit& u, int wr, int wc, int fr, int fq) const {
        int fr_ = fr, fq_ = fq; asm volatile("" : "+v"(fr_), "+v"(fq_));
        const int row0 = u.pm * BM + wr * 64 + fr_, col0 = u.pn * BM + wc * 32 + 8 * fq_;
#pragma unroll
        for (int ai = 0; ai < 2; ++ai)
#pragma unroll
            for (int m = 0; m < 4; ++m) { const size_t ro = (size_t)(row0 + ai * HALF + m * 16) * 1024 + col0;
#pragma unroll
                for (int bj = 0; bj < 2; ++bj) { float b[8]; unpack8(*(const u32x4*)(SGB + ro + bj * HALF), b);
                    const f32x4 v0 = acc[ai][bj][m][0], v1 = acc[ai][bj][m][1];
                    const float o[8] = {v0[0] * b[0], v0[1] * b[1], v0[2] * b[2], v0[3] * b[3], v1[0] * b[4], v1[1] * b[5], v1[2] * b[6], v1[3] * b[7]};
                    *(u32x4*)(MX + ro + bj * HALF) = pack8f(o); }
                asm volatile("" ::: "memory"); }
    }
};
struct EpiM3 {
    static constexpr bool PERM = true, AFTER_DRAIN = false, MIDK = false;
    const float* xp; const float* xs; float* yp; float* ys;
    __device__ __forceinline__ void mid(f32x4 (&)[2][2][4][2], const Unit&, int, int, int, int) const {}
    __device__ __forceinline__ void operator()(const f32x4 (&acc)[2][2][4][2], const Unit& u, int wr, int wc, int fr, int fq) const {
        const bool samp = u.pm >= NTP / 256; const int row0 = (samp ? u.pm - NTP / 256 : u.pm) * BM + wr * 64 + fr, col0 = u.pn * BM + wc * 32 + 8 * fq;
        const float* xb = samp ? xs : xp; float* yb = samp ? ys : yp;
#pragma unroll
        for (int ai = 0; ai < 2; ++ai)
#pragma unroll
            for (int m = 0; m < 4; ++m) { const size_t ro = (size_t)(row0 + ai * HALF + m * 16) * 1024 + col0;
#pragma unroll
                for (int bj = 0; bj < 2; ++bj) { const f32x4 x0 = *(const f32x4*)(xb + ro + bj * HALF), x1 = *(const f32x4*)(xb + ro + bj * HALF + 4);
                    *(f32x4*)(yb + ro + bj * HALF) = x0 * DN_ALPHA + acc[ai][bj][m][0]; *(f32x4*)(yb + ro + bj * HALF + 4) = x1 * DN_ALPHA + acc[ai][bj][m][1]; } }
    }
};
}

__device__ __forceinline__ float wave_sum(float v) {
#pragma unroll
    for (int o = 1; o < 64; o <<= 1) v += __shfl_xor(v, o);
    return v;
}

__device__ __forceinline__ void simple_select_row(LAS unsigned char* lds, int row, unsigned long long* mrow, const bf16* QI_, const float* SM_, const bf16* KI_, const float* cache_ik_) {
    const int tid_ = threadIdx.x, lane_ = tid_ & 63, wave_ = tid_ >> 6;
    LAS float* sc = (LAS float*)(lds + RING_OFF);
    LAS float* qv = (LAS float*)(lds + RING_OFF + 16384);
    const bool samp = row >= NTP; const int b = samp ? (row - NTP) / DEC_SEQ : row / SEQ; const int q = samp ? (row - NTP) % DEC_SEQ : row % SEQ;
    const int S = samp ? PAST_LEN + DEC_SEQ : ((q >> 6) + 1) * 64;
    if (S <= TOPK_MAX) { if (tid_ < 32) mrow[tid_] = (tid_ < (S >> 6)) ? ~0ull : 0ull; return; }
    qv[tid_] = bf2f(QI_[(size_t)row * 512 + tid_]); if (tid_ < 8) qv[512 + tid_] = SM_[(size_t)row * 16 + tid_] * 0.35355339059327373f;
    __syncthreads();
    const int nIt = (S + 511) / 512;
    for (int i = 0; i < nIt; ++i) { const int s = tid_ + 512 * i;
        if (s < S) { float kf[64];
            if (samp && s < PAST_LEN) { const float* kr = cache_ik_ + ((size_t)b * PAST_LEN + s) * 64;
#pragma unroll
                for (int j = 0; j < 64; ++j) kf[j] = kr[j]; }
            else { const bf16* kr = KI_ + (samp ? (size_t)NTP + (size_t)b * DEC_SEQ + (s - PAST_LEN) : (size_t)b * SEQ + s) * 64;
#pragma unroll
                for (int j = 0; j < 64; ++j) kf[j] = bf2f(kr[j]); }
            float a = 0.f;
#pragma unroll
            for (int h = 0; h < 8; ++h) { float d = 0.f;
#pragma unroll
                for (int j = 0; j < 64; ++j) d += qv[h * 64 + j] * kf[j];
                a += qv[512 + h] * fmaxf(d, 0.f); }
            sc[s] = a; } }
    __syncthreads();
    for (int i = 0; i < nIt; ++i) { const int s = tid_ + 512 * i; bool keep = false;
        if (s < S) { const int v = __float_as_int(sc[s]); const int vk = v ^ ((v >> 31) & 0x7fffffff); int rank = 0;
            for (int j = 0; j < S; ++j) { const int u = __float_as_int(sc[j]); const int uk = u ^ ((u >> 31) & 0x7fffffff); rank += (uk > vk) || (uk == vk && j < s); } keep = rank < TOPK_MAX; }
        const unsigned long long bm = __ballot(keep);
        if (lane_ == 0 && (wave_ + 8 * i) * 64 < S) mrow[wave_ + 8 * i] = bm; }
    if (!samp) { const int nw = S >> 6; if (tid_ >= nw && tid_ < 32) mrow[tid_] = 0ull; }
    __syncthreads();
}
__device__ __forceinline__ void simple_attn_task(int row, int h, int dc, const unsigned long long* mrow, const bf16* QB_, const bf16* KBc_, const bf16* VBc_, const float* cache_k_, const float* cache_v_,
                                                  const float* k_sample_, const float* v_sample_, const float* rel_bias_, bf16* orow) {
    const bool samp = row >= NTP; const int b = samp ? (row - NTP) / DEC_SEQ : row / SEQ; const int q = samp ? (row - NTP) % DEC_SEQ : row % SEQ;
    const int S = samp ? PAST_LEN + DEC_SEQ : ((q >> 6) + 1) * 64; const int qpos = samp ? PAST_LEN + q : q;
    const bf16* qr = QB_ + (size_t)row * 1024 + h * 128;
    float mx = -INFINITY, sum = 0.f, o[16];
#pragma unroll
    for (int i = 0; i < 16; ++i) o[i] = 0.f;
    for (int w = 0; w * 64 < S; ++w) { unsigned long long bits = mrow[w];
        while (bits) { const int s = w * 64 + __builtin_ctzll(bits); bits &= bits - 1;
            float d = 0.f; float vv[16];
            if (samp) { const float* kr = (s < PAST_LEN) ? cache_k_ + ((size_t)b * PAST_LEN + s) * 1024 + h * 128 : k_sample_ + ((size_t)b * DEC_SEQ + (s - PAST_LEN)) * 1024 + h * 128;
                const float* vr = (s < PAST_LEN) ? cache_v_ + ((size_t)b * PAST_LEN + s) * 1024 + h * 128 + dc * 16 : v_sample_ + ((size_t)b * DEC_SEQ + (s - PAST_LEN)) * 1024 + h * 128 + dc * 16;
#pragma unroll 8
                for (int j = 0; j < 128; ++j) d += bf2f(qr[j]) * kr[j];
#pragma unroll
                for (int i = 0; i < 16; ++i) vv[i] = vr[i]; }
            else { const bf16* kr = KBc_ + ((size_t)b * SEQ + s) * 1024 + h * 128; const bf16* vr = VBc_ + ((size_t)b * SEQ + s) * 1024 + h * 128 + dc * 16;
#pragma unroll 8
                for (int j = 0; j < 128; ++j) d += bf2f(qr[j]) * bf2f(kr[j]);
#pragma unroll
                for (int i = 0; i < 16; ++i) vv[i] = bf2f(vr[i]); }
            const float lg = d * 0.08838834764831845f + rel_bias_[t5b(s - qpos) * 8 + h];
            if (lg > mx) { const float f = __expf(mx - lg); sum *= f;
#pragma unroll
                for (int i = 0; i < 16; ++i) o[i] *= f; mx = lg; }
            const float p = __expf(lg - mx); sum += p;
#pragma unroll
            for (int i = 0; i < 16; ++i) o[i] += p * vv[i]; } }
    const float inv = 1.0f / sum;
#pragma unroll
    for (int i = 0; i < 16; ++i) orow[i] = (bf16)f2bf(o[i] * inv);
}

typedef const __attribute__((address_space(4))) Args* kargp_t;
#define MK_ARGS kargp_t ap_ = (kargp_t)__builtin_amdgcn_kernarg_segment_ptr(); asm volatile("" : "+s"(ap_))
#define args (*ap_)
__global__ void __launch_bounds__(NWAVES * 64, 2) mk_fwd(Args kargs_by_value) {
    extern __shared__ __attribute__((aligned(16))) unsigned char lds_raw[];
    LAS unsigned char* lds = (LAS unsigned char*)lds_raw;
    int lo, hi; unsigned* barw;
    { MK_ARGS; lo = args.ph_lo; hi = args.ph_hi; barw = (unsigned*)((gu32*)(args.ws + WS_CTL) + CW_BAR); }
    volatile LAS unsigned* MISC = (volatile LAS unsigned*)(lds + MISC_OFF);
    for (int u = threadIdx.x; u < (LDS_BYTES - LDSCTL_OFF) / 4; u += NWAVES * 64) ((LAS unsigned*)(lds + LDSCTL_OFF))[u] = 0u;
    __syncthreads();
    XcdBarrier bar = xcd_barrier_post(barw, MISC + 8);
#ifndef PHMASK
#define PHMASK 0x3ff
#endif
#define IN(k) (((PHMASK >> (k)) & 1) && lo <= (k) && (k) < hi)
#define GBAR() xcd_barrier(bar)
#define WMIX ((bf16*)(args.ws + WS_WMIX))
#define WMRG ((bf16*)(args.ws + WS_WMRG))
#define WAB ((bf16*)(args.ws + WS_WAB))
#define WO ((bf16*)(args.ws + WS_WO))
#define XB ((bf16*)(args.ws + WS_XB))
#define QA ((bf16*)(args.ws + WS_QA))
#define KA ((bf16*)(args.ws + WS_KA))
#define VA ((bf16*)(args.ws + WS_VA))
#define QB ((bf16*)(args.ws + WS_QB))
#define QI ((bf16*)(args.ws + WS_QI))
#define KI ((bf16*)(args.ws + WS_KI))
#define SM ((float*)(args.ws + WS_SM))
#define MASK ((unsigned long long*)(args.ws + WS_MASK))
#define MASKS ((unsigned long long*)(args.ws + WS_MASKS))
#define HST ((float*)(args.ws + WS_HST))
#define BC ((float*)(args.ws + WS_BC))
#define WV ((float*)(args.ws + WS_WV))
#define CMX ((float*)(args.ws + WS_CMX))
#define CHS ((float*)(args.ws + WS_CHS))
#define MCH (CHS + 2 * NCHK)
#define SMATP ((float*)(args.ws + WS_SMAT))
#define SMATS (SMATP + 128 * 4096)
#define CB ((float*)(args.ws + WS_CB))
#define NBf ((float*)(args.ws + WS_NB))
#define HA VA
#define OB QB
#define BR QA
#define SGA VA
#define SGB QB
#define MX XB
#define y_prompt (args.out)
#define y_sample (y_prompt + (size_t)NTP * 1024)
#define k_prompt (y_sample + (size_t)NTS * 1024)
#define v_prompt (k_prompt + (size_t)NTP * 1024)
#define ik_prompt (v_prompt + (size_t)NTP * 1024)
#define C_prompt (ik_prompt + (size_t)NTP * 64)
#define n_prompt (C_prompt + (size_t)BATCH * 4 * 65536)
#define m_prompt (n_prompt + (size_t)BATCH * 1024)
#define k_sample (m_prompt + BATCH * 4)
#define v_sample (k_sample + (size_t)NTS * 1024)
#define ik_sample (v_sample + (size_t)NTS * 1024)
#define C_sample (ik_sample + (size_t)NTS * 64)
#define n_sample (C_sample + (size_t)DEC_BATCH * 4 * 65536)
#define m_sample (n_sample + (size_t)DEC_BATCH * 1024)
#define KBc ((bf16*)y_prompt)
#define VBc (KBc + (size_t)NTP * 1024)
#define cache_k (args.in[2])
#define cache_v (args.in[3])
#define cache_ik (args.in[4])
#define state_C (args.in[5])
#define state_n (args.in[6])
#define state_m (args.in[7])
#define b_gates (args.in[9])
#define a_norm_g (args.in[10])
#define rel_bias (args.in[14])
#define ln_g (args.in[15])
#define ln_b (args.in[16])
#define gtid ({ int t__ = (int)threadIdx.x; asm volatile("" : "+v"(t__)); (long)blockIdx.x * (NWAVES * 64) + (long)t__; })
#define GT ((long)gridDim.x * (NWAVES * 64))
#define gw (vcu * NWAVES + wave)
#define NGW ((int)gridDim.x * NWAVES)
#define tid ((int)threadIdx.x)
#define lane ((int)(threadIdx.x & 63))
#define wave (__builtin_amdgcn_readfirstlane((int)(threadIdx.x >> 6)))
#define G ((int)gridDim.x)
#define vcu ((G % 8 == 0) ? ((int)blockIdx.x % 8) * (G / 8) + (int)blockIdx.x / 8 : (int)blockIdx.x)

    if (IN(0)) { MK_ARGS;
        P0Args a{args.in[0], args.in[1], args.in[8], args.in[11], args.in[12], args.in[13], XB, WMIX, WMRG, WAB, WO};
        p0_prologue(a, lds, vcu, G, wave, lane);
        GBAR();
    }
    if (IN(1)) { MK_ARGS;
        pg8::Gemm g{XB, WMIX, NTOK, N_MIX, 1024}; pg8::StaticOrder S; S.init(NTOK, N_MIX, G, (int)blockIdx.x);
        pg8::EpiMix E{QA, KBc, QI, KI, SM, k_prompt, k_sample, ik_prompt, ik_sample};
        pg8::gemm_phase<pg8::EpiMix, pg8::StaticOrder, true, true>(lds + RING_OFF, g, S, E);
        GBAR();
    }
    if (IN(2)) { MK_ARGS;
        static_assert(ml::L_END <= LDSCTL_OFF, "mLSTM LDS image");
#ifdef PROBE_ML
#define HAREF ((bf16*)(args.ws + WS_HA))
        for (long t = gtid; t < NCHK; t += GT) {
            int h, L; long tok0;
            if (t < 4096) { const int b = (int)(t >> 7); h = (int)((t >> 5) & 3); const int c = (int)(t & 31); tok0 = (long)b * SEQ + c * 64; L = 64; }
            else { const int b = (int)((t - 4096) >> 2); h = (int)((t - 4096) & 3); tok0 = NTP + (long)b * DEC_SEQ; L = DEC_SEQ; }
            const float bi = b_gates[h], bfg = b_gates[4 + h]; float cum = 0.f, cmax = -INFINITY;
            for (int l = 0; l < L; ++l) { const long tok = tok0 + l; const float ig = SM[tok * 16 + 8 + h] + bi; const float lf = logsig(SM[tok * 16 + 12 + h] + bfg);
                cum += lf; const float w = ig - cum; cmax = fmaxf(cmax, w); BC[tok * 4 + h] = cum; WV[tok * 4 + h] = w; CMX[tok * 4 + h] = cmax; }
            CHS[2 * t] = cum; CHS[2 * t + 1] = cmax;
        }
        GBAR();
        for (long t = gtid; t < BATCH * 4 + DEC_BATCH * 4; t += GT) {
            if (t < BATCH * 4) { float m = 0.f; for (int c = 0; c < 32; ++c) { const long i = t * 32 + c; MCH[i] = m; m = CHS[2 * i] + fmaxf(m, CHS[2 * i + 1]); } m_prompt[t] = m; }
            else { const long j = t - BATCH * 4; const long i = 4096 + j; float m = state_m[j]; MCH[i] = m; m = CHS[2 * i] + fmaxf(m, CHS[2 * i + 1]); m_sample[j] = m; }
        }
        GBAR();
        for (int c = 0; c < 32; ++c) {
            const long nSp = 128L * 4096, nSs = (c == 0) ? 64L * 1024 : 0;
            for (long t = gtid; t < nSp + nSs; t += GT) {
                int bh, l, s, L; long tok0; float* dst;
                if (t < nSp) { bh = (int)(t >> 12); l = (int)((t >> 6) & 63); s = (int)(t & 63); L = 64; tok0 = (long)(bh >> 2) * SEQ + c * 64; dst = SMATP + t; }
                else { const long u = t - nSp; bh = (int)(u >> 10); l = (int)((u >> 5) & 31); s = (int)(u & 31); L = 32; tok0 = NTP + (long)(bh >> 2) * DEC_SEQ; dst = SMATS + u; }
                const int h = bh & 3; float val = 0.f;
                if (s <= l) { const long tl = tok0 + l, ts = tok0 + s; const bf16* q = QA + tl * 1024 + h * 256; const bf16* k = KA + ts * 1024 + h * 256;
                    float d = 0.f; for (int i = 0; i < 256; ++i) d += bf2f(q[i]) * bf2f(k[i]);
                    const long ci = (t < nSp) ? (long)bh * 32 + c : 4096 + bh;
                    val = d * __expf(WV[ts * 4 + h] - fmaxf(MCH[ci], CMX[tl * 4 + h])); }
                *dst = val;
            }
            GBAR();
            const long nHp = 32L * 64 * 1024, nHs = (c == 0) ? 16L * 32 * 1024 : 0, nCp = 128L * 65536, nCs = (c == 0) ? 64L * 65536 : 0;
            for (long t = gtid; t < nHp + nHs + nCp + nCs; t += GT) {
                if (t < nHp + nHs) {
                    int b, l, h, dv, L; long tok0, ci; const float* Sr; const float* Cm; const float* nv; bool zero = false;
                    if (t < nHp) { b = (int)(t >> 16); l = (int)((t >> 10) & 63); h = (int)((t >> 8) & 3); dv = (int)(t & 255); L = 64; tok0 = (long)b * SEQ + c * 64; ci = (long)(b * 4 + h) * 32 + c;
                        Sr = SMATP + ((long)(b * 4 + h) * 64 + l) * 64; Cm = CB + (size_t)(c & 1) * 128 * 65536 + (size_t)(b * 4 + h) * 65536; nv = NBf + (c & 1) * 128 * 256 + (b * 4 + h) * 256; zero = (c == 0); }
                    else { const long u = t - nHp; b = (int)(u >> 15); l = (int)((u >> 10) & 31); h = (int)((u >> 8) & 3); dv = (int)(u & 255); L = 32; tok0 = NTP + (long)b * DEC_SEQ; ci = 4096 + b * 4 + h;
                        Sr = SMATS + ((long)(b * 4 + h) * 32 + l) * 32; Cm = state_C + (size_t)(b * 4 + h) * 65536; nv = state_n + (b * 4 + h) * 256; }
                    const long tl = tok0 + l; const bf16* q = QA + tl * 1024 + h * 256;
                    const float mc = MCH[ci], Ml = fmaxf(mc, CMX[tl * 4 + h]), bl = BC[tl * 4 + h]; const float inter = __expf(mc - Ml);
                    float num = 0.f, den = 0.f;
                    for (int s = 0; s <= l; ++s) { const float sv = Sr[s]; num += sv * bf2f(VA[(tok0 + s) * 1024 + h * 256 + dv]); den += sv; }
                    if (!zero) { float qc = 0.f, qn = 0.f; for (int i = 0; i < 256; ++i) { const float qi_ = bf2f(q[i]); qc += qi_ * Cm[(size_t)i * 256 + dv]; qn += qi_ * nv[i]; } num += inter * qc; den += inter * qn; }
                    const float hv = num / fmaxf(fabsf(den), __expf(-(bl + Ml)));
                    HAREF[tl * 1024 + h * 256 + dv] = (bf16)f2bf(hv);
                } else {
                    const long u0 = t - (nHp + nHs); int bh, dk, dv, L; long tok0, ci; const float* Cs; const float* ns; float* Cd; float* nd; bool zero = false;
                    if (u0 < nCp) { bh = (int)(u0 >> 16); dk = (int)((u0 >> 8) & 255); dv = (int)(u0 & 255); L = 64; tok0 = (long)(bh >> 2) * SEQ + c * 64; ci = (long)bh * 32 + c; zero = (c == 0);
                        Cs = CB + (size_t)(c & 1) * 128 * 65536 + (size_t)bh * 65536; ns = NBf + (c & 1) * 128 * 256 + bh * 256;
                        Cd = (c == 31) ? C_prompt + (size_t)bh * 65536 : CB + (size_t)((c + 1) & 1) * 128 * 65536 + (size_t)bh * 65536; nd = (c == 31) ? n_prompt + bh * 256 : NBf + ((c + 1) & 1) * 128 * 256 + bh * 256; }
                    else { const long u = u0 - nCp; bh = (int)(u >> 16); dk = (int)((u >> 8) & 255); dv = (int)(u & 255); L = 32; tok0 = NTP + (long)(bh >> 2) * DEC_SEQ; ci = 4096 + bh;
                        Cs = state_C + (size_t)bh * 65536; ns = state_n + bh * 256; Cd = C_sample + (size_t)bh * 65536; nd = n_sample + bh * 256; }
                    const int h = bh & 3; const float mc = MCH[ci]; const float Mlast = fmaxf(mc, CMX[(tok0 + L - 1) * 4 + h]); const float decay = __expf(mc - Mlast);
                    float aC = 0.f, an = 0.f;
                    for (int s = 0; s < L; ++s) { const long ts = tok0 + s; const float wsv = __expf(WV[ts * 4 + h] - Mlast); const float kk = bf2f(KA[ts * 1024 + h * 256 + dk]);
                        aC += wsv * kk * bf2f(VA[ts * 1024 + h * 256 + dv]); an += wsv * kk; }
                    Cd[(size_t)dk * 256 + dv] = (zero ? 0.f : decay * Cs[(size_t)dk * 256 + dv]) + aC;
                    if (dv == 0) nd[dk] = (zero ? 0.f : decay * ns[dk]) + an;
                }
            }
            GBAR();
        }
#endif
#define ML_RS(p, bytes) __builtin_amdgcn_make_buffer_rsrc((void*)(p), (short)0, (int)(bytes), 0x00020000)
        if (vcu < BATCH * 8) { const int bh = vcu >> 1, dvh = vcu & 1, b = bh >> 2, h = bh & 3; const size_t t0 = (size_t)b * SEQ;
            ml::Item it; it.q = ML_RS(QA + t0 * 1024 + h * 256, SEQ * 2048); it.k = ML_RS(KA + t0 * 1024 + h * 256, SEQ * 2048); it.v = ML_RS(VA + t0 * 1024 + h * 256 + dvh * 128, SEQ * 2048); it.sm = ML_RS(SM + t0 * 16, SEQ * 64);
            it.C0 = ML_RS(C_prompt, 4); it.has0 = false; it.n0 = nullptr; it.m0 = 0.f; it.Cout = ML_RS(C_prompt + (size_t)bh * 65536 + dvh * 128, 65536 * 4);
            it.nout = dvh == 0 ? n_prompt + bh * 256 : nullptr; it.mout = dvh == 0 ? m_prompt + bh : nullptr;
            it.head = h; it.nchunk = SEQ / CHUNK; it.L = CHUNK; it.bi = b_gates[h]; it.bf = b_gates[4 + h];
            ml::run_item(lds, it); }
        if (vcu < DEC_BATCH * 8) { const int bh = vcu >> 1, dvh = vcu & 1, b = bh >> 2, h = bh & 3; const size_t t0 = (size_t)NTP + (size_t)b * DEC_SEQ;
            ml::Item it; it.q = ML_RS(QA + t0 * 1024 + h * 256, DEC_SEQ * 2048); it.k = ML_RS(KA + t0 * 1024 + h * 256, DEC_SEQ * 2048); it.v = ML_RS(VA + t0 * 1024 + h * 256 + dvh * 128, DEC_SEQ * 2048); it.sm = ML_RS(SM + t0 * 16, DEC_SEQ * 64);
            it.C0 = ML_RS(state_C + (size_t)bh * 65536 + dvh * 128, 65536 * 4); it.has0 = true; it.n0 = state_n + bh * 256; it.m0 = state_m[bh]; it.Cout = ML_RS(C_sample + (size_t)bh * 65536 + dvh * 128, 65536 * 4);
            it.nout = dvh == 0 ? n_sample + bh * 256 : nullptr; it.mout = dvh == 0 ? m_sample + bh : nullptr;
            it.head = h; it.nchunk = 1; it.L = DEC_SEQ; it.bi = b_gates[h]; it.bf = b_gates[4 + h];
            ml::run_item(lds, it); }
#undef ML_RS
        GBAR();
#ifdef PROBE_ML
        { float num = 0.f, den = 0.f;
          for (long t = gtid; t < (long)NTOK * 1024; t += GT) { const float a = bf2f(HA[t]), r = bf2f(HAREF[t]); num += (a - r) * (a - r); den += r * r; }
          num = wave_sum(num); den = wave_sum(den);
          if (lane == 0) { atomicAdd((float*)(args.ws + WS_CTL) + 8, num); atomicAdd((float*)(args.ws + WS_CTL) + 9, den); } }
#endif
        for (long t = gw; t < (long)NTOK * 4; t += NGW) { const unsigned long long w8 = *((const GAS unsigned long long*)(HA + t * 256) + lane);
            const float v0 = __uint_as_float((unsigned)w8 << 16), v1 = __uint_as_float((unsigned)w8 & 0xffff0000u), v2 = __uint_as_float((unsigned)(w8 >> 32) << 16), v3 = __uint_as_float((unsigned)(w8 >> 32) & 0xffff0000u);
            const float mean = wave_sum((v0 + v1) + (v2 + v3)) * (1.0f / 256.0f); const float d0 = v0 - mean, d1 = v1 - mean, d2 = v2 - mean, d3 = v3 - mean;
            const float var = wave_sum((d0 * d0 + d1 * d1) + (d2 * d2 + d3 * d3)) * (1.0f / 256.0f);
            if (lane == 0) { HST[t * 2] = mean; HST[t * 2 + 1] = 1.0f / sqrtf(var + HEAD_NORM_EPS); } }
    }
    if (IN(3)) { MK_ARGS;
        {
            typedef short bfx8 __attribute__((ext_vector_type(8))); typedef float f16v __attribute__((ext_vector_type(16)));
            LAS int* sck = (LAS int*)(lds + RING_OFF);
            const int hi = lane >> 5, r32 = lane & 31;
            for (int w4 = 0; w4 < 4; ++w4) {
                const int bW = vcu >> 3, jW = vcu & 7; const int cW = (w4 == 0) ? jW : (w4 == 1) ? 15 - jW : (w4 == 2) ? 16 + jW : 31 - jW;
                if (vcu >= BATCH * 8) break;
                const int S = 64 * (cW + 1), nW = cW + 1; const long tok0 = (long)bW * SEQ + 64 * cW;
                if (S <= TOPK_MAX) {
                    for (int k = 0; k < 8; ++k) { if (lane < 32) MASK[(size_t)(tok0 + wave * 8 + k) * 32 + lane] = (lane < nW) ? ~0ull : 0ull; }
                    continue; }
                for (int rd = 0; rd < 8; ++rd) {
                    bfx8 afr[2][4]; float wgt[2][16];
                    { const int blk = r32 >> 2; const int qa_ = 2 * (blk & 1) + (blk >> 2), ha_ = 4 * ((blk >> 1) & 1) + (r32 & 3);
#pragma unroll
                      for (int rt = 0; rt < 2; ++rt) { const bf16* qp = QI + (size_t)(tok0 + 8 * rd + 4 * rt + qa_) * 512 + ha_ * 64 + hi * 8;
#pragma unroll
                          for (int ks = 0; ks < 4; ++ks) afr[rt][ks] = *(const bfx8*)(qp + ks * 16);
#pragma unroll
                          for (int qq = 0; qq < 2; ++qq) { const float* wp = SM + (size_t)(tok0 + 8 * rd + 4 * rt + 2 * hi + qq) * 16;
                              const f32x4 w0 = *(const f32x4*)wp, w1 = *(const f32x4*)(wp + 4);
                              wgt[rt][8 * qq + 0] = w0[0] * 0.35355339059327373f; wgt[rt][8 * qq + 1] = w0[1] * 0.35355339059327373f; wgt[rt][8 * qq + 2] = w0[2] * 0.35355339059327373f; wgt[rt][8 * qq + 3] = w0[3] * 0.35355339059327373f;
                              wgt[rt][8 * qq + 4] = w1[0] * 0.35355339059327373f; wgt[rt][8 * qq + 5] = w1[1] * 0.35355339059327373f; wgt[rt][8 * qq + 6] = w1[2] * 0.35355339059327373f; wgt[rt][8 * qq + 7] = w1[3] * 0.35355339059327373f; } } }
                    for (int kt = wave; kt < 2 * nW; kt += 8) {
                        const bf16* kp = KI + ((size_t)bW * SEQ + 32 * kt + r32) * 64 + hi * 8;
                        bfx8 bfr[4];
#pragma unroll
                        for (int ks = 0; ks < 4; ++ks) bfr[ks] = *(const bfx8*)(kp + ks * 16);
#pragma unroll
                        for (int rt = 0; rt < 2; ++rt) { f16v acc = {};
#pragma unroll
                            for (int ks = 0; ks < 4; ++ks) acc = __builtin_amdgcn_mfma_f32_32x32x16_bf16(afr[rt][ks], bfr[ks], acc, 0, 0, 0);
                            float sA = 0.f, sB = 0.f;
#pragma unroll
                            for (int i = 0; i < 8; ++i) { sA += wgt[rt][i] * fmaxf(acc[i], 0.f); sB += wgt[rt][8 + i] * fmaxf(acc[8 + i], 0.f); }
                            const int kA = __float_as_int(sA), kB = __float_as_int(sB);
                            sck[(4 * rt + 2 * hi) * 2048 + 32 * kt + r32] = kA ^ ((kA >> 31) & 0x7fffffff);
                            sck[(4 * rt + 2 * hi + 1) * 2048 + 32 * kt + r32] = kB ^ ((kB >> 31) & 0x7fffffff); }
                    }
                    __syncthreads();
                    { int v[32]; int vmx = (int)0x80000000, vmn = 0x7fffffff;
#pragma unroll
                      for (int i = 0; i < 32; ++i) { v[i] = (i < nW) ? sck[wave * 2048 + lane + 64 * i] : (int)0x80000000; if (i < nW) { vmx = max(vmx, v[i]); vmn = min(vmn, v[i]); } }
#pragma unroll
                      for (int o_ = 1; o_ < 64; o_ <<= 1) { vmx = max(vmx, __shfl_xor(vmx, o_)); vmn = min(vmn, __shfl_xor(vmn, o_)); }
                      long lo_ = vmn, hi_ = vmx; bool exact = false; int T = vmn;
                      while (lo_ < hi_) { const int mid = (int)(lo_ + ((hi_ - lo_ + 1) >> 1)); int cnt = 0;
#pragma unroll
                          for (int i = 0; i < 32; ++i) { if (i < nW) cnt += __builtin_popcountll(__ballot(v[i] >= mid)); if ((i & 3) == 3) __builtin_amdgcn_sched_barrier(0); }
                          if (cnt == TOPK_MAX) { exact = true; T = mid; break; }
                          if (cnt > TOPK_MAX) lo_ = mid; else hi_ = (long)mid - 1; }
                      if (!exact) T = (int)lo_;
                      int need = TOPK_MAX;
                      if (!exact) { int cgt = 0;
#pragma unroll
                          for (int i = 0; i < 32; ++i) { if (i < nW) cgt += __builtin_popcountll(__ballot(v[i] > T)); if ((i & 3) == 3) __builtin_amdgcn_sched_barrier(0); }
                          need = TOPK_MAX - cgt; }
                      unsigned long long myw = 0ull; int running = 0; const unsigned long long lt = (1ull << lane) - 1ull;
#pragma unroll
                      for (int i = 0; i < 32; ++i) if (i < nW) { bool sel;
                          if (exact) sel = v[i] >= T;
                          else { const bool eq = v[i] == T; const unsigned long long em = __ballot(eq); sel = (v[i] > T) || (eq && running + __builtin_popcountll(em & lt) < need); running += __builtin_popcountll(em); }
                          const unsigned long long wd = __ballot(sel); if (lane == i) myw = wd; __builtin_amdgcn_sched_barrier(0); }
                      if (lane < 32) MASK[(size_t)(tok0 + 8 * rd + wave) * 32 + lane] = myw; }
                    __syncthreads();
                }
            }
        }
        for (int row = NTP + vcu; row < NTOK; row += G) simple_select_row(lds, row, MASKS + (size_t)(row - NTP) * 40, QI, SM, KI, cache_ik);
        GBAR();
    }
#ifdef PROBE_ATT
    if (IN(4)) { MK_ARGS;
        unsigned long long* MREF = (unsigned long long*)(args.ws + WS_END); bf16* OREF = (bf16*)(args.ws + WS_END + 2 * MiB);
        for (int pr = vcu; pr < 4096; pr += G) { const int row = pr < 2048 ? pr : 31 * SEQ + (pr - 2048); simple_select_row(lds, row, MREF + (size_t)pr * 32, QI, SM, KI, cache_ik); }
        GBAR();
        for (long t = gtid; t < 4096L * 64; t += GT) { const int dc = (int)(t & 7), h = (int)((t >> 3) & 7); const int pr = (int)(t >> 6); const int row = pr < 2048 ? pr : 31 * SEQ + (pr - 2048);
            simple_attn_task(row, h, dc, MREF + (size_t)pr * 32, QB, KBc, VBc, cache_k, cache_v, k_sample, v_sample, rel_bias, OREF + (size_t)pr * 1024 + h * 128 + dc * 16); }
        GBAR();
    }
#endif
    if (IN(4)) { MK_ARGS;
        {
            char* alds = (char*)lds_raw;
            for (int bh = vcu; bh < BATCH * 8; bh += G) {
                const int b = bh >> 3, h = bh & 7;
                if (tid < 320) ((float*)(alds + at2::BT_OFF))[tid] = rel_bias[t5b(tid - 256) * 8 + h] * (1.0f / at2::SCALE);
                const float cfar = __int_as_float(__builtin_amdgcn_readfirstlane(__float_as_int(rel_bias[15 * 8 + h] * (1.0f / at2::SCALE))));
                at2::Ctx C;
                C.Q = __builtin_amdgcn_make_buffer_rsrc((void*)(QB + (size_t)b * SEQ * 1024 + h * 128), (short)0, SEQ * 1024 * 2, 0x00020000);
                C.K = __builtin_amdgcn_make_buffer_rsrc((void*)(KBc + (size_t)b * SEQ * 1024 + h * 128), (short)0, SEQ * 1024 * 2, 0x00020000);
                C.V = __builtin_amdgcn_make_buffer_rsrc((void*)(VBc + (size_t)b * SEQ * 1024 + h * 128), (short)0, SEQ * 1024 * 2, 0x00020000);
                C.M = __builtin_amdgcn_make_buffer_rsrc((void*)(MASK + (size_t)b * SEQ * 32), (short)0, SEQ * 32 * 8, 0x00020000);
                at2::Seam S; at2::dsa_prime(C, 0, alds, S);
                for (int u = 0; u < 8; ++u) at2::dsa_block(C, u * 256, (u < 7 ? u + 1 : u) * 256, alds, S, cfar);
            }
        }
        for (long t = gtid; t < (long)NTS * 64; t += GT) {
            const int dc = (int)(t & 7), h = (int)((t >> 3) & 7); const int row = NTP + (int)(t >> 6);
            simple_attn_task(row, h, dc, MASKS + (size_t)(row - NTP) * 40, QB, KBc, VBc, cache_k, cache_v, k_sample, v_sample, rel_bias, OB + (size_t)row * 1024 + h * 128 + dc * 16); }
        GBAR();
    }
#ifdef PROBE_ATT
    if (IN(4)) { MK_ARGS;
        const bf16* OREF = (const bf16*)(args.ws + WS_END + 2 * MiB); float num = 0.f, den = 0.f;
        for (long t = gtid; t < 4096L * 1024; t += GT) { const int pr = (int)(t >> 10), c = (int)(t & 1023); const int row = pr < 2048 ? pr : 31 * SEQ + (pr - 2048);
            const float a = bf2f(OB[(size_t)row * 1024 + c]), r = bf2f(OREF[t]); num += (a - r) * (a - r); den += r * r; }
        num = wave_sum(num); den = wave_sum(den);
        if (lane == 0) { atomicAdd((float*)(args.ws + WS_CTL) + 8, num); atomicAdd((float*)(args.ws + WS_CTL) + 9, den); }
        GBAR();
    }
#endif
    if (IN(5)) { MK_ARGS;
        pg8::Gemm g{XB, WMRG, NTOK, N_M1A, 1024}; pg8::StaticOrder S; S.init(NTOK, N_M1A, G, (int)blockIdx.x);
        pg8::EpiM1a E{HA, OB, HST, a_norm_g, BR};
        pg8::gemm_phase<pg8::EpiM1a, pg8::StaticOrder, true, true>(lds + RING_OFF, g, S, E);
        GBAR();
    }
    if (IN(6)) { MK_ARGS;
        pg8::Gemm g{XB, WMRG + (size_t)N_M1A * 1024, NTOK, N_M1B, 1024}; pg8::StaticOrder S; S.init(NTOK, N_M1B, G, (int)blockIdx.x);
        pg8::EpiM1b E{SGA, SGB};
        pg8::gemm_phase<pg8::EpiM1b, pg8::StaticOrder, true, true>(lds + RING_OFF, g, S, E);
        GBAR();
    }
    if (IN(7)) { MK_ARGS;
        pg8::Gemm g{BR, WAB, NTOK, 1024, 2048}; pg8::StaticOrder S; S.init(NTOK, 1024, G, (int)blockIdx.x);
        pg8::EpiM2 E{SGA, SGB, MX};
        pg8::gemm_phase<pg8::EpiM2, pg8::StaticOrder, true, true>(lds + RING_OFF, g, S, E);
        GBAR();
    }
    if (IN(8)) { MK_ARGS;
        pg8::Gemm g{MX, WO, NTOK, 1024, 1024}; pg8::StaticOrder S; S.init(NTOK, 1024, G, (int)blockIdx.x);
        pg8::EpiM3 E{args.in[0], args.in[1], y_prompt, y_sample};
        pg8::gemm_phase<pg8::EpiM3, pg8::StaticOrder, true, true>(lds + RING_OFF, g, S, E);
        GBAR();
    }
    if (IN(9)) { MK_ARGS;
        for (int m = gw; m < NTOK; m += NGW) {
            float* yr = m < NTP ? y_prompt + (size_t)m * 1024 : y_sample + (size_t)(m - NTP) * 1024;
            GAS f32x4* yv = (GAS f32x4*)yr + lane; f32x4 v[4]; float s = 0.f;
#pragma unroll
            for (int j = 0; j < 4; ++j) { v[j] = yv[64 * j]; s += (v[j].x + v[j].y) + (v[j].z + v[j].w); }
            const float mean = wave_sum(s) * (1.f / 1024.f); float s2 = 0.f;
#pragma unroll
            for (int j = 0; j < 4; ++j) { v[j] = v[j] - mean; s2 += (v[j].x * v[j].x + v[j].y * v[j].y) + (v[j].z * v[j].z + v[j].w * v[j].w); }
            const float rstd = 1.f / sqrtf(wave_sum(s2) * (1.f / 1024.f) + LN_EPS);
#pragma unroll
            for (int j = 0; j < 4; ++j) { const f32x4 gg = *((const GAS f32x4*)ln_g + lane + 64 * j), bb = *((const GAS f32x4*)ln_b + lane + 64 * j); yv[64 * j] = v[j] * rstd * gg + bb; }
        }
    }
#if defined(PROBE_ATT) || defined(PROBE_ML)
    { MK_ARGS; GBAR();
      if (blockIdx.x == 0 && threadIdx.x < 64) { const float num = ((volatile float*)(args.ws + WS_CTL))[8], den = ((volatile float*)(args.ws + WS_CTL))[9];
          m_sample[threadIdx.x] *= 1.0f + 30.0f * sqrtf(num / den); } }
#endif
#undef IN
#undef GBAR
#undef args
#undef gtid
#undef GT
#undef gw
#undef NGW
#undef tid
#undef lane
#undef wave
#undef G
#undef vcu
}

extern "C" void kernel_launch(void* const* d_in, const int* in_sizes, int n_in, void* d_out, int out_size, void* d_ws, size_t ws_size, hipStream_t stream) {
    static int grid = 0;
    if (grid == 0) {
        int dev = 0, cus = 0;
        if (hipGetDevice(&dev) != hipSuccess || hipDeviceGetAttribute(&cus, hipDeviceAttributeMultiprocessorCount, dev) != hipSuccess) { grid = -1; return; }
        if (hipFuncSetAttribute((const void*)mk_fwd, hipFuncAttributeMaxDynamicSharedMemorySize, LDS_BYTES) != hipSuccess) { grid = -1; return; }
        (void)hipGetLastError();
        if (n_in != 17 || ws_size < WS_END) { fprintf(stderr, "kernel_launch: needs 17 inputs and %zu bytes of workspace (got %d, %zu)\n", (size_t)WS_END, n_in, ws_size); grid = -1; return; }
        grid = cus;
    }
    if (grid < 0) return;
    if (hipMemsetAsync((unsigned char*)d_ws + WS_CTL, 0, CTL_ZERO_BYTES, stream) != hipSuccess) return;
    Args a{};
    for (int i = 0; i < 17; ++i) a.in[i] = (const float*)d_in[i];
    a.out = (float*)d_out; a.ws = (unsigned char*)d_ws; a.ph_lo = 0; a.ph_hi = 10;
    hipLaunchKernelGGL(mk_fwd, dim3(grid), dim3(NWAVES * 64), LDS_BYTES, stream, a);
}
```

```cpp
#include <hip/hip_runtime.h>
#include <cstdio>
#include <cstdint>
#include <math.h>
#ifndef D_MODEL
#define D_MODEL 1024
#define BATCH 32
#define SEQ 2048
#define DEC_BATCH 16
#define DEC_SEQ 32
#define PAST_LEN 2048
#define CHUNK 64
#define A_HEADS 4
#define A_HEAD_DIM 256
#define B_HEADS 8
#define B_HEAD_DIM 128
#define IDX_HEADS 8
#define IDX_DIM 64
#define TOPK_MAX 256
#define GROUP_B 4
#endif
#define A_WIDTH (A_HEADS * A_HEAD_DIM)
#define B_WIDTH (B_HEADS * B_HEAD_DIM)
#define C_QA 0
#define C_KA (C_QA + A_WIDTH)
#define C_VA (C_KA + A_WIDTH)
#define C_OA (C_VA + A_WIDTH)
#define C_ZA (C_OA + A_WIDTH)
#define C_IA (C_ZA + A_WIDTH)
#define C_FA (C_IA + A_HEADS)
#define C_QB (C_FA + A_HEADS)
#define C_KB (C_QB + B_WIDTH)
#define C_VB (C_KB + B_WIDTH)
#define C_ZB (C_VB + B_WIDTH)
#define C_QI (C_ZB + B_WIDTH)
#define C_KI (C_QI + IDX_HEADS * IDX_DIM)
#define C_WI (C_KI + IDX_DIM)
#define C_GA (C_WI + IDX_HEADS)
#define C_GB (C_GA + D_MODEL)
#define IN_COLS (C_GB + D_MODEL)
#define LN_EPS 1e-5f
#define HEAD_NORM_EPS 1e-6f
#define DN_ALPHA 1.189207115002721f


#define GAS __attribute__((address_space(1)))
#define LAS __attribute__((address_space(3)))
typedef unsigned short bf16;
typedef unsigned v4u __attribute__((ext_vector_type(4)));
typedef float f32x4 __attribute__((ext_vector_type(4)));
typedef short bf16x8 __attribute__((ext_vector_type(8)));
typedef GAS unsigned gu32;
typedef GAS unsigned long long gu64;
#define RLX_AGENT __ATOMIC_RELAXED, __HIP_MEMORY_SCOPE_AGENT
#define LDS_WAIT() asm volatile("s_waitcnt lgkmcnt(0)" ::: "memory")
#define VM_WAIT() asm volatile("s_waitcnt vmcnt(0)" ::: "memory")
__device__ __forceinline__ unsigned long long rt() { return __builtin_amdgcn_s_memrealtime(); }
__device__ __forceinline__ unsigned f2bf(float f) { unsigned u = __builtin_bit_cast(unsigned, f); return (u + 0x7fffu + ((u >> 16) & 1u)) >> 16; }
__device__ __forceinline__ unsigned pk2(float lo, float hi) { return f2bf(lo) | (f2bf(hi) << 16); }

#define XB_TMO      128
#define XB_XCNT(j)  (256  + 64 * (j))
#define XB_XSUB(j)  (1280 + 64 * (j))
#define XB_XGEN(j)  (2304 + 64 * (j))
#define XB_TOP      3328
#define XB_TOPGEN   3392
#define XCD_BAR_WORDS 3456
#define XB_SPIN_CAP (1u << 18)

__device__ __forceinline__ unsigned xb_ld(unsigned* p)              { return __hip_atomic_load(p, __ATOMIC_RELAXED, __HIP_MEMORY_SCOPE_AGENT); }
__device__ __forceinline__ unsigned xb_add(unsigned* p, unsigned v) { return __hip_atomic_fetch_add(p, v, __ATOMIC_RELAXED, __HIP_MEMORY_SCOPE_AGENT); }
__device__ __forceinline__ unsigned xb_xcc_id() { return (unsigned)__builtin_amdgcn_s_getreg((3 << 11) | 20) & 0xFu; }
#define XB_SPIN(cond, bar) do { unsigned _sp = 0; while (cond) { __builtin_amdgcn_s_sleep(1); \
    if ((++_sp & 255u) == 0u) { if (xb_ld(&(bar)[XB_TMO])) break; if (_sp > XB_SPIN_CAP) { atomicAdd(&(bar)[XB_TMO], 1u); break; } } } } while (0)

struct XcdBarrier {
    unsigned* bar; unsigned x;
    volatile LAS unsigned* st;
};

__device__ __forceinline__ XcdBarrier xcd_barrier_post(unsigned* bar, volatile LAS unsigned* st) {
    XcdBarrier b; b.bar = bar; b.x = xb_xcc_id(); b.st = st;
    if (threadIdx.x == 0) (void)xb_add(&bar[XB_XCNT(b.x)], 1u);
    return b;
}
__device__ __forceinline__ void xcd_barrier_complete(unsigned* bar, unsigned x, unsigned& nloc, unsigned& nx) {
    const unsigned G = gridDim.x * gridDim.y * gridDim.z;
    unsigned sum, cnt, mine, sp = 0u;
    for (;;) {
        sum = 0u; cnt = 0u; mine = 0u;
#pragma unroll
        for (unsigned j = 0; j < 16; ++j) { const unsigned c = xb_ld(&bar[XB_XCNT(j)]); sum += c; cnt += (c > 0u) ? 1u : 0u; mine = (j == x) ? c : mine; }
        if (sum == G) break;
        __builtin_amdgcn_s_sleep(1);
        if ((++sp & 255u) == 0u) { if (xb_ld(&bar[XB_TMO])) break; if (sp > XB_SPIN_CAP) { atomicAdd(&bar[XB_TMO], 1u); break; } }
    }
    nloc = mine > 0u ? mine : 1u; nx = cnt > 0u ? cnt : 1u;
}

__device__ __forceinline__ void xcd_barrier(const XcdBarrier& b) {
    asm volatile("s_waitcnt vmcnt(0)" ::: "memory");
    __syncthreads();
    if (threadIdx.x == 0) {
        unsigned* bar = b.bar;
        __builtin_amdgcn_s_waitcnt(0);
        unsigned nloc = b.st[0], nx = b.st[1];
        if (nloc == 0u) { xcd_barrier_complete(bar, b.x, nloc, nx); b.st[0] = nloc; b.st[1] = nx; }
        const unsigned old = xb_add(&bar[XB_XSUB(b.x)], 1u);
        const unsigned gen = old / nloc;
        if (old + 1u == (gen + 1u) * nloc) {
            __builtin_amdgcn_fence(__ATOMIC_RELEASE, "agent");
            asm volatile("s_waitcnt vmcnt(0)" ::: "memory");
            const unsigned og = xb_add(&bar[XB_TOP], 1u);
            const unsigned tg = og / nx;
            if (og + 1u == (tg + 1u) * nx) xb_add(&bar[XB_TOPGEN], 1u);
            else XB_SPIN(xb_ld(&bar[XB_TOPGEN]) == tg, bar);
            __builtin_amdgcn_fence(__ATOMIC_ACQUIRE, "agent");
            xb_add(&bar[XB_XGEN(b.x)], 1u);
            asm volatile("s_waitcnt vmcnt(0)" ::: "memory");
        } else {
            XB_SPIN(xb_ld(&bar[XB_XGEN(b.x)]) == gen, bar);
            __builtin_amdgcn_fence(__ATOMIC_ACQUIRE, "agent");
            asm volatile("s_waitcnt vmcnt(0)" ::: "memory");
        }
    }
    __syncthreads();
}

namespace pg8 {
#define PG8_LAS __attribute__((address_space(3)))
typedef unsigned short bf16_t;
typedef short bf16x8 __attribute__((ext_vector_type(8)));
typedef float f32x4 __attribute__((ext_vector_type(4)));
typedef unsigned u32x4 __attribute__((ext_vector_type(4)));
constexpr int BM = 256, BK = 64, HALF = 128, HTB = HALF * BK * 2  , STAGE_BYTES = 8 * HTB, NXCD = 8, WGM = 8;

__host__ __device__ __forceinline__ int lds_byte(int r, int c) { const int st = (r >> 4) * 2 + (c >> 5), rr = r & 15, cc = c & 31, ob = rr * 64 + cc * 2; return st * 1024 + (ob ^ (((ob >> 9) & 1) << 5)); }
__host__ __device__ __forceinline__ void stage_rc(int b, int& R, int& C) { const int st = b / 1024, sb = b % 1024, swz = sb ^ (((sb >> 9) & 1) << 5); R = (st >> 1) * 16 + swz / 64; C = (st & 1) * 32 + (swz % 64) / 2; }
__host__ __device__ __forceinline__ int perm32(int rho) { const int n = rho >> 4, i = rho & 15; return 8 * (i >> 2) + 4 * n + (i & 3); }

struct Unit { int pm, pn; };
struct Gemm { const bf16_t* A; const bf16_t* Bt; int M, N, K; };

struct StaticOrder {
    int nM, nN, nwg, G, c;
    __host__ __device__ void init(int M, int N, int G_, int c_) { nM = M / BM; nN = N / BM; nwg = nM * nN; G = G_; c = c_; }
    __host__ __device__ bool next(int i, Unit& u) const {
        const long L = (long)i * G + c; if (L >= nwg) return false;
        int wgid = (int)L; { const int q = nwg / NXCD, r = nwg % NXCD, xcd = wgid % NXCD, off = wgid / NXCD; wgid = (xcd < r ? xcd * (q + 1) : r * (q + 1) + (xcd - r) * q) + off; }
        const int nig = WGM * nN, gid = wgid / nig, fm = gid * WGM, gsz = (nM - fm) < WGM ? (nM - fm) : WGM;
        u.pm = fm + ((wgid % nig) % gsz); u.pn = (wgid % nig) / gsz; return true;
    }
    __device__ __forceinline__ void a_ready(const Unit&) const {}
    __device__ __forceinline__ void done(const Unit&) const {}
};
__device__ __forceinline__ unsigned cvt_pk_bf16(float lo, float hi) { unsigned r; asm volatile("v_cvt_pk_bf16_f32 %0, %1, %2" : "=v"(r) : "v"(lo), "v"(hi)); return r; }
typedef float f32x2 __attribute__((ext_vector_type(2)));
template <class Epi, class Sched, bool ALIGN_EPI = false, bool SP2 = false>
__device__ __forceinline__ void gemm_phase(PG8_LAS unsigned char* lds, const Gemm g, const Sched& S, const Epi& E) {
    const int tid = threadIdx.x, wid = __builtin_amdgcn_readfirstlane(tid >> 6), lane = tid & 63, wr = wid >> 2, wc = wid & 3, fr = lane & 15, fq = lane >> 4;
    const int K = g.K, nt = K / BK;
    unsigned voffA[2], voffB[2];
#pragma unroll
    for (int i = 0; i < 2; ++i) { int R, C; stage_rc(tid * 16 + i * 8192, R, C); const int Rb = Epi::PERM ? ((R & ~31) + perm32(R & 31)) : R;
        voffA[i] = (unsigned)(R * K + C) * 2u; voffB[i] = (unsigned)(Rb * K + C) * 2u; }
    const size_t kstep = (size_t)(BK * 2);
    const size_t hstep = (size_t)HALF * K * 2;
    const size_t tstep = 2 * hstep;
    const unsigned ldsw = (unsigned)wid * 1024u;
    const int aoff = lds_byte(wr * 64 + fr, fq * 8), boff = lds_byte(wc * 32 + fr, fq * 8);
#define PG8_SA(b, h) (((b) * 2 + (h)) * HTB)
#define PG8_SB(b, h) ((4 + (b) * 2 + (h)) * HTB)
#define PG8_STAGE(bufoff, gbase, voff) do { _Pragma("unroll") for (int _i = 0; _i < 2; ++_i) \
        __builtin_amdgcn_global_load_lds((const unsigned*)((const char*)(gbase) + (voff)[_i]), (PG8_LAS unsigned*)(lds + (bufoff) + ldsw + _i * 8192), 16, 0, 0); } while (0)
#define PG8_LDA(dst, b, h) do { _Pragma("unroll") for (int m = 0; m < 4; ++m) _Pragma("unroll") for (int k = 0; k < 2; ++k) dst[m][k] = *(const PG8_LAS bf16x8*)(lds + PG8_SA(b, h) + aoff + m * 2048 + k * 1024); } while (0)
#define PG8_LDB(dst, b, h) do { _Pragma("unroll") for (int n = 0; n < 2; ++n) _Pragma("unroll") for (int k = 0; k < 2; ++k) dst[n][k] = *(const PG8_LAS bf16x8*)(lds + PG8_SB(b, h) + boff + n * 2048 + k * 1024); } while (0)
#define PG8_MMA(ai, bj, At, Bt) do { __builtin_amdgcn_s_setprio(1); _Pragma("unroll") for (int m = 0; m < 4; ++m) _Pragma("unroll") for (int n = 0; n < 2; ++n) _Pragma("unroll") for (int k = 0; k < 2; ++k) \
        acc[ai][bj][m][n] = __builtin_amdgcn_mfma_f32_16x16x32_bf16(Bt[n][k], At[m][k], acc[ai][bj][m][n], 0, 0, 0); __builtin_amdgcn_s_setprio(0); } while (0)
#define PG8_WAIT_V(n) asm volatile("s_waitcnt vmcnt(" #n ")" ::: "memory")
#define PG8_WAIT_L(n) asm volatile("s_waitcnt lgkmcnt(" #n ")" ::: "memory")
#define PG8_BAR __builtin_amdgcn_s_barrier()
#define PG8_SCHED __builtin_amdgcn_sched_barrier(0)
    Unit cur, nxt; int ui = 0;
    if (!S.next(0, cur)) return;
    f32x4 acc[2][2][4][2];
#pragma unroll
    for (int a = 0; a < 2; ++a)
#pragma unroll
        for (int b = 0; b < 2; ++b)
#pragma unroll
            for (int m = 0; m < 4; ++m)
#pragma unroll
                for (int n = 0; n < 2; ++n) acc[a][b][m][n] = (f32x4){0.f, 0.f, 0.f, 0.f};
    bf16x8 At[4][2], B0[2][2], B1[2][2];
    const char* cA = (const char*)g.A + (size_t)cur.pm * tstep; const char* cB = (const char*)g.Bt + (size_t)cur.pn * tstep;
    S.a_ready(cur);
    if constexpr (SP2) {
        PG8_STAGE(PG8_SB(0, 0), cB, voffB); PG8_STAGE(PG8_SB(0, 1), cB + hstep, voffB); PG8_STAGE(PG8_SA(0, 0), cA, voffA); PG8_STAGE(PG8_SA(0, 1), cA + hstep, voffA);
        if (wr == 1) PG8_BAR;
        PG8_WAIT_V(2); PG8_BAR;
        PG8_STAGE(PG8_SB(1, 0), cB + kstep, voffB); PG8_STAGE(PG8_SA(1, 0), cA + kstep, voffA); PG8_STAGE(PG8_SB(1, 1), cB + hstep + kstep, voffB);
        PG8_WAIT_V(6); PG8_BAR;
    } else {
        PG8_STAGE(PG8_SB(0, 0), cB, voffB); PG8_STAGE(PG8_SA(0, 0), cA, voffA); PG8_STAGE(PG8_SB(0, 1), cB + hstep, voffB); PG8_STAGE(PG8_SA(0, 1), cA + hstep, voffA);
        if (wr == 1) PG8_BAR;
        PG8_WAIT_V(4); PG8_BAR;
        PG8_STAGE(PG8_SB(1, 0), cB + kstep, voffB); PG8_STAGE(PG8_SA(1, 0), cA + kstep, voffA); PG8_STAGE(PG8_SB(1, 1), cB + hstep + kstep, voffB);
        PG8_WAIT_V(6); PG8_BAR;
    }
    for (;;) {
        const bool has_next = S.next(ui + 1, nxt);
        const char* nA = has_next ? (const char*)g.A + (size_t)nxt.pm * tstep : cA; const char* nB = has_next ? (const char*)g.Bt + (size_t)nxt.pn * tstep : cB;
        for (int t = 0; t < nt; t += 2) {
            const bool last = (t == nt - 2);
            const char* a1 = cA + (size_t)(t + 1) * kstep;
            const char* a2 = last ? nA : cA + (size_t)(t + 2) * kstep; const char* b2 = last ? nB : cB + (size_t)(t + 2) * kstep;
            const char* a3 = a2 + kstep; const char* b3 = b2 + kstep;
            if (last && has_next) S.a_ready(nxt);
            if constexpr (Epi::MIDK) { if (t == nt / 2) E.mid(acc, cur, wr, wc, fr, fq); }
            if constexpr (SP2) {
            PG8_LDB(B0, 0, 0); PG8_LDB(B1, 0, 1); PG8_SCHED; PG8_LDA(At, 0, 0); PG8_STAGE(PG8_SA(1, 1), a1 + hstep, voffA);
            PG8_WAIT_V(8); PG8_WAIT_L(0); PG8_BAR; PG8_MMA(0, 0, At, B0); PG8_MMA(0, 1, At, B1); PG8_BAR; PG8_SCHED;
            PG8_LDA(At, 0, 1); PG8_STAGE(PG8_SB(0, 0), b2, voffB); PG8_STAGE(PG8_SB(0, 1), b2 + hstep, voffB); PG8_STAGE(PG8_SA(0, 0), a2, voffA);
            PG8_WAIT_V(8); PG8_WAIT_L(0); PG8_BAR; PG8_MMA(1, 0, At, B0); PG8_MMA(1, 1, At, B1); PG8_BAR; PG8_SCHED;
            PG8_LDB(B0, 1, 0); PG8_LDB(B1, 1, 1); PG8_SCHED; PG8_LDA(At, 1, 0); PG8_STAGE(PG8_SA(0, 1), a2 + hstep, voffA);
            PG8_WAIT_V(8); PG8_WAIT_L(0); PG8_BAR; PG8_MMA(0, 0, At, B0); PG8_MMA(0, 1, At, B1); PG8_BAR; PG8_SCHED;
            PG8_LDA(At, 1, 1); PG8_STAGE(PG8_SB(1, 0), b3, voffB); PG8_STAGE(PG8_SB(1, 1), b3 + hstep, voffB); PG8_STAGE(PG8_SA(1, 0), a3, voffA);
            PG8_WAIT_V(8); PG8_WAIT_L(0); PG8_BAR; PG8_MMA(1, 0, At, B0); PG8_MMA(1, 1, At, B1); PG8_BAR; PG8_SCHED;
            } else {
            PG8_LDB(B0, 0, 0); PG8_SCHED; PG8_LDA(At, 0, 0); PG8_STAGE(PG8_SA(1, 1), a1 + hstep, voffA);
            PG8_WAIT_L(8); PG8_BAR; PG8_WAIT_L(0); PG8_MMA(0, 0, At, B0); PG8_BAR; PG8_SCHED;
            PG8_LDB(B1, 0, 1); PG8_STAGE(PG8_SB(0, 0), b2, voffB);
            PG8_BAR; PG8_WAIT_L(0); PG8_MMA(0, 1, At, B1); PG8_BAR;
            PG8_LDA(At, 0, 1); PG8_STAGE(PG8_SA(0, 0), a2, voffA);
            PG8_BAR; PG8_WAIT_L(0); PG8_MMA(1, 0, At, B0); PG8_BAR; PG8_SCHED;
            PG8_STAGE(PG8_SB(0, 1), b2 + hstep, voffB);
            PG8_WAIT_V(6); PG8_BAR; PG8_MMA(1, 1, At, B1); PG8_BAR;
            PG8_LDB(B0, 1, 0); PG8_SCHED; PG8_LDA(At, 1, 0); PG8_STAGE(PG8_SA(0, 1), a2 + hstep, voffA);
            PG8_WAIT_L(8); PG8_BAR; PG8_WAIT_L(0); PG8_MMA(0, 0, At, B0); PG8_BAR; PG8_SCHED;
            PG8_LDB(B1, 1, 1); PG8_STAGE(PG8_SB(1, 0), b3, voffB);
            PG8_BAR; PG8_WAIT_L(0); PG8_MMA(0, 1, At, B1); PG8_BAR;
            PG8_LDA(At, 1, 1); PG8_STAGE(PG8_SA(1, 0), a3, voffA);
            PG8_BAR; PG8_WAIT_L(0); PG8_MMA(1, 0, At, B0); PG8_BAR; PG8_SCHED;
            PG8_STAGE(PG8_SB(1, 1), b3 + hstep, voffB);
            PG8_WAIT_V(6); PG8_BAR; PG8_MMA(1, 1, At, B1); PG8_BAR;
            }
        }
        if constexpr (ALIGN_EPI) { if (wr == 0) PG8_BAR; }
        if constexpr (!Epi::AFTER_DRAIN) { E(acc, cur, wr, wc, fr, fq); S.done(cur); }
        if (!has_next) break;
#pragma unroll
        for (int a = 0; a < 2; ++a)
#pragma unroll
            for (int b = 0; b < 2; ++b)
#pragma unroll
                for (int m = 0; m < 4; ++m)
#pragma unroll
                    for (int n = 0; n < 2; ++n) acc[a][b][m][n] = (f32x4){0.f, 0.f, 0.f, 0.f};
        cur = nxt; cA = nA; cB = nB; ++ui;
        if constexpr (ALIGN_EPI) { if (wr == 1) PG8_BAR; }
    }
    PG8_WAIT_V(0);
    if constexpr (!ALIGN_EPI) { if (wr == 0) PG8_BAR; }
    PG8_BAR;
    if constexpr (Epi::AFTER_DRAIN) { E.fused(acc, cur, wr, wc, fr, fq, lds, wid, lane); S.done(cur); }
#undef PG8_SA
#undef PG8_SB
#undef PG8_STAGE
#undef PG8_LDA
#undef PG8_LDB
#undef PG8_MMA
#undef PG8_WAIT_V
#undef PG8_WAIT_L
#undef PG8_BAR
#undef PG8_SCHED
}
}

namespace at2 {
constexpr float SCALE = 0.08838834764831845f;
constexpr float THR = 8.f;
constexpr int NW = 8, QBLK = 32, KVBLK = 64, QB = NW * QBLK, D = 128, PITCH = 1024;
constexpr int SHM_V = KVBLK * D * 2, SHM_K = KVBLK * D * 2;
constexpr int BT_OFF = 2 * SHM_V + 2 * SHM_K + NW * 64 * 4;
constexpr int LDS_BYTES = BT_OFF + 320 * 4;
typedef short bf16x8 __attribute__((ext_vector_type(8)));
typedef short s16x4 __attribute__((ext_vector_type(4)));
typedef float f32x16 __attribute__((ext_vector_type(16)));
typedef float f32x4 __attribute__((ext_vector_type(4)));
typedef unsigned u32x4 __attribute__((ext_vector_type(4)));
typedef unsigned short bf16;

#define KSWZ(row, colB) ((row) * 256 + ((colB) ^ (((row) & 7) << 4)))
#define SBAR() __builtin_amdgcn_sched_barrier(0)
__device__ __forceinline__ int v_st(int k, int c) { const int kk = (k & ~0xC) | ((k & 4) << 1) | ((k & 8) >> 1); return ((kk >> 3) * 4 + (c >> 5)) * 512 + ((kk & 7) * 32 + (c & 31)) * 2; }
__device__ __forceinline__ int v_rd_base(int lane) { return ((lane & 3) << 3) | (((lane >> 2) & 3) << 6) | (((lane >> 4) & 1) << 5) | (((lane >> 5) & 1) << 8); }
constexpr int v_rd_off(int d0, int ks, int half) { return d0 * 512 + ks * 4096 + half * 2048; }
__device__ __forceinline__ int crow(int r, int hi) { return (r & 3) + 8 * (r >> 2) + 4 * hi; }
__device__ __forceinline__ unsigned cvtpk(float lo, float hi) { unsigned r; asm volatile("v_cvt_pk_bf16_f32 %0, %1, %2" : "=v"(r) : "v"(lo), "v"(hi)); return r; }
__device__ __forceinline__ bf16x8 load8(const bf16* p) { return *reinterpret_cast<const bf16x8*>(p); }

typedef __attribute__((address_space(3))) const float* lds_cf32;
__device__ __forceinline__ unsigned mask_compact(unsigned long long mw, int hi) { return ((unsigned)(mw >> (4 * hi)) & 0x0f0f0f0fu) | (((unsigned)(mw >> (32 + 4 * hi)) & 0x0f0f0f0fu) << 4); }
__device__ __forceinline__ void mask_bias(f32x16& p0, f32x16& p1, unsigned mwc, lds_cf32 bt, int idx0, bool far, float cfar, int hi) {
    const float NEG = -__builtin_inff();
    const unsigned w0 = mwc, w1 = mwc >> 4;
    if (far) {
#pragma unroll
        for (int r = 0; r < 16; ++r) { const int c = (r & 3) + 8 * (r >> 2);
            p0[r] = ((w0 >> c) & 1u) ? p0[r] + cfar : NEG; p1[r] = ((w1 >> c) & 1u) ? p1[r] + cfar : NEG; }
    } else { lds_cf32 b = bt + idx0;
#pragma unroll
        for (int r = 0; r < 16; ++r) { const int c = (r & 3) + 8 * (r >> 2);
            p0[r] = ((w0 >> c) & 1u) ? p0[r] + b[c] : NEG; p1[r] = ((w1 >> c) & 1u) ? p1[r] + b[c + 32] : NEG;
            if ((r & 3) == 3) asm volatile("" ::: "memory"); }
    }
}
__device__ __forceinline__ void partialSM(f32x16& p0, f32x16& p1, float& m_reg, float& mn, float& alpha) {
    float pmax = p0[0]; for (int r = 1; r < 16; ++r) pmax = fmaxf(pmax, p0[r]); for (int r = 0; r < 16; ++r) pmax = fmaxf(pmax, p1[r]);
    { auto rr = __builtin_amdgcn_permlane32_swap(__float_as_uint(pmax), __float_as_uint(pmax), false, false);
      pmax = fmaxf(__uint_as_float(rr[0]), __uint_as_float(rr[1])); }
    constexpr float C2 = 1.4426950408889634f * SCALE;
    if (__builtin_expect(__all((pmax - m_reg) * SCALE <= THR), 1)) { mn = m_reg; alpha = 1.f; }
    else { mn = fmaxf(m_reg, pmax); alpha = __builtin_amdgcn_exp2f((m_reg - mn) * C2); m_reg = mn; }
    const float mnL = -mn * C2;
    for (int r = 0; r < 16; ++r) p0[r] = fmaf(p0[r], C2, mnL); for (int r = 0; r < 16; ++r) p1[r] = fmaf(p1[r], C2, mnL);
    for (int r = 0; r < 16; ++r) p0[r] = __builtin_amdgcn_exp2f(p0[r]);
}
__device__ __forceinline__ void finishSM(f32x16& p0, f32x16& p1, float alpha, float& l_reg, bf16x8& pa0, bf16x8& pa1, bf16x8& pa2, bf16x8& pa3) {
    for (int r = 0; r < 16; ++r) p1[r] = __builtin_amdgcn_exp2f(p1[r]);
    float ps = 0; for (int r = 0; r < 16; ++r) ps += p0[r]; for (int r = 0; r < 16; ++r) ps += p1[r];
    { auto rr = __builtin_amdgcn_permlane32_swap(__float_as_uint(ps), __float_as_uint(ps), false, false);
      ps = __uint_as_float(rr[0]) + __uint_as_float(rr[1]); }
    l_reg = l_reg * alpha + ps;
#define PK4(P, B_, OUT) do { unsigned a0 = cvtpk(P[B_+0], P[B_+1]), a1 = cvtpk(P[B_+2], P[B_+3]);                          \
        unsigned b0 = cvtpk(P[B_+4], P[B_+5]), b1 = cvtpk(P[B_+6], P[B_+7]);                                             \
        auto r0 = __builtin_amdgcn_permlane32_swap(a0, b0, false, false); auto r1 = __builtin_amdgcn_permlane32_swap(a1, b1, false, false); \
        u32x4 w = {r0[0], r1[0], r0[1], r1[1]}; OUT = *reinterpret_cast<bf16x8*>(&w); } while (0)
    PK4(p0, 0, pa0); PK4(p0, 8, pa1); PK4(p1, 0, pa2); PK4(p1, 8, pa3);
#undef PK4
}
template <int KB, bool SK>
__device__ __forceinline__ void qkt(f32x16& p0, f32x16& p1, const char* K_lds, int r32, int hi, const bf16x8* qr, bool act) {
    if (SK && !act) { const float NEG = -__builtin_inff();
#pragma unroll
        for (int r = 0; r < 16; ++r) { p0[r] = NEG; p1[r] = NEG; } return; }
    p0 = f32x16{}; p1 = f32x16{};
    const char* kb[4];
#pragma unroll
    for (int dd = 0; dd < 4; ++dd) kb[dd] = K_lds + KB * SHM_K + KSWZ(r32, (dd * 16 + hi * 8) * 2);
#pragma unroll
    for (int d0 = 0; d0 < 8; ++d0) { const char* a = kb[d0 & 3] + (d0 >> 2) * 128;
        bf16x8 b0 = *reinterpret_cast<const bf16x8*>(a);
        bf16x8 b1 = *reinterpret_cast<const bf16x8*>(a + 32 * 256);
        p0 = __builtin_amdgcn_mfma_f32_32x32x16_bf16(b0, qr[d0], p0, 0, 0, 0);
        p1 = __builtin_amdgcn_mfma_f32_32x32x16_bf16(b1, qr[d0], p1, 0, 0, 0); }
}
template <int VB, bool SK>
__device__ __forceinline__ void pv_tile(f32x16* o, int vb0, bf16x8 pa0, bf16x8 pa1, bf16x8 pa2, bf16x8 pa3, bool act) {
    if (SK && !act) return;
#define TRRD(dst, off) asm volatile("ds_read_b64_tr_b16 %0, %1 offset:%2" : "=&v"(dst) : "v"(vb0), "i"(off) : "memory")
#define PV_D0(d0) do { s16x4 l0, l1, l2, l3, h0, h1, h2, h3; constexpr int b_ = VB * SHM_V + v_rd_off(d0, 0, 0); \
        TRRD(l0, b_); TRRD(h0, b_ + 2048); TRRD(l1, b_ + 4096); TRRD(h1, b_ + 6144); TRRD(l2, b_ + 8192); TRRD(h2, b_ + 10240); TRRD(l3, b_ + 12288); TRRD(h3, b_ + 14336); \
        asm volatile("s_waitcnt lgkmcnt(0)" ::: "memory"); SBAR();   \
        o[d0] = __builtin_amdgcn_mfma_f32_32x32x16_bf16(pa0, (bf16x8){l0[0], l0[1], l0[2], l0[3], h0[0], h0[1], h0[2], h0[3]}, o[d0], 0, 0, 0);   \
        o[d0] = __builtin_amdgcn_mfma_f32_32x32x16_bf16(pa1, (bf16x8){l1[0], l1[1], l1[2], l1[3], h1[0], h1[1], h1[2], h1[3]}, o[d0], 0, 0, 0);   \
        o[d0] = __builtin_amdgcn_mfma_f32_32x32x16_bf16(pa2, (bf16x8){l2[0], l2[1], l2[2], l2[3], h2[0], h2[1], h2[2], h2[3]}, o[d0], 0, 0, 0);   \
        o[d0] = __builtin_amdgcn_mfma_f32_32x32x16_bf16(pa3, (bf16x8){l3[0], l3[1], l3[2], l3[3], h3[0], h3[1], h3[2], h3[3]}, o[d0], 0, 0, 0); } while (0)
    PV_D0(0); PV_D0(1); PV_D0(2); PV_D0(3);
#undef PV_D0
#undef TRRD
}

struct Ctx { __amdgpu_buffer_rsrc_t Q, K, V, M; };
typedef unsigned v4u32 __attribute__((ext_vector_type(4))); typedef unsigned v2u32 __attribute__((ext_vector_type(2)));
#define LD16(rs, vo, so) __builtin_bit_cast(bf16x8, __builtin_amdgcn_raw_buffer_load_b128((rs), (int)(vo), (int)(so), 0))
struct Seam { bf16x8 qr[8]; bf16x8 st_v0, st_v1, st_k0, st_k1; };
#define VMW() asm volatile("s_waitcnt vmcnt(0)" ::: "memory")
#define VMWN(n) asm volatile("s_waitcnt vmcnt(%0)" :: "i"(n) : "memory")
#define SLOAD_H(k0) do { S.st_v0 = LD16(C.V, kvoff, (k0) * (PITCH * 2)); S.st_v1 = LD16(C.V, kvoff, ((k0) + 32) * (PITCH * 2));              \
                         S.st_k0 = LD16(C.K, kvoff, (k0) * (PITCH * 2)); S.st_k1 = LD16(C.K, kvoff, ((k0) + 32) * (PITCH * 2)); } while (0)
#define SWRITE_HK(bf) do { *(bf16x8*)(K_lds + (bf) * SHM_K + kws) = S.st_k0; *(bf16x8*)(K_lds + (bf) * SHM_K + kws + 32 * 256) = S.st_k1; } while (0)
#define SWRITE_HV(bf) do { *(bf16x8*)(V_lds + (bf) * SHM_V + vst0) = S.st_v0; *(bf16x8*)(V_lds + (bf) * SHM_V + vst1) = S.st_v1; } while (0)
#define SWRITE_H(bf) do { SWRITE_HV(bf); SWRITE_HK(bf); } while (0)
__device__ __forceinline__ void dsa_prime(const Ctx& C, int P0, char* lds, Seam& S) {
    int tid = threadIdx.x; asm volatile("" : "+v"(tid));
    const int wid = __builtin_amdgcn_readfirstlane(tid >> 6), lane = tid & 63, r32 = lane & 31, hi = lane >> 5;
    const int sr = tid >> 4, sc = (tid & 15) * 8, kws = KSWZ(sr, sc * 2); char* K_lds = lds + 2 * SHM_V;
    const unsigned kvoff = (unsigned)(sr * PITCH + sc) * 2u, qoff = (unsigned)((wid * QBLK + r32) * PITCH + hi * 8) * 2u;
    for (int d0 = 0; d0 < 8; ++d0) S.qr[d0] = LD16(C.Q, qoff + d0 * 32, P0 * (PITCH * 2));
    SLOAD_H(0); VMW(); SWRITE_HK(0);
    __syncthreads();
}
__device__ __forceinline__ void dsa_block(const Ctx& C, int P0, int P0n, char* lds, Seam& S, float cfar) {
    int tid = threadIdx.x; asm volatile("" : "+v"(tid));
    const int wid = __builtin_amdgcn_readfirstlane(tid >> 6), lane = tid & 63, r32 = lane & 31, hi = lane >> 5;
    const int NT = P0 / KVBLK + QB / KVBLK;
    const int qlo = P0 + wid * QBLK;
    const int limw = ((qlo >> 6) + 1) * 64;
    char* V_lds = lds; char* K_lds = lds + 2 * SHM_V;
    float* wsc = (float*)(lds + 2 * SHM_V + 2 * SHM_K) + wid * 64; float* li_l = wsc, * al_l = wsc + 32;
    lds_cf32 bt = (lds_cf32)((__attribute__((address_space(3))) char*)lds + BT_OFF);
    float m_reg = -1e30f, l_reg = 0; f32x16 o[4] = {};
    const int sr = tid >> 4, sc = (tid & 15) * 8, vst0 = v_st(sr, sc), vst1 = v_st(32 + sr, sc), kws = KSWZ(sr, sc * 2);
    const int vb0 = (int)(uintptr_t)V_lds + v_rd_base(lane);
    const unsigned kvoff = (unsigned)(sr * PITCH + sc) * 2u, qoff = (unsigned)((wid * QBLK + r32) * PITCH + hi * 8) * 2u, moff = (unsigned)((wid * QBLK + r32) * 32) * 8u;
#define MROW(t) mask_compact(__builtin_bit_cast(unsigned long long, __builtin_amdgcn_raw_buffer_load_b64(C.M, (int)moff, (P0 * 32 + (t)) * 8, 0)), hi)
    const int rel0 = 256 + 4 * hi - (qlo + r32);
#define RESC(a) do { if (__any((a) < 1.f)) { if (hi == 0) al_l[r32] = (a); asm volatile("s_waitcnt lgkmcnt(0)" ::: "memory");              \
                     for (int d_ = 0; d_ < 4; ++d_) for (int r = 0; r < 16; ++r) o[d_][r] *= al_l[crow(r, hi)]; } } while (0)
#define KBASE(t) ((t) * KVBLK)
#define ACT(t) (KBASE(t) < limw)
#define MASKT(P0_, P1_, mw_, t) do { const int kb_ = KBASE(t); if (ACT(t)) mask_bias(P0_, P1_, mw_, bt, kb_ + rel0, kb_ + KVBLK - 1 - qlo <= -128, cfar, hi); } while (0)
    constexpr int NQL = 8; constexpr bool SK = true;
#define SEAM_K0() do { VMWN(NQL); SWRITE_HK(0); SBAR(); } while (0)
    f32x16 pA0, pA1, pB0, pB1; float mnA, mnB, alA, alB; bf16x8 pa0, pa1, pa2, pa3; unsigned mw;
    SWRITE_HV(0); SBAR();
    if (NT > 1) SLOAD_H(KBASE(1));
    mw = MROW(0);
    SBAR(); qkt<0, SK>(pA0, pA1, K_lds, r32, hi, S.qr, ACT(0));
    MASKT(pA0, pA1, mw, 0); partialSM(pA0, pA1, m_reg, mnA, alA);
    if (NT > 1) { VMW(); SWRITE_H(1); }
    __syncthreads();
#define HALF_STEP(PX0, PX1, mnX, alX, PY0, PY1, alY, t, KB, VB, SB) do {                                                      \
        SBAR(); mw = MROW(t); qkt<KB, SK>(PX0, PX1, K_lds, r32, hi, S.qr, ACT(t));                                          \
        finishSM(PY0, PY1, alY, l_reg, pa0, pa1, pa2, pa3); SBAR();                                                           \
        if ((t) + 1 < NT) { SLOAD_H(KBASE((t) + 1)); SBAR(); }                                                        \
        pv_tile<VB, SK>(o, vb0, pa0, pa1, pa2, pa3, ACT((t) - 1)); MASKT(PX0, PX1, mw, (t)); partialSM(PX0, PX1, m_reg, mnX, alX); \
        __syncthreads();                                                                                                      \
        if ((t) + 1 < NT) { VMW(); SWRITE_H(SB); }                                                                            \
        RESC(alX); __syncthreads(); } while (0)
    for (int t = 1; t + 1 < NT; t += 2) {
        HALF_STEP(pB0, pB1, mnB, alB, pA0, pA1, alA, t, 1, 0, 0);
        HALF_STEP(pA0, pA1, mnA, alA, pB0, pB1, alB, t + 1, 0, 1, 1);
    }
    const bool even = (NT & 1) == 0;
    if (even) { SBAR(); mw = MROW(NT - 1); qkt<1, SK>(pB0, pB1, K_lds, r32, hi, S.qr, ACT(NT - 1)); SBAR(); }
    SLOAD_H(0); SBAR();
#pragma unroll
    for (int d0 = 0; d0 < 8; ++d0) S.qr[d0] = LD16(C.Q, qoff + d0 * 32, P0n * (PITCH * 2));
    SBAR();
    finishSM(pA0, pA1, alA, l_reg, pa0, pa1, pa2, pa3); SBAR();
    pv_tile<0, SK>(o, vb0, pa0, pa1, pa2, pa3, ACT(even ? NT - 2 : NT - 1));
    if (even) { MASKT(pB0, pB1, mw, NT - 1); partialSM(pB0, pB1, m_reg, mnB, alB); __syncthreads(); RESC(alB);
        finishSM(pB0, pB1, alB, l_reg, pa0, pa1, pa2, pa3); SBAR(); pv_tile<1, SK>(o, vb0, pa0, pa1, pa2, pa3, ACT(NT - 1)); }
    SBAR(); SEAM_K0();
    if (hi == 0) li_l[r32] = l_reg; asm volatile("s_waitcnt lgkmcnt(0)" ::: "memory");
    float rli[16];
#pragma unroll
    for (int r = 0; r < 16; ++r) rli[r] = __builtin_amdgcn_rcpf(li_l[crow(r, hi)]);
    const unsigned ooff = (unsigned)((wid * QBLK + 4 * hi) * PITCH + r32) * 2u;
#pragma unroll
    for (int r = 0; r < 16; ++r) { const int so = (P0 + (r & 3) + 8 * (r >> 2)) * (PITCH * 2);
#pragma unroll
        for (int d0 = 0; d0 < 4; ++d0) { const float v = o[d0][r] * rli[r];
            const float vn = __shfl_xor(v, 1);
            if ((r32 & 1) == 0) __builtin_amdgcn_raw_buffer_store_b32(cvtpk(v, vn), C.Q, (int)(ooff + d0 * 64), so, 0); } }
    __syncthreads();
#undef RESC
#undef MROW
#undef KBASE
#undef ACT
#undef MASKT
#undef SEAM_K0
#undef HALF_STEP
}
#undef VMW
#undef VMWN
#undef SLOAD_H
#undef SWRITE_HK
#undef SWRITE_HV
#undef SWRITE_H
#undef KSWZ
#undef SBAR
}

constexpr int NWAVES = 8;
constexpr int NTP = BATCH * SEQ, NTS = DEC_BATCH * DEC_SEQ, NTOK = NTP + NTS;
constexpr int NPM = NTOK / 256;
constexpr int N_MIX = 27 * 256, N_M1A = 12 * 256, N_M1B = 8 * 256;
static_assert(NTP % 256 == 0 && NTS % 256 == 0 && D_MODEL == 1024 && A_WIDTH == 1024 && B_WIDTH == 1024, "geometry");

constexpr size_t MiB = 1u << 20;
constexpr size_t WS_CTL = 0, CTL_ZERO_BYTES = 1 * MiB;
constexpr size_t WS_WMIX = 1 * MiB;
constexpr size_t WS_WMRG = WS_WMIX + 14 * MiB;
constexpr size_t WS_WAB  = WS_WMRG + 10 * MiB;
constexpr size_t WS_WO   = WS_WAB + 4 * MiB;
constexpr size_t WS_XB   = WS_WO + 2 * MiB;
constexpr size_t ROWBUF  = (size_t)NTOK * 1024 * 2;
constexpr size_t WS_QA   = WS_XB + ROWBUF;
constexpr size_t WS_KA   = WS_QA + ROWBUF;
constexpr size_t WS_VA   = WS_KA + ROWBUF;
constexpr size_t WS_QB   = WS_VA + ROWBUF;
constexpr size_t WS_QI   = WS_QB + ROWBUF;
constexpr size_t WS_KI   = WS_QI + 65 * MiB;
constexpr size_t WS_SM   = WS_KI + 9 * MiB;
constexpr size_t WS_MASK = WS_SM + 5 * MiB;
constexpr size_t WS_HST  = WS_MASK + 16 * MiB;
constexpr size_t WS_NAIVE = WS_HST + 3 * MiB;
constexpr size_t WS_NEED = WS_NAIVE;
static_assert(WS_WMIX + (size_t)N_MIX * 1024 * 2 <= WS_WMRG && WS_QI + (size_t)NTOK * 512 * 2 <= WS_KI && WS_KI + (size_t)NTOK * 64 * 2 <= WS_SM && WS_SM + (size_t)NTOK * 64 <= WS_MASK
              && WS_HST + (size_t)NTOK * 32 <= WS_NAIVE, "d_ws map");
constexpr int CW_BAR = 4096;
constexpr int RING_OFF = 0, RING_BYTES = 131072;
constexpr int LDS_BYTES = 147456;
constexpr int LDSCTL_OFF = LDS_BYTES - 512, MISC_OFF = LDSCTL_OFF + 320;

struct Args { const float* in[17]; float* out; unsigned char* ws; int ph_lo, ph_hi; };

__device__ __forceinline__ float bf2f(bf16 v) { return __uint_as_float((unsigned)v << 16); }
__device__ __forceinline__ float sigm(float x) { return 1.0f / (1.0f + __expf(-x)); }

__device__ __forceinline__ void tr_item(const float* W, int ldw, int c0, int nv, int k0, bf16* WT, int ldt, int r0, int kofs, LAS float* scr, int lane) {
    const int n_ = lane & 31;
#pragma unroll 8
    for (int i = 0; i < 32; ++i) { const int kk = 2 * i + (lane >> 5); scr[kk * 33 + n_] = (n_ < nv) ? W[(size_t)(k0 + kk) * ldw + c0 + n_] : 0.f; }
    LDS_WAIT(); asm volatile("" ::: "memory");
    const int c = lane & 7;
#pragma unroll
    for (int j = 0; j < 4; ++j) { const int n = (lane >> 3) + 8 * j; const LAS float* s = scr + (8 * c) * 33 + n;
        v4u o; o.x = pk2(s[0 * 33], s[1 * 33]); o.y = pk2(s[2 * 33], s[3 * 33]); o.z = pk2(s[4 * 33], s[5 * 33]); o.w = pk2(s[6 * 33], s[7 * 33]);
        if (n < nv) *(GAS v4u*)(WT + (size_t)(r0 + n) * ldt + kofs + k0 + 8 * c) = o; }
    LDS_WAIT(); asm volatile("" ::: "memory");
}
struct Seg { int src, n, dst; };
__device__ __forceinline__ Seg win_seg(int s) {
    switch (s) {
        case 0: return Seg{C_QA, 1024, 0};      case 1: return Seg{C_KA, 1024, 1024};  case 2: return Seg{C_VA, 1024, 2048};
        case 3: return Seg{C_QB, 1024, 3072};   case 4: return Seg{C_KB, 1024, 4096};  case 5: return Seg{C_VB, 1024, 5120};
        case 6: return Seg{C_QI, 512, 6144};    case 7: return Seg{C_KI, 64, 6656};    case 8: return Seg{C_WI, 8, 6720};
        case 9: return Seg{C_IA, 4, 6728};      case 10: return Seg{C_FA, 4, 6732};
        case 27: return Seg{C_ZB, 1024, 2048};  case 28: return Seg{C_GA, 1024, 3072}; case 29: return Seg{C_GB, 1024, 4096};
        default: { const int j = (s - 11) >> 1; return (s & 1) ? Seg{C_OA + 128 * j, 128, 256 * j} : Seg{C_ZA + 128 * j, 128, 256 * j + 128}; }
    }
}
struct P0Args { const float *xp, *xs, *w_in, *w_out_a, *w_out_b, *w_o; bf16 *XB, *WMIX, *WMRG, *WAB, *WO; };
__device__ __forceinline__ void p0_prologue(const P0Args& a, LAS unsigned char* lds, int vcu, int G, int wave, int lane) {
    LAS float* scr = (LAS float*)(lds + RING_OFF + wave * 16384);
    const int gw = vcu * NWAVES + wave, NGW = G * NWAVES;
    int base = 0;
    for (int s = 0; s < 30; ++s) {
        const Seg sg = win_seg(s); const int nblk = (sg.n + 31) / 32, nit = nblk * 16;
        bf16* WT = s < 11 ? a.WMIX : a.WMRG;
        for (int it = gw - (base % NGW); it < nit; it += NGW) { if (it < 0) continue; const int kb = it / nblk, nb = it % nblk; const int nv = sg.n - 32 * nb < 32 ? sg.n - 32 * nb : 32;
            tr_item(a.w_in, IN_COLS, sg.src + 32 * nb, nv, 64 * kb, WT, 1024, sg.dst + 32 * nb, 0, scr, lane); }
        base += nit;
    }
    for (int i = gw * 64 + lane; i < 176 * 128; i += NGW * 64) ((GAS v4u*)(a.WMIX + (size_t)6736 * 1024))[i] = (v4u){0u, 0u, 0u, 0u};
    for (int it = gw; it < 3 * 512; it += NGW) { const int w = it / 512, r = it % 512, kb = r / 32, nb = r % 32;
        if (w == 0) tr_item(a.w_out_a, 1024, 32 * nb, 32, 64 * kb, a.WAB, 2048, 32 * nb, 0, scr, lane);
        else if (w == 1) tr_item(a.w_out_b, 1024, 32 * nb, 32, 64 * kb, a.WAB, 2048, 32 * nb, 1024, scr, lane);
        else tr_item(a.w_o, 1024, 32 * nb, 32, 64 * kb, a.WO, 1024, 32 * nb, 0, scr, lane); }
    for (int m = gw; m < NTOK; m += NGW) {
        const float* xr = m < NTP ? a.xp + (size_t)m * 1024 : a.xs + (size_t)(m - NTP) * 1024;
        const GAS f32x4* xv = (const GAS f32x4*)xr + lane; GAS unsigned long long* o8 = (GAS unsigned long long*)(a.XB + (size_t)m * 1024) + lane;
#pragma unroll
        for (int j = 0; j < 4; ++j) { const f32x4 v = xv[64 * j]; o8[64 * j] = (unsigned long long)pk2(v.x, v.y) | ((unsigned long long)pk2(v.z, v.w) << 32); }
    }
}

namespace pg8 {
struct EpiMix {
    static constexpr bool PERM = true, AFTER_DRAIN = false, MIDK = false;
    bf16_t* QA4;
    bf16_t* KVc;
    bf16_t *QI, *KI; float* SM;
    float *okvp, *okvs;
    float *oikp, *oiks;
    __device__ __forceinline__ void mid(f32x4 (&)[2][2][4][2], const Unit&, int, int, int, int) const {}
    __device__ __forceinline__ void operator()(const f32x4 (&acc)[2][2][4][2], const Unit& u, int wr, int wc, int fr, int fq) const {
        const int pn = u.pn; const bool samp = u.pm >= NTP / 256;
        const int row0 = u.pm * BM + wr * 64 + fr, cl = wc * 32 + 8 * fq;
        if (pn < 16) {
            bf16_t* base = QA4 + (size_t)(pn >> 2) * ((size_t)NTOK * 1024); const float sc = (pn >= 4 && pn < 8) ? 0.0625f : 1.0f;
            const int col0 = (pn & 3) * 256 + cl;
#pragma unroll
            for (int ai = 0; ai < 2; ++ai)
#pragma unroll
                for (int m = 0; m < 4; ++m) { bf16_t* rowp = base + (size_t)(row0 + ai * HALF + m * 16) * 1024 + col0;
#pragma unroll
                    for (int bj = 0; bj < 2; ++bj) { const f32x4 v0 = acc[ai][bj][m][0] * sc, v1 = acc[ai][bj][m][1] * sc;
                        u32x4 w; w.x = cvt_pk_bf16(v0[0], v0[1]); w.y = cvt_pk_bf16(v0[2], v0[3]); w.z = cvt_pk_bf16(v1[0], v1[1]); w.w = cvt_pk_bf16(v1[2], v1[3]);
                        *(u32x4*)(rowp + bj * HALF) = w; } }
        } else if (pn < 24) {
            const int isV = pn >= 20 ? 1 : 0; const int col0 = (pn & 3) * 256 + cl;
            float* of = samp ? okvs + (size_t)isV * ((size_t)NTS * 1024) : okvp + (size_t)isV * ((size_t)NTP * 1024);
            bf16_t* cb = KVc + (size_t)isV * ((size_t)NTP * 1024);
#pragma unroll
            for (int ai = 0; ai < 2; ++ai)
#pragma unroll
                for (int m = 0; m < 4; ++m) { const int r = row0 + ai * HALF + m * 16; const int rr = samp ? r - NTP : r;
#pragma unroll
                    for (int bj = 0; bj < 2; ++bj) { const f32x4 v0 = acc[ai][bj][m][0], v1 = acc[ai][bj][m][1];
                        float* fp = of + (size_t)rr * 1024 + col0 + bj * HALF; *(f32x4*)fp = v0; *(f32x4*)(fp + 4) = v1;
                        if (!samp) { u32x4 w; w.x = cvt_pk_bf16(v0[0], v0[1]); w.y = cvt_pk_bf16(v0[2], v0[3]); w.z = cvt_pk_bf16(v1[0], v1[1]); w.w = cvt_pk_bf16(v1[2], v1[3]);
                            *(u32x4*)(cb + (size_t)r * 1024 + col0 + bj * HALF) = w; } } }
        } else if (pn < 26) {
            const int col0 = (pn - 24) * 256 + cl;
#pragma unroll
            for (int ai = 0; ai < 2; ++ai)
#pragma unroll
                for (int m = 0; m < 4; ++m) { bf16_t* rowp = QI + (size_t)(row0 + ai * HALF + m * 16) * 512 + col0;
#pragma unroll
                    for (int bj = 0; bj < 2; ++bj) { const f32x4 v0 = acc[ai][bj][m][0] * 0.125f, v1 = acc[ai][bj][m][1] * 0.125f;
                        u32x4 w; w.x = cvt_pk_bf16(v0[0], v0[1]); w.y = cvt_pk_bf16(v0[2], v0[3]); w.z = cvt_pk_bf16(v1[0], v1[1]); w.w = cvt_pk_bf16(v1[2], v1[3]);
                        *(u32x4*)(rowp + bj * HALF) = w; } }
        } else {
            float* oik = samp ? oiks : oikp;
#pragma unroll
            for (int ai = 0; ai < 2; ++ai)
#pragma unroll
                for (int m = 0; m < 4; ++m) { const int r = row0 + ai * HALF + m * 16; const int rr = samp ? r - NTP : r; const f32x4 v0 = acc[ai][0][m][0], v1 = acc[ai][0][m][1];
                    if (wc < 2) { float* fp = oik + (size_t)rr * 64 + cl; *(f32x4*)fp = v0; *(f32x4*)(fp + 4) = v1;
                        u32x4 w; w.x = cvt_pk_bf16(v0[0], v0[1]); w.y = cvt_pk_bf16(v0[2], v0[3]); w.z = cvt_pk_bf16(v1[0], v1[1]); w.w = cvt_pk_bf16(v1[2], v1[3]);
                        *(u32x4*)(KI + (size_t)r * 64 + cl) = w; }
                    else if (wc == 2 && fq < 2) { float* fp = SM + (size_t)r * 16 + 8 * fq; *(f32x4*)fp = v0; *(f32x4*)(fp + 4) = v1; } }
        }
    }
};
}


namespace ml {
typedef short bfx8 __attribute__((ext_vector_type(8)));
typedef short s16x4 __attribute__((ext_vector_type(4)));
typedef float f32x16 __attribute__((ext_vector_type(16)));
typedef float f32x2_t __attribute__((ext_vector_type(2))); typedef __bf16 bf16x2_t __attribute__((ext_vector_type(2)));
typedef short v4i16_t __attribute__((ext_vector_type(4)));
typedef unsigned u32x4 __attribute__((ext_vector_type(4)));
typedef unsigned u32x2 __attribute__((ext_vector_type(2)));
typedef float f32x4 __attribute__((ext_vector_type(4)));
#define MLAS __attribute__((address_space(3)))
constexpr int QP = 528, VP = 272;
constexpr int L_Q = 0, L_K = 64 * QP, L_V = 2 * 64 * QP, L_VW = L_V + 64 * VP, L_EX = L_VW + 64 * VP;
constexpr int L_G = L_EX + 32768;
constexpr int L_GW = L_G, L_GM = L_G + 256, L_GI = L_G + 512, L_GE = L_G + 768, L_GS = L_G + 1024;
constexpr int L_NV = L_G + 1280;
constexpr int L_QN = L_NV + 1024;
constexpr int L_DP = L_QN + 256;
constexpr int L_END = L_DP + 384;
__device__ __forceinline__ unsigned cvtpk(float lo, float hi) { f32x2_t v = {lo, hi}; bf16x2_t b = __builtin_convertvector(v, bf16x2_t); return __builtin_bit_cast(unsigned, b); }
__device__ __forceinline__ bfx8 pack_step(const f32x16& x, int s) {
    u32x4 p; p.x = cvtpk(x[8 * s + 0], x[8 * s + 1]); p.y = cvtpk(x[8 * s + 2], x[8 * s + 3]); p.z = cvtpk(x[8 * s + 4], x[8 * s + 5]); p.w = cvtpk(x[8 * s + 6], x[8 * s + 7]);
    return __builtin_bit_cast(bfx8, p);
}
__device__ __forceinline__ s16x4 vtr(MLAS const unsigned char* p) { return __builtin_bit_cast(s16x4, __builtin_amdgcn_ds_read_tr16_b64_v4i16((MLAS v4i16_t*)p)); }
__device__ __forceinline__ bfx8 cat8(s16x4 lo, s16x4 hi) { return (bfx8){lo[0], lo[1], lo[2], lo[3], hi[0], hi[1], hi[2], hi[3]}; }
__device__ __forceinline__ int crow(int r, int hi) { return (r & 3) + 8 * (r >> 2) + 4 * hi; }
__device__ __forceinline__ float logsig_(float x) { return fminf(x, 0.0f) - log1pf(__expf(-fabsf(x))); }
__device__ __forceinline__ float wsum_(float v) {
#pragma unroll
    for (int o = 1; o < 64; o <<= 1) v += __shfl_xor(v, o);
    return v; }
#define ML_MFMA(a, b, c) __builtin_amdgcn_mfma_f32_32x32x16_bf16((a), (b), (c), 0, 0, 0)

struct Item {
    __amdgpu_buffer_rsrc_t q, k, v;
    __amdgpu_buffer_rsrc_t sm;
    __amdgpu_buffer_rsrc_t C0, Cout;
    const float* n0; float m0; bool has0;
    float* nout; float* mout;
    int head, nchunk, L; float bi, bf;
};
#define ML_LD16(rs, vo, so) __builtin_bit_cast(u32x4, __builtin_amdgcn_raw_buffer_load_b128((rs), (int)(vo), (int)(so), 0))
#define ML_LDF(rs, vo, so) __builtin_bit_cast(float, __builtin_amdgcn_raw_buffer_load_b32((rs), (int)(vo), (int)(so), 0))

__device__ __forceinline__ void run_item(MLAS unsigned char* lds, const Item& it) {
    int tid = threadIdx.x; asm volatile("" : "+v"(tid));
    const int wave = __builtin_amdgcn_readfirstlane(tid >> 6), lane0 = tid & 63, g = wave >> 2, cb = wave & 3;
#define ML_LANE int lane = lane0; asm volatile("" : "+v"(lane)); const int r32 = lane & 31, hi = lane >> 5; (void)r32; (void)hi
    const int L = it.L, h = it.head;
    const unsigned coff = (unsigned)((lane0 >> 5) * 4096 + (lane0 & 31) * 4), qkoff = (unsigned)((tid >> 5) * 2048 + (tid & 31) * 16), voff = (unsigned)((tid >> 4) * 2048 + (tid & 15) * 16), hoff = (unsigned)((4 * (lane0 >> 5) * 1024 + (lane0 & 31)) * 2);
    f32x16 Cacc[4];
#pragma unroll
    for (int j = 0; j < 4; ++j)
#pragma unroll
        for (int i = 0; i < 16; ++i) Cacc[j][i] = it.has0 ? ML_LDF(it.C0, coff, ((128 * g + 32 * j + (i & 3) + 8 * (i >> 2)) * 256 + 32 * cb) * 4) : 0.f;
    if (tid < 256) ((MLAS float*)(lds + L_NV))[tid] = it.has0 ? it.n0[tid] : 0.f;
    float m = it.m0;
    u32x4 pq[4], pk[4], pv[2]; float pia, pfa;
#define ML_PREFETCH(c_) do { const int t0_ = (c_) * L; \
        _Pragma("unroll") for (int i = 0; i < 4; ++i) { const bool ok_ = 16 * i < L;     \
            pq[i] = ok_ ? ML_LD16(it.q, qkoff, (t0_ + 16 * i) * 2048) : (u32x4){0u, 0u, 0u, 0u}; pk[i] = ok_ ? ML_LD16(it.k, qkoff, (t0_ + 16 * i) * 2048) : (u32x4){0u, 0u, 0u, 0u}; } \
        _Pragma("unroll") for (int i = 0; i < 2; ++i) pv[i] = (32 * i < L) ? ML_LD16(it.v, voff, (t0_ + 32 * i) * 2048) : (u32x4){0u, 0u, 0u, 0u}; \
        { const int lane = lane0; const bool ok_ = lane < L; const float a_ = ML_LDF(it.sm, lane * 64, t0_ * 64 + (8 + h) * 4), f_ = ML_LDF(it.sm, lane * 64, t0_ * 64 + (12 + h) * 4); pia = ok_ ? a_ : 0.f; pfa = ok_ ? f_ : 0.f; } } while (0)
    ML_PREFETCH(0);
    for (int c = 0; c < it.nchunk; ++c) {
        float wsl, decay, mnext;
        { ML_LANE;
        float lf = (lane < L) ? logsig_(pfa + it.bf) : 0.f; float cum = lf;
#pragma unroll
        for (int o = 1; o < 64; o <<= 1) { const float t_ = __shfl_up(cum, o); if (lane >= o) cum += t_; }
        const float wv = (lane < L) ? (pia + it.bi) - cum : -INFINITY; float cmx = wv;
#pragma unroll
        for (int o = 1; o < 64; o <<= 1) { const float t_ = __shfl_up(cmx, o); if (lane >= o) cmx = fmaxf(cmx, t_); }
        const float Ml = fmaxf(m, cmx); const float M63 = __shfl(Ml, 63), cum63 = __shfl(cum, 63);
        wsl = __expf(wv - M63); decay = __expf(m - M63); mnext = cum63 + M63;
        if (wave == 0) { ((MLAS float*)(lds + L_GW))[lane] = wv; ((MLAS float*)(lds + L_GM))[lane] = Ml; ((MLAS float*)(lds + L_GI))[lane] = __expf(m - Ml);
                         ((MLAS float*)(lds + L_GE))[lane] = __expf(-(cum + Ml)); ((MLAS float*)(lds + L_GS))[lane] = wsl; } }
#pragma unroll
        for (int i = 0; i < 4; ++i) { const int p_ = tid + 512 * i, row_ = p_ >> 5, cp_ = p_ & 31;
            *(MLAS u32x4*)(lds + L_Q + row_ * QP + cp_ * 16) = pq[i]; *(MLAS u32x4*)(lds + L_K + row_ * QP + cp_ * 16) = pk[i]; }
#pragma unroll
        for (int i = 0; i < 2; ++i) { const int p_ = tid + 512 * i, row_ = p_ >> 4, cp_ = p_ & 15; const float wr_ = __shfl(wsl, row_ & 63);
            *(MLAS u32x4*)(lds + L_V + row_ * VP + cp_ * 16) = pv[i];
            u32x4 o_;
#pragma unroll
            for (int e = 0; e < 4; ++e) o_[e] = cvtpk(__uint_as_float(pv[i][e] << 16) * wr_, __uint_as_float(pv[i][e] & 0xffff0000u) * wr_);
            *(MLAS u32x4*)(lds + L_VW + row_ * VP + cp_ * 16) = o_; }
        __syncthreads();
        const int sb = g; f32x16 S0 = {}, S1 = {};
        { ML_LANE;
            MLAS const unsigned char* kp = lds + L_K + (32 * sb + r32) * QP + hi * 16; MLAS const unsigned char* q0 = lds + L_Q + r32 * QP + hi * 16; MLAS const unsigned char* q1 = q0 + 32 * QP;
#pragma unroll 4
            for (int ks = 0; ks < 16; ++ks) { const bfx8 ka = *(MLAS const bfx8*)(kp + ks * 32); const bfx8 qb1 = *(MLAS const bfx8*)(q1 + ks * 32);
                S1 = ML_MFMA(ka, qb1, S1);
                if (g == 0) { const bfx8 qb0 = *(MLAS const bfx8*)(q0 + ks * 32); S0 = ML_MFMA(ka, qb0, S0); } }
        }
        { ML_LANE;
            const float M1 = ((MLAS const float*)(lds + L_GM))[32 + r32], M0 = ((MLAS const float*)(lds + L_GM))[r32]; float d0 = 0.f, d1 = 0.f;
#pragma unroll
            for (int i = 0; i < 16; ++i) { const int sl = crow(i, hi); const float ws_ = ((MLAS const float*)(lds + L_GW))[32 * sb + sl];
                const int s_ = 32 * sb + sl;
                S1[i] = (s_ <= 32 + r32) ? S1[i] * __expf(ws_ - M1) : 0.f; d1 += S1[i];
                if (g == 0) { S0[i] = (s_ <= r32) ? S0[i] * __expf(ws_ - M0) : 0.f; d0 += S0[i]; } }
            { auto rr = __builtin_amdgcn_permlane32_swap(__float_as_uint(d1), __float_as_uint(d1), false, false); d1 = __uint_as_float(rr[0]) + __uint_as_float(rr[1]); }
            { auto rr = __builtin_amdgcn_permlane32_swap(__float_as_uint(d0), __float_as_uint(d0), false, false); d0 = __uint_as_float(rr[0]) + __uint_as_float(rr[1]); }
            if (cb == 0 && hi == 0) { if (g == 0) { ((MLAS float*)(lds + L_DP))[r32] = d0; ((MLAS float*)(lds + L_DP))[32 + r32] = d1; } else ((MLAS float*)(lds + L_DP))[64 + r32] = d1; }
        }
        f32x16 Y0 = {}, Y1 = {};
        { ML_LANE;
#pragma unroll
        for (int j = 0; j < 4; ++j)
#pragma unroll
            for (int ks = 0; ks < 2; ++ks) { const bfx8 xs = pack_step(Cacc[j], ks);
                MLAS const unsigned char* qa = lds + L_Q + r32 * QP + (128 * g + 32 * j + 16 * ks + 4 * hi) * 2;
                const u32x2 a0l = *(MLAS const u32x2*)(qa), a0h = *(MLAS const u32x2*)(qa + 16), a1l = *(MLAS const u32x2*)(qa + 32 * QP), a1h = *(MLAS const u32x2*)(qa + 32 * QP + 16);
                const bfx8 pa0 = __builtin_bit_cast(bfx8, (u32x4){a0l.x, a0l.y, a0h.x, a0h.y}), pa1 = __builtin_bit_cast(bfx8, (u32x4){a1l.x, a1l.y, a1h.x, a1h.y});
                Y0 = ML_MFMA(pa0, xs, Y0); Y1 = ML_MFMA(pa1, xs, Y1); }
#pragma unroll
        for (int i = 0; i < 16; ++i) { Y0[i] *= ((MLAS const float*)(lds + L_GI))[crow(i, hi)]; Y1[i] *= ((MLAS const float*)(lds + L_GI))[32 + crow(i, hi)]; } }
        { ML_LANE;
            const int i16 = lane & 15, q_ = i16 >> 2, p_ = i16 & 3, gi = lane >> 4;
            MLAS const unsigned char* vb = lds + L_V + (32 * sb + 4 * hi + q_) * VP + (32 * cb + 16 * (gi & 1) + 4 * p_) * 2;
#pragma unroll
            for (int ks = 0; ks < 2; ++ks) { const bfx8 pb = cat8(vtr(vb + (16 * ks) * VP), vtr(vb + (16 * ks + 8) * VP));
                Y1 = ML_MFMA(pack_step(S1, ks), pb, Y1);
                if (g == 0) Y0 = ML_MFMA(pack_step(S0, ks), pb, Y0); }
        }
        { ML_LANE;
            const f32x4 nv = *(MLAS const f32x4*)(lds + L_NV + lane * 16);
#pragma unroll
            for (int rr_ = 0; rr_ < 8; ++rr_) { const int l_ = 8 * wave + rr_; const u32x2 qw = *(MLAS const u32x2*)(lds + L_Q + l_ * QP + lane * 8);
                float d_ = __uint_as_float(qw.x << 16) * nv.x + __uint_as_float(qw.x & 0xffff0000u) * nv.y + __uint_as_float(qw.y << 16) * nv.z + __uint_as_float(qw.y & 0xffff0000u) * nv.w;
                d_ = wsum_(d_); if (lane == 0) ((MLAS float*)(lds + L_QN))[l_] = d_; }
        }
        { ML_LANE;
            MLAS float* ex = (MLAS float*)(lds + L_EX + ((1 - g) * 4 + cb) * 4096) + lane;
#pragma unroll
            for (int i = 0; i < 16; ++i) ex[i * 64] = (g == 0) ? Y1[i] : Y0[i];
        }
        __syncthreads();
        if (c + 1 < it.nchunk) ML_PREFETCH(c + 1);
        { ML_LANE;
            MLAS const float* ex = (MLAS const float*)(lds + L_EX + (g * 4 + cb) * 4096) + lane; f32x16 Y = (g == 0) ? Y0 : Y1;
#pragma unroll
            for (int i = 0; i < 16; ++i) Y[i] += ex[i * 64];
#pragma unroll
            for (int i = 0; i < 16; ++i) { const int l_ = 32 * g + crow(i, hi);
                const float dsum = (g == 0) ? ((MLAS const float*)(lds + L_DP))[l_] : ((MLAS const float*)(lds + L_DP))[l_] + ((MLAS const float*)(lds + L_DP))[32 + l_];
                const float den = dsum + ((MLAS const float*)(lds + L_GI))[l_] * ((MLAS const float*)(lds + L_QN))[l_];
                const float hv = Y[i] / fmaxf(fabsf(den), ((MLAS const float*)(lds + L_GE))[l_]);
                const float hn = __shfl_xor(hv, 1);
                if (32 * g < L && (r32 & 1) == 0) __builtin_amdgcn_raw_buffer_store_b32(cvtpk(hv, hn), it.v, (int)hoff, ((c * L + 32 * g + (i & 3) + 8 * (i >> 2)) * 1024 + 32 * cb) * 2, 0); }
        }
        if (tid < 256) { float a_ = 0.f;
#pragma unroll 8
            for (int s = 0; s < 64; ++s) a_ += ((MLAS const float*)(lds + L_GS))[s] * bf2f(*(MLAS const unsigned short*)(lds + L_K + s * QP + tid * 2));
            ((MLAS float*)(lds + L_NV))[tid] = decay * ((MLAS const float*)(lds + L_NV))[tid] + a_; }
        { ML_LANE;
            const int i16 = lane & 15, q_ = i16 >> 2, p_ = i16 & 3, gi = lane >> 4;
            MLAS const unsigned char* kb_ = lds + L_K + (8 * hi + q_) * QP + (128 * g + 16 * (gi & 1) + 4 * p_) * 2;
            MLAS const unsigned char* vw_ = lds + L_VW + (8 * hi + q_) * VP + (32 * cb + 16 * (gi & 1) + 4 * p_) * 2;
#pragma unroll
            for (int j = 0; j < 4; ++j)
#pragma unroll
                for (int i = 0; i < 16; ++i) Cacc[j][i] *= decay;
#pragma unroll
            for (int ks = 0; ks < 4; ++ks) { const bfx8 vb_ = cat8(vtr(vw_ + (16 * ks) * VP), vtr(vw_ + (16 * ks + 4) * VP));
#pragma unroll
                for (int j = 0; j < 4; ++j) { const bfx8 ka_ = cat8(vtr(kb_ + (16 * ks) * QP + 64 * j), vtr(kb_ + (16 * ks + 4) * QP + 64 * j));
                    Cacc[j] = ML_MFMA(ka_, vb_, Cacc[j]); } }
        }
        m = mnext;
        __syncthreads();
    }
#undef ML_PREFETCH
#undef ML_LANE
#pragma unroll
    for (int j = 0; j < 4; ++j)
#pragma unroll
        for (int i = 0; i < 16; ++i) __builtin_amdgcn_raw_buffer_store_b32(__float_as_uint(Cacc[j][i]), it.Cout, (int)coff, ((128 * g + 32 * j + (i & 3) + 8 * (i >> 2)) * 256 + 32 * cb) * 4, 0);
    if (it.nout && tid < 256) it.nout[tid] = ((MLAS const float*)(lds + L_NV))[tid];
    if (it.mout && tid == 0) *it.mout = m;
    __syncthreads();
}
#undef ML_MFMA
#undef ML_LD16
#undef ML_LDF
#undef MLAS
}

constexpr size_t WS_BC = WS_NAIVE, WS_WV = WS_BC + 2 * MiB, WS_CMX = WS_WV + 2 * MiB;
constexpr size_t WS_CHS = WS_CMX + 2 * MiB;
constexpr size_t WS_SMAT = WS_CHS + 1 * MiB;
constexpr size_t WS_CB = WS_SMAT + 3 * MiB;
constexpr size_t WS_NB = WS_CB + 64 * MiB;
constexpr size_t WS_MASKS = WS_NB + 1 * MiB;
constexpr size_t WS_HA = WS_MASKS + 1 * MiB;
constexpr size_t WS_END = WS_HA + ROWBUF;
constexpr int NCHK = BATCH * 4 * 32 + DEC_BATCH * 4;

__device__ __forceinline__ float logsig(float x) { return fminf(x, 0.0f) - log1pf(__expf(-fabsf(x))); }
__device__ __forceinline__ float siluf(float x) { return x / (1.0f + __expf(-x)); }
__device__ __forceinline__ int t5b(int rel) { const int n = rel < 0 ? -rel : rel; const int v = n < 8 ? n : 8 + (n >= 12) + (n >= 16) + (n >= 23) + (n >= 32) + (n >= 46) + (n >= 64) + (n >= 91); return (rel > 0 ? 16 : 0) + v; }

namespace pg8 {
__device__ __forceinline__ void unpack8(u32x4 w, float (&f)[8]) {
    f[0] = __uint_as_float(w.x << 16); f[1] = __uint_as_float(w.x & 0xffff0000u); f[2] = __uint_as_float(w.y << 16); f[3] = __uint_as_float(w.y & 0xffff0000u);
    f[4] = __uint_as_float(w.z << 16); f[5] = __uint_as_float(w.z & 0xffff0000u); f[6] = __uint_as_float(w.w << 16); f[7] = __uint_as_float(w.w & 0xffff0000u);
}
__device__ __forceinline__ u32x4 pack8f(const float (&f)[8]) { u32x4 w; w.x = cvt_pk_bf16(f[0], f[1]); w.y = cvt_pk_bf16(f[2], f[3]); w.z = cvt_pk_bf16(f[4], f[5]); w.w = cvt_pk_bf16(f[6], f[7]); return w; }
__device__ __forceinline__ float sg_(float x) { return 1.0f / (1.0f + __expf(-x)); }
struct EpiM1a {
    static constexpr bool PERM = true, AFTER_DRAIN = false, MIDK = false;
    const bf16_t* HA; const bf16_t* OB; const float* HST; const float* ang; bf16_t* BR;
    __device__ __forceinline__ void mid(f32x4 (&)[2][2][4][2], const Unit&, int, int, int, int) const {}
    __device__ __forceinline__ void operator()(const f32x4 (&acc)[2][2][4][2], const Unit& u, int wr, int wc, int fr, int fq) const {
        const int pn = u.pn; const int row0 = u.pm * BM + wr * 64 + fr, cl = wc * 32 + 8 * fq;
        if (pn < 8) {
            const int ch0 = 128 * pn + cl, head = pn >> 1;
            const f32x4 g0 = *(const f32x4*)(ang + ch0), g1 = *(const f32x4*)(ang + ch0 + 4);
            const float g[8] = {g0[0], g0[1], g0[2], g0[3], g1[0], g1[1], g1[2], g1[3]};
#pragma unroll
            for (int ai = 0; ai < 2; ++ai)
#pragma unroll
                for (int m = 0; m < 4; ++m) { const int r = row0 + ai * HALF + m * 16;
                    float h[8]; unpack8(*(const u32x4*)(HA + (size_t)r * 1024 + ch0), h);
                    const float mean = HST[((size_t)r * 4 + head) * 2], rstd = HST[((size_t)r * 4 + head) * 2 + 1];
                    const f32x4 o0 = acc[ai][0][m][0], o1 = acc[ai][0][m][1], z0 = acc[ai][1][m][0], z1 = acc[ai][1][m][1];
                    const float oa[8] = {o0[0], o0[1], o0[2], o0[3], o1[0], o1[1], o1[2], o1[3]}, za[8] = {z0[0], z0[1], z0[2], z0[3], z1[0], z1[1], z1[2], z1[3]};
                    float o[8];
#pragma unroll
                    for (int i = 0; i < 8; ++i) o[i] = ((h[i] - mean) * rstd * g[i] * sg_(oa[i])) * (za[i] * sg_(za[i]));
                    *(u32x4*)(BR + (size_t)r * 2048 + ch0) = pack8f(o); }
        } else {
#pragma unroll
            for (int ai = 0; ai < 2; ++ai)
#pragma unroll
                for (int m = 0; m < 4; ++m) { const int r = row0 + ai * HALF + m * 16;
#pragma unroll
                    for (int bj = 0; bj < 2; ++bj) { const int ch0 = 256 * (pn - 8) + 128 * bj + cl;
                        float ob[8]; unpack8(*(const u32x4*)(OB + (size_t)r * 1024 + ch0), ob);
                        const f32x4 z0 = acc[ai][bj][m][0], z1 = acc[ai][bj][m][1]; const float zb[8] = {z0[0], z0[1], z0[2], z0[3], z1[0], z1[1], z1[2], z1[3]};
                        float o[8];
#pragma unroll
                        for (int i = 0; i < 8; ++i) o[i] = ob[i] * (zb[i] * sg_(zb[i]));
                        *(u32x4*)(BR + (size_t)r * 2048 + 1024 + ch0) = pack8f(o); } }
        }
    }
};
struct EpiM1b {
    static constexpr bool PERM = true, AFTER_DRAIN = false, MIDK = false;
    bf16_t* SGA; bf16_t* SGB;
    __device__ __forceinline__ void mid(f32x4 (&)[2][2][4][2], const Unit&, int, int, int, int) const {}
    __device__ __forceinline__ void operator()(const f32x4 (&acc)[2][2][4][2], const Unit& u, int wr, int wc, int fr, int fq) const {
        const int pn = u.pn; const int row0 = u.pm * BM + wr * 64 + fr, cl = wc * 32 + 8 * fq;
        bf16_t* base = pn < 4 ? SGA : SGB; const int col0 = (pn & 3) * 256 + cl;
#pragma unroll
        for (int ai = 0; ai < 2; ++ai)
#pragma unroll
            for (int m = 0; m < 4; ++m) { bf16_t* rowp = base + (size_t)(row0 + ai * HALF + m * 16) * 1024 + col0;
#pragma unroll
                for (int bj = 0; bj < 2; ++bj) { const f32x4 v0 = acc[ai][bj][m][0], v1 = acc[ai][bj][m][1];
                    const float o[8] = {sg_(v0[0]), sg_(v0[1]), sg_(v0[2]), sg_(v0[3]), sg_(v1[0]), sg_(v1[1]), sg_(v1[2]), sg_(v1[3])};
                    *(u32x4*)(rowp + bj * HALF) = pack8f(o); } }
    }
};
struct EpiM2 {
    static constexpr bool PERM = true, AFTER_DRAIN = false, MIDK = true;
    const bf16_t* SGA; const bf16_t* SGB; bf16_t* MX;
    __device__ __forceinline__ void mid(f32x4 (&acc)[2][2][4][2], const Unit& u, int wr, int wc, int fr, int fq) const {
        int fr_ = fr, fq_ = fq; asm volatile("" : "+v"(fr_), "+v"(fq_));
        const int row0 = u.pm * BM + wr * 64 + fr_, col0 = u.pn * BM + wc * 32 + 8 * fq_;
#pragma unroll
        for (int ai = 0; ai < 2; ++ai)
#pragma unroll
            for (int m = 0; m < 4; ++m) { const size_t ro = (size_t)(row0 + ai * HALF + m * 16) * 1024 + col0;
#pragma unroll
                for (int bj = 0; bj < 2; ++bj) { float a[8], b[8]; unpack8(*(const u32x4*)(SGA + ro + bj * HALF), a); unpack8(*(const u32x4*)(SGB + ro + bj * HALF), b);
#pragma unroll
                    for (int i = 0; i < 4; ++i) { acc[ai][bj][m][0][i] *= a[i] * __builtin_amdgcn_rcpf(b[i]); acc[ai][bj][m][1][i] *= a[4 + i] * __builtin_amdgcn_rcpf(b[4 + i]); } }
                asm volatile("" ::: "memory"); }
    }
    __device__ __forceinline__ void operator()(const f32x4 (&acc)[2][2][4][2], const Unit& u, int wr, int wc, int fr, int fq) const {
        int fr_ = fr, fq_ = fq; asm volatile("" : "+v"(fr_), "+v"(fq_));
        const int row0 = u.pm * BM + wr * 64 + fr_, col0 = u.pn * BM + wc * 32 + 8 * fq_;
#pragma unroll
        for (int ai = 0; ai < 2; ++ai)
#pragma unroll
            for (int m = 0; m < 4; ++m) { const size_t ro = (size_t)(row0 + ai * HALF + m * 16) * 1024 + col0;
#pragma unroll
                for (int bj = 0; bj < 2; ++bj) { float b[8]; unpack8(*(const u32x4*)(SGB + ro + bj * HALF), b);
                    const f32x4 v0 = acc[ai][bj][m][0], v1 = acc[ai][bj][m][1];
                    const float o[8] = {v0[0] * b[0], v0[1] * b[1], v0[2] * b[2], v0[3] * b[3], v1[0] * b[4], v1[1] * b[5], v1[2] * b[6], v1[3] * b[7]};
                    *(u32x4*)(MX + ro + bj * HALF) = pack8f(o); }
                asm volatile("" ::: "memory"); }
    }
};
struct EpiM3 {
    static constexpr bool PERM = true, AFTER_DRAIN = false, MIDK = false;
    const float* xp; const float* xs; float* yp; float* ys;
    __device__ __forceinline__ void mid(f32x4 (&)[2][2][4][2], const Unit&, int, int, int, int) const {}
    __device__ __forceinline__ void operator()(const f32x4 (&acc)[2][2][4][2], const Unit& u, int wr, int wc, int fr, int fq) const {
        const bool samp = u.pm >= NTP / 256; const int row0 = (samp ? u.pm - NTP / 256 : u.pm) * BM + wr * 64 + fr, col0 = u.pn * BM + wc * 32 + 8 * fq;
        const float* xb = samp ? xs : xp; float* yb = samp ? ys : yp;
#pragma unroll
        for (int ai = 0; ai < 2; ++ai)
#pragma unroll
            for (int m = 0; m < 4; ++m) { const size_t ro = (size_t)(row0 + ai * HALF + m * 16) * 1024 + col0;
#pragma unroll
                for (int bj = 0; bj < 2; ++bj) { const f32x4 x0 = *(const f32x4*)(xb + ro + bj * HALF), x1 = *(const f32x4*)(xb + ro + bj * HALF + 4);
                    *(f32x4*)(yb + ro + bj * HALF) = x0 * DN_ALPHA + acc[ai][bj][m][0]; *(f32x4*)(yb + ro + bj * HALF + 4) = x1 * DN_ALPHA + acc[ai][bj][m][1]; } }
    }
};
}

__device__ __forceinline__ float wave_sum(float v) {
#pragma unroll
    for (int o = 1; o < 64; o <<= 1) v += __shfl_xor(v, o);
    return v;
}

__device__ __forceinline__ void simple_select_row(LAS unsigned char* lds, int row, unsigned long long* mrow, const bf16* QI_, const float* SM_, const bf16* KI_, const float* cache_ik_) {
    const int tid_ = threadIdx.x, lane_ = tid_ & 63, wave_ = tid_ >> 6;
    LAS float* sc = (LAS float*)(lds + RING_OFF);
    LAS float* qv = (LAS float*)(lds + RING_OFF + 16384);
    const bool samp = row >= NTP; const int b = samp ? (row - NTP) / DEC_SEQ : row / SEQ; const int q = samp ? (row - NTP) % DEC_SEQ : row % SEQ;
    const int S = samp ? PAST_LEN + DEC_SEQ : ((q >> 6) + 1) * 64;
    if (S <= TOPK_MAX) { if (tid_ < 32) mrow[tid_] = (tid_ < (S >> 6)) ? ~0ull : 0ull; return; }
    qv[tid_] = bf2f(QI_[(size_t)row * 512 + tid_]); if (tid_ < 8) qv[512 + tid_] = SM_[(size_t)row * 16 + tid_] * 0.35355339059327373f;
    __syncthreads();
    const int nIt = (S + 511) / 512;
    for (int i = 0; i < nIt; ++i) { const int s = tid_ + 512 * i;
        if (s < S) { float kf[64];
            if (samp && s < PAST_LEN) { const float* kr = cache_ik_ + ((size_t)b * PAST_LEN + s) * 64;
#pragma unroll
                for (int j = 0; j < 64; ++j) kf[j] = kr[j]; }
            else { const bf16* kr = KI_ + (samp ? (size_t)NTP + (size_t)b * DEC_SEQ + (s - PAST_LEN) : (size_t)b * SEQ + s) * 64;
#pragma unroll
                for (int j = 0; j < 64; ++j) kf[j] = bf2f(kr[j]); }
            float a = 0.f;
#pragma unroll
            for (int h = 0; h < 8; ++h) { float d = 0.f;
#pragma unroll
                for (int j = 0; j < 64; ++j) d += qv[h * 64 + j] * kf[j];
                a += qv[512 + h] * fmaxf(d, 0.f); }
            sc[s] = a; } }
    __syncthreads();
    for (int i = 0; i < nIt; ++i) { const int s = tid_ + 512 * i; bool keep = false;
        if (s < S) { const int v = __float_as_int(sc[s]); const int vk = v ^ ((v >> 31) & 0x7fffffff); int rank = 0;
            for (int j = 0; j < S; ++j) { const int u = __float_as_int(sc[j]); const int uk = u ^ ((u >> 31) & 0x7fffffff); rank += (uk > vk) || (uk == vk && j < s); } keep = rank < TOPK_MAX; }
        const unsigned long long bm = __ballot(keep);
        if (lane_ == 0 && (wave_ + 8 * i) * 64 < S) mrow[wave_ + 8 * i] = bm; }
    if (!samp) { const int nw = S >> 6; if (tid_ >= nw && tid_ < 32) mrow[tid_] = 0ull; }
    __syncthreads();
}
__device__ __forceinline__ void simple_attn_task(int row, int h, int dc, const unsigned long long* mrow, const bf16* QB_, const bf16* KBc_, const bf16* VBc_, const float* cache_k_, const float* cache_v_,
                                                  const float* k_sample_, const float* v_sample_, const float* rel_bias_, bf16* orow) {
    const bool samp = row >= NTP; const int b = samp ? (row - NTP) / DEC_SEQ : row / SEQ; const int q = samp ? (row - NTP) % DEC_SEQ : row % SEQ;
    const int S = samp ? PAST_LEN + DEC_SEQ : ((q >> 6) + 1) * 64; const int qpos = samp ? PAST_LEN + q : q;
    const bf16* qr = QB_ + (size_t)row * 1024 + h * 128;
    float mx = -INFINITY, sum = 0.f, o[16];
#pragma unroll
    for (int i = 0; i < 16; ++i) o[i] = 0.f;
    for (int w = 0; w * 64 < S; ++w) { unsigned long long bits = mrow[w];
        while (bits) { const int s = w * 64 + __builtin_ctzll(bits); bits &= bits - 1;
            float d = 0.f; float vv[16];
            if (samp) { const float* kr = (s < PAST_LEN) ? cache_k_ + ((size_t)b * PAST_LEN + s) * 1024 + h * 128 : k_sample_ + ((size_t)b * DEC_SEQ + (s - PAST_LEN)) * 1024 + h * 128;
                const float* vr = (s < PAST_LEN) ? cache_v_ + ((size_t)b * PAST_LEN + s) * 1024 + h * 128 + dc * 16 : v_sample_ + ((size_t)b * DEC_SEQ + (s - PAST_LEN)) * 1024 + h * 128 + dc * 16;
#pragma unroll 8
                for (int j = 0; j < 128; ++j) d += bf2f(qr[j]) * kr[j];
#pragma unroll
                for (int i = 0; i < 16; ++i) vv[i] = vr[i]; }
            else { const bf16* kr = KBc_ + ((size_t)b * SEQ + s) * 1024 + h * 128; const bf16* vr = VBc_ + ((size_t)b * SEQ + s) * 1024 + h * 128 + dc * 16;
#pragma unroll 8
                for (int j = 0; j < 128; ++j) d += bf2f(qr[j]) * bf2f(kr[j]);
#pragma unroll
                for (int i = 0; i < 16; ++i) vv[i] = bf2f(vr[i]); }
            const float lg = d * 0.08838834764831845f + rel_bias_[t5b(s - qpos) * 8 + h];
            if (lg > mx) { const float f = __expf(mx - lg); sum *= f;
#pragma unroll
                for (int i = 0; i < 16; ++i) o[i] *= f; mx = lg; }
            const float p = __expf(lg - mx); sum += p;
#pragma unroll
            for (int i = 0; i < 16; ++i) o[i] += p * vv[i]; } }
    const float inv = 1.0f / sum;
#pragma unroll
    for (int i = 0; i < 16; ++i) orow[i] = (bf16)f2bf(o[i] * inv);
}


template <int NWMAX>
__device__ __forceinline__ unsigned long long wave_select(LAS const int* row, int nW, int lane_) {
    int v[NWMAX]; int vmx = (int)0x80000000, vmn = 0x7fffffff;
#pragma unroll
    for (int i = 0; i < NWMAX; ++i) { v[i] = (i < nW) ? row[lane_ + 64 * i] : (int)0x80000000; if (i < nW) { vmx = max(vmx, v[i]); if (v[i] != (int)0x80000000) vmn = min(vmn, v[i]); } }
#pragma unroll
    for (int o_ = 1; o_ < 64; o_ <<= 1) { vmx = max(vmx, __shfl_xor(vmx, o_)); vmn = min(vmn, __shfl_xor(vmn, o_)); }
    long lo_ = vmn, hi_ = vmx; bool exact = false; int T = vmn;
    while (lo_ < hi_) { const int mid = (int)(lo_ + ((hi_ - lo_ + 1) >> 1)); int cnt = 0;
#pragma unroll
        for (int i = 0; i < NWMAX; ++i) { if (i < nW) cnt += __builtin_popcountll(__ballot(v[i] >= mid)); if ((i & 3) == 3) __builtin_amdgcn_sched_barrier(0); }
        if (cnt == TOPK_MAX) { exact = true; T = mid; break; }
        if (cnt > TOPK_MAX) lo_ = mid; else hi_ = (long)mid - 1; }
    if (!exact) T = (int)lo_;
    int need = TOPK_MAX;
    if (!exact) { int cgt = 0;
#pragma unroll
        for (int i = 0; i < NWMAX; ++i) { if (i < nW) cgt += __builtin_popcountll(__ballot(v[i] > T)); if ((i & 3) == 3) __builtin_amdgcn_sched_barrier(0); }
        need = TOPK_MAX - cgt; }
    unsigned long long myw = 0ull; int running = 0; const unsigned long long lt = (1ull << lane_) - 1ull;
#pragma unroll
    for (int i = 0; i < NWMAX; ++i) if (i < nW) { bool sel;
        if (exact) sel = v[i] >= T;
        else { const bool eq = v[i] == T; const unsigned long long em = __ballot(eq); sel = (v[i] > T) || (eq && running + __builtin_popcountll(em & lt) < need); running += __builtin_popcountll(em); }
        const unsigned long long wd = __ballot(sel); if (lane_ == i) myw = wd; __builtin_amdgcn_sched_barrier(0); }
    return myw;
}
__device__ __forceinline__ void sample_select_row(LAS unsigned char* lds, int row, unsigned long long* mrow, const bf16* QI_, const float* SM_, const bf16* KI_, const float* cache_ik_) {
    const int tid_ = threadIdx.x, lane_ = tid_ & 63, wave_ = __builtin_amdgcn_readfirstlane(tid_ >> 6);
    LAS int* sck = (LAS int*)(lds + RING_OFF);
    LAS float* qv = (LAS float*)(lds + RING_OFF + 16384);
    const int b = (row - NTP) / DEC_SEQ; constexpr int S = PAST_LEN + DEC_SEQ;
    qv[tid_] = bf2f(QI_[(size_t)row * 512 + tid_]); if (tid_ < 8) qv[512 + tid_] = SM_[(size_t)row * 16 + tid_] * 0.35355339059327373f;
    __syncthreads();
#pragma unroll 1
    for (int i = 0; i < 5; ++i) { const int s = tid_ + 512 * i;
        if (s < 2112) { int key = (int)0x80000000;
            if (s < S) { float kf[64];
                if (s < PAST_LEN) { const float* kr = cache_ik_ + ((size_t)b * PAST_LEN + s) * 64;
#pragma unroll
                    for (int j = 0; j < 64; ++j) kf[j] = kr[j]; }
                else { const bf16* kr = KI_ + ((size_t)NTP + (size_t)b * DEC_SEQ + (s - PAST_LEN)) * 64;
#pragma unroll
                    for (int j = 0; j < 64; ++j) kf[j] = bf2f(kr[j]); }
                float a = 0.f;
#pragma unroll
                for (int h = 0; h < 8; ++h) { float d = 0.f;
#pragma unroll
                    for (int j = 0; j < 64; ++j) d += qv[h * 64 + j] * kf[j];
                    a += qv[512 + h] * fmaxf(d, 0.f); }
                const int kb_ = __float_as_int(a); key = kb_ ^ ((kb_ >> 31) & 0x7fffffff); }
            sck[s] = key; } }
    __syncthreads();
    if (wave_ == 0) { const unsigned long long myw = wave_select<33>(sck, 33, lane_); if (lane_ < 33) mrow[lane_] = myw; }
    __syncthreads();
}
__device__ __forceinline__ void sample_attn_row(LAS unsigned char* lds, int b, int r, const unsigned long long* mrow, bf16* qo_row  , const float* cache_k_, const float* cache_v_,
                                                 const float* k_new, const float* v_new  , const float* rel_bias_) {
    const int tid_ = threadIdx.x, lane_ = tid_ & 63, h = __builtin_amdgcn_readfirstlane(tid_ >> 6);
    LAS int* idx = (LAS int*)(lds + RING_OFF);
    LAS float* qf = (LAS float*)(lds + RING_OFF + 1024) + h * 128;
    if (h == 0) { int base = 0; const unsigned long long lt = (1ull << lane_) - 1ull;
        for (int w = 0; w < 33; ++w) { const unsigned long long bits = mrow[w]; if ((bits >> lane_) & 1ull) idx[base + __builtin_popcountll(bits & lt)] = 64 * w + lane_; base += __builtin_popcountll(bits); } }
    qf[lane_] = bf2f(qo_row[h * 128 + lane_]); qf[64 + lane_] = bf2f(qo_row[h * 128 + 64 + lane_]);
    __syncthreads();
    const int qpos = PAST_LEN + r; float lg[4]; int sk[4];
#pragma unroll
    for (int rnd = 0; rnd < 4; ++rnd) { const int s = idx[64 * rnd + lane_]; sk[rnd] = s;
        const float* kr = (s < PAST_LEN) ? cache_k_ + ((size_t)b * PAST_LEN + s) * 1024 + h * 128 : k_new + (size_t)(s - PAST_LEN) * 1024 + h * 128;
        float d = 0.f;
#pragma unroll 8
        for (int d4 = 0; d4 < 32; ++d4) { const f32x4 kk = *(const f32x4*)(kr + 4 * d4); const f32x4 qq = *(LAS const f32x4*)(qf + 4 * d4); d += (kk.x * qq.x + kk.y * qq.y) + (kk.z * qq.z + kk.w * qq.w); }
        lg[rnd] = d * 0.08838834764831845f + rel_bias_[t5b(s - qpos) * 8 + h]; }
    float mx = fmaxf(fmaxf(lg[0], lg[1]), fmaxf(lg[2], lg[3]));
#pragma unroll
    for (int o_ = 1; o_ < 64; o_ <<= 1) mx = fmaxf(mx, __shfl_xor(mx, o_));
    float p[4], sum = 0.f;
#pragma unroll
    for (int rnd = 0; rnd < 4; ++rnd) { p[rnd] = __expf(lg[rnd] - mx); sum += p[rnd]; }
    sum = wave_sum(sum);
    float a0 = 0.f, a1 = 0.f;
#pragma unroll
    for (int rnd = 0; rnd < 4; ++rnd) {
#pragma unroll 8
        for (int j = 0; j < 64; ++j) { const float pj = __int_as_float(__builtin_amdgcn_readlane(__float_as_int(p[rnd]), j)); const int sj = __builtin_amdgcn_readlane(sk[rnd], j);
            const float* vr = (sj < PAST_LEN) ? cache_v_ + ((size_t)b * PAST_LEN + sj) * 1024 + h * 128 : v_new + (size_t)(sj - PAST_LEN) * 1024 + h * 128;
            const float2 vv = *(const float2*)(vr + 2 * lane_); a0 += pj * vv.x; a1 += pj * vv.y; } }
    const float inv = 1.0f / sum;
    *(unsigned*)(qo_row + h * 128 + 2 * lane_) = pk2(a0 * inv, a1 * inv);
    __syncthreads();
}

typedef const __attribute__((address_space(4))) Args* kargp_t;
#define MK_ARGS kargp_t ap_ = (kargp_t)__builtin_amdgcn_kernarg_segment_ptr(); asm volatile("" : "+s"(ap_))
#define args (*ap_)
__global__ void __launch_bounds__(NWAVES * 64, 2) mk_fwd(Args kargs_by_value) {
    extern __shared__ __attribute__((aligned(16))) unsigned char lds_raw[];
    LAS unsigned char* lds = (LAS unsigned char*)lds_raw;
    int lo, hi; unsigned* barw;
    { MK_ARGS; lo = args.ph_lo; hi = args.ph_hi; barw = (unsigned*)((gu32*)(args.ws + WS_CTL) + CW_BAR); }
    volatile LAS unsigned* MISC = (volatile LAS unsigned*)(lds + MISC_OFF);
    for (int u = threadIdx.x; u < (LDS_BYTES - LDSCTL_OFF) / 4; u += NWAVES * 64) ((LAS unsigned*)(lds + LDSCTL_OFF))[u] = 0u;
    __syncthreads();
    XcdBarrier bar = xcd_barrier_post(barw, MISC + 8);
#ifndef DUPMASK
#define DUPMASK 0
#endif
#ifndef PHMASK
#define PHMASK 0x3ff
#endif
#define IN(k) (((PHMASK >> (k)) & 1) && lo <= (k) && (k) < hi)
#define GBAR() xcd_barrier(bar)
#define WMIX ((bf16*)(args.ws + WS_WMIX))
#define WMRG ((bf16*)(args.ws + WS_WMRG))
#define WAB ((bf16*)(args.ws + WS_WAB))
#define WO ((bf16*)(args.ws + WS_WO))
#define XB ((bf16*)(args.ws + WS_XB))
#define QA ((bf16*)(args.ws + WS_QA))
#define KA ((bf16*)(args.ws + WS_KA))
#define VA ((bf16*)(args.ws + WS_VA))
#define QB ((bf16*)(args.ws + WS_QB))
#define QI ((bf16*)(args.ws + WS_QI))
#define KI ((bf16*)(args.ws + WS_KI))
#define SM ((float*)(args.ws + WS_SM))
#define MASK ((unsigned long long*)(args.ws + WS_MASK))
#define MASKS ((unsigned long long*)(args.ws + WS_MASKS))
#define HST ((float*)(args.ws + WS_HST))
#define BC ((float*)(args.ws + WS_BC))
#define WV ((float*)(args.ws + WS_WV))
#define CMX ((float*)(args.ws + WS_CMX))
#define CHS ((float*)(args.ws + WS_CHS))
#define MCH (CHS + 2 * NCHK)
#define SMATP ((float*)(args.ws + WS_SMAT))
#define SMATS (SMATP + 128 * 4096)
#define CB ((float*)(args.ws + WS_CB))
#define NBf ((float*)(args.ws + WS_NB))
#define HA VA
#define OB QB
#define BR QA
#define SGA VA
#define SGB QB
#define MX XB
#define y_prompt (args.out)
#define y_sample (y_prompt + (size_t)NTP * 1024)
#define k_prompt (y_sample + (size_t)NTS * 1024)
#define v_prompt (k_prompt + (size_t)NTP * 1024)
#define ik_prompt (v_prompt + (size_t)NTP * 1024)
#define C_prompt (ik_prompt + (size_t)NTP * 64)
#define n_prompt (C_prompt + (size_t)BATCH * 4 * 65536)
#define m_prompt (n_prompt + (size_t)BATCH * 1024)
#define k_sample (m_prompt + BATCH * 4)
#define v_sample (k_sample + (size_t)NTS * 1024)
#define ik_sample (v_sample + (size_t)NTS * 1024)
#define C_sample (ik_sample + (size_t)NTS * 64)
#define n_sample (C_sample + (size_t)DEC_BATCH * 4 * 65536)
#define m_sample (n_sample + (size_t)DEC_BATCH * 1024)
#define KBc ((bf16*)y_prompt)
#define VBc (KBc + (size_t)NTP * 1024)
#define cache_k (args.in[2])
#define cache_v (args.in[3])
#define cache_ik (args.in[4])
#define state_C (args.in[5])
#define state_n (args.in[6])
#define state_m (args.in[7])
#define b_gates (args.in[9])
#define a_norm_g (args.in[10])
#define rel_bias (args.in[14])
#define ln_g (args.in[15])
#define ln_b (args.in[16])
#define gtid ({ int t__ = (int)threadIdx.x; asm volatile("" : "+v"(t__)); (long)blockIdx.x * (NWAVES * 64) + (long)t__; })
#define GT ((long)gridDim.x * (NWAVES * 64))
#define gw (vcu * NWAVES + wave)
#define NGW ((int)gridDim.x * NWAVES)
#define tid ((int)threadIdx.x)
#define lane ((int)(threadIdx.x & 63))
#define wave (__builtin_amdgcn_readfirstlane((int)(threadIdx.x >> 6)))
#define G ((int)gridDim.x)
#define vcu ((G % 8 == 0) ? ((int)blockIdx.x % 8) * (G / 8) + (int)blockIdx.x / 8 : (int)blockIdx.x)

    if (IN(0))
#if (DUPMASK >> 0) & 1
    for (int rep_ = 0; rep_ < 2; ++rep_)
#endif
    { MK_ARGS;
        P0Args a{args.in[0], args.in[1], args.in[8], args.in[11], args.in[12], args.in[13], XB, WMIX, WMRG, WAB, WO};
        p0_prologue(a, lds, vcu, G, wave, lane);
        GBAR();
    }
    if (IN(1))
#if (DUPMASK >> 1) & 1
    for (int rep_ = 0; rep_ < 2; ++rep_)
#endif
    { MK_ARGS;
        pg8::Gemm g{XB, WMIX, NTOK, N_MIX, 1024}; pg8::StaticOrder S; S.init(NTOK, N_MIX, G, (int)blockIdx.x);
        pg8::EpiMix E{QA, KBc, QI, KI, SM, k_prompt, k_sample, ik_prompt, ik_sample};
        pg8::gemm_phase<pg8::EpiMix, pg8::StaticOrder, true, true>(lds + RING_OFF, g, S, E);
        GBAR();
    }
    if (IN(2))
#if (DUPMASK >> 2) & 1
    for (int rep_ = 0; rep_ < 2; ++rep_)
#endif
    { MK_ARGS;
        static_assert(ml::L_END <= LDSCTL_OFF, "mLSTM LDS image");
#ifdef PROBE_ML
#define HAREF ((bf16*)(args.ws + WS_HA))
        for (long t = gtid; t < NCHK; t += GT) {
            int h, L; long tok0;
            if (t < 4096) { const int b = (int)(t >> 7); h = (int)((t >> 5) & 3); const int c = (int)(t & 31); tok0 = (long)b * SEQ + c * 64; L = 64; }
            else { const int b = (int)((t - 4096) >> 2); h = (int)((t - 4096) & 3); tok0 = NTP + (long)b * DEC_SEQ; L = DEC_SEQ; }
            const float bi = b_gates[h], bfg = b_gates[4 + h]; float cum = 0.f, cmax = -INFINITY;
            for (int l = 0; l < L; ++l) { const long tok = tok0 + l; const float ig = SM[tok * 16 + 8 + h] + bi; const float lf = logsig(SM[tok * 16 + 12 + h] + bfg);
                cum += lf; const float w = ig - cum; cmax = fmaxf(cmax, w); BC[tok * 4 + h] = cum; WV[tok * 4 + h] = w; CMX[tok * 4 + h] = cmax; }
            CHS[2 * t] = cum; CHS[2 * t + 1] = cmax;
        }
        GBAR();
        for (long t = gtid; t < BATCH * 4 + DEC_BATCH * 4; t += GT) {
            if (t < BATCH * 4) { float m = 0.f; for (int c = 0; c < 32; ++c) { const long i = t * 32 + c; MCH[i] = m; m = CHS[2 * i] + fmaxf(m, CHS[2 * i + 1]); } m_prompt[t] = m; }
            else { const long j = t - BATCH * 4; const long i = 4096 + j; float m = state_m[j]; MCH[i] = m; m = CHS[2 * i] + fmaxf(m, CHS[2 * i + 1]); m_sample[j] = m; }
        }
        GBAR();
        for (int c = 0; c < 32; ++c) {
            const long nSp = 128L * 4096, nSs = (c == 0) ? 64L * 1024 : 0;
            for (long t = gtid; t < nSp + nSs; t += GT) {
                int bh, l, s, L; long tok0; float* dst;
                if (t < nSp) { bh = (int)(t >> 12); l = (int)((t >> 6) & 63); s = (int)(t & 63); L = 64; tok0 = (long)(bh >> 2) * SEQ + c * 64; dst = SMATP + t; }
                else { const long u = t - nSp; bh = (int)(u >> 10); l = (int)((u >> 5) & 31); s = (int)(u & 31); L = 32; tok0 = NTP + (long)(bh >> 2) * DEC_SEQ; dst = SMATS + u; }
                const int h = bh & 3; float val = 0.f;
                if (s <= l) { const long tl = tok0 + l, ts = tok0 + s; const bf16* q = QA + tl * 1024 + h * 256; const bf16* k = KA + ts * 1024 + h * 256;
                    float d = 0.f; for (int i = 0; i < 256; ++i) d += bf2f(q[i]) * bf2f(k[i]);
                    const long ci = (t < nSp) ? (long)bh * 32 + c : 4096 + bh;
                    val = d * __expf(WV[ts * 4 + h] - fmaxf(MCH[ci], CMX[tl * 4 + h])); }
                *dst = val;
            }
            GBAR();
            const long nHp = 32L * 64 * 1024, nHs = (c == 0) ? 16L * 32 * 1024 : 0, nCp = 128L * 65536, nCs = (c == 0) ? 64L * 65536 : 0;
            for (long t = gtid; t < nHp + nHs + nCp + nCs; t += GT) {
                if (t < nHp + nHs) {
                    int b, l, h, dv, L; long tok0, ci; const float* Sr; const float* Cm; const float* nv; bool zero = false;
                    if (t < nHp) { b = (int)(t >> 16); l = (int)((t >> 10) & 63); h = (int)((t >> 8) & 3); dv = (int)(t & 255); L = 64; tok0 = (long)b * SEQ + c * 64; ci = (long)(b * 4 + h) * 32 + c;
                        Sr = SMATP + ((long)(b * 4 + h) * 64 + l) * 64; Cm = CB + (size_t)(c & 1) * 128 * 65536 + (size_t)(b * 4 + h) * 65536; nv = NBf + (c & 1) * 128 * 256 + (b * 4 + h) * 256; zero = (c == 0); }
                    else { const long u = t - nHp; b = (int)(u >> 15); l = (int)((u >> 10) & 31); h = (int)((u >> 8) & 3); dv = (int)(u & 255); L = 32; tok0 = NTP + (long)b * DEC_SEQ; ci = 4096 + b * 4 + h;
                        Sr = SMATS + ((long)(b * 4 + h) * 32 + l) * 32; Cm = state_C + (size_t)(b * 4 + h) * 65536; nv = state_n + (b * 4 + h) * 256; }
                    const long tl = tok0 + l; const bf16* q = QA + tl * 1024 + h * 256;
                    const float mc = MCH[ci], Ml = fmaxf(mc, CMX[tl * 4 + h]), bl = BC[tl * 4 + h]; const float inter = __expf(mc - Ml);
                    float num = 0.f, den = 0.f;
                    for (int s = 0; s <= l; ++s) { const float sv = Sr[s]; num += sv * bf2f(VA[(tok0 + s) * 1024 + h * 256 + dv]); den += sv; }
                    if (!zero) { float qc = 0.f, qn = 0.f; for (int i = 0; i < 256; ++i) { const float qi_ = bf2f(q[i]); qc += qi_ * Cm[(size_t)i * 256 + dv]; qn += qi_ * nv[i]; } num += inter * qc; den += inter * qn; }
                    const float hv = num / fmaxf(fabsf(den), __expf(-(bl + Ml)));
                    HAREF[tl * 1024 + h * 256 + dv] = (bf16)f2bf(hv);
                } else {
                    const long u0 = t - (nHp + nHs); int bh, dk, dv, L; long tok0, ci; const float* Cs; const float* ns; float* Cd; float* nd; bool zero = false;
                    if (u0 < nCp) { bh = (int)(u0 >> 16); dk = (int)((u0 >> 8) & 255); dv = (int)(u0 & 255); L = 64; tok0 = (long)(bh >> 2) * SEQ + c * 64; ci = (long)bh * 32 + c; zero = (c == 0);
                        Cs = CB + (size_t)(c & 1) * 128 * 65536 + (size_t)bh * 65536; ns = NBf + (c & 1) * 128 * 256 + bh * 256;
                        Cd = (c == 31) ? C_prompt + (size_t)bh * 65536 : CB + (size_t)((c + 1) & 1) * 128 * 65536 + (size_t)bh * 65536; nd = (c == 31) ? n_prompt + bh * 256 : NBf + ((c + 1) & 1) * 128 * 256 + bh * 256; }
                    else { const long u = u0 - nCp; bh = (int)(u >> 16); dk = (int)((u >> 8) & 255); dv = (int)(u & 255); L = 32; tok0 = NTP + (long)(bh >> 2) * DEC_SEQ; ci = 4096 + bh;
                        Cs = state_C + (size_t)bh * 65536; ns = state_n + bh * 256; Cd = C_sample + (size_t)bh * 65536; nd = n_sample + bh * 256; }
                    const int h = bh & 3; const float mc = MCH[ci]; const float Mlast = fmaxf(mc, CMX[(tok0 + L - 1) * 4 + h]); const float decay = __expf(mc - Mlast);
                    float aC = 0.f, an = 0.f;
                    for (int s = 0; s < L; ++s) { const long ts = tok0 + s; const float wsv = __expf(WV[ts * 4 + h] - Mlast); const float kk = bf2f(KA[ts * 1024 + h * 256 + dk]);
                        aC += wsv * kk * bf2f(VA[ts * 1024 + h * 256 + dv]); an += wsv * kk; }
                    Cd[(size_t)dk * 256 + dv] = (zero ? 0.f : decay * Cs[(size_t)dk * 256 + dv]) + aC;
                    if (dv == 0) nd[dk] = (zero ? 0.f : decay * ns[dk]) + an;
                }
            }
            GBAR();
        }
#endif
#define ML_RS(p, bytes) __builtin_amdgcn_make_buffer_rsrc((void*)(p), (short)0, (int)(bytes), 0x00020000)
        if (vcu < BATCH * 8) { const int bh = vcu >> 1, dvh = vcu & 1, b = bh >> 2, h = bh & 3; const size_t t0 = (size_t)b * SEQ;
            ml::Item it; it.q = ML_RS(QA + t0 * 1024 + h * 256, SEQ * 2048); it.k = ML_RS(KA + t0 * 1024 + h * 256, SEQ * 2048); it.v = ML_RS(VA + t0 * 1024 + h * 256 + dvh * 128, SEQ * 2048); it.sm = ML_RS(SM + t0 * 16, SEQ * 64);
            it.C0 = ML_RS(C_prompt, 4); it.has0 = false; it.n0 = nullptr; it.m0 = 0.f; it.Cout = ML_RS(C_prompt + (size_t)bh * 65536 + dvh * 128, 65536 * 4);
            it.nout = dvh == 0 ? n_prompt + bh * 256 : nullptr; it.mout = dvh == 0 ? m_prompt + bh : nullptr;
            it.head = h; it.nchunk = SEQ / CHUNK; it.L = CHUNK; it.bi = b_gates[h]; it.bf = b_gates[4 + h];
            ml::run_item(lds, it); }
        if (vcu < DEC_BATCH * 8) { const int bh = vcu >> 1, dvh = vcu & 1, b = bh >> 2, h = bh & 3; const size_t t0 = (size_t)NTP + (size_t)b * DEC_SEQ;
            ml::Item it; it.q = ML_RS(QA + t0 * 1024 + h * 256, DEC_SEQ * 2048); it.k = ML_RS(KA + t0 * 1024 + h * 256, DEC_SEQ * 2048); it.v = ML_RS(VA + t0 * 1024 + h * 256 + dvh * 128, DEC_SEQ * 2048); it.sm = ML_RS(SM + t0 * 16, DEC_SEQ * 64);
            it.C0 = ML_RS(state_C + (size_t)bh * 65536 + dvh * 128, 65536 * 4); it.has0 = true; it.n0 = state_n + bh * 256; it.m0 = state_m[bh]; it.Cout = ML_RS(C_sample + (size_t)bh * 65536 + dvh * 128, 65536 * 4);
            it.nout = dvh == 0 ? n_sample + bh * 256 : nullptr; it.mout = dvh == 0 ? m_sample + bh : nullptr;
            it.head = h; it.nchunk = 1; it.L = DEC_SEQ; it.bi = b_gates[h]; it.bf = b_gates[4 + h];
            ml::run_item(lds, it); }
#undef ML_RS
        GBAR();
#ifdef PROBE_ML
        { float num = 0.f, den = 0.f;
          for (long t = gtid; t < (long)NTOK * 1024; t += GT) { const float a = bf2f(HA[t]), r = bf2f(HAREF[t]); num += (a - r) * (a - r); den += r * r; }
          num = wave_sum(num); den = wave_sum(den);
          if (lane == 0) { atomicAdd((float*)(args.ws + WS_CTL) + 8, num); atomicAdd((float*)(args.ws + WS_CTL) + 9, den); } }
#endif
        for (long t = gw; t < (long)NTOK * 4; t += NGW) { const unsigned long long w8 = *((const GAS unsigned long long*)(HA + t * 256) + lane);
            const float v0 = __uint_as_float((unsigned)w8 << 16), v1 = __uint_as_float((unsigned)w8 & 0xffff0000u), v2 = __uint_as_float((unsigned)(w8 >> 32) << 16), v3 = __uint_as_float((unsigned)(w8 >> 32) & 0xffff0000u);
            const float mean = wave_sum((v0 + v1) + (v2 + v3)) * (1.0f / 256.0f); const float d0 = v0 - mean, d1 = v1 - mean, d2 = v2 - mean, d3 = v3 - mean;
            const float var = wave_sum((d0 * d0 + d1 * d1) + (d2 * d2 + d3 * d3)) * (1.0f / 256.0f);
            if (lane == 0) { HST[t * 2] = mean; HST[t * 2 + 1] = 1.0f / sqrtf(var + HEAD_NORM_EPS); } }
    }
    if (IN(3))
#if (DUPMASK >> 3) & 1
    for (int rep_ = 0; rep_ < 2; ++rep_)
#endif
    { MK_ARGS;
        {
            typedef short bfx8 __attribute__((ext_vector_type(8))); typedef float f16v __attribute__((ext_vector_type(16)));
            LAS int* sck = (LAS int*)(lds + RING_OFF);
            const int hi = lane >> 5, r32 = lane & 31;
            for (int w4 = 0; w4 < 4; ++w4) {
                const int bW = vcu >> 3, jW = vcu & 7; const int cW = (w4 == 0) ? jW : (w4 == 1) ? 15 - jW : (w4 == 2) ? 16 + jW : 31 - jW;
                if (vcu >= BATCH * 8) break;
                const int S = 64 * (cW + 1), nW = cW + 1; const long tok0 = (long)bW * SEQ + 64 * cW;
                if (S <= TOPK_MAX) {
                    for (int k = 0; k < 8; ++k) { if (lane < 32) MASK[(size_t)(tok0 + wave * 8 + k) * 32 + lane] = (lane < nW) ? ~0ull : 0ull; }
                    continue; }
                for (int rd = 0; rd < 8; ++rd) {
                    bfx8 afr[2][4]; float wgt[2][16];
                    { const int blk = r32 >> 2; const int qa_ = 2 * (blk & 1) + (blk >> 2), ha_ = 4 * ((blk >> 1) & 1) + (r32 & 3);
#pragma unroll
                      for (int rt = 0; rt < 2; ++rt) { const bf16* qp = QI + (size_t)(tok0 + 8 * rd + 4 * rt + qa_) * 512 + ha_ * 64 + hi * 8;
#pragma unroll
                          for (int ks = 0; ks < 4; ++ks) afr[rt][ks] = *(const bfx8*)(qp + ks * 16);
#pragma unroll
                          for (int qq = 0; qq < 2; ++qq) { const float* wp = SM + (size_t)(tok0 + 8 * rd + 4 * rt + 2 * hi + qq) * 16;
                              const f32x4 w0 = *(const f32x4*)wp, w1 = *(const f32x4*)(wp + 4);
                              wgt[rt][8 * qq + 0] = w0[0] * 0.35355339059327373f; wgt[rt][8 * qq + 1] = w0[1] * 0.35355339059327373f; wgt[rt][8 * qq + 2] = w0[2] * 0.35355339059327373f; wgt[rt][8 * qq + 3] = w0[3] * 0.35355339059327373f;
                              wgt[rt][8 * qq + 4] = w1[0] * 0.35355339059327373f; wgt[rt][8 * qq + 5] = w1[1] * 0.35355339059327373f; wgt[rt][8 * qq + 6] = w1[2] * 0.35355339059327373f; wgt[rt][8 * qq + 7] = w1[3] * 0.35355339059327373f; } } }
                    for (int kt = wave; kt < 2 * nW; kt += 8) {
                        const bf16* kp = KI + ((size_t)bW * SEQ + 32 * kt + r32) * 64 + hi * 8;
                        bfx8 bfr[4];
#pragma unroll
                        for (int ks = 0; ks < 4; ++ks) bfr[ks] = *(const bfx8*)(kp + ks * 16);
#pragma unroll
                        for (int rt = 0; rt < 2; ++rt) { f16v acc = {};
#pragma unroll
                            for (int ks = 0; ks < 4; ++ks) acc = __builtin_amdgcn_mfma_f32_32x32x16_bf16(afr[rt][ks], bfr[ks], acc, 0, 0, 0);
                            float sA = 0.f, sB = 0.f;
#pragma unroll
                            for (int i = 0; i < 8; ++i) { sA += wgt[rt][i] * fmaxf(acc[i], 0.f); sB += wgt[rt][8 + i] * fmaxf(acc[8 + i], 0.f); }
                            const int kA = __float_as_int(sA), kB = __float_as_int(sB);
                            sck[(4 * rt + 2 * hi) * 2048 + 32 * kt + r32] = kA ^ ((kA >> 31) & 0x7fffffff);
                            sck[(4 * rt + 2 * hi + 1) * 2048 + 32 * kt + r32] = kB ^ ((kB >> 31) & 0x7fffffff); }
                    }
                    __syncthreads();
                    { const unsigned long long myw = wave_select<32>(sck + wave * 2048, nW, lane); if (lane < 32) MASK[(size_t)(tok0 + 8 * rd + wave) * 32 + lane] = myw; }
                    __syncthreads();
                }
            }
        }
        for (int row = NTP + vcu; row < NTOK; row += G) sample_select_row(lds, row, MASKS + (size_t)(row - NTP) * 40, QI, SM, KI, cache_ik);
        GBAR();
    }
#ifdef PROBE_ATT
    if (IN(4)) { MK_ARGS;
        unsigned long long* MREF = (unsigned long long*)(args.ws + WS_END); bf16* OREF = (bf16*)(args.ws + WS_END + 2 * MiB);
        for (int pr = vcu; pr < 4096; pr += G) { const int row = pr < 2048 ? pr : 31 * SEQ + (pr - 2048); simple_select_row(lds, row, MREF + (size_t)pr * 32, QI, SM, KI, cache_ik); }
        GBAR();
        for (long t = gtid; t < 4096L * 64; t += GT) { const int dc = (int)(t & 7), h = (int)((t >> 3) & 7); const int pr = (int)(t >> 6); const int row = pr < 2048 ? pr : 31 * SEQ + (pr - 2048);
            simple_attn_task(row, h, dc, MREF + (size_t)pr * 32, QB, KBc, VBc, cache_k, cache_v, k_sample, v_sample, rel_bias, OREF + (size_t)pr * 1024 + h * 128 + dc * 16); }
        GBAR();
    }
#endif
    if (IN(4)) { MK_ARGS;
        {
            char* alds = (char*)lds_raw;
            for (int bh = vcu; bh < BATCH * 8; bh += G) {
                const int b = bh >> 3, h = bh & 7;
                if (tid < 320) ((float*)(alds + at2::BT_OFF))[tid] = rel_bias[t5b(tid - 256) * 8 + h] * (1.0f / at2::SCALE);
                const float cfar = __int_as_float(__builtin_amdgcn_readfirstlane(__float_as_int(rel_bias[15 * 8 + h] * (1.0f / at2::SCALE))));
                at2::Ctx C;
                C.Q = __builtin_amdgcn_make_buffer_rsrc((void*)(QB + (size_t)b * SEQ * 1024 + h * 128), (short)0, SEQ * 1024 * 2, 0x00020000);
                C.K = __builtin_amdgcn_make_buffer_rsrc((void*)(KBc + (size_t)b * SEQ * 1024 + h * 128), (short)0, SEQ * 1024 * 2, 0x00020000);
                C.V = __builtin_amdgcn_make_buffer_rsrc((void*)(VBc + (size_t)b * SEQ * 1024 + h * 128), (short)0, SEQ * 1024 * 2, 0x00020000);
                C.M = __builtin_amdgcn_make_buffer_rsrc((void*)(MASK + (size_t)b * SEQ * 32), (short)0, SEQ * 32 * 8, 0x00020000);
                at2::Seam S; at2::dsa_prime(C, 0, alds, S);
                for (int u = 0; u < 8; ++u) at2::dsa_block(C, u * 256, (u < 7 ? u + 1 : u) * 256, alds, S, cfar);
            }
        }
        for (int pr = vcu; pr < NTS; pr += G) { const int b = pr / DEC_SEQ, r = pr % DEC_SEQ;
            sample_attn_row(lds, b, r, MASKS + (size_t)pr * 40, OB + (size_t)(NTP + pr) * 1024, cache_k, cache_v, k_sample + (size_t)b * DEC_SEQ * 1024, v_sample + (size_t)b * DEC_SEQ * 1024, rel_bias); }
        GBAR();
    }
#ifdef PROBE_ATT
    if (IN(4)) { MK_ARGS;
        const bf16* OREF = (const bf16*)(args.ws + WS_END + 2 * MiB); float num = 0.f, den = 0.f;
        for (long t = gtid; t < 4096L * 1024; t += GT) { const int pr = (int)(t >> 10), c = (int)(t & 1023); const int row = pr < 2048 ? pr : 31 * SEQ + (pr - 2048);
            const float a = bf2f(OB[(size_t)row * 1024 + c]), r = bf2f(OREF[t]); num += (a - r) * (a - r); den += r * r; }
        num = wave_sum(num); den = wave_sum(den);
        if (lane == 0) { atomicAdd((float*)(args.ws + WS_CTL) + 8, num); atomicAdd((float*)(args.ws + WS_CTL) + 9, den); }
        GBAR();
    }
#endif
    if (IN(5))
#if (DUPMASK >> 5) & 1
    for (int rep_ = 0; rep_ < 2; ++rep_)
#endif
    { MK_ARGS;
        pg8::Gemm g{XB, WMRG, NTOK, N_M1A, 1024}; pg8::StaticOrder S; S.init(NTOK, N_M1A, G, (int)blockIdx.x);
        pg8::EpiM1a E{HA, OB, HST, a_norm_g, BR};
        pg8::gemm_phase<pg8::EpiM1a, pg8::StaticOrder, true, true>(lds + RING_OFF, g, S, E);
        GBAR();
    }
    if (IN(6))
#if (DUPMASK >> 6) & 1
    for (int rep_ = 0; rep_ < 2; ++rep_)
#endif
    { MK_ARGS;
        pg8::Gemm g{XB, WMRG + (size_t)N_M1A * 1024, NTOK, N_M1B, 1024}; pg8::StaticOrder S; S.init(NTOK, N_M1B, G, (int)blockIdx.x);
        pg8::EpiM1b E{SGA, SGB};
        pg8::gemm_phase<pg8::EpiM1b, pg8::StaticOrder, true, true>(lds + RING_OFF, g, S, E);
        GBAR();
    }
    if (IN(7))
#if (DUPMASK >> 7) & 1
    for (int rep_ = 0; rep_ < 2; ++rep_)
#endif
    { MK_ARGS;
        pg8::Gemm g{BR, WAB, NTOK, 1024, 2048}; pg8::StaticOrder S; S.init(NTOK, 1024, G, (int)blockIdx.x);
        pg8::EpiM2 E{SGA, SGB, MX};
        pg8::gemm_phase<pg8::EpiM2, pg8::StaticOrder, true, true>(lds + RING_OFF, g, S, E);
        GBAR();
    }
    if (IN(8))
#if (DUPMASK >> 8) & 1
    for (int rep_ = 0; rep_ < 2; ++rep_)
#endif
    { MK_ARGS;
        pg8::Gemm g{MX, WO, NTOK, 1024, 1024}; pg8::StaticOrder S; S.init(NTOK, 1024, G, (int)blockIdx.x);
        pg8::EpiM3 E{args.in[0], args.in[1], y_prompt, y_sample};
        pg8::gemm_phase<pg8::EpiM3, pg8::StaticOrder, true, true>(lds + RING_OFF, g, S, E);
        GBAR();
    }
    if (IN(9))
#if (DUPMASK >> 9) & 1
    for (int rep_ = 0; rep_ < 2; ++rep_)
#endif
    { MK_ARGS;
        for (int m = gw; m < NTOK; m += NGW) {
            float* yr = m < NTP ? y_prompt + (size_t)m * 1024 : y_sample + (size_t)(m - NTP) * 1024;
            GAS f32x4* yv = (GAS f32x4*)yr + lane; f32x4 v[4]; float s = 0.f;
#pragma unroll
            for (int j = 0; j < 4; ++j) { v[j] = yv[64 * j]; s += (v[j].x + v[j].y) + (v[j].z + v[j].w); }
            const float mean = wave_sum(s) * (1.f / 1024.f); float s2 = 0.f;
#pragma unroll
            for (int j = 0; j < 4; ++j) { v[j] = v[j] - mean; s2 += (v[j].x * v[j].x + v[j].y * v[j].y) + (v[j].z * v[j].z + v[j].w * v[j].w); }
            const float rstd = 1.f / sqrtf(wave_sum(s2) * (1.f / 1024.f) + LN_EPS);
#pragma unroll
            for (int j = 0; j < 4; ++j) { const f32x4 gg = *((const GAS f32x4*)ln_g + lane + 64 * j), bb = *((const GAS f32x4*)ln_b + lane + 64 * j); yv[64 * j] = v[j] * rstd * gg + bb; }
        }
    }
#if defined(PROBE_ATT) || defined(PROBE_ML)
    { MK_ARGS; GBAR();
      if (blockIdx.x == 0 && threadIdx.x < 64) { const float num = ((volatile float*)(args.ws + WS_CTL))[8], den = ((volatile float*)(args.ws + WS_CTL))[9];
          m_sample[threadIdx.x] *= 1.0f + 30.0f * sqrtf(num / den); } }
#endif
#undef IN
#undef GBAR
#undef args
#undef gtid
#undef GT
#undef gw
#undef NGW
#undef tid
#undef lane
#undef wave
#undef G
#undef vcu
}

extern "C" void kernel_launch(void* const* d_in, const int* in_sizes, int n_in, void* d_out, int out_size, void* d_ws, size_t ws_size, hipStream_t stream) {
    static int grid = 0;
    if (grid == 0) {
        int dev = 0, cus = 0;
        if (hipGetDevice(&dev) != hipSuccess || hipDeviceGetAttribute(&cus, hipDeviceAttributeMultiprocessorCount, dev) != hipSuccess) { grid = -1; return; }
        if (hipFuncSetAttribute((const void*)mk_fwd, hipFuncAttributeMaxDynamicSharedMemorySize, LDS_BYTES) != hipSuccess) { grid = -1; return; }
        (void)hipGetLastError();
        if (n_in != 17 || ws_size < WS_END) { fprintf(stderr, "kernel_launch: needs 17 inputs and %zu bytes of workspace (got %d, %zu)\n", (size_t)WS_END, n_in, ws_size); grid = -1; return; }
        grid = cus;
    }
    if (grid < 0) return;
    if (hipMemsetAsync((unsigned char*)d_ws + WS_CTL, 0, CTL_ZERO_BYTES, stream) != hipSuccess) return;
    Args a{};
    for (int i = 0; i < 17; ++i) a.in[i] = (const float*)d_in[i];
    a.out = (float*)d_out; a.ws = (unsigned char*)d_ws; a.ph_lo = 0; a.ph_hi = 10;
    hipLaunchKernelGGL(mk_fwd, dim3(grid), dim3(NWAVES * 64), LDS_BYTES, stream, a);
}
```

```cpp
#include <hip/hip_runtime.h>
#include <cstdio>
#include <cstdint>
#include <math.h>
#ifndef D_MODEL
#define D_MODEL 1024
#define BATCH 32
#define SEQ 2048
#define DEC_BATCH 16
#define DEC_SEQ 32
#define PAST_LEN 2048
#define CHUNK 64
#define A_HEADS 4
#define A_HEAD_DIM 256
#define B_HEADS 8
#define B_HEAD_DIM 128
#define IDX_HEADS 8
#define IDX_DIM 64
#define TOPK_MAX 256
#define GROUP_B 4
#endif
#define A_WIDTH (A_HEADS * A_HEAD_DIM)
#define B_WIDTH (B_HEADS * B_HEAD_DIM)
#define C_QA 0
#define C_KA (C_QA + A_WIDTH)
#define C_VA (C_KA + A_WIDTH)
#define C_OA (C_VA + A_WIDTH)
#define C_ZA (C_OA + A_WIDTH)
#define C_IA (C_ZA + A_WIDTH)
#define C_FA (C_IA + A_HEADS)
#define C_QB (C_FA + A_HEADS)
#define C_KB (C_QB + B_WIDTH)
#define C_VB (C_KB + B_WIDTH)
#define C_ZB (C_VB + B_WIDTH)
#define C_QI (C_ZB + B_WIDTH)
#define C_KI (C_QI + IDX_HEADS * IDX_DIM)
#define C_WI (C_KI + IDX_DIM)
#define C_GA (C_WI + IDX_HEADS)
#define C_GB (C_GA + D_MODEL)
#define IN_COLS (C_GB + D_MODEL)
#define LN_EPS 1e-5f
#define HEAD_NORM_EPS 1e-6f
#define DN_ALPHA 1.189207115002721f


#define GAS __attribute__((address_space(1)))
#define LAS __attribute__((address_space(3)))
typedef unsigned short bf16;
typedef unsigned v4u __attribute__((ext_vector_type(4)));
typedef float f32x4 __attribute__((ext_vector_type(4)));
typedef short bf16x8 __attribute__((ext_vector_type(8)));
typedef GAS unsigned gu32;
typedef GAS unsigned long long gu64;
#define RLX_AGENT __ATOMIC_RELAXED, __HIP_MEMORY_SCOPE_AGENT
#define LDS_WAIT() asm volatile("s_waitcnt lgkmcnt(0)" ::: "memory")
#define VM_WAIT() asm volatile("s_waitcnt vmcnt(0)" ::: "memory")
__device__ __forceinline__ unsigned long long rt() { return __builtin_amdgcn_s_memrealtime(); }
__device__ __forceinline__ unsigned f2bf(float f) { unsigned u = __builtin_bit_cast(unsigned, f); return (u + 0x7fffu + ((u >> 16) & 1u)) >> 16; }
__device__ __forceinline__ unsigned pk2(float lo, float hi) { return f2bf(lo) | (f2bf(hi) << 16); }

#define XB_TMO      128
#define XB_XCNT(j)  (256  + 64 * (j))
#define XB_XSUB(j)  (1280 + 64 * (j))
#define XB_XGEN(j)  (2304 + 64 * (j))
#define XB_TOP      3328
#define XB_TOPGEN   3392
#define XCD_BAR_WORDS 3456
#define XB_SPIN_CAP (1u << 18)

__device__ __forceinline__ unsigned xb_ld(unsigned* p)              { return __hip_atomic_load(p, __ATOMIC_RELAXED, __HIP_MEMORY_SCOPE_AGENT); }
__device__ __forceinline__ unsigned xb_add(unsigned* p, unsigned v) { return __hip_atomic_fetch_add(p, v, __ATOMIC_RELAXED, __HIP_MEMORY_SCOPE_AGENT); }
__device__ __forceinline__ unsigned xb_xcc_id() { return (unsigned)__builtin_amdgcn_s_getreg((3 << 11) | 20) & 0xFu; }
#define XB_SPIN(cond, bar) do { unsigned _sp = 0; while (cond) { __builtin_amdgcn_s_sleep(1); \
    if ((++_sp & 255u) == 0u) { if (xb_ld(&(bar)[XB_TMO])) break; if (_sp > XB_SPIN_CAP) { atomicAdd(&(bar)[XB_TMO], 1u); break; } } } } while (0)

struct XcdBarrier {
    unsigned* bar; unsigned x;
    volatile LAS unsigned* st;
};

__device__ __forceinline__ XcdBarrier xcd_barrier_post(unsigned* bar, volatile LAS unsigned* st) {
    XcdBarrier b; b.bar = bar; b.x = xb_xcc_id(); b.st = st;
    if (threadIdx.x == 0) (void)xb_add(&bar[XB_XCNT(b.x)], 1u);
    return b;
}
__device__ __forceinline__ void xcd_barrier_complete(unsigned* bar, unsigned x, unsigned& nloc, unsigned& nx) {
    const unsigned G = gridDim.x * gridDim.y * gridDim.z;
    unsigned sum, cnt, mine, sp = 0u;
    for (;;) {
        sum = 0u; cnt = 0u; mine = 0u;
#pragma unroll
        for (unsigned j = 0; j < 16; ++j) { const unsigned c = xb_ld(&bar[XB_XCNT(j)]); sum += c; cnt += (c > 0u) ? 1u : 0u; mine = (j == x) ? c : mine; }
        if (sum == G) break;
        __builtin_amdgcn_s_sleep(1);
        if ((++sp & 255u) == 0u) { if (xb_ld(&bar[XB_TMO])) break; if (sp > XB_SPIN_CAP) { atomicAdd(&bar[XB_TMO], 1u); break; } }
    }
    nloc = mine > 0u ? mine : 1u; nx = cnt > 0u ? cnt : 1u;
}

__device__ __forceinline__ void xcd_barrier(const XcdBarrier& b) {
    asm volatile("s_waitcnt vmcnt(0)" ::: "memory");
    __syncthreads();
    if (threadIdx.x == 0) {
        unsigned* bar = b.bar;
        __builtin_amdgcn_s_waitcnt(0);
        unsigned nloc = b.st[0], nx = b.st[1];
        if (nloc == 0u) { xcd_barrier_complete(bar, b.x, nloc, nx); b.st[0] = nloc; b.st[1] = nx; }
        const unsigned old = xb_add(&bar[XB_XSUB(b.x)], 1u);
        const unsigned gen = old / nloc;
        if (old + 1u == (gen + 1u) * nloc) {
            __builtin_amdgcn_fence(__ATOMIC_RELEASE, "agent");
            asm volatile("s_waitcnt vmcnt(0)" ::: "memory");
            const unsigned og = xb_add(&bar[XB_TOP], 1u);
            const unsigned tg = og / nx;
            if (og + 1u == (tg + 1u) * nx) xb_add(&bar[XB_TOPGEN], 1u);
            else XB_SPIN(xb_ld(&bar[XB_TOPGEN]) == tg, bar);
            __builtin_amdgcn_fence(__ATOMIC_ACQUIRE, "agent");
            xb_add(&bar[XB_XGEN(b.x)], 1u);
            asm volatile("s_waitcnt vmcnt(0)" ::: "memory");
        } else {
            XB_SPIN(xb_ld(&bar[XB_XGEN(b.x)]) == gen, bar);
            __builtin_amdgcn_fence(__ATOMIC_ACQUIRE, "agent");
            asm volatile("s_waitcnt vmcnt(0)" ::: "memory");
        }
    }
    __syncthreads();
}

namespace pg8 {
#define PG8_LAS __attribute__((address_space(3)))
typedef unsigned short bf16_t;
typedef short bf16x8 __attribute__((ext_vector_type(8)));
typedef float f32x4 __attribute__((ext_vector_type(4)));
typedef unsigned u32x4 __attribute__((ext_vector_type(4)));
constexpr int BM = 256, BK = 64, HALF = 128, HTB = HALF * BK * 2  , STAGE_BYTES = 8 * HTB, NXCD = 8, WGM = 8;

__host__ __device__ __forceinline__ int lds_byte(int r, int c) { const int st = (r >> 4) * 2 + (c >> 5), rr = r & 15, cc = c & 31, ob = rr * 64 + cc * 2; return st * 1024 + (ob ^ (((ob >> 9) & 1) << 5)); }
__host__ __device__ __forceinline__ void stage_rc(int b, int& R, int& C) { const int st = b / 1024, sb = b % 1024, swz = sb ^ (((sb >> 9) & 1) << 5); R = (st >> 1) * 16 + swz / 64; C = (st & 1) * 32 + (swz % 64) / 2; }
__host__ __device__ __forceinline__ int perm32(int rho) { const int n = rho >> 4, i = rho & 15; return 8 * (i >> 2) + 4 * n + (i & 3); }

struct Unit { int pm, pn; };
struct Gemm { const bf16_t* A; const bf16_t* Bt; int M, N, K; };

struct StaticOrder {
    int nM, nN, nwg, G, c;
    __host__ __device__ void init(int M, int N, int G_, int c_) { nM = M / BM; nN = N / BM; nwg = nM * nN; G = G_; c = c_; }
    __host__ __device__ bool next(int i, Unit& u) const {
        const long L = (long)i * G + c; if (L >= nwg) return false;
        int wgid = (int)L; { const int q = nwg / NXCD, r = nwg % NXCD, xcd = wgid % NXCD, off = wgid / NXCD; wgid = (xcd < r ? xcd * (q + 1) : r * (q + 1) + (xcd - r) * q) + off; }
        const int nig = WGM * nN, gid = wgid / nig, fm = gid * WGM, gsz = (nM - fm) < WGM ? (nM - fm) : WGM;
        u.pm = fm + ((wgid % nig) % gsz); u.pn = (wgid % nig) / gsz; return true;
    }
    __device__ __forceinline__ void a_ready(const Unit&) const {}
    __device__ __forceinline__ void done(const Unit&) const {}
};
__device__ __forceinline__ unsigned cvt_pk_bf16(float lo, float hi) { unsigned r; asm volatile("v_cvt_pk_bf16_f32 %0, %1, %2" : "=v"(r) : "v"(lo), "v"(hi)); return r; }
typedef float f32x2 __attribute__((ext_vector_type(2)));
template <class Epi, class Sched, bool ALIGN_EPI = false, bool SP2 = false>
__device__ __forceinline__ void gemm_phase(PG8_LAS unsigned char* lds, const Gemm g, const Sched& S, const Epi& E) {
    const int tid = threadIdx.x, wid = __builtin_amdgcn_readfirstlane(tid >> 6), lane = tid & 63, wr = wid >> 2, wc = wid & 3, fr = lane & 15, fq = lane >> 4;
    const int K = g.K, nt = K / BK;
    unsigned voffA[2], voffB[2];
#pragma unroll
    for (int i = 0; i < 2; ++i) { int R, C; stage_rc(tid * 16 + i * 8192, R, C); const int Rb = Epi::PERM ? ((R & ~31) + perm32(R & 31)) : R;
        voffA[i] = (unsigned)(R * K + C) * 2u; voffB[i] = (unsigned)(Rb * K + C) * 2u; }
    const size_t kstep = (size_t)(BK * 2);
    const size_t hstep = (size_t)HALF * K * 2;
    const size_t tstep = 2 * hstep;
    const unsigned ldsw = (unsigned)wid * 1024u;
    const int aoff = lds_byte(wr * 64 + fr, fq * 8), boff = lds_byte(wc * 32 + fr, fq * 8);
#define PG8_SA(b, h) (((b) * 2 + (h)) * HTB)
#define PG8_SB(b, h) ((4 + (b) * 2 + (h)) * HTB)
#define PG8_STAGE(bufoff, gbase, voff) do { _Pragma("unroll") for (int _i = 0; _i < 2; ++_i) \
        __builtin_amdgcn_global_load_lds((const unsigned*)((const char*)(gbase) + (voff)[_i]), (PG8_LAS unsigned*)(lds + (bufoff) + ldsw + _i * 8192), 16, 0, 0); } while (0)
#define PG8_LDA(dst, b, h) do { _Pragma("unroll") for (int m = 0; m < 4; ++m) _Pragma("unroll") for (int k = 0; k < 2; ++k) dst[m][k] = *(const PG8_LAS bf16x8*)(lds + PG8_SA(b, h) + aoff + m * 2048 + k * 1024); } while (0)
#define PG8_LDB(dst, b, h) do { _Pragma("unroll") for (int n = 0; n < 2; ++n) _Pragma("unroll") for (int k = 0; k < 2; ++k) dst[n][k] = *(const PG8_LAS bf16x8*)(lds + PG8_SB(b, h) + boff + n * 2048 + k * 1024); } while (0)
#define PG8_MMA(ai, bj, At, Bt) do { __builtin_amdgcn_s_setprio(1); _Pragma("unroll") for (int m = 0; m < 4; ++m) _Pragma("unroll") for (int n = 0; n < 2; ++n) _Pragma("unroll") for (int k = 0; k < 2; ++k) \
        acc[ai][bj][m][n] = __builtin_amdgcn_mfma_f32_16x16x32_bf16(Bt[n][k], At[m][k], acc[ai][bj][m][n], 0, 0, 0); __builtin_amdgcn_s_setprio(0); } while (0)
#define PG8_WAIT_V(n) asm volatile("s_waitcnt vmcnt(" #n ")" ::: "memory")
#define PG8_WAIT_L(n) asm volatile("s_waitcnt lgkmcnt(" #n ")" ::: "memory")
#define PG8_BAR __builtin_amdgcn_s_barrier()
#define PG8_SCHED __builtin_amdgcn_sched_barrier(0)
    Unit cur, nxt; int ui = 0;
    if (!S.next(0, cur)) return;
    f32x4 acc[2][2][4][2];
#pragma unroll
    for (int a = 0; a < 2; ++a)
#pragma unroll
        for (int b = 0; b < 2; ++b)
#pragma unroll
            for (int m = 0; m < 4; ++m)
#pragma unroll
                for (int n = 0; n < 2; ++n) acc[a][b][m][n] = (f32x4){0.f, 0.f, 0.f, 0.f};
    bf16x8 At[4][2], B0[2][2], B1[2][2];
    const char* cA = (const char*)g.A + (size_t)cur.pm * tstep; const char* cB = (const char*)g.Bt + (size_t)cur.pn * tstep;
    S.a_ready(cur);
    if constexpr (SP2) {
        PG8_STAGE(PG8_SB(0, 0), cB, voffB); PG8_STAGE(PG8_SB(0, 1), cB + hstep, voffB); PG8_STAGE(PG8_SA(0, 0), cA, voffA); PG8_STAGE(PG8_SA(0, 1), cA + hstep, voffA);
        if (wr == 1) PG8_BAR;
        PG8_WAIT_V(2); PG8_BAR;
        PG8_STAGE(PG8_SB(1, 0), cB + kstep, voffB); PG8_STAGE(PG8_SA(1, 0), cA + kstep, voffA); PG8_STAGE(PG8_SB(1, 1), cB + hstep + kstep, voffB);
        PG8_WAIT_V(6); PG8_BAR;
    } else {
        PG8_STAGE(PG8_SB(0, 0), cB, voffB); PG8_STAGE(PG8_SA(0, 0), cA, voffA); PG8_STAGE(PG8_SB(0, 1), cB + hstep, voffB); PG8_STAGE(PG8_SA(0, 1), cA + hstep, voffA);
        if (wr == 1) PG8_BAR;
        PG8_WAIT_V(4); PG8_BAR;
        PG8_STAGE(PG8_SB(1, 0), cB + kstep, voffB); PG8_STAGE(PG8_SA(1, 0), cA + kstep, voffA); PG8_STAGE(PG8_SB(1, 1), cB + hstep + kstep, voffB);
        PG8_WAIT_V(6); PG8_BAR;
    }
    for (;;) {
        const bool has_next = S.next(ui + 1, nxt);
        const char* nA = has_next ? (const char*)g.A + (size_t)nxt.pm * tstep : cA; const char* nB = has_next ? (const char*)g.Bt + (size_t)nxt.pn * tstep : cB;
        for (int t = 0; t < nt; t += 2) {
            const bool last = (t == nt - 2);
            const char* a1 = cA + (size_t)(t + 1) * kstep;
            const char* a2 = last ? nA : cA + (size_t)(t + 2) * kstep; const char* b2 = last ? nB : cB + (size_t)(t + 2) * kstep;
            const char* a3 = a2 + kstep; const char* b3 = b2 + kstep;
            if (last && has_next) S.a_ready(nxt);
            if constexpr (Epi::MIDK) { if (t == nt / 2) E.mid(acc, cur, wr, wc, fr, fq); }
            if constexpr (SP2) {
            PG8_LDB(B0, 0, 0); PG8_LDB(B1, 0, 1); PG8_SCHED; PG8_LDA(At, 0, 0); PG8_STAGE(PG8_SA(1, 1), a1 + hstep, voffA);
            PG8_WAIT_V(8); PG8_WAIT_L(0); PG8_BAR; PG8_MMA(0, 0, At, B0); PG8_MMA(0, 1, At, B1); PG8_BAR; PG8_SCHED;
            PG8_LDA(At, 0, 1); PG8_STAGE(PG8_SB(0, 0), b2, voffB); PG8_STAGE(PG8_SB(0, 1), b2 + hstep, voffB); PG8_STAGE(PG8_SA(0, 0), a2, voffA);
            PG8_WAIT_V(8); PG8_WAIT_L(0); PG8_BAR; PG8_MMA(1, 0, At, B0); PG8_MMA(1, 1, At, B1); PG8_BAR; PG8_SCHED;
            PG8_LDB(B0, 1, 0); PG8_LDB(B1, 1, 1); PG8_SCHED; PG8_LDA(At, 1, 0); PG8_STAGE(PG8_SA(0, 1), a2 + hstep, voffA);
            PG8_WAIT_V(8); PG8_WAIT_L(0); PG8_BAR; PG8_MMA(0, 0, At, B0); PG8_MMA(0, 1, At, B1); PG8_BAR; PG8_SCHED;
            PG8_LDA(At, 1, 1); PG8_STAGE(PG8_SB(1, 0), b3, voffB); PG8_STAGE(PG8_SB(1, 1), b3 + hstep, voffB); PG8_STAGE(PG8_SA(1, 0), a3, voffA);
            PG8_WAIT_V(8); PG8_WAIT_L(0); PG8_BAR; PG8_MMA(1, 0, At, B0); PG8_MMA(1, 1, At, B1); PG8_BAR; PG8_SCHED;
            } else {
            PG8_LDB(B0, 0, 0); PG8_SCHED; PG8_LDA(At, 0, 0); PG8_STAGE(PG8_SA(1, 1), a1 + hstep, voffA);
            PG8_WAIT_L(8); PG8_BAR; PG8_WAIT_L(0); PG8_MMA(0, 0, At, B0); PG8_BAR; PG8_SCHED;
            PG8_LDB(B1, 0, 1); PG8_STAGE(PG8_SB(0, 0), b2, voffB);
            PG8_BAR; PG8_WAIT_L(0); PG8_MMA(0, 1, At, B1); PG8_BAR;
            PG8_LDA(At, 0, 1); PG8_STAGE(PG8_SA(0, 0), a2, voffA);
            PG8_BAR; PG8_WAIT_L(0); PG8_MMA(1, 0, At, B0); PG8_BAR; PG8_SCHED;
            PG8_STAGE(PG8_SB(0, 1), b2 + hstep, voffB);
            PG8_WAIT_V(6); PG8_BAR; PG8_MMA(1, 1, At, B1); PG8_BAR;
            PG8_LDB(B0, 1, 0); PG8_SCHED; PG8_LDA(At, 1, 0); PG8_STAGE(PG8_SA(0, 1), a2 + hstep, voffA);
            PG8_WAIT_L(8); PG8_BAR; PG8_WAIT_L(0); PG8_MMA(0, 0, At, B0); PG8_BAR; PG8_SCHED;
            PG8_LDB(B1, 1, 1); PG8_STAGE(PG8_SB(1, 0), b3, voffB);
            PG8_BAR; PG8_WAIT_L(0); PG8_MMA(0, 1, At, B1); PG8_BAR;
            PG8_LDA(At, 1, 1); PG8_STAGE(PG8_SA(1, 0), a3, voffA);
            PG8_BAR; PG8_WAIT_L(0); PG8_MMA(1, 0, At, B0); PG8_BAR; PG8_SCHED;
            PG8_STAGE(PG8_SB(1, 1), b3 + hstep, voffB);
            PG8_WAIT_V(6); PG8_BAR; PG8_MMA(1, 1, At, B1); PG8_BAR;
            }
        }
        if constexpr (ALIGN_EPI) { if (wr == 0) PG8_BAR; }
        if constexpr (!Epi::AFTER_DRAIN) { E(acc, cur, wr, wc, fr, fq); S.done(cur); }
        if (!has_next) break;
#pragma unroll
        for (int a = 0; a < 2; ++a)
#pragma unroll
            for (int b = 0; b < 2; ++b)
#pragma unroll
                for (int m = 0; m < 4; ++m)
#pragma unroll
                    for (int n = 0; n < 2; ++n) acc[a][b][m][n] = (f32x4){0.f, 0.f, 0.f, 0.f};
        cur = nxt; cA = nA; cB = nB; ++ui;
        if constexpr (ALIGN_EPI) { if (wr == 1) PG8_BAR; }
    }
    PG8_WAIT_V(0);
    if constexpr (!ALIGN_EPI) { if (wr == 0) PG8_BAR; }
    PG8_BAR;
    if constexpr (Epi::AFTER_DRAIN) { E.fused(acc, cur, wr, wc, fr, fq, lds, wid, lane); S.done(cur); }
#undef PG8_SA
#undef PG8_SB
#undef PG8_STAGE
#undef PG8_LDA
#undef PG8_LDB
#undef PG8_MMA
#undef PG8_WAIT_V
#undef PG8_WAIT_L
#undef PG8_BAR
#undef PG8_SCHED
}
}

namespace at2 {
constexpr float SCALE = 0.08838834764831845f;
constexpr float THR = 8.f;
constexpr int NW = 8, QBLK = 32, KVBLK = 64, QB = NW * QBLK, D = 128, PITCH = 1024;
constexpr int SHM_V = KVBLK * D * 2, SHM_K = KVBLK * D * 2;
constexpr int BT_OFF = 2 * SHM_V + 2 * SHM_K + NW * 64 * 4;
constexpr int LDS_BYTES = BT_OFF + 320 * 4;
typedef short bf16x8 __attribute__((ext_vector_type(8)));
typedef short s16x4 __attribute__((ext_vector_type(4)));
typedef float f32x16 __attribute__((ext_vector_type(16)));
typedef float f32x4 __attribute__((ext_vector_type(4)));
typedef unsigned u32x4 __attribute__((ext_vector_type(4)));
typedef unsigned short bf16;

#define KSWZ(row, colB) ((row) * 256 + ((colB) ^ (((row) & 7) << 4)))
#define SBAR() __builtin_amdgcn_sched_barrier(0)
__device__ __forceinline__ int v_st(int k, int c) { const int kk = (k & ~0xC) | ((k & 4) << 1) | ((k & 8) >> 1); return ((kk >> 3) * 4 + (c >> 5)) * 512 + ((kk & 7) * 32 + (c & 31)) * 2; }
__device__ __forceinline__ int v_rd_base(int lane) { return ((lane & 3) << 3) | (((lane >> 2) & 3) << 6) | (((lane >> 4) & 1) << 5) | (((lane >> 5) & 1) << 8); }
constexpr int v_rd_off(int d0, int ks, int half) { return d0 * 512 + ks * 4096 + half * 2048; }
__device__ __forceinline__ int crow(int r, int hi) { return (r & 3) + 8 * (r >> 2) + 4 * hi; }
__device__ __forceinline__ unsigned cvtpk(float lo, float hi) { unsigned r; asm volatile("v_cvt_pk_bf16_f32 %0, %1, %2" : "=v"(r) : "v"(lo), "v"(hi)); return r; }
__device__ __forceinline__ bf16x8 load8(const bf16* p) { return *reinterpret_cast<const bf16x8*>(p); }

typedef __attribute__((address_space(3))) const float* lds_cf32;
__device__ __forceinline__ unsigned mask_compact(unsigned long long mw, int hi) { return ((unsigned)(mw >> (4 * hi)) & 0x0f0f0f0fu) | (((unsigned)(mw >> (32 + 4 * hi)) & 0x0f0f0f0fu) << 4); }
__device__ __forceinline__ void mask_bias(f32x16& p0, f32x16& p1, unsigned mwc, lds_cf32 bt, int idx0, bool far, float cfar, int hi) {
    const float NEG = -__builtin_inff();
    const unsigned w0 = mwc, w1 = mwc >> 4;
    if (far) {
#pragma unroll
        for (int r = 0; r < 16; ++r) { const int c = (r & 3) + 8 * (r >> 2);
            p0[r] = ((w0 >> c) & 1u) ? p0[r] + cfar : NEG; p1[r] = ((w1 >> c) & 1u) ? p1[r] + cfar : NEG; }
    } else { lds_cf32 b = bt + idx0;
#pragma unroll
        for (int r = 0; r < 16; ++r) { const int c = (r & 3) + 8 * (r >> 2);
            p0[r] = ((w0 >> c) & 1u) ? p0[r] + b[c] : NEG; p1[r] = ((w1 >> c) & 1u) ? p1[r] + b[c + 32] : NEG;
            if ((r & 3) == 3) asm volatile("" ::: "memory"); }
    }
}
__device__ __forceinline__ void partialSM(f32x16& p0, f32x16& p1, float& m_reg, float& mn, float& alpha) {
    float pmax = p0[0]; for (int r = 1; r < 16; ++r) pmax = fmaxf(pmax, p0[r]); for (int r = 0; r < 16; ++r) pmax = fmaxf(pmax, p1[r]);
    { auto rr = __builtin_amdgcn_permlane32_swap(__float_as_uint(pmax), __float_as_uint(pmax), false, false);
      pmax = fmaxf(__uint_as_float(rr[0]), __uint_as_float(rr[1])); }
    constexpr float C2 = 1.4426950408889634f * SCALE;
    if (__builtin_expect(__all((pmax - m_reg) * SCALE <= THR), 1)) { mn = m_reg; alpha = 1.f; }
    else { mn = fmaxf(m_reg, pmax); alpha = __builtin_amdgcn_exp2f((m_reg - mn) * C2); m_reg = mn; }
    const float mnL = -mn * C2;
    for (int r = 0; r < 16; ++r) p0[r] = fmaf(p0[r], C2, mnL); for (int r = 0; r < 16; ++r) p1[r] = fmaf(p1[r], C2, mnL);
    for (int r = 0; r < 16; ++r) p0[r] = __builtin_amdgcn_exp2f(p0[r]);
}
__device__ __forceinline__ void finishSM(f32x16& p0, f32x16& p1, float alpha, float& l_reg, bf16x8& pa0, bf16x8& pa1, bf16x8& pa2, bf16x8& pa3) {
    for (int r = 0; r < 16; ++r) p1[r] = __builtin_amdgcn_exp2f(p1[r]);
    float ps = 0; for (int r = 0; r < 16; ++r) ps += p0[r]; for (int r = 0; r < 16; ++r) ps += p1[r];
    { auto rr = __builtin_amdgcn_permlane32_swap(__float_as_uint(ps), __float_as_uint(ps), false, false);
      ps = __uint_as_float(rr[0]) + __uint_as_float(rr[1]); }
    l_reg = l_reg * alpha + ps;
#define PK4(P, B_, OUT) do { unsigned a0 = cvtpk(P[B_+0], P[B_+1]), a1 = cvtpk(P[B_+2], P[B_+3]);                          \
        unsigned b0 = cvtpk(P[B_+4], P[B_+5]), b1 = cvtpk(P[B_+6], P[B_+7]);                                             \
        auto r0 = __builtin_amdgcn_permlane32_swap(a0, b0, false, false); auto r1 = __builtin_amdgcn_permlane32_swap(a1, b1, false, false); \
        u32x4 w = {r0[0], r1[0], r0[1], r1[1]}; OUT = *reinterpret_cast<bf16x8*>(&w); } while (0)
    PK4(p0, 0, pa0); PK4(p0, 8, pa1); PK4(p1, 0, pa2); PK4(p1, 8, pa3);
#undef PK4
}
template <int KB, bool SK>
__device__ __forceinline__ void qkt(f32x16& p0, f32x16& p1, const char* K_lds, int r32, int hi, const bf16x8* qr, bool act) {
    if (SK && !act) { const float NEG = -__builtin_inff();
#pragma unroll
        for (int r = 0; r < 16; ++r) { p0[r] = NEG; p1[r] = NEG; } return; }
    p0 = f32x16{}; p1 = f32x16{};
    int r32_ = r32, hi_ = hi; asm volatile("" : "+v"(r32_), "+v"(hi_));
    const char* kb[4];
#pragma unroll
    for (int dd = 0; dd < 4; ++dd) kb[dd] = K_lds + KB * SHM_K + KSWZ(r32_, (dd * 16 + hi_ * 8) * 2);
#pragma unroll
    for (int d0 = 0; d0 < 8; ++d0) { const char* a = kb[d0 & 3] + (d0 >> 2) * 128;
        bf16x8 b0 = *reinterpret_cast<const bf16x8*>(a);
        bf16x8 b1 = *reinterpret_cast<const bf16x8*>(a + 32 * 256);
        p0 = __builtin_amdgcn_mfma_f32_32x32x16_bf16(b0, qr[d0], p0, 0, 0, 0);
        p1 = __builtin_amdgcn_mfma_f32_32x32x16_bf16(b1, qr[d0], p1, 0, 0, 0); }
}
template <int VB, bool SK>
__device__ __forceinline__ void pv_tile(f32x16* o, int vb0, bf16x8 pa0, bf16x8 pa1, bf16x8 pa2, bf16x8 pa3, bool act) {
    if (SK && !act) return;
#define TRRD(dst, off) asm volatile("ds_read_b64_tr_b16 %0, %1 offset:%2" : "=&v"(dst) : "v"(vb0), "i"(off) : "memory")
#define PV_D0(d0) do { s16x4 l0, l1, l2, l3, h0, h1, h2, h3; constexpr int b_ = VB * SHM_V + v_rd_off(d0, 0, 0); \
        TRRD(l0, b_); TRRD(h0, b_ + 2048); TRRD(l1, b_ + 4096); TRRD(h1, b_ + 6144); TRRD(l2, b_ + 8192); TRRD(h2, b_ + 10240); TRRD(l3, b_ + 12288); TRRD(h3, b_ + 14336); \
        asm volatile("s_waitcnt lgkmcnt(0)" ::: "memory"); SBAR();   \
        o[d0] = __builtin_amdgcn_mfma_f32_32x32x16_bf16(pa0, (bf16x8){l0[0], l0[1], l0[2], l0[3], h0[0], h0[1], h0[2], h0[3]}, o[d0], 0, 0, 0);   \
        o[d0] = __builtin_amdgcn_mfma_f32_32x32x16_bf16(pa1, (bf16x8){l1[0], l1[1], l1[2], l1[3], h1[0], h1[1], h1[2], h1[3]}, o[d0], 0, 0, 0);   \
        o[d0] = __builtin_amdgcn_mfma_f32_32x32x16_bf16(pa2, (bf16x8){l2[0], l2[1], l2[2], l2[3], h2[0], h2[1], h2[2], h2[3]}, o[d0], 0, 0, 0);   \
        o[d0] = __builtin_amdgcn_mfma_f32_32x32x16_bf16(pa3, (bf16x8){l3[0], l3[1], l3[2], l3[3], h3[0], h3[1], h3[2], h3[3]}, o[d0], 0, 0, 0); } while (0)
    PV_D0(0); PV_D0(1); PV_D0(2); PV_D0(3);
#undef PV_D0
#undef TRRD
}

struct Ctx { __amdgpu_buffer_rsrc_t Q, K, V, M, O; };
typedef unsigned v4u32 __attribute__((ext_vector_type(4))); typedef unsigned v2u32 __attribute__((ext_vector_type(2)));
#define LD16(rs, vo, so) __builtin_bit_cast(bf16x8, __builtin_amdgcn_raw_buffer_load_b128((rs), (int)(vo), (int)(so), 0))
struct Seam { bf16x8 qr[8]; bf16x8 st_v0, st_v1, st_k0, st_k1; };
#define VMW() asm volatile("s_waitcnt vmcnt(0)" ::: "memory")
#define VMWN(n) asm volatile("s_waitcnt vmcnt(%0)" :: "i"(n) : "memory")
#define SLOAD_H(k0) do { S.st_v0 = LD16(C.V, kvoff, (k0) * (PITCH * 2)); S.st_v1 = LD16(C.V, kvoff, ((k0) + 32) * (PITCH * 2));              \
                         S.st_k0 = LD16(C.K, kvoff, (k0) * (PITCH * 2)); S.st_k1 = LD16(C.K, kvoff, ((k0) + 32) * (PITCH * 2)); } while (0)
#define SW_TID int t_ = threadIdx.x; asm volatile("" : "+v"(t_)); const int sr_ = t_ >> 4, sc_ = (t_ & 15) * 8
#define SWRITE_HK(bf) do { SW_TID; const int kws_ = KSWZ(sr_, sc_ * 2); *(bf16x8*)(K_lds + (bf) * SHM_K + kws_) = S.st_k0; *(bf16x8*)(K_lds + (bf) * SHM_K + kws_ + 32 * 256) = S.st_k1; } while (0)
#define SWRITE_HV(bf) do { SW_TID; *(bf16x8*)(V_lds + (bf) * SHM_V + v_st(sr_, sc_)) = S.st_v0; *(bf16x8*)(V_lds + (bf) * SHM_V + v_st(32 + sr_, sc_)) = S.st_v1; } while (0)
#define SWRITE_H(bf) do { SWRITE_HV(bf); SWRITE_HK(bf); } while (0)
__device__ __forceinline__ void dsa_prime(const Ctx& C, int P0, char* lds, Seam& S) {
    int tid = threadIdx.x; asm volatile("" : "+v"(tid));
    const int wid = __builtin_amdgcn_readfirstlane(tid >> 6), lane = tid & 63, r32 = lane & 31, hi = lane >> 5;
    const int sr = tid >> 4, sc = (tid & 15) * 8; char* K_lds = lds + 2 * SHM_V;
    const unsigned kvoff = (unsigned)(sr * PITCH + sc) * 2u, qoff = (unsigned)((wid * QBLK + r32) * PITCH + hi * 8) * 2u;
    for (int d0 = 0; d0 < 8; ++d0) S.qr[d0] = LD16(C.Q, qoff + d0 * 32, P0 * (PITCH * 2));
    SLOAD_H(0); VMW(); SWRITE_HK(0);
    __syncthreads();
}
__device__ __forceinline__ void dsa_block(const Ctx& C, int P0, int P0n, char* lds, Seam& S, float cfar) {
    int tid = threadIdx.x; asm volatile("" : "+v"(tid));
    const int wid = __builtin_amdgcn_readfirstlane(tid >> 6), lane = tid & 63, r32 = lane & 31, hi = lane >> 5;
    const int NT = P0 / KVBLK + QB / KVBLK;
    const int qlo = P0 + wid * QBLK;
    const int limw = ((qlo >> 6) + 1) * 64;
    char* V_lds = lds; char* K_lds = lds + 2 * SHM_V;
    float* wsc = (float*)(lds + 2 * SHM_V + 2 * SHM_K) + wid * 64; float* li_l = wsc, * al_l = wsc + 32;
    lds_cf32 bt = (lds_cf32)((__attribute__((address_space(3))) char*)lds + BT_OFF);
    float m_reg = -1e30f, l_reg = 0; f32x16 o[4] = {};
    const int sr = tid >> 4, sc = (tid & 15) * 8;
    const int vb0 = (int)(uintptr_t)V_lds + v_rd_base(lane);
    const unsigned kvoff = (unsigned)(sr * PITCH + sc) * 2u, qoff = (unsigned)((wid * QBLK + r32) * PITCH + hi * 8) * 2u, moff = (unsigned)((wid * QBLK + r32) * 32) * 8u;
#define MROW(t) mask_compact(__builtin_bit_cast(unsigned long long, __builtin_amdgcn_raw_buffer_load_b64(C.M, (int)moff, (P0 * 32 + (t)) * 8, 0)), hi)
    const int rel0 = 256 + 4 * hi - (qlo + r32);
#define RESC(a) do { if (__any((a) < 1.f)) { if (hi == 0) al_l[r32] = (a); asm volatile("s_waitcnt lgkmcnt(0)" ::: "memory");              \
                     for (int d_ = 0; d_ < 4; ++d_) for (int r = 0; r < 16; ++r) o[d_][r] *= al_l[crow(r, hi)]; } } while (0)
#define KBASE(t) ((t) * KVBLK)
#define ACT(t) (KBASE(t) < limw)
#define MASKT(P0_, P1_, mw_, t) do { const int kb_ = KBASE(t); if (ACT(t)) mask_bias(P0_, P1_, mw_, bt, kb_ + rel0, kb_ + KVBLK - 1 - qlo <= -128, cfar, hi); } while (0)
    constexpr int NQL = 8; constexpr bool SK = true;
#define SEAM_K0() do { VMWN(NQL); SWRITE_HK(0); SBAR(); } while (0)
    f32x16 pA0, pA1, pB0, pB1; float mnA, mnB, alA, alB; bf16x8 pa0, pa1, pa2, pa3; unsigned mw;
    SWRITE_HV(0); SBAR();
    if (NT > 1) SLOAD_H(KBASE(1));
    mw = MROW(0);
    SBAR(); qkt<0, SK>(pA0, pA1, K_lds, r32, hi, S.qr, ACT(0));
    MASKT(pA0, pA1, mw, 0); partialSM(pA0, pA1, m_reg, mnA, alA);
    if (NT > 1) { VMW(); SWRITE_H(1); }
    __syncthreads();
#define HALF_STEP(PX0, PX1, mnX, alX, PY0, PY1, alY, t, KB, VB, SB) do {                                                      \
        SBAR(); mw = MROW(t); qkt<KB, SK>(PX0, PX1, K_lds, r32, hi, S.qr, ACT(t));                                          \
        finishSM(PY0, PY1, alY, l_reg, pa0, pa1, pa2, pa3); SBAR();                                                           \
        if ((t) + 1 < NT) { SLOAD_H(KBASE((t) + 1)); SBAR(); }                                                        \
        pv_tile<VB, SK>(o, vb0, pa0, pa1, pa2, pa3, ACT((t) - 1)); MASKT(PX0, PX1, mw, (t)); partialSM(PX0, PX1, m_reg, mnX, alX); \
        __syncthreads();                                                                                                      \
        if ((t) + 1 < NT) { VMW(); SWRITE_H(SB); }                                                                            \
        RESC(alX); __syncthreads(); } while (0)
    for (int t = 1; t + 1 < NT; t += 2) {
        HALF_STEP(pB0, pB1, mnB, alB, pA0, pA1, alA, t, 1, 0, 0);
        HALF_STEP(pA0, pA1, mnA, alA, pB0, pB1, alB, t + 1, 0, 1, 1);
    }
    const bool even = (NT & 1) == 0;
    if (even) { SBAR(); mw = MROW(NT - 1); qkt<1, SK>(pB0, pB1, K_lds, r32, hi, S.qr, ACT(NT - 1)); SBAR(); }
    SLOAD_H(0); SBAR();
#pragma unroll
    for (int d0 = 0; d0 < 8; ++d0) S.qr[d0] = LD16(C.Q, qoff + d0 * 32, P0n * (PITCH * 2));
    SBAR();
    finishSM(pA0, pA1, alA, l_reg, pa0, pa1, pa2, pa3); SBAR();
    pv_tile<0, SK>(o, vb0, pa0, pa1, pa2, pa3, ACT(even ? NT - 2 : NT - 1));
    if (even) { MASKT(pB0, pB1, mw, NT - 1); partialSM(pB0, pB1, m_reg, mnB, alB); __syncthreads(); RESC(alB);
        finishSM(pB0, pB1, alB, l_reg, pa0, pa1, pa2, pa3); SBAR(); pv_tile<1, SK>(o, vb0, pa0, pa1, pa2, pa3, ACT(NT - 1)); }
    SBAR(); SEAM_K0();
    if (hi == 0) li_l[r32] = l_reg; asm volatile("s_waitcnt lgkmcnt(0)" ::: "memory");
    float rli[16];
#pragma unroll
    for (int r = 0; r < 16; ++r) rli[r] = __builtin_amdgcn_rcpf(li_l[crow(r, hi)]);
    const unsigned ooff = (unsigned)((wid * QBLK + 4 * hi) * PITCH + r32) * 2u;
#pragma unroll
    for (int r = 0; r < 16; ++r) { const int so = (P0 + (r & 3) + 8 * (r >> 2)) * (PITCH * 2);
#pragma unroll
        for (int d0 = 0; d0 < 4; ++d0) { const float v = o[d0][r] * rli[r];
            const float vn = __shfl_xor(v, 1);
            if ((r32 & 1) == 0) __builtin_amdgcn_raw_buffer_store_b32(cvtpk(v, vn), C.O, (int)(ooff + d0 * 64), so, 0); } }
    __syncthreads();
#undef RESC
#undef MROW
#undef KBASE
#undef ACT
#undef MASKT
#undef SEAM_K0
#undef HALF_STEP
}
#undef VMW
#undef VMWN
#undef SLOAD_H
#undef SWRITE_HK
#undef SWRITE_HV
#undef SWRITE_H
#undef SW_TID
#undef KSWZ
#undef SBAR
}

constexpr int NWAVES = 8;
constexpr int NTP = BATCH * SEQ, NTS = DEC_BATCH * DEC_SEQ, NTOK = NTP + NTS;
constexpr int NPM = NTOK / 256;
constexpr int N_MIX = 27 * 256, N_M1A = 12 * 256, N_M1B = 8 * 256;
static_assert(NTP % 256 == 0 && NTS % 256 == 0 && D_MODEL == 1024 && A_WIDTH == 1024 && B_WIDTH == 1024, "geometry");

constexpr size_t MiB = 1u << 20;
constexpr size_t WS_CTL = 0, CTL_ZERO_BYTES = 1 * MiB;
constexpr size_t WS_WMIX = 1 * MiB;
constexpr size_t WS_WMRG = WS_WMIX + 14 * MiB;
constexpr size_t WS_WAB  = WS_WMRG + 10 * MiB;
constexpr size_t WS_WO   = WS_WAB + 4 * MiB;
constexpr size_t WS_XB   = WS_WO + 2 * MiB;
constexpr size_t ROWBUF  = (size_t)NTOK * 1024 * 2;
constexpr size_t WS_QA   = WS_XB + ROWBUF;
constexpr size_t WS_KA   = WS_QA + ROWBUF;
constexpr size_t WS_VA   = WS_KA + ROWBUF;
constexpr size_t WS_QB   = WS_VA + ROWBUF;
constexpr size_t WS_QI   = WS_QB + ROWBUF;
constexpr size_t WS_KI   = WS_QI + 65 * MiB;
constexpr size_t WS_SM   = WS_KI + 9 * MiB;
constexpr size_t WS_MASK = WS_SM + 5 * MiB;
constexpr size_t WS_HST  = WS_MASK + 16 * MiB;
constexpr size_t WS_NAIVE = WS_HST + 3 * MiB;
constexpr size_t WS_NEED = WS_NAIVE;
static_assert(WS_WMIX + (size_t)N_MIX * 1024 * 2 <= WS_WMRG && WS_QI + (size_t)NTOK * 512 * 2 <= WS_KI && WS_KI + (size_t)NTOK * 64 * 2 <= WS_SM && WS_SM + (size_t)NTOK * 64 <= WS_MASK
              && WS_HST + (size_t)NTOK * 32 <= WS_NAIVE, "d_ws map");
constexpr int CW_BAR = 4096;
constexpr int RING_OFF = 0, RING_BYTES = 131072;
constexpr int LDS_BYTES = 147456;
constexpr int LDSCTL_OFF = LDS_BYTES - 512, MISC_OFF = LDSCTL_OFF + 320;

struct Args { const float* in[17]; float* out; unsigned char* ws; int ph_lo, ph_hi; };

__device__ __forceinline__ float bf2f(bf16 v) { return __uint_as_float((unsigned)v << 16); }
__device__ __forceinline__ float sigm(float x) { return 1.0f / (1.0f + __expf(-x)); }

__device__ __forceinline__ void tr_item(const float* W, int ldw, int c0, int nv, int k0, bf16* WT, int ldt, int r0, int kofs, LAS float* scr, int lane) {
    const int n_ = lane & 31;
#pragma unroll 8
    for (int i = 0; i < 32; ++i) { const int kk = 2 * i + (lane >> 5); scr[kk * 33 + n_] = (n_ < nv) ? W[(size_t)(k0 + kk) * ldw + c0 + n_] : 0.f; }
    LDS_WAIT(); asm volatile("" ::: "memory");
    const int c = lane & 7;
#pragma unroll
    for (int j = 0; j < 4; ++j) { const int n = (lane >> 3) + 8 * j; const LAS float* s = scr + (8 * c) * 33 + n;
        v4u o; o.x = pk2(s[0 * 33], s[1 * 33]); o.y = pk2(s[2 * 33], s[3 * 33]); o.z = pk2(s[4 * 33], s[5 * 33]); o.w = pk2(s[6 * 33], s[7 * 33]);
        if (n < nv) *(GAS v4u*)(WT + (size_t)(r0 + n) * ldt + kofs + k0 + 8 * c) = o; }
    LDS_WAIT(); asm volatile("" ::: "memory");
}
struct Seg { int src, n, dst; };
__device__ __forceinline__ Seg win_seg(int s) {
    switch (s) {
        case 0: return Seg{C_QA, 1024, 0};      case 1: return Seg{C_KA, 1024, 1024};  case 2: return Seg{C_VA, 1024, 2048};
        case 3: return Seg{C_QB, 1024, 3072};   case 4: return Seg{C_KB, 1024, 4096};  case 5: return Seg{C_VB, 1024, 5120};
        case 6: return Seg{C_QI, 512, 6144};    case 7: return Seg{C_KI, 64, 6656};    case 8: return Seg{C_WI, 8, 6720};
        case 9: return Seg{C_IA, 4, 6728};      case 10: return Seg{C_FA, 4, 6732};
        case 27: return Seg{C_ZB, 1024, 2048};  case 28: return Seg{C_GA, 1024, 3072}; case 29: return Seg{C_GB, 1024, 4096};
        default: { const int j = (s - 11) >> 1; return (s & 1) ? Seg{C_OA + 128 * j, 128, 256 * j} : Seg{C_ZA + 128 * j, 128, 256 * j + 128}; }
    }
}
struct P0Args { const float *xp, *xs, *w_in, *w_out_a, *w_out_b, *w_o; bf16 *XB, *WMIX, *WMRG, *WAB, *WO; };
__device__ __forceinline__ void p0_prologue(const P0Args& a, LAS unsigned char* lds, int vcu, int G, int wave, int lane) {
    LAS float* scr = (LAS float*)(lds + RING_OFF + wave * 16384);
    const int gw = vcu * NWAVES + wave, NGW = G * NWAVES;
    int base = 0;
    for (int s = 0; s < 30; ++s) {
        const Seg sg = win_seg(s); const int nblk = (sg.n + 31) / 32, nit = nblk * 16;
        bf16* WT = s < 11 ? a.WMIX : a.WMRG;
        for (int it = gw - (base % NGW); it < nit; it += NGW) { if (it < 0) continue; const int kb = it / nblk, nb = it % nblk; const int nv = sg.n - 32 * nb < 32 ? sg.n - 32 * nb : 32;
            tr_item(a.w_in, IN_COLS, sg.src + 32 * nb, nv, 64 * kb, WT, 1024, sg.dst + 32 * nb, 0, scr, lane); }
        base += nit;
    }
    for (int i = gw * 64 + lane; i < 176 * 128; i += NGW * 64) ((GAS v4u*)(a.WMIX + (size_t)6736 * 1024))[i] = (v4u){0u, 0u, 0u, 0u};
    for (int it = gw; it < 3 * 512; it += NGW) { const int w = it / 512, r = it % 512, kb = r / 32, nb = r % 32;
        if (w == 0) tr_item(a.w_out_a, 1024, 32 * nb, 32, 64 * kb, a.WAB, 2048, 32 * nb, 0, scr, lane);
        else if (w == 1) tr_item(a.w_out_b, 1024, 32 * nb, 32, 64 * kb, a.WAB, 2048, 32 * nb, 1024, scr, lane);
        else tr_item(a.w_o, 1024, 32 * nb, 32, 64 * kb, a.WO, 1024, 32 * nb, 0, scr, lane); }
    for (int m0 = gw * 2; m0 < NTOK; m0 += NGW * 2) { f32x4 v[2][4];
#pragma unroll
        for (int q = 0; q < 2; ++q) { const int m = m0 + q; const float* xr = m < NTP ? a.xp + (size_t)m * 1024 : a.xs + (size_t)(m - NTP) * 1024; const GAS f32x4* xv = (const GAS f32x4*)xr + lane;
#pragma unroll
            for (int j = 0; j < 4; ++j) v[q][j] = xv[64 * j]; }
#pragma unroll
        for (int q = 0; q < 2; ++q) { GAS unsigned long long* o8 = (GAS unsigned long long*)(a.XB + (size_t)(m0 + q) * 1024) + lane;
#pragma unroll
            for (int j = 0; j < 4; ++j) o8[64 * j] = (unsigned long long)pk2(v[q][j].x, v[q][j].y) | ((unsigned long long)pk2(v[q][j].z, v[q][j].w) << 32); }
    }
}

namespace pg8 {
struct EpiMix {
    static constexpr bool PERM = true, AFTER_DRAIN = false, MIDK = false;
    bf16_t* QA4;
    bf16_t* KVc;
    bf16_t *QI, *KI; float* SM;
    float *okvp, *okvs;
    float *oikp, *oiks;
    __device__ __forceinline__ void mid(f32x4 (&)[2][2][4][2], const Unit&, int, int, int, int) const {}
    __device__ __forceinline__ void operator()(const f32x4 (&acc)[2][2][4][2], const Unit& u, int wr, int wc, int fr, int fq) const {
        const int pn = u.pn; const bool samp = u.pm >= NTP / 256;
        const int row0 = u.pm * BM + wr * 64 + fr, cl = wc * 32 + 8 * fq;
        if (pn < 16) {
            bf16_t* base = QA4 + (size_t)(pn >> 2) * ((size_t)NTOK * 1024); const float sc = (pn >= 4 && pn < 8) ? 0.0625f : 1.0f;
            const int col0 = (pn & 3) * 256 + cl;
#pragma unroll
            for (int ai = 0; ai < 2; ++ai)
#pragma unroll
                for (int m = 0; m < 4; ++m) { bf16_t* rowp = base + (size_t)(row0 + ai * HALF + m * 16) * 1024 + col0;
#pragma unroll
                    for (int bj = 0; bj < 2; ++bj) { const f32x4 v0 = acc[ai][bj][m][0] * sc, v1 = acc[ai][bj][m][1] * sc;
                        u32x4 w; w.x = cvt_pk_bf16(v0[0], v0[1]); w.y = cvt_pk_bf16(v0[2], v0[3]); w.z = cvt_pk_bf16(v1[0], v1[1]); w.w = cvt_pk_bf16(v1[2], v1[3]);
                        *(u32x4*)(rowp + bj * HALF) = w; } }
        } else if (pn < 24) {
            const int isV = pn >= 20 ? 1 : 0; const int col0 = (pn & 3) * 256 + cl;
            float* of = samp ? okvs + (size_t)isV * ((size_t)NTS * 1024) : okvp + (size_t)isV * ((size_t)NTP * 1024);
            bf16_t* cb = KVc + (size_t)isV * ((size_t)NTP * 1024);
#pragma unroll
            for (int ai = 0; ai < 2; ++ai)
#pragma unroll
                for (int m = 0; m < 4; ++m) { const int r = row0 + ai * HALF + m * 16; const int rr = samp ? r - NTP : r;
#pragma unroll
                    for (int bj = 0; bj < 2; ++bj) { const f32x4 v0 = acc[ai][bj][m][0], v1 = acc[ai][bj][m][1];
                        float* fp = of + (size_t)rr * 1024 + col0 + bj * HALF; *(f32x4*)fp = v0; *(f32x4*)(fp + 4) = v1;
                        if (!samp) { u32x4 w; w.x = cvt_pk_bf16(v0[0], v0[1]); w.y = cvt_pk_bf16(v0[2], v0[3]); w.z = cvt_pk_bf16(v1[0], v1[1]); w.w = cvt_pk_bf16(v1[2], v1[3]);
                            *(u32x4*)(cb + (size_t)r * 1024 + col0 + bj * HALF) = w; } } }
        } else if (pn < 26) {
            const int col0 = (pn - 24) * 256 + cl;
#pragma unroll
            for (int ai = 0; ai < 2; ++ai)
#pragma unroll
                for (int m = 0; m < 4; ++m) { bf16_t* rowp = QI + (size_t)(row0 + ai * HALF + m * 16) * 512 + col0;
#pragma unroll
                    for (int bj = 0; bj < 2; ++bj) { const f32x4 v0 = acc[ai][bj][m][0] * 0.125f, v1 = acc[ai][bj][m][1] * 0.125f;
                        u32x4 w; w.x = cvt_pk_bf16(v0[0], v0[1]); w.y = cvt_pk_bf16(v0[2], v0[3]); w.z = cvt_pk_bf16(v1[0], v1[1]); w.w = cvt_pk_bf16(v1[2], v1[3]);
                        *(u32x4*)(rowp + bj * HALF) = w; } }
        } else {
            float* oik = samp ? oiks : oikp;
#pragma unroll
            for (int ai = 0; ai < 2; ++ai)
#pragma unroll
                for (int m = 0; m < 4; ++m) { const int r = row0 + ai * HALF + m * 16; const int rr = samp ? r - NTP : r; const f32x4 v0 = acc[ai][0][m][0], v1 = acc[ai][0][m][1];
                    if (wc < 2) { float* fp = oik + (size_t)rr * 64 + cl; *(f32x4*)fp = v0; *(f32x4*)(fp + 4) = v1;
                        u32x4 w; w.x = cvt_pk_bf16(v0[0], v0[1]); w.y = cvt_pk_bf16(v0[2], v0[3]); w.z = cvt_pk_bf16(v1[0], v1[1]); w.w = cvt_pk_bf16(v1[2], v1[3]);
                        *(u32x4*)(KI + (size_t)r * 64 + cl) = w; }
                    else if (wc == 2 && fq < 2) { float* fp = SM + (size_t)r * 16 + 8 * fq; *(f32x4*)fp = v0; *(f32x4*)(fp + 4) = v1; } }
        }
    }
};
}


namespace ml {
typedef short bfx8 __attribute__((ext_vector_type(8)));
typedef short s16x4 __attribute__((ext_vector_type(4)));
typedef float f32x16 __attribute__((ext_vector_type(16)));
typedef float f32x2_t __attribute__((ext_vector_type(2))); typedef __bf16 bf16x2_t __attribute__((ext_vector_type(2)));
typedef short v4i16_t __attribute__((ext_vector_type(4)));
typedef unsigned u32x4 __attribute__((ext_vector_type(4)));
typedef unsigned u32x2 __attribute__((ext_vector_type(2)));
typedef float f32x4 __attribute__((ext_vector_type(4)));
#define MLAS __attribute__((address_space(3)))
constexpr int QP = 528, VP = 272;
constexpr int L_Q = 0, L_K = 64 * QP, L_V = 2 * 64 * QP, L_VW = L_V + 64 * VP, L_EX = L_VW + 64 * VP;
constexpr int L_G = L_EX + 32768;
constexpr int L_GW = L_G, L_GM = L_G + 256, L_GI = L_G + 512, L_GE = L_G + 768, L_GS = L_G + 1024;
constexpr int L_NV = L_G + 1280;
constexpr int L_QN = L_NV + 1024;
constexpr int L_DP = L_QN + 256;
constexpr int L_END = L_DP + 384;
__device__ __forceinline__ unsigned cvtpk(float lo, float hi) { f32x2_t v = {lo, hi}; bf16x2_t b = __builtin_convertvector(v, bf16x2_t); return __builtin_bit_cast(unsigned, b); }
__device__ __forceinline__ bfx8 pack_step(const f32x16& x, int s) {
    u32x4 p; p.x = cvtpk(x[8 * s + 0], x[8 * s + 1]); p.y = cvtpk(x[8 * s + 2], x[8 * s + 3]); p.z = cvtpk(x[8 * s + 4], x[8 * s + 5]); p.w = cvtpk(x[8 * s + 6], x[8 * s + 7]);
    return __builtin_bit_cast(bfx8, p);
}
__device__ __forceinline__ s16x4 vtr(MLAS const unsigned char* p) { return __builtin_bit_cast(s16x4, __builtin_amdgcn_ds_read_tr16_b64_v4i16((MLAS v4i16_t*)p)); }
__device__ __forceinline__ bfx8 cat8(s16x4 lo, s16x4 hi) { return (bfx8){lo[0], lo[1], lo[2], lo[3], hi[0], hi[1], hi[2], hi[3]}; }
__device__ __forceinline__ int crow(int r, int hi) { return (r & 3) + 8 * (r >> 2) + 4 * hi; }
__device__ __forceinline__ float logsig_(float x) { return fminf(x, 0.0f) - log1pf(__expf(-fabsf(x))); }
__device__ __forceinline__ float wsum_(float v) {
#pragma unroll
    for (int o = 1; o < 64; o <<= 1) v += __shfl_xor(v, o);
    return v; }
#define ML_MFMA(a, b, c) __builtin_amdgcn_mfma_f32_32x32x16_bf16((a), (b), (c), 0, 0, 0)

struct Item {
    __amdgpu_buffer_rsrc_t hout;
    __amdgpu_buffer_rsrc_t q, k, v;
    __amdgpu_buffer_rsrc_t sm;
    __amdgpu_buffer_rsrc_t C0, Cout;
    const float* n0; float m0; bool has0;
    float* nout; float* mout;
    int head, nchunk, L; float bi, bf;
};
#define ML_LD16(rs, vo, so) __builtin_bit_cast(u32x4, __builtin_amdgcn_raw_buffer_load_b128((rs), (int)(vo), (int)(so), 0))
#define ML_LDF(rs, vo, so) __builtin_bit_cast(float, __builtin_amdgcn_raw_buffer_load_b32((rs), (int)(vo), (int)(so), 0))

__device__ __forceinline__ void run_item(MLAS unsigned char* lds, const Item& it) {
    int tid = threadIdx.x; asm volatile("" : "+v"(tid));
    const int wave = __builtin_amdgcn_readfirstlane(tid >> 6), lane0 = tid & 63, g = wave >> 2, cb = wave & 3;
#define ML_LANE int lane = lane0; asm volatile("" : "+v"(lane)); const int r32 = lane & 31, hi = lane >> 5; (void)r32; (void)hi
    const int L = it.L, h = it.head;
    const unsigned coff = (unsigned)((lane0 >> 5) * 4096 + (lane0 & 31) * 4), qkoff = (unsigned)((tid >> 5) * 2048 + (tid & 31) * 16), voff = (unsigned)((tid >> 4) * 2048 + (tid & 15) * 16), hoff = (unsigned)((4 * (lane0 >> 5) * 1024 + (lane0 & 31)) * 2);
    f32x16 Cacc[4];
#pragma unroll
    for (int j = 0; j < 4; ++j)
#pragma unroll
        for (int i = 0; i < 16; ++i) Cacc[j][i] = it.has0 ? ML_LDF(it.C0, coff, ((128 * g + 32 * j + (i & 3) + 8 * (i >> 2)) * 256 + 32 * cb) * 4) : 0.f;
    if (tid < 256) ((MLAS float*)(lds + L_NV))[tid] = it.has0 ? it.n0[tid] : 0.f;
    float m = it.m0;
    u32x4 pq[4], pk[4], pv[2]; float pia, pfa;
#define ML_PREFETCH(c_) do { const int t0_ = (c_) * L; \
        _Pragma("unroll") for (int i = 0; i < 4; ++i) { const bool ok_ = 16 * i < L;     \
            pq[i] = ok_ ? ML_LD16(it.q, qkoff, (t0_ + 16 * i) * 2048) : (u32x4){0u, 0u, 0u, 0u}; pk[i] = ok_ ? ML_LD16(it.k, qkoff, (t0_ + 16 * i) * 2048) : (u32x4){0u, 0u, 0u, 0u}; } \
        _Pragma("unroll") for (int i = 0; i < 2; ++i) pv[i] = (32 * i < L) ? ML_LD16(it.v, voff, (t0_ + 32 * i) * 2048) : (u32x4){0u, 0u, 0u, 0u}; \
        { const int lane = lane0; const bool ok_ = lane < L; const float a_ = ML_LDF(it.sm, lane * 64, t0_ * 64 + (8 + h) * 4), f_ = ML_LDF(it.sm, lane * 64, t0_ * 64 + (12 + h) * 4); pia = ok_ ? a_ : 0.f; pfa = ok_ ? f_ : 0.f; } } while (0)
    ML_PREFETCH(0);
    for (int c = 0; c < it.nchunk; ++c) {
        float wsl, decay, mnext;
        { ML_LANE;
        float lf = (lane < L) ? logsig_(pfa + it.bf) : 0.f; float cum = lf;
#pragma unroll
        for (int o = 1; o < 64; o <<= 1) { const float t_ = __shfl_up(cum, o); if (lane >= o) cum += t_; }
        const float wv = (lane < L) ? (pia + it.bi) - cum : -INFINITY; float cmx = wv;
#pragma unroll
        for (int o = 1; o < 64; o <<= 1) { const float t_ = __shfl_up(cmx, o); if (lane >= o) cmx = fmaxf(cmx, t_); }
        const float Ml = fmaxf(m, cmx); const float M63 = __shfl(Ml, 63), cum63 = __shfl(cum, 63);
        wsl = __expf(wv - M63); decay = __expf(m - M63); mnext = cum63 + M63;
        if (wave == 0) { ((MLAS float*)(lds + L_GW))[lane] = wv; ((MLAS float*)(lds + L_GM))[lane] = Ml; ((MLAS float*)(lds + L_GI))[lane] = __expf(m - Ml);
                         ((MLAS float*)(lds + L_GE))[lane] = __expf(-(cum + Ml)); ((MLAS float*)(lds + L_GS))[lane] = wsl; } }
#pragma unroll
        for (int i = 0; i < 4; ++i) { const int p_ = tid + 512 * i, row_ = p_ >> 5, cp_ = p_ & 31;
            *(MLAS u32x4*)(lds + L_Q + row_ * QP + cp_ * 16) = pq[i]; *(MLAS u32x4*)(lds + L_K + row_ * QP + cp_ * 16) = pk[i]; }
#pragma unroll
        for (int i = 0; i < 2; ++i) { const int p_ = tid + 512 * i, row_ = p_ >> 4, cp_ = p_ & 15; const float wr_ = __shfl(wsl, row_ & 63);
            *(MLAS u32x4*)(lds + L_V + row_ * VP + cp_ * 16) = pv[i];
            u32x4 o_;
#pragma unroll
            for (int e = 0; e < 4; ++e) o_[e] = cvtpk(__uint_as_float(pv[i][e] << 16) * wr_, __uint_as_float(pv[i][e] & 0xffff0000u) * wr_);
            *(MLAS u32x4*)(lds + L_VW + row_ * VP + cp_ * 16) = o_; }
        __syncthreads();
        const int sb = g; f32x16 S0 = {}, S1 = {};
        { ML_LANE;
            MLAS const unsigned char* kp = lds + L_K + (32 * sb + r32) * QP + hi * 16; MLAS const unsigned char* q0 = lds + L_Q + r32 * QP + hi * 16; MLAS const unsigned char* q1 = q0 + 32 * QP;
#pragma unroll 4
            for (int ks = 0; ks < 16; ++ks) { const bfx8 ka = *(MLAS const bfx8*)(kp + ks * 32); const bfx8 qb1 = *(MLAS const bfx8*)(q1 + ks * 32);
                S1 = ML_MFMA(ka, qb1, S1);
                if (g == 0) { const bfx8 qb0 = *(MLAS const bfx8*)(q0 + ks * 32); S0 = ML_MFMA(ka, qb0, S0); } }
        }
        { ML_LANE;
            const float M1 = ((MLAS const float*)(lds + L_GM))[32 + r32], M0 = ((MLAS const float*)(lds + L_GM))[r32]; float d0 = 0.f, d1 = 0.f;
#pragma unroll
            for (int i = 0; i < 16; ++i) { const int sl = crow(i, hi); const float ws_ = ((MLAS const float*)(lds + L_GW))[32 * sb + sl];
                const int s_ = 32 * sb + sl;
                S1[i] = (s_ <= 32 + r32) ? S1[i] * __expf(ws_ - M1) : 0.f; d1 += S1[i];
                if (g == 0) { S0[i] = (s_ <= r32) ? S0[i] * __expf(ws_ - M0) : 0.f; d0 += S0[i]; } }
            { auto rr = __builtin_amdgcn_permlane32_swap(__float_as_uint(d1), __float_as_uint(d1), false, false); d1 = __uint_as_float(rr[0]) + __uint_as_float(rr[1]); }
            { auto rr = __builtin_amdgcn_permlane32_swap(__float_as_uint(d0), __float_as_uint(d0), false, false); d0 = __uint_as_float(rr[0]) + __uint_as_float(rr[1]); }
            if (cb == 0 && hi == 0) { if (g == 0) { ((MLAS float*)(lds + L_DP))[r32] = d0; ((MLAS float*)(lds + L_DP))[32 + r32] = d1; } else ((MLAS float*)(lds + L_DP))[64 + r32] = d1; }
        }
        f32x16 Y0 = {}, Y1 = {};
        { ML_LANE;
#pragma unroll
        for (int j = 0; j < 4; ++j)
#pragma unroll
            for (int ks = 0; ks < 2; ++ks) { const bfx8 xs = pack_step(Cacc[j], ks);
                MLAS const unsigned char* qa = lds + L_Q + r32 * QP + (128 * g + 32 * j + 16 * ks + 4 * hi) * 2;
                const u32x2 a0l = *(MLAS const u32x2*)(qa), a0h = *(MLAS const u32x2*)(qa + 16), a1l = *(MLAS const u32x2*)(qa + 32 * QP), a1h = *(MLAS const u32x2*)(qa + 32 * QP + 16);
                const bfx8 pa0 = __builtin_bit_cast(bfx8, (u32x4){a0l.x, a0l.y, a0h.x, a0h.y}), pa1 = __builtin_bit_cast(bfx8, (u32x4){a1l.x, a1l.y, a1h.x, a1h.y});
                Y0 = ML_MFMA(pa0, xs, Y0); Y1 = ML_MFMA(pa1, xs, Y1); }
#pragma unroll
        for (int i = 0; i < 16; ++i) { Y0[i] *= ((MLAS const float*)(lds + L_GI))[crow(i, hi)]; Y1[i] *= ((MLAS const float*)(lds + L_GI))[32 + crow(i, hi)]; } }
        { ML_LANE;
            const int i16 = lane & 15, q_ = i16 >> 2, p_ = i16 & 3, gi = lane >> 4;
            MLAS const unsigned char* vb = lds + L_V + (32 * sb + 4 * hi + q_) * VP + (32 * cb + 16 * (gi & 1) + 4 * p_) * 2;
#pragma unroll
            for (int ks = 0; ks < 2; ++ks) { const bfx8 pb = cat8(vtr(vb + (16 * ks) * VP), vtr(vb + (16 * ks + 8) * VP));
                Y1 = ML_MFMA(pack_step(S1, ks), pb, Y1);
                if (g == 0) Y0 = ML_MFMA(pack_step(S0, ks), pb, Y0); }
        }
        { ML_LANE;
            const f32x4 nv = *(MLAS const f32x4*)(lds + L_NV + lane * 16);
#pragma unroll
            for (int rr_ = 0; rr_ < 8; ++rr_) { const int l_ = 8 * wave + rr_; const u32x2 qw = *(MLAS const u32x2*)(lds + L_Q + l_ * QP + lane * 8);
                float d_ = __uint_as_float(qw.x << 16) * nv.x + __uint_as_float(qw.x & 0xffff0000u) * nv.y + __uint_as_float(qw.y << 16) * nv.z + __uint_as_float(qw.y & 0xffff0000u) * nv.w;
                d_ = wsum_(d_); if (lane == 0) ((MLAS float*)(lds + L_QN))[l_] = d_; }
        }
        { ML_LANE;
            MLAS float* ex = (MLAS float*)(lds + L_EX + ((1 - g) * 4 + cb) * 4096) + lane;
#pragma unroll
            for (int i = 0; i < 16; ++i) ex[i * 64] = (g == 0) ? Y1[i] : Y0[i];
        }
        __syncthreads();
        if (c + 1 < it.nchunk) ML_PREFETCH(c + 1);
        { ML_LANE;
            MLAS const float* ex = (MLAS const float*)(lds + L_EX + (g * 4 + cb) * 4096) + lane; f32x16 Y = (g == 0) ? Y0 : Y1;
#pragma unroll
            for (int i = 0; i < 16; ++i) Y[i] += ex[i * 64];
#pragma unroll
            for (int i = 0; i < 16; ++i) { const int l_ = 32 * g + crow(i, hi);
                const float dsum = (g == 0) ? ((MLAS const float*)(lds + L_DP))[l_] : ((MLAS const float*)(lds + L_DP))[l_] + ((MLAS const float*)(lds + L_DP))[32 + l_];
                const float den = dsum + ((MLAS const float*)(lds + L_GI))[l_] * ((MLAS const float*)(lds + L_QN))[l_];
                const float hv = Y[i] / fmaxf(fabsf(den), ((MLAS const float*)(lds + L_GE))[l_]);
                const float hn = __shfl_xor(hv, 1);
                if (32 * g < L && (r32 & 1) == 0) __builtin_amdgcn_raw_buffer_store_b32(cvtpk(hv, hn), it.hout, (int)hoff, ((c * L + 32 * g + (i & 3) + 8 * (i >> 2)) * 1024 + 32 * cb) * 2, 0); }
        }
        if (tid < 256) { float a_ = 0.f;
#pragma unroll 8
            for (int s = 0; s < 64; ++s) a_ += ((MLAS const float*)(lds + L_GS))[s] * bf2f(*(MLAS const unsigned short*)(lds + L_K + s * QP + tid * 2));
            ((MLAS float*)(lds + L_NV))[tid] = decay * ((MLAS const float*)(lds + L_NV))[tid] + a_; }
        { ML_LANE;
            const int i16 = lane & 15, q_ = i16 >> 2, p_ = i16 & 3, gi = lane >> 4;
            MLAS const unsigned char* kb_ = lds + L_K + (8 * hi + q_) * QP + (128 * g + 16 * (gi & 1) + 4 * p_) * 2;
            MLAS const unsigned char* vw_ = lds + L_VW + (8 * hi + q_) * VP + (32 * cb + 16 * (gi & 1) + 4 * p_) * 2;
#pragma unroll
            for (int j = 0; j < 4; ++j)
#pragma unroll
                for (int i = 0; i < 16; ++i) Cacc[j][i] *= decay;
#pragma unroll
            for (int ks = 0; ks < 4; ++ks) { const bfx8 vb_ = cat8(vtr(vw_ + (16 * ks) * VP), vtr(vw_ + (16 * ks + 4) * VP));
#pragma unroll
                for (int j = 0; j < 4; ++j) { const bfx8 ka_ = cat8(vtr(kb_ + (16 * ks) * QP + 64 * j), vtr(kb_ + (16 * ks + 4) * QP + 64 * j));
                    Cacc[j] = ML_MFMA(ka_, vb_, Cacc[j]); } }
        }
        m = mnext;
        __syncthreads();
    }
#undef ML_PREFETCH
#undef ML_LANE
#pragma unroll
    for (int j = 0; j < 4; ++j)
#pragma unroll
        for (int i = 0; i < 16; ++i) __builtin_amdgcn_raw_buffer_store_b32(__float_as_uint(Cacc[j][i]), it.Cout, (int)coff, ((128 * g + 32 * j + (i & 3) + 8 * (i >> 2)) * 256 + 32 * cb) * 4, 0);
    if (it.nout && tid < 256) it.nout[tid] = ((MLAS const float*)(lds + L_NV))[tid];
    if (it.mout && tid == 0) *it.mout = m;
    __syncthreads();
}
#undef ML_MFMA
#undef ML_LD16
#undef ML_LDF
#undef MLAS
}

constexpr size_t WS_BC = WS_NAIVE, WS_WV = WS_BC + 2 * MiB, WS_CMX = WS_WV + 2 * MiB;
constexpr size_t WS_CHS = WS_CMX + 2 * MiB;
constexpr size_t WS_SMAT = WS_CHS + 1 * MiB;
constexpr size_t WS_CB = WS_SMAT + 3 * MiB;
constexpr size_t WS_NB = WS_CB + 64 * MiB;
constexpr size_t WS_MASKS = WS_NB + 1 * MiB;
constexpr size_t WS_HA = WS_MASKS + 1 * MiB;
constexpr size_t WS_END = WS_HA + ROWBUF;
constexpr int NCHK = BATCH * 4 * 32 + DEC_BATCH * 4;

__device__ __forceinline__ float logsig(float x) { return fminf(x, 0.0f) - log1pf(__expf(-fabsf(x))); }
__device__ __forceinline__ float siluf(float x) { return x / (1.0f + __expf(-x)); }
__device__ __forceinline__ int t5b(int rel) { const int n = rel < 0 ? -rel : rel; const int v = n < 8 ? n : 8 + (n >= 12) + (n >= 16) + (n >= 23) + (n >= 32) + (n >= 46) + (n >= 64) + (n >= 91); return (rel > 0 ? 16 : 0) + v; }

namespace pg8 {
__device__ __forceinline__ void unpack8(u32x4 w, float (&f)[8]) {
    f[0] = __uint_as_float(w.x << 16); f[1] = __uint_as_float(w.x & 0xffff0000u); f[2] = __uint_as_float(w.y << 16); f[3] = __uint_as_float(w.y & 0xffff0000u);
    f[4] = __uint_as_float(w.z << 16); f[5] = __uint_as_float(w.z & 0xffff0000u); f[6] = __uint_as_float(w.w << 16); f[7] = __uint_as_float(w.w & 0xffff0000u);
}
__device__ __forceinline__ u32x4 pack8f(const float (&f)[8]) { u32x4 w; w.x = cvt_pk_bf16(f[0], f[1]); w.y = cvt_pk_bf16(f[2], f[3]); w.z = cvt_pk_bf16(f[4], f[5]); w.w = cvt_pk_bf16(f[6], f[7]); return w; }
__device__ __forceinline__ float sg_(float x) { return 1.0f / (1.0f + __expf(-x)); }
struct EpiM1a {
    static constexpr bool PERM = true, AFTER_DRAIN = false, MIDK = false;
    const bf16_t* HA; const bf16_t* OB; const float* HST; const float* ang; bf16_t* BR;
    __device__ __forceinline__ void mid(f32x4 (&)[2][2][4][2], const Unit&, int, int, int, int) const {}
    __device__ __forceinline__ void operator()(const f32x4 (&acc)[2][2][4][2], const Unit& u, int wr, int wc, int fr, int fq) const {
        const int pn = u.pn; const int row0 = u.pm * BM + wr * 64 + fr, cl = wc * 32 + 8 * fq;
        if (pn < 8) {
            const int ch0 = 128 * pn + cl, head = pn >> 1;
            const f32x4 g0 = *(const f32x4*)(ang + ch0), g1 = *(const f32x4*)(ang + ch0 + 4);
            const float g[8] = {g0[0], g0[1], g0[2], g0[3], g1[0], g1[1], g1[2], g1[3]};
#pragma unroll
            for (int ai = 0; ai < 2; ++ai)
#pragma unroll
                for (int m = 0; m < 4; ++m) { const int r = row0 + ai * HALF + m * 16;
                    float h[8]; unpack8(*(const u32x4*)(HA + (size_t)r * 1024 + ch0), h);
                    const float mean = HST[((size_t)r * 4 + head) * 2], rstd = HST[((size_t)r * 4 + head) * 2 + 1];
                    const f32x4 o0 = acc[ai][0][m][0], o1 = acc[ai][0][m][1], z0 = acc[ai][1][m][0], z1 = acc[ai][1][m][1];
                    const float oa[8] = {o0[0], o0[1], o0[2], o0[3], o1[0], o1[1], o1[2], o1[3]}, za[8] = {z0[0], z0[1], z0[2], z0[3], z1[0], z1[1], z1[2], z1[3]};
                    float o[8];
#pragma unroll
                    for (int i = 0; i < 8; ++i) o[i] = ((h[i] - mean) * rstd * g[i] * sg_(oa[i])) * (za[i] * sg_(za[i]));
                    *(u32x4*)(BR + (size_t)r * 2048 + ch0) = pack8f(o); }
        } else {
#pragma unroll
            for (int ai = 0; ai < 2; ++ai)
#pragma unroll
                for (int m = 0; m < 4; ++m) { const int r = row0 + ai * HALF + m * 16;
#pragma unroll
                    for (int bj = 0; bj < 2; ++bj) { const int ch0 = 256 * (pn - 8) + 128 * bj + cl;
                        float ob[8]; unpack8(*(const u32x4*)(OB + (size_t)r * 1024 + ch0), ob);
                        const f32x4 z0 = acc[ai][bj][m][0], z1 = acc[ai][bj][m][1]; const float zb[8] = {z0[0], z0[1], z0[2], z0[3], z1[0], z1[1], z1[2], z1[3]};
                        float o[8];
#pragma unroll
                        for (int i = 0; i < 8; ++i) o[i] = ob[i] * (zb[i] * sg_(zb[i]));
                        *(u32x4*)(BR + (size_t)r * 2048 + 1024 + ch0) = pack8f(o); } }
        }
    }
};
struct EpiM1b {
    static constexpr bool PERM = true, AFTER_DRAIN = false, MIDK = false;
    bf16_t* SGA; bf16_t* SGB;
    __device__ __forceinline__ void mid(f32x4 (&)[2][2][4][2], const Unit&, int, int, int, int) const {}
    __device__ __forceinline__ void operator()(const f32x4 (&acc)[2][2][4][2], const Unit& u, int wr, int wc, int fr, int fq) const {
        const int pn = u.pn; const int row0 = u.pm * BM + wr * 64 + fr, cl = wc * 32 + 8 * fq;
        bf16_t* base = pn < 4 ? SGA : SGB; const int col0 = (pn & 3) * 256 + cl;
#pragma unroll
        for (int ai = 0; ai < 2; ++ai)
#pragma unroll
            for (int m = 0; m < 4; ++m) { bf16_t* rowp = base + (size_t)(row0 + ai * HALF + m * 16) * 1024 + col0;
#pragma unroll
                for (int bj = 0; bj < 2; ++bj) { const f32x4 v0 = acc[ai][bj][m][0], v1 = acc[ai][bj][m][1];
                    const float o[8] = {sg_(v0[0]), sg_(v0[1]), sg_(v0[2]), sg_(v0[3]), sg_(v1[0]), sg_(v1[1]), sg_(v1[2]), sg_(v1[3])};
                    *(u32x4*)(rowp + bj * HALF) = pack8f(o); } }
    }
};
struct EpiM2 {
    static constexpr bool PERM = true, AFTER_DRAIN = false, MIDK = true;
    const bf16_t* SGA; const bf16_t* SGB; bf16_t* MX;
    __device__ __forceinline__ void mid(f32x4 (&acc)[2][2][4][2], const Unit& u, int wr, int wc, int fr, int fq) const {
        int fr_ = fr, fq_ = fq; asm volatile("" : "+v"(fr_), "+v"(fq_));
        const int row0 = u.pm * BM + wr * 64 + fr_, col0 = u.pn * BM + wc * 32 + 8 * fq_;
#pragma unroll
        for (int ai = 0; ai < 2; ++ai)
#pragma unroll
            for (int m = 0; m < 4; ++m) { const size_t ro = (size_t)(row0 + ai * HALF + m * 16) * 1024 + col0;
#pragma unroll
                for (int bj = 0; bj < 2; ++bj) { float a[8], b[8]; unpack8(*(const u32x4*)(SGA + ro + bj * HALF), a); unpack8(*(const u32x4*)(SGB + ro + bj * HALF), b);
#pragma unroll
                    for (int i = 0; i < 4; ++i) { acc[ai][bj][m][0][i] *= a[i] * __builtin_amdgcn_rcpf(b[i]); acc[ai][bj][m][1][i] *= a[4 + i] * __builtin_amdgcn_rcpf(b[4 + i]); } }
                asm volatile("" ::: "memory"); }
    }
    __device__ __forceinline__ void operator()(const f32x4 (&acc)[2][2][4][2], const Unit& u, int wr, int wc, int fr, int fq) const {
        int fr_ = fr, fq_ = fq; asm volatile("" : "+v"(fr_), "+v"(fq_));
        const int row0 = u.pm * BM + wr * 64 + fr_, col0 = u.pn * BM + wc * 32 + 8 * fq_;
#pragma unroll
        for (int ai = 0; ai < 2; ++ai)
#pragma unroll
            for (int m = 0; m < 4; ++m) { const size_t ro = (size_t)(row0 + ai * HALF + m * 16) * 1024 + col0;
#pragma unroll
                for (int bj = 0; bj < 2; ++bj) { float b[8]; unpack8(*(const u32x4*)(SGB + ro + bj * HALF), b);
                    const f32x4 v0 = acc[ai][bj][m][0], v1 = acc[ai][bj][m][1];
                    const float o[8] = {v0[0] * b[0], v0[1] * b[1], v0[2] * b[2], v0[3] * b[3], v1[0] * b[4], v1[1] * b[5], v1[2] * b[6], v1[3] * b[7]};
                    *(u32x4*)(MX + ro + bj * HALF) = pack8f(o); }
                asm volatile("" ::: "memory"); }
    }
};
struct EpiM3 {
    static constexpr bool PERM = true, AFTER_DRAIN = false, MIDK = false;
    const float* xp; const float* xs; float* yp; float* ys;
    __device__ __forceinline__ void mid(f32x4 (&)[2][2][4][2], const Unit&, int, int, int, int) const {}
    __device__ __forceinline__ void operator()(const f32x4 (&acc)[2][2][4][2], const Unit& u, int wr, int wc, int fr, int fq) const {
        const bool samp = u.pm >= NTP / 256; const int row0 = (samp ? u.pm - NTP / 256 : u.pm) * BM + wr * 64 + fr, col0 = u.pn * BM + wc * 32 + 8 * fq;
        const float* xb = samp ? xs : xp; float* yb = samp ? ys : yp;
#pragma unroll
        for (int ai = 0; ai < 2; ++ai)
#pragma unroll
            for (int m = 0; m < 4; ++m) { const size_t ro = (size_t)(row0 + ai * HALF + m * 16) * 1024 + col0;
#pragma unroll
                for (int bj = 0; bj < 2; ++bj) { const f32x4 x0 = *(const f32x4*)(xb + ro + bj * HALF), x1 = *(const f32x4*)(xb + ro + bj * HALF + 4);
                    *(f32x4*)(yb + ro + bj * HALF) = x0 * DN_ALPHA + acc[ai][bj][m][0]; *(f32x4*)(yb + ro + bj * HALF + 4) = x1 * DN_ALPHA + acc[ai][bj][m][1]; } }
    }
};
}

__device__ __forceinline__ float wave_sum(float v) {
#pragma unroll
    for (int o = 1; o < 64; o <<= 1) v += __shfl_xor(v, o);
    return v;
}

__device__ __forceinline__ void simple_select_row(LAS unsigned char* lds, int row, unsigned long long* mrow, const bf16* QI_, const float* SM_, const bf16* KI_, const float* cache_ik_) {
    const int tid_ = threadIdx.x, lane_ = tid_ & 63, wave_ = tid_ >> 6;
    LAS float* sc = (LAS float*)(lds + RING_OFF);
    LAS float* qv = (LAS float*)(lds + RING_OFF + 16384);
    const bool samp = row >= NTP; const int b = samp ? (row - NTP) / DEC_SEQ : row / SEQ; const int q = samp ? (row - NTP) % DEC_SEQ : row % SEQ;
    const int S = samp ? PAST_LEN + DEC_SEQ : ((q >> 6) + 1) * 64;
    if (S <= TOPK_MAX) { if (tid_ < 32) mrow[tid_] = (tid_ < (S >> 6)) ? ~0ull : 0ull; return; }
    qv[tid_] = bf2f(QI_[(size_t)row * 512 + tid_]); if (tid_ < 8) qv[512 + tid_] = SM_[(size_t)row * 16 + tid_] * 0.35355339059327373f;
    __syncthreads();
    const int nIt = (S + 511) / 512;
    for (int i = 0; i < nIt; ++i) { const int s = tid_ + 512 * i;
        if (s < S) { float kf[64];
            if (samp && s < PAST_LEN) { const float* kr = cache_ik_ + ((size_t)b * PAST_LEN + s) * 64;
#pragma unroll
                for (int j = 0; j < 64; ++j) kf[j] = kr[j]; }
            else { const bf16* kr = KI_ + (samp ? (size_t)NTP + (size_t)b * DEC_SEQ + (s - PAST_LEN) : (size_t)b * SEQ + s) * 64;
#pragma unroll
                for (int j = 0; j < 64; ++j) kf[j] = bf2f(kr[j]); }
            float a = 0.f;
#pragma unroll
            for (int h = 0; h < 8; ++h) { float d = 0.f;
#pragma unroll
                for (int j = 0; j < 64; ++j) d += qv[h * 64 + j] * kf[j];
                a += qv[512 + h] * fmaxf(d, 0.f); }
            sc[s] = a; } }
    __syncthreads();
    for (int i = 0; i < nIt; ++i) { const int s = tid_ + 512 * i; bool keep = false;
        if (s < S) { const int v = __float_as_int(sc[s]); const int vk = v ^ ((v >> 31) & 0x7fffffff); int rank = 0;
            for (int j = 0; j < S; ++j) { const int u = __float_as_int(sc[j]); const int uk = u ^ ((u >> 31) & 0x7fffffff); rank += (uk > vk) || (uk == vk && j < s); } keep = rank < TOPK_MAX; }
        const unsigned long long bm = __ballot(keep);
        if (lane_ == 0 && (wave_ + 8 * i) * 64 < S) mrow[wave_ + 8 * i] = bm; }
    if (!samp) { const int nw = S >> 6; if (tid_ >= nw && tid_ < 32) mrow[tid_] = 0ull; }
    __syncthreads();
}
__device__ __forceinline__ void simple_attn_task(int row, int h, int dc, const unsigned long long* mrow, const bf16* QB_, const bf16* KBc_, const bf16* VBc_, const float* cache_k_, const float* cache_v_,
                                                  const float* k_sample_, const float* v_sample_, const float* rel_bias_, bf16* orow) {
    const bool samp = row >= NTP; const int b = samp ? (row - NTP) / DEC_SEQ : row / SEQ; const int q = samp ? (row - NTP) % DEC_SEQ : row % SEQ;
    const int S = samp ? PAST_LEN + DEC_SEQ : ((q >> 6) + 1) * 64; const int qpos = samp ? PAST_LEN + q : q;
    const bf16* qr = QB_ + (size_t)row * 1024 + h * 128;
    float mx = -INFINITY, sum = 0.f, o[16];
#pragma unroll
    for (int i = 0; i < 16; ++i) o[i] = 0.f;
    for (int w = 0; w * 64 < S; ++w) { unsigned long long bits = mrow[w];
        while (bits) { const int s = w * 64 + __builtin_ctzll(bits); bits &= bits - 1;
            float d = 0.f; float vv[16];
            if (samp) { const float* kr = (s < PAST_LEN) ? cache_k_ + ((size_t)b * PAST_LEN + s) * 1024 + h * 128 : k_sample_ + ((size_t)b * DEC_SEQ + (s - PAST_LEN)) * 1024 + h * 128;
                const float* vr = (s < PAST_LEN) ? cache_v_ + ((size_t)b * PAST_LEN + s) * 1024 + h * 128 + dc * 16 : v_sample_ + ((size_t)b * DEC_SEQ + (s - PAST_LEN)) * 1024 + h * 128 + dc * 16;
#pragma unroll 8
                for (int j = 0; j < 128; ++j) d += bf2f(qr[j]) * kr[j];
#pragma unroll
                for (int i = 0; i < 16; ++i) vv[i] = vr[i]; }
            else { const bf16* kr = KBc_ + ((size_t)b * SEQ + s) * 1024 + h * 128; const bf16* vr = VBc_ + ((size_t)b * SEQ + s) * 1024 + h * 128 + dc * 16;
#pragma unroll 8
                for (int j = 0; j < 128; ++j) d += bf2f(qr[j]) * bf2f(kr[j]);
#pragma unroll
                for (int i = 0; i < 16; ++i) vv[i] = bf2f(vr[i]); }
            const float lg = d * 0.08838834764831845f + rel_bias_[t5b(s - qpos) * 8 + h];
            if (lg > mx) { const float f = __expf(mx - lg); sum *= f;
#pragma unroll
                for (int i = 0; i < 16; ++i) o[i] *= f; mx = lg; }
            const float p = __expf(lg - mx); sum += p;
#pragma unroll
            for (int i = 0; i < 16; ++i) o[i] += p * vv[i]; } }
    const float inv = 1.0f / sum;
#pragma unroll
    for (int i = 0; i < 16; ++i) orow[i] = (bf16)f2bf(o[i] * inv);
}


template <int NW>
__device__ __forceinline__ unsigned long long wave_select(LAS const int* row, int nW, int lane_) {
    int v[NW]; int vmx = (int)0x80000000, vmn = 0x7fffffff;
#pragma unroll
    for (int i = 0; i < NW; ++i) { v[i] = (i < nW) ? row[lane_ + 64 * i] : (int)0x80000000; vmx = max(vmx, v[i]); if (v[i] != (int)0x80000000) vmn = min(vmn, v[i]); }
#pragma unroll
    for (int o_ = 1; o_ < 64; o_ <<= 1) { vmx = max(vmx, __shfl_xor(vmx, o_)); vmn = min(vmn, __shfl_xor(vmn, o_)); }
    int lo_ = __builtin_amdgcn_readfirstlane(vmn), hi_ = __builtin_amdgcn_readfirstlane(vmx); bool exact = false; int T = lo_;
    while (lo_ < hi_) { const int mid = lo_ + (int)((((unsigned)hi_ - (unsigned)lo_) + 1u) >> 1); int cnt = 0;
#pragma unroll
        for (int i = 0; i < NW; ++i) { cnt += __builtin_popcountll(__ballot(v[i] >= mid)); if ((i & 3) == 3) __builtin_amdgcn_sched_barrier(0); }
        if (cnt == TOPK_MAX) { exact = true; T = mid; break; }
        if (cnt > TOPK_MAX) lo_ = mid; else hi_ = mid - 1; }
    if (!exact) T = lo_;
    int need = TOPK_MAX;
    if (!exact) { int cgt = 0;
#pragma unroll
        for (int i = 0; i < NW; ++i) { cgt += __builtin_popcountll(__ballot(v[i] > T)); if ((i & 3) == 3) __builtin_amdgcn_sched_barrier(0); }
        need = TOPK_MAX - cgt; }
    unsigned long long myw = 0ull; int running = 0; const unsigned long long lt = (1ull << lane_) - 1ull;
#pragma unroll
    for (int i = 0; i < NW; ++i) { bool sel;
        if (exact) sel = v[i] >= T;
        else { const bool eq = v[i] == T; const unsigned long long em = __ballot(eq); sel = (v[i] > T) || (eq && running + __builtin_popcountll(em & lt) < need); running += __builtin_popcountll(em); }
        const unsigned long long wd = __ballot(sel); if (lane_ == i) myw = wd; __builtin_amdgcn_sched_barrier(0); }
    return myw;
}
__device__ __forceinline__ void sample_select_row(LAS unsigned char* lds, int row, unsigned long long* mrow, const bf16* QI_, const float* SM_, const bf16* KI_, const float* cache_ik_) {
    const int tid_ = threadIdx.x, lane_ = tid_ & 63, wave_ = __builtin_amdgcn_readfirstlane(tid_ >> 6);
    LAS int* sck = (LAS int*)(lds + RING_OFF);
    LAS float* qv = (LAS float*)(lds + RING_OFF + 16384);
    const int b = (row - NTP) / DEC_SEQ; constexpr int S = PAST_LEN + DEC_SEQ;
    qv[tid_] = bf2f(QI_[(size_t)row * 512 + tid_]); if (tid_ < 8) qv[512 + tid_] = SM_[(size_t)row * 16 + tid_] * 0.35355339059327373f;
    __syncthreads();
#pragma unroll 1
    for (int i = 0; i < 5; ++i) { const int s = tid_ + 512 * i;
        if (s < 2112) { int key = (int)0x80000000;
            if (s < S) { float kf[64];
                if (s < PAST_LEN) { const float* kr = cache_ik_ + ((size_t)b * PAST_LEN + s) * 64;
#pragma unroll
                    for (int j = 0; j < 64; ++j) kf[j] = kr[j]; }
                else { const bf16* kr = KI_ + ((size_t)NTP + (size_t)b * DEC_SEQ + (s - PAST_LEN)) * 64;
#pragma unroll
                    for (int j = 0; j < 64; ++j) kf[j] = bf2f(kr[j]); }
                float a = 0.f;
#pragma unroll
                for (int h = 0; h < 8; ++h) { float d = 0.f;
#pragma unroll
                    for (int j = 0; j < 64; ++j) d += qv[h * 64 + j] * kf[j];
                    a += qv[512 + h] * fmaxf(d, 0.f); }
                const int kb_ = __float_as_int(a); key = kb_ ^ ((kb_ >> 31) & 0x7fffffff); }
            sck[s] = key; } }
    __syncthreads();
    if (wave_ == 0) { const unsigned long long myw = wave_select<33>(sck, 33, lane_); if (lane_ < 33) mrow[lane_] = myw; }
    __syncthreads();
}
__device__ __forceinline__ void sample_attn_row(LAS unsigned char* lds, int b, int r, const unsigned long long* mrow, bf16* qo_row  , const float* cache_k_, const float* cache_v_,
                                                 const float* k_new, const float* v_new  , const float* rel_bias_) {
    const int tid_ = threadIdx.x, lane_ = tid_ & 63, h = __builtin_amdgcn_readfirstlane(tid_ >> 6);
    LAS int* idx = (LAS int*)(lds + RING_OFF);
    LAS float* qf = (LAS float*)(lds + RING_OFF + 1024) + h * 128;
    if (h == 0) { int base = 0; const unsigned long long lt = (1ull << lane_) - 1ull;
        for (int w = 0; w < 33; ++w) { const unsigned long long bits = mrow[w]; if ((bits >> lane_) & 1ull) idx[base + __builtin_popcountll(bits & lt)] = 64 * w + lane_; base += __builtin_popcountll(bits); } }
    qf[lane_] = bf2f(qo_row[h * 128 + lane_]); qf[64 + lane_] = bf2f(qo_row[h * 128 + 64 + lane_]);
    __syncthreads();
    const int qpos = PAST_LEN + r; float lg[4]; int sk[4];
#pragma unroll
    for (int rnd = 0; rnd < 4; ++rnd) { const int s = idx[64 * rnd + lane_]; sk[rnd] = s;
        const float* kr = (s < PAST_LEN) ? cache_k_ + ((size_t)b * PAST_LEN + s) * 1024 + h * 128 : k_new + (size_t)(s - PAST_LEN) * 1024 + h * 128;
        float d = 0.f;
#pragma unroll 8
        for (int d4 = 0; d4 < 32; ++d4) { const f32x4 kk = *(const f32x4*)(kr + 4 * d4); const f32x4 qq = *(LAS const f32x4*)(qf + 4 * d4); d += (kk.x * qq.x + kk.y * qq.y) + (kk.z * qq.z + kk.w * qq.w); }
        lg[rnd] = d * 0.08838834764831845f + rel_bias_[t5b(s - qpos) * 8 + h]; }
    float mx = fmaxf(fmaxf(lg[0], lg[1]), fmaxf(lg[2], lg[3]));
#pragma unroll
    for (int o_ = 1; o_ < 64; o_ <<= 1) mx = fmaxf(mx, __shfl_xor(mx, o_));
    float p[4], sum = 0.f;
#pragma unroll
    for (int rnd = 0; rnd < 4; ++rnd) { p[rnd] = __expf(lg[rnd] - mx); sum += p[rnd]; }
    sum = wave_sum(sum);
    float a0 = 0.f, a1 = 0.f;
#pragma unroll
    for (int rnd = 0; rnd < 4; ++rnd) {
#pragma unroll 8
        for (int j = 0; j < 64; ++j) { const float pj = __int_as_float(__builtin_amdgcn_readlane(__float_as_int(p[rnd]), j)); const int sj = __builtin_amdgcn_readlane(sk[rnd], j);
            const float* vr = (sj < PAST_LEN) ? cache_v_ + ((size_t)b * PAST_LEN + sj) * 1024 + h * 128 : v_new + (size_t)(sj - PAST_LEN) * 1024 + h * 128;
            const float2 vv = *(const float2*)(vr + 2 * lane_); a0 += pj * vv.x; a1 += pj * vv.y; } }
    const float inv = 1.0f / sum;
    *(unsigned*)(qo_row + h * 128 + 2 * lane_) = pk2(a0 * inv, a1 * inv);
    __syncthreads();
}

typedef const __attribute__((address_space(4))) Args* kargp_t;
#define MK_ARGS kargp_t ap_ = (kargp_t)__builtin_amdgcn_kernarg_segment_ptr(); asm volatile("" : "+s"(ap_))
#define args (*ap_)
__global__ void __launch_bounds__(NWAVES * 64, 2) mk_fwd(Args kargs_by_value) {
    extern __shared__ __attribute__((aligned(16))) unsigned char lds_raw[];
    LAS unsigned char* lds = (LAS unsigned char*)lds_raw;
    int lo, hi; unsigned* barw;
    { MK_ARGS; lo = args.ph_lo; hi = args.ph_hi; barw = (unsigned*)((gu32*)(args.ws + WS_CTL) + CW_BAR); }
    volatile LAS unsigned* MISC = (volatile LAS unsigned*)(lds + MISC_OFF);
    for (int u = threadIdx.x; u < (LDS_BYTES - LDSCTL_OFF) / 4; u += NWAVES * 64) ((LAS unsigned*)(lds + LDSCTL_OFF))[u] = 0u;
    __syncthreads();
    XcdBarrier bar = xcd_barrier_post(barw, MISC + 8);
#ifndef DUPMASK
#define DUPMASK 0
#endif
#ifndef PHMASK
#define PHMASK 0x3ff
#endif
#define IN(k) (((PHMASK >> (k)) & 1) && lo <= (k) && (k) < hi)
#define GBAR() xcd_barrier(bar)
#define WMIX ((bf16*)(args.ws + WS_WMIX))
#define WMRG ((bf16*)(args.ws + WS_WMRG))
#define WAB ((bf16*)(args.ws + WS_WAB))
#define WO ((bf16*)(args.ws + WS_WO))
#define XB ((bf16*)(args.ws + WS_XB))
#define QA ((bf16*)(args.ws + WS_QA))
#define KA ((bf16*)(args.ws + WS_KA))
#define VA ((bf16*)(args.ws + WS_VA))
#define QB ((bf16*)(args.ws + WS_QB))
#define QI ((bf16*)(args.ws + WS_QI))
#define KI ((bf16*)(args.ws + WS_KI))
#define SM ((float*)(args.ws + WS_SM))
#define MASK ((unsigned long long*)(args.ws + WS_MASK))
#define MASKS ((unsigned long long*)(args.ws + WS_MASKS))
#define HST ((float*)(args.ws + WS_HST))
#define BC ((float*)(args.ws + WS_BC))
#define WV ((float*)(args.ws + WS_WV))
#define CMX ((float*)(args.ws + WS_CMX))
#define CHS ((float*)(args.ws + WS_CHS))
#define MCH (CHS + 2 * NCHK)
#define SMATP ((float*)(args.ws + WS_SMAT))
#define SMATS (SMATP + 128 * 4096)
#define CB ((float*)(args.ws + WS_CB))
#define NBf ((float*)(args.ws + WS_NB))
#define HA VA
#define OB QB
#define BR QA
#define SGA VA
#define SGB QB
#define MX XB
#define y_prompt (args.out)
#define y_sample (y_prompt + (size_t)NTP * 1024)
#define k_prompt (y_sample + (size_t)NTS * 1024)
#define v_prompt (k_prompt + (size_t)NTP * 1024)
#define ik_prompt (v_prompt + (size_t)NTP * 1024)
#define C_prompt (ik_prompt + (size_t)NTP * 64)
#define n_prompt (C_prompt + (size_t)BATCH * 4 * 65536)
#define m_prompt (n_prompt + (size_t)BATCH * 1024)
#define k_sample (m_prompt + BATCH * 4)
#define v_sample (k_sample + (size_t)NTS * 1024)
#define ik_sample (v_sample + (size_t)NTS * 1024)
#define C_sample (ik_sample + (size_t)NTS * 64)
#define n_sample (C_sample + (size_t)DEC_BATCH * 4 * 65536)
#define m_sample (n_sample + (size_t)DEC_BATCH * 1024)
#define KBc ((bf16*)y_prompt)
#define VBc (KBc + (size_t)NTP * 1024)
#define cache_k (args.in[2])
#define cache_v (args.in[3])
#define cache_ik (args.in[4])
#define state_C (args.in[5])
#define state_n (args.in[6])
#define state_m (args.in[7])
#define b_gates (args.in[9])
#define a_norm_g (args.in[10])
#define rel_bias (args.in[14])
#define ln_g (args.in[15])
#define ln_b (args.in[16])
#define gtid ({ int t__ = (int)threadIdx.x; asm volatile("" : "+v"(t__)); (long)blockIdx.x * (NWAVES * 64) + (long)t__; })
#define GT ((long)gridDim.x * (NWAVES * 64))
#define gw (vcu * NWAVES + wave)
#define NGW ((int)gridDim.x * NWAVES)
#define tid ((int)threadIdx.x)
#define lane ((int)(threadIdx.x & 63))
#define wave (__builtin_amdgcn_readfirstlane((int)(threadIdx.x >> 6)))
#define G ((int)gridDim.x)
#define vcu ((G % 8 == 0) ? ((int)blockIdx.x % 8) * (G / 8) + (int)blockIdx.x / 8 : (int)blockIdx.x)

    if (IN(0))
#if (DUPMASK >> 0) & 1
    for (int rep_ = 0; rep_ < 2; ++rep_)
#endif
    { MK_ARGS;
        P0Args a{args.in[0], args.in[1], args.in[8], args.in[11], args.in[12], args.in[13], XB, WMIX, WMRG, WAB, WO};
        p0_prologue(a, lds, vcu, G, wave, lane);
        GBAR();
    }
    if (IN(1))
#if (DUPMASK >> 1) & 1
    for (int rep_ = 0; rep_ < 2; ++rep_)
#endif
    { MK_ARGS;
        pg8::Gemm g{XB, WMIX, NTOK, N_MIX, 1024}; pg8::StaticOrder S; S.init(NTOK, N_MIX, G, (int)blockIdx.x);
        pg8::EpiMix E{QA, KBc, QI, KI, SM, k_prompt, k_sample, ik_prompt, ik_sample};
        pg8::gemm_phase<pg8::EpiMix, pg8::StaticOrder, true, true>(lds + RING_OFF, g, S, E);
        GBAR();
    }
    if (IN(2))
#if (DUPMASK >> 2) & 1
    for (int rep_ = 0; rep_ < 2; ++rep_)
#endif
    { MK_ARGS;
        static_assert(ml::L_END <= LDSCTL_OFF, "mLSTM LDS image");
#ifdef PROBE_ML
#define HAREF ((bf16*)(args.ws + WS_HA))
        for (long t = gtid; t < NCHK; t += GT) {
            int h, L; long tok0;
            if (t < 4096) { const int b = (int)(t >> 7); h = (int)((t >> 5) & 3); const int c = (int)(t & 31); tok0 = (long)b * SEQ + c * 64; L = 64; }
            else { const int b = (int)((t - 4096) >> 2); h = (int)((t - 4096) & 3); tok0 = NTP + (long)b * DEC_SEQ; L = DEC_SEQ; }
            const float bi = b_gates[h], bfg = b_gates[4 + h]; float cum = 0.f, cmax = -INFINITY;
            for (int l = 0; l < L; ++l) { const long tok = tok0 + l; const float ig = SM[tok * 16 + 8 + h] + bi; const float lf = logsig(SM[tok * 16 + 12 + h] + bfg);
                cum += lf; const float w = ig - cum; cmax = fmaxf(cmax, w); BC[tok * 4 + h] = cum; WV[tok * 4 + h] = w; CMX[tok * 4 + h] = cmax; }
            CHS[2 * t] = cum; CHS[2 * t + 1] = cmax;
        }
        GBAR();
        for (long t = gtid; t < BATCH * 4 + DEC_BATCH * 4; t += GT) {
            if (t < BATCH * 4) { float m = 0.f; for (int c = 0; c < 32; ++c) { const long i = t * 32 + c; MCH[i] = m; m = CHS[2 * i] + fmaxf(m, CHS[2 * i + 1]); } m_prompt[t] = m; }
            else { const long j = t - BATCH * 4; const long i = 4096 + j; float m = state_m[j]; MCH[i] = m; m = CHS[2 * i] + fmaxf(m, CHS[2 * i + 1]); m_sample[j] = m; }
        }
        GBAR();
        for (int c = 0; c < 32; ++c) {
            const long nSp = 128L * 4096, nSs = (c == 0) ? 64L * 1024 : 0;
            for (long t = gtid; t < nSp + nSs; t += GT) {
                int bh, l, s, L; long tok0; float* dst;
                if (t < nSp) { bh = (int)(t >> 12); l = (int)((t >> 6) & 63); s = (int)(t & 63); L = 64; tok0 = (long)(bh >> 2) * SEQ + c * 64; dst = SMATP + t; }
                else { const long u = t - nSp; bh = (int)(u >> 10); l = (int)((u >> 5) & 31); s = (int)(u & 31); L = 32; tok0 = NTP + (long)(bh >> 2) * DEC_SEQ; dst = SMATS + u; }
                const int h = bh & 3; float val = 0.f;
                if (s <= l) { const long tl = tok0 + l, ts = tok0 + s; const bf16* q = QA + tl * 1024 + h * 256; const bf16* k = KA + ts * 1024 + h * 256;
                    float d = 0.f; for (int i = 0; i < 256; ++i) d += bf2f(q[i]) * bf2f(k[i]);
                    const long ci = (t < nSp) ? (long)bh * 32 + c : 4096 + bh;
                    val = d * __expf(WV[ts * 4 + h] - fmaxf(MCH[ci], CMX[tl * 4 + h])); }
                *dst = val;
            }
            GBAR();
            const long nHp = 32L * 64 * 1024, nHs = (c == 0) ? 16L * 32 * 1024 : 0, nCp = 128L * 65536, nCs = (c == 0) ? 64L * 65536 : 0;
            for (long t = gtid; t < nHp + nHs + nCp + nCs; t += GT) {
                if (t < nHp + nHs) {
                    int b, l, h, dv, L; long tok0, ci; const float* Sr; const float* Cm; const float* nv; bool zero = false;
                    if (t < nHp) { b = (int)(t >> 16); l = (int)((t >> 10) & 63); h = (int)((t >> 8) & 3); dv = (int)(t & 255); L = 64; tok0 = (long)b * SEQ + c * 64; ci = (long)(b * 4 + h) * 32 + c;
                        Sr = SMATP + ((long)(b * 4 + h) * 64 + l) * 64; Cm = CB + (size_t)(c & 1) * 128 * 65536 + (size_t)(b * 4 + h) * 65536; nv = NBf + (c & 1) * 128 * 256 + (b * 4 + h) * 256; zero = (c == 0); }
                    else { const long u = t - nHp; b = (int)(u >> 15); l = (int)((u >> 10) & 31); h = (int)((u >> 8) & 3); dv = (int)(u & 255); L = 32; tok0 = NTP + (long)b * DEC_SEQ; ci = 4096 + b * 4 + h;
                        Sr = SMATS + ((long)(b * 4 + h) * 32 + l) * 32; Cm = state_C + (size_t)(b * 4 + h) * 65536; nv = state_n + (b * 4 + h) * 256; }
                    const long tl = tok0 + l; const bf16* q = QA + tl * 1024 + h * 256;
                    const float mc = MCH[ci], Ml = fmaxf(mc, CMX[tl * 4 + h]), bl = BC[tl * 4 + h]; const float inter = __expf(mc - Ml);
                    float num = 0.f, den = 0.f;
                    for (int s = 0; s <= l; ++s) { const float sv = Sr[s]; num += sv * bf2f(VA[(tok0 + s) * 1024 + h * 256 + dv]); den += sv; }
                    if (!zero) { float qc = 0.f, qn = 0.f; for (int i = 0; i < 256; ++i) { const float qi_ = bf2f(q[i]); qc += qi_ * Cm[(size_t)i * 256 + dv]; qn += qi_ * nv[i]; } num += inter * qc; den += inter * qn; }
                    const float hv = num / fmaxf(fabsf(den), __expf(-(bl + Ml)));
                    HAREF[tl * 1024 + h * 256 + dv] = (bf16)f2bf(hv);
                } else {
                    const long u0 = t - (nHp + nHs); int bh, dk, dv, L; long tok0, ci; const float* Cs; const float* ns; float* Cd; float* nd; bool zero = false;
                    if (u0 < nCp) { bh = (int)(u0 >> 16); dk = (int)((u0 >> 8) & 255); dv = (int)(u0 & 255); L = 64; tok0 = (long)(bh >> 2) * SEQ + c * 64; ci = (long)bh * 32 + c; zero = (c == 0);
                        Cs = CB + (size_t)(c & 1) * 128 * 65536 + (size_t)bh * 65536; ns = NBf + (c & 1) * 128 * 256 + bh * 256;
                        Cd = (c == 31) ? C_prompt + (size_t)bh * 65536 : CB + (size_t)((c + 1) & 1) * 128 * 65536 + (size_t)bh * 65536; nd = (c == 31) ? n_prompt + bh * 256 : NBf + ((c + 1) & 1) * 128 * 256 + bh * 256; }
                    else { const long u = u0 - nCp; bh = (int)(u >> 16); dk = (int)((u >> 8) & 255); dv = (int)(u & 255); L = 32; tok0 = NTP + (long)(bh >> 2) * DEC_SEQ; ci = 4096 + bh;
                        Cs = state_C + (size_t)bh * 65536; ns = state_n + bh * 256; Cd = C_sample + (size_t)bh * 65536; nd = n_sample + bh * 256; }
                    const int h = bh & 3; const float mc = MCH[ci]; const float Mlast = fmaxf(mc, CMX[(tok0 + L - 1) * 4 + h]); const float decay = __expf(mc - Mlast);
                    float aC = 0.f, an = 0.f;
                    for (int s = 0; s < L; ++s) { const long ts = tok0 + s; const float wsv = __expf(WV[ts * 4 + h] - Mlast); const float kk = bf2f(KA[ts * 1024 + h * 256 + dk]);
                        aC += wsv * kk * bf2f(VA[ts * 1024 + h * 256 + dv]); an += wsv * kk; }
                    Cd[(size_t)dk * 256 + dv] = (zero ? 0.f : decay * Cs[(size_t)dk * 256 + dv]) + aC;
                    if (dv == 0) nd[dk] = (zero ? 0.f : decay * ns[dk]) + an;
                }
            }
            GBAR();
        }
#endif
#define ML_RS(p, bytes) __builtin_amdgcn_make_buffer_rsrc((void*)(p), (short)0, (int)(bytes), 0x00020000)
        if (vcu < BATCH * 8) { const int bh = vcu >> 1, dvh = vcu & 1, b = bh >> 2, h = bh & 3; const size_t t0 = (size_t)b * SEQ;
            ml::Item it; it.q = ML_RS(QA + t0 * 1024 + h * 256, SEQ * 2048); it.k = ML_RS(KA + t0 * 1024 + h * 256, SEQ * 2048); it.v = ML_RS(VA + t0 * 1024 + h * 256 + dvh * 128, SEQ * 2048); it.sm = ML_RS(SM + t0 * 16, SEQ * 64);
            it.C0 = ML_RS(C_prompt, 4); it.has0 = false; it.n0 = nullptr; it.m0 = 0.f; it.Cout = ML_RS(C_prompt + (size_t)bh * 65536 + dvh * 128, 65536 * 4);
            it.nout = dvh == 0 ? n_prompt + bh * 256 : nullptr; it.mout = dvh == 0 ? m_prompt + bh : nullptr;
            it.head = h; it.nchunk = SEQ / CHUNK; it.L = CHUNK; it.bi = b_gates[h]; it.bf = b_gates[4 + h]; it.hout = it.v;
#if (DUPMASK >> 2) & 1
            { float* no_ = it.nout; float* mo_ = it.mout;
              for (int dry_ = 1; dry_ >= 0; --dry_) { it.hout = dry_ ? ML_RS(args.ws + WS_HA, SEQ * 2048) : it.v; it.Cout = dry_ ? ML_RS(args.ws + WS_HA + 8 * MiB + (size_t)vcu * 65536 * 4, 65536 * 4) : ML_RS(C_prompt + (size_t)bh * 65536 + dvh * 128, 65536 * 4);
                  it.nout = dry_ ? nullptr : no_; it.mout = dry_ ? nullptr : mo_; ml::run_item(lds, it); } } }
#else
            ml::run_item(lds, it); }
#endif
        if (vcu < DEC_BATCH * 8) { const int bh = vcu >> 1, dvh = vcu & 1, b = bh >> 2, h = bh & 3; const size_t t0 = (size_t)NTP + (size_t)b * DEC_SEQ;
            ml::Item it; it.q = ML_RS(QA + t0 * 1024 + h * 256, DEC_SEQ * 2048); it.k = ML_RS(KA + t0 * 1024 + h * 256, DEC_SEQ * 2048); it.v = ML_RS(VA + t0 * 1024 + h * 256 + dvh * 128, DEC_SEQ * 2048); it.sm = ML_RS(SM + t0 * 16, DEC_SEQ * 64);
            it.C0 = ML_RS(state_C + (size_t)bh * 65536 + dvh * 128, 65536 * 4); it.has0 = true; it.n0 = state_n + bh * 256; it.m0 = state_m[bh]; it.Cout = ML_RS(C_sample + (size_t)bh * 65536 + dvh * 128, 65536 * 4);
            it.nout = dvh == 0 ? n_sample + bh * 256 : nullptr; it.mout = dvh == 0 ? m_sample + bh : nullptr;
            it.head = h; it.nchunk = 1; it.L = DEC_SEQ; it.bi = b_gates[h]; it.bf = b_gates[4 + h]; it.hout = it.v;
            ml::run_item(lds, it); }
#undef ML_RS
        GBAR();
#ifdef PROBE_ML
        { float num = 0.f, den = 0.f;
          for (long t = gtid; t < (long)NTOK * 1024; t += GT) { const float a = bf2f(HA[t]), r = bf2f(HAREF[t]); num += (a - r) * (a - r); den += r * r; }
          num = wave_sum(num); den = wave_sum(den);
          if (lane == 0) { atomicAdd((float*)(args.ws + WS_CTL) + 8, num); atomicAdd((float*)(args.ws + WS_CTL) + 9, den); } }
#endif
        { const int sub = lane >> 3, l8 = lane & 7;
          for (long t0 = (long)gw * 8; t0 < (long)NTOK * 4; t0 += (long)NGW * 8) { const long t = t0 + sub;
              const GAS v4u* src = (const GAS v4u*)(HA + t * 256 + l8 * 32); v4u w[4];
#pragma unroll
              for (int j = 0; j < 4; ++j) w[j] = src[j];
              float f[32];
#pragma unroll
              for (int j = 0; j < 4; ++j)
#pragma unroll
                  for (int e = 0; e < 4; ++e) { f[8 * j + 2 * e] = __uint_as_float(w[j][e] << 16); f[8 * j + 2 * e + 1] = __uint_as_float(w[j][e] & 0xffff0000u); }
              float s1 = 0.f;
#pragma unroll
              for (int e = 0; e < 32; ++e) s1 += f[e];
              s1 += __shfl_xor(s1, 1); s1 += __shfl_xor(s1, 2); s1 += __shfl_xor(s1, 4);
              const float mean = s1 * (1.0f / 256.0f); float s2 = 0.f;
#pragma unroll
              for (int e = 0; e < 32; ++e) { const float d = f[e] - mean; s2 += d * d; }
              s2 += __shfl_xor(s2, 1); s2 += __shfl_xor(s2, 2); s2 += __shfl_xor(s2, 4);
              if (l8 == 0) { HST[t * 2] = mean; HST[t * 2 + 1] = 1.0f / sqrtf(s2 * (1.0f / 256.0f) + HEAD_NORM_EPS); } } }
    }
    if (IN(3))
#if (DUPMASK >> 3) & 1
    for (int rep_ = 0; rep_ < 2; ++rep_)
#endif
    { MK_ARGS;
        {
            typedef short bfx8 __attribute__((ext_vector_type(8))); typedef float f16v __attribute__((ext_vector_type(16)));
            LAS int* sck = (LAS int*)(lds + RING_OFF);
            const int hi = lane >> 5, r32 = lane & 31;
            for (int w4 = 0; w4 < 4; ++w4) {
                const int bW = vcu >> 3, jW = vcu & 7; const int cW = (w4 == 0) ? jW : (w4 == 1) ? 15 - jW : (w4 == 2) ? 16 + jW : 31 - jW;
                if (vcu >= BATCH * 8) break;
                const int S = 64 * (cW + 1), nW = cW + 1; const long tok0 = (long)bW * SEQ + 64 * cW;
                if (S <= TOPK_MAX) {
                    for (int k = 0; k < 8; ++k) { if (lane < 32) MASK[(size_t)(tok0 + wave * 8 + k) * 32 + lane] = (lane < nW) ? ~0ull : 0ull; }
                    continue; }
                { LAS unsigned char* qil = lds + RING_OFF + 65536; LAS float* sml = (LAS float*)(lds + RING_OFF + 65536 + 73728);
#pragma unroll
                  for (int i = 0; i < 8; ++i) { const int p_ = tid + 512 * i, row_ = p_ >> 6, wi_ = p_ & 63;
                      *(LAS v4u*)(qil + row_ * 1152 + (wi_ >> 3) * 144 + (wi_ & 7) * 16) = *(const v4u*)(QI + (size_t)(tok0 + row_) * 512 + wi_ * 8); }
                  sml[tid] = SM[(size_t)(tok0 + (tid >> 3)) * 16 + (tid & 7)] * 0.35355339059327373f;
                  asm volatile("s_waitcnt vmcnt(0) lgkmcnt(0)" ::: "memory"); __builtin_amdgcn_s_barrier(); asm volatile("" ::: "memory"); }
                bfx8 bfr[8][4];
#pragma unroll
                for (int i = 0; i < 8; ++i) { const int kt = wave + 8 * i;
                    if (kt < 2 * nW) { const bf16* kp = KI + ((size_t)bW * SEQ + 32 * kt + r32) * 64 + hi * 8;
#pragma unroll
                        for (int ks = 0; ks < 4; ++ks) bfr[i][ks] = *(const bfx8*)(kp + ks * 16); }
                    else {
#pragma unroll
                        for (int ks = 0; ks < 4; ++ks) bfr[i][ks] = (bfx8){0, 0, 0, 0, 0, 0, 0, 0}; } }
                for (int rd = 0; rd < 8; ++rd) {
                    bfx8 afr[2][4]; float wgt[2][16];
                    { const int blk = r32 >> 2; const int qa_ = 2 * (blk & 1) + (blk >> 2), ha_ = 4 * ((blk >> 1) & 1) + (r32 & 3);
                      LAS const unsigned char* qil = lds + RING_OFF + 65536; LAS const float* sml = (LAS const float*)(lds + RING_OFF + 65536 + 73728);
#pragma unroll
                      for (int rt = 0; rt < 2; ++rt) { LAS const unsigned char* qp = qil + (8 * rd + 4 * rt + qa_) * 1152 + ha_ * 144 + hi * 16;
#pragma unroll
                          for (int ks = 0; ks < 4; ++ks) afr[rt][ks] = *(LAS const bfx8*)(qp + ks * 32);
#pragma unroll
                          for (int qq = 0; qq < 2; ++qq) { LAS const float* wp = sml + (8 * rd + 4 * rt + 2 * hi + qq) * 8;
                              const f32x4 w0 = *(LAS const f32x4*)wp, w1 = *(LAS const f32x4*)(wp + 4);
                              wgt[rt][8 * qq + 0] = w0[0]; wgt[rt][8 * qq + 1] = w0[1]; wgt[rt][8 * qq + 2] = w0[2]; wgt[rt][8 * qq + 3] = w0[3];
                              wgt[rt][8 * qq + 4] = w1[0]; wgt[rt][8 * qq + 5] = w1[1]; wgt[rt][8 * qq + 6] = w1[2]; wgt[rt][8 * qq + 7] = w1[3]; } } }
#pragma unroll
                    for (int i8 = 0; i8 < 8; ++i8) { const int kt = wave + 8 * i8; if (kt < 2 * nW) {
#pragma unroll
                        for (int rt = 0; rt < 2; ++rt) { f16v acc = {};
#pragma unroll
                            for (int ks = 0; ks < 4; ++ks) acc = __builtin_amdgcn_mfma_f32_32x32x16_bf16(afr[rt][ks], bfr[i8][ks], acc, 0, 0, 0);
                            float sA = 0.f, sB = 0.f;
#pragma unroll
                            for (int i = 0; i < 8; ++i) { sA += wgt[rt][i] * fmaxf(acc[i], 0.f); sB += wgt[rt][8 + i] * fmaxf(acc[8 + i], 0.f); }
                            const int kA = __float_as_int(sA), kB = __float_as_int(sB);
                            sck[(4 * rt + 2 * hi) * 2048 + 32 * kt + r32] = kA ^ ((kA >> 31) & 0x7fffffff);
                            sck[(4 * rt + 2 * hi + 1) * 2048 + 32 * kt + r32] = kB ^ ((kB >> 31) & 0x7fffffff); }
                    } }
                    asm volatile("s_waitcnt lgkmcnt(0)" ::: "memory"); __builtin_amdgcn_s_barrier(); asm volatile("" ::: "memory");
                    { const unsigned long long myw = (nW <= 16) ? wave_select<16>(sck + wave * 2048, nW, lane) : wave_select<32>(sck + wave * 2048, nW, lane); if (lane < 32) MASK[(size_t)(tok0 + 8 * rd + wave) * 32 + lane] = myw; }
                    asm volatile("s_waitcnt lgkmcnt(0)" ::: "memory"); __builtin_amdgcn_s_barrier(); asm volatile("" ::: "memory");
                }
            }
        }
        for (int row = NTP + vcu; row < NTOK; row += G) sample_select_row(lds, row, MASKS + (size_t)(row - NTP) * 40, QI, SM, KI, cache_ik);
        GBAR();
    }
#ifdef PROBE_ATT
    if (IN(4)) { MK_ARGS;
        unsigned long long* MREF = (unsigned long long*)(args.ws + WS_END); bf16* OREF = (bf16*)(args.ws + WS_END + 2 * MiB);
        for (int pr = vcu; pr < 4096; pr += G) { const int row = pr < 2048 ? pr : 31 * SEQ + (pr - 2048); simple_select_row(lds, row, MREF + (size_t)pr * 32, QI, SM, KI, cache_ik); }
        GBAR();
        for (long t = gtid; t < 4096L * 64; t += GT) { const int dc = (int)(t & 7), h = (int)((t >> 3) & 7); const int pr = (int)(t >> 6); const int row = pr < 2048 ? pr : 31 * SEQ + (pr - 2048);
            simple_attn_task(row, h, dc, MREF + (size_t)pr * 32, QB, KBc, VBc, cache_k, cache_v, k_sample, v_sample, rel_bias, OREF + (size_t)pr * 1024 + h * 128 + dc * 16); }
        GBAR();
    }
#endif
    if (IN(4)) { MK_ARGS;
        {
            char* alds = (char*)lds_raw;
            for (int bh = vcu; bh < BATCH * 8; bh += G) {
                const int b = bh >> 3, h = bh & 7;
                if (tid < 320) ((float*)(alds + at2::BT_OFF))[tid] = rel_bias[t5b(tid - 256) * 8 + h] * (1.0f / at2::SCALE);
                const float cfar = __int_as_float(__builtin_amdgcn_readfirstlane(__float_as_int(rel_bias[15 * 8 + h] * (1.0f / at2::SCALE))));
                at2::Ctx C;
                C.Q = __builtin_amdgcn_make_buffer_rsrc((void*)(QB + (size_t)b * SEQ * 1024 + h * 128), (short)0, SEQ * 1024 * 2, 0x00020000);
                C.K = __builtin_amdgcn_make_buffer_rsrc((void*)(KBc + (size_t)b * SEQ * 1024 + h * 128), (short)0, SEQ * 1024 * 2, 0x00020000);
                C.V = __builtin_amdgcn_make_buffer_rsrc((void*)(VBc + (size_t)b * SEQ * 1024 + h * 128), (short)0, SEQ * 1024 * 2, 0x00020000);
                C.M = __builtin_amdgcn_make_buffer_rsrc((void*)(MASK + (size_t)b * SEQ * 32), (short)0, SEQ * 32 * 8, 0x00020000);
                C.O = C.Q;
#if (DUPMASK >> 4) & 1
                for (int dry_ = 1; dry_ >= 0; --dry_) { C.O = dry_ ? __builtin_amdgcn_make_buffer_rsrc((void*)(args.ws + WS_HA), (short)0, SEQ * 1024 * 2, 0x00020000) : C.Q;
#endif
                at2::Seam S; at2::dsa_prime(C, 0, alds, S);
                for (int u = 0; u < 8; ++u) at2::dsa_block(C, u * 256, (u < 7 ? u + 1 : u) * 256, alds, S, cfar);
#if (DUPMASK >> 4) & 1
                }
#endif
            }
        }
#ifdef PROBE_SAMP
        { unsigned long long* MREF = (unsigned long long*)(args.ws + WS_END); bf16* OREF = (bf16*)(args.ws + WS_END + 2 * MiB);
          for (int row = NTP + vcu; row < NTOK; row += G) simple_select_row(lds, row, MREF + (size_t)(row - NTP) * 40, QI, SM, KI, cache_ik);
          GBAR();
          for (long t = gtid; t < (long)NTS * 64; t += GT) { const int dc = (int)(t & 7), h = (int)((t >> 3) & 7); const int pr = (int)(t >> 6);
              simple_attn_task(NTP + pr, h, dc, MREF + (size_t)pr * 40, QB, KBc, VBc, cache_k, cache_v, k_sample, v_sample, rel_bias, OREF + (size_t)pr * 1024 + h * 128 + dc * 16); }
          GBAR(); }
#endif
        for (int pr = vcu; pr < NTS; pr += G) { const int b = pr / DEC_SEQ, r = pr % DEC_SEQ;
            sample_attn_row(lds, b, r, MASKS + (size_t)pr * 40, OB + (size_t)(NTP + pr) * 1024, cache_k, cache_v, k_sample + (size_t)b * DEC_SEQ * 1024, v_sample + (size_t)b * DEC_SEQ * 1024, rel_bias); }
        GBAR();
#ifdef PROBE_SAMP
        { const unsigned long long* MREF = (const unsigned long long*)(args.ws + WS_END); const bf16* OREF = (const bf16*)(args.ws + WS_END + 2 * MiB); float num = 0.f, den = 0.f, dif = 0.f;
          for (long t = gtid; t < (long)NTS * 1024; t += GT) { const float a = bf2f(OB[(size_t)NTP * 1024 + t]), r_ = bf2f(OREF[t]); num += (a - r_) * (a - r_); den += r_ * r_; }
          for (long t = gtid; t < (long)NTS * 33; t += GT) { const int pr = (int)(t / 33), w = (int)(t % 33); dif += (float)__builtin_popcountll(MASKS[(size_t)pr * 40 + w] ^ MREF[(size_t)pr * 40 + w]); }
          num = wave_sum(num); den = wave_sum(den); dif = wave_sum(dif);
          if (lane == 0) { atomicAdd((float*)(args.ws + WS_CTL) + 8, num); atomicAdd((float*)(args.ws + WS_CTL) + 9, den); atomicAdd((float*)(args.ws + WS_CTL) + 10, dif); }
          GBAR(); }
#endif
    }
#ifdef PROBE_ATT
    if (IN(4)) { MK_ARGS;
        const bf16* OREF = (const bf16*)(args.ws + WS_END + 2 * MiB); float num = 0.f, den = 0.f;
        for (long t = gtid; t < 4096L * 1024; t += GT) { const int pr = (int)(t >> 10), c = (int)(t & 1023); const int row = pr < 2048 ? pr : 31 * SEQ + (pr - 2048);
            const float a = bf2f(OB[(size_t)row * 1024 + c]), r = bf2f(OREF[t]); num += (a - r) * (a - r); den += r * r; }
        num = wave_sum(num); den = wave_sum(den);
        if (lane == 0) { atomicAdd((float*)(args.ws + WS_CTL) + 8, num); atomicAdd((float*)(args.ws + WS_CTL) + 9, den); }
        GBAR();
    }
#endif
    if (IN(5))
#if (DUPMASK >> 5) & 1
    for (int rep_ = 0; rep_ < 2; ++rep_)
#endif
    { MK_ARGS;
        pg8::Gemm g{XB, WMRG, NTOK, N_M1A, 1024}; pg8::StaticOrder S; S.init(NTOK, N_M1A, G, (int)blockIdx.x);
        pg8::EpiM1a E{HA, OB, HST, a_norm_g, BR};
        pg8::gemm_phase<pg8::EpiM1a, pg8::StaticOrder, true, true>(lds + RING_OFF, g, S, E);
        GBAR();
    }
    if (IN(6))
#if (DUPMASK >> 6) & 1
    for (int rep_ = 0; rep_ < 2; ++rep_)
#endif
    { MK_ARGS;
        pg8::Gemm g{XB, WMRG + (size_t)N_M1A * 1024, NTOK, N_M1B, 1024}; pg8::StaticOrder S; S.init(NTOK, N_M1B, G, (int)blockIdx.x);
        pg8::EpiM1b E{SGA, SGB};
        pg8::gemm_phase<pg8::EpiM1b, pg8::StaticOrder, true, true>(lds + RING_OFF, g, S, E);
        GBAR();
    }
    if (IN(7))
#if (DUPMASK >> 7) & 1
    for (int rep_ = 0; rep_ < 2; ++rep_)
#endif
    { MK_ARGS;
        pg8::Gemm g{BR, WAB, NTOK, 1024, 2048}; pg8::StaticOrder S; S.init(NTOK, 1024, G, (int)blockIdx.x);
        pg8::EpiM2 E{SGA, SGB, MX};
        pg8::gemm_phase<pg8::EpiM2, pg8::StaticOrder, true, true>(lds + RING_OFF, g, S, E);
        GBAR();
    }
    if (IN(8))
#if (DUPMASK >> 8) & 1
    for (int rep_ = 0; rep_ < 2; ++rep_)
#endif
    { MK_ARGS;
        pg8::Gemm g{MX, WO, NTOK, 1024, 1024}; pg8::StaticOrder S; S.init(NTOK, 1024, G, (int)blockIdx.x);
        pg8::EpiM3 E{args.in[0], args.in[1], y_prompt, y_sample};
        pg8::gemm_phase<pg8::EpiM3, pg8::StaticOrder, true, true>(lds + RING_OFF, g, S, E);
        GBAR();
    }
    if (IN(9))
#if (DUPMASK >> 9) & 1
    for (int rep_ = 0; rep_ < 2; ++rep_)
#endif
    { MK_ARGS;
        for (int m0 = gw * 2; m0 < NTOK; m0 += NGW * 2) {
            GAS f32x4* yv[2]; f32x4 v[2][4]; float sm_[2] = {0.f, 0.f};
#pragma unroll
            for (int q = 0; q < 2; ++q) { const int m = m0 + q; float* yr = m < NTP ? y_prompt + (size_t)m * 1024 : y_sample + (size_t)(m - NTP) * 1024; yv[q] = (GAS f32x4*)yr + lane;
#pragma unroll
                for (int j = 0; j < 4; ++j) v[q][j] = yv[q][64 * j]; }
#pragma unroll
            for (int q = 0; q < 2; ++q) {
#pragma unroll
                for (int j = 0; j < 4; ++j) sm_[q] += (v[q][j].x + v[q][j].y) + (v[q][j].z + v[q][j].w);
                const float mean = wave_sum(sm_[q]) * (1.f / 1024.f); float s2 = 0.f;
#pragma unroll
                for (int j = 0; j < 4; ++j) { v[q][j] = v[q][j] - mean; s2 += (v[q][j].x * v[q][j].x + v[q][j].y * v[q][j].y) + (v[q][j].z * v[q][j].z + v[q][j].w * v[q][j].w); }
                const float rstd = 1.f / sqrtf(wave_sum(s2) * (1.f / 1024.f) + LN_EPS);
#pragma unroll
                for (int j = 0; j < 4; ++j) { const f32x4 gg = *((const GAS f32x4*)ln_g + lane + 64 * j), bb = *((const GAS f32x4*)ln_b + lane + 64 * j); yv[q][64 * j] = v[q][j] * rstd * gg + bb; } }
        }
    }
#if defined(PROBE_ATT) || defined(PROBE_ML) || defined(PROBE_SAMP)
    { MK_ARGS; GBAR();
      if (blockIdx.x == 0 && threadIdx.x < 64) { const float num = ((volatile float*)(args.ws + WS_CTL))[8], den = ((volatile float*)(args.ws + WS_CTL))[9];
          const float dif = ((volatile float*)(args.ws + WS_CTL))[10];
          m_sample[threadIdx.x] *= 1.0f + 30.0f * (sqrtf(num / den) + dif / (float)(NTS * TOPK_MAX)); } }
#endif
#undef IN
#undef GBAR
#undef args
#undef gtid
#undef GT
#undef gw
#undef NGW
#undef tid
#undef lane
#undef wave
#undef G
#undef vcu
}

extern "C" void kernel_launch(void* const* d_in, const int* in_sizes, int n_in, void* d_out, int out_size, void* d_ws, size_t ws_size, hipStream_t stream) {
    static int grid = 0;
    if (grid == 0) {
        int dev = 0, cus = 0;
        if (hipGetDevice(&dev) != hipSuccess || hipDeviceGetAttribute(&cus, hipDeviceAttributeMultiprocessorCount, dev) != hipSuccess) { grid = -1; return; }
        if (hipFuncSetAttribute((const void*)mk_fwd, hipFuncAttributeMaxDynamicSharedMemorySize, LDS_BYTES) != hipSuccess) { grid = -1; return; }
        (void)hipGetLastError();
        if (n_in != 17 || ws_size < WS_END) { fprintf(stderr, "kernel_launch: needs 17 inputs and %zu bytes of workspace (got %d, %zu)\n", (size_t)WS_END, n_in, ws_size); grid = -1; return; }
        grid = cus;
    }
    if (grid < 0) return;
    if (hipMemsetAsync((unsigned char*)d_ws + WS_CTL, 0, CTL_ZERO_BYTES, stream) != hipSuccess) return;
    Args a{};
    for (int i = 0; i < 17; ++i) a.in[i] = (const float*)d_in[i];
    a.out = (float*)d_out; a.ws = (unsigned char*)d_ws; a.ph_lo = 0; a.ph_hi = 10;
    hipLaunchKernelGGL(mk_fwd, dim3(grid), dim3(NWAVES * 64), LDS_BYTES, stream, a);
}
```

```cpp
#include <hip/hip_runtime.h>
#include <cstdio>
#include <cstdint>
#include <math.h>
#ifndef D_MODEL
#define D_MODEL 1024
#define BATCH 32
#define SEQ 2048
#define DEC_BATCH 16
#define DEC_SEQ 32
#define PAST_LEN 2048
#define CHUNK 64
#define A_HEADS 4
#define A_HEAD_DIM 256
#define B_HEADS 8
#define B_HEAD_DIM 128
#define IDX_HEADS 8
#define IDX_DIM 64
#define TOPK_MAX 256
#define GROUP_B 4
#endif
#define A_WIDTH (A_HEADS * A_HEAD_DIM)
#define B_WIDTH (B_HEADS * B_HEAD_DIM)
#define C_QA 0
#define C_KA (C_QA + A_WIDTH)
#define C_VA (C_KA + A_WIDTH)
#define C_OA (C_VA + A_WIDTH)
#define C_ZA (C_OA + A_WIDTH)
#define C_IA (C_ZA + A_WIDTH)
#define C_FA (C_IA + A_HEADS)
#define C_QB (C_FA + A_HEADS)
#define C_KB (C_QB + B_WIDTH)
#define C_VB (C_KB + B_WIDTH)
#define C_ZB (C_VB + B_WIDTH)
#define C_QI (C_ZB + B_WIDTH)
#define C_KI (C_QI + IDX_HEADS * IDX_DIM)
#define C_WI (C_KI + IDX_DIM)
#define C_GA (C_WI + IDX_HEADS)
#define C_GB (C_GA + D_MODEL)
#define IN_COLS (C_GB + D_MODEL)
#define LN_EPS 1e-5f
#define HEAD_NORM_EPS 1e-6f
#define DN_ALPHA 1.189207115002721f


#define GAS __attribute__((address_space(1)))
#define LAS __attribute__((address_space(3)))
typedef unsigned short bf16;
typedef unsigned v4u __attribute__((ext_vector_type(4)));
typedef float f32x4 __attribute__((ext_vector_type(4)));
typedef short bf16x8 __attribute__((ext_vector_type(8)));
typedef GAS unsigned gu32;
typedef GAS unsigned long long gu64;
#define RLX_AGENT __ATOMIC_RELAXED, __HIP_MEMORY_SCOPE_AGENT
#define LDS_WAIT() asm volatile("s_waitcnt lgkmcnt(0)" ::: "memory")
#define VM_WAIT() asm volatile("s_waitcnt vmcnt(0)" ::: "memory")
__device__ __forceinline__ unsigned long long rt() { return __builtin_amdgcn_s_memrealtime(); }
__device__ __forceinline__ unsigned f2bf(float f) { unsigned u = __builtin_bit_cast(unsigned, f); return (u + 0x7fffu + ((u >> 16) & 1u)) >> 16; }
__device__ __forceinline__ unsigned pk2(float lo, float hi) { return f2bf(lo) | (f2bf(hi) << 16); }

#define XB_TMO      128
#define XB_XCNT(j)  (256  + 64 * (j))
#define XB_XSUB(j)  (1280 + 64 * (j))
#define XB_XGEN(j)  (2304 + 64 * (j))
#define XB_TOP      3328
#define XB_TOPGEN   3392
#define XCD_BAR_WORDS 3456
#define XB_SPIN_CAP (1u << 18)

__device__ __forceinline__ unsigned xb_ld(unsigned* p)              { return __hip_atomic_load(p, __ATOMIC_RELAXED, __HIP_MEMORY_SCOPE_AGENT); }
__device__ __forceinline__ unsigned xb_add(unsigned* p, unsigned v) { return __hip_atomic_fetch_add(p, v, __ATOMIC_RELAXED, __HIP_MEMORY_SCOPE_AGENT); }
__device__ __forceinline__ unsigned xb_xcc_id() { return (unsigned)__builtin_amdgcn_s_getreg((3 << 11) | 20) & 0xFu; }
#define XB_SPIN(cond, bar) do { unsigned _sp = 0; while (cond) { __builtin_amdgcn_s_sleep(1); \
    if ((++_sp & 255u) == 0u) { if (xb_ld(&(bar)[XB_TMO])) break; if (_sp > XB_SPIN_CAP) { atomicAdd(&(bar)[XB_TMO], 1u); break; } } } } while (0)

struct XcdBarrier {
    unsigned* bar; unsigned x;
    volatile LAS unsigned* st;
};

__device__ __forceinline__ XcdBarrier xcd_barrier_post(unsigned* bar, volatile LAS unsigned* st) {
    XcdBarrier b; b.bar = bar; b.x = xb_xcc_id(); b.st = st;
    if (threadIdx.x == 0) (void)xb_add(&bar[XB_XCNT(b.x)], 1u);
    return b;
}
__device__ __forceinline__ void xcd_barrier_complete(unsigned* bar, unsigned x, unsigned& nloc, unsigned& nx) {
    const unsigned G = gridDim.x * gridDim.y * gridDim.z;
    unsigned sum, cnt, mine, sp = 0u;
    for (;;) {
        sum = 0u; cnt = 0u; mine = 0u;
#pragma unroll
        for (unsigned j = 0; j < 16; ++j) { const unsigned c = xb_ld(&bar[XB_XCNT(j)]); sum += c; cnt += (c > 0u) ? 1u : 0u; mine = (j == x) ? c : mine; }
        if (sum == G) break;
        __builtin_amdgcn_s_sleep(1);
        if ((++sp & 255u) == 0u) { if (xb_ld(&bar[XB_TMO])) break; if (sp > XB_SPIN_CAP) { atomicAdd(&bar[XB_TMO], 1u); break; } }
    }
    nloc = mine > 0u ? mine : 1u; nx = cnt > 0u ? cnt : 1u;
}

__device__ __forceinline__ void xcd_barrier(const XcdBarrier& b) {
    asm volatile("s_waitcnt vmcnt(0)" ::: "memory");
    __syncthreads();
    if (threadIdx.x == 0) {
        unsigned* bar = b.bar;
        __builtin_amdgcn_s_waitcnt(0);
        unsigned nloc = b.st[0], nx = b.st[1];
        if (nloc == 0u) { xcd_barrier_complete(bar, b.x, nloc, nx); b.st[0] = nloc; b.st[1] = nx; }
        const unsigned old = xb_add(&bar[XB_XSUB(b.x)], 1u);
        const unsigned gen = old / nloc;
        if (old + 1u == (gen + 1u) * nloc) {
            __builtin_amdgcn_fence(__ATOMIC_RELEASE, "agent");
            asm volatile("s_waitcnt vmcnt(0)" ::: "memory");
            const unsigned og = xb_add(&bar[XB_TOP], 1u);
            const unsigned tg = og / nx;
            if (og + 1u == (tg + 1u) * nx) xb_add(&bar[XB_TOPGEN], 1u);
            else XB_SPIN(xb_ld(&bar[XB_TOPGEN]) == tg, bar);
            __builtin_amdgcn_fence(__ATOMIC_ACQUIRE, "agent");
            xb_add(&bar[XB_XGEN(b.x)], 1u);
            asm volatile("s_waitcnt vmcnt(0)" ::: "memory");
        } else {
            XB_SPIN(xb_ld(&bar[XB_XGEN(b.x)]) == gen, bar);
            __builtin_amdgcn_fence(__ATOMIC_ACQUIRE, "agent");
            asm volatile("s_waitcnt vmcnt(0)" ::: "memory");
        }
    }
    __syncthreads();
}

namespace pg8 {
#define PG8_LAS __attribute__((address_space(3)))
typedef unsigned short bf16_t;
typedef short bf16x8 __attribute__((ext_vector_type(8)));
typedef float f32x4 __attribute__((ext_vector_type(4)));
typedef unsigned u32x4 __attribute__((ext_vector_type(4)));
constexpr int BM = 256, BK = 64, HALF = 128, HTB = HALF * BK * 2  , STAGE_BYTES = 8 * HTB, NXCD = 8, WGM = 8;

__host__ __device__ __forceinline__ int lds_byte(int r, int c) { const int st = (r >> 4) * 2 + (c >> 5), rr = r & 15, cc = c & 31, ob = rr * 64 + cc * 2; return st * 1024 + (ob ^ (((ob >> 9) & 1) << 5)); }
__host__ __device__ __forceinline__ void stage_rc(int b, int& R, int& C) { const int st = b / 1024, sb = b % 1024, swz = sb ^ (((sb >> 9) & 1) << 5); R = (st >> 1) * 16 + swz / 64; C = (st & 1) * 32 + (swz % 64) / 2; }
__host__ __device__ __forceinline__ int perm32(int rho) { const int n = rho >> 4, i = rho & 15; return 8 * (i >> 2) + 4 * n + (i & 3); }

struct Unit { int pm, pn; };
struct Gemm { const bf16_t* A; const bf16_t* Bt; int M, N, K; };

struct StaticOrder {
    int nM, nN, nwg, G, c;
    __host__ __device__ void init(int M, int N, int G_, int c_) { nM = M / BM; nN = N / BM; nwg = nM * nN; G = G_; c = c_; }
    __host__ __device__ bool next(int i, Unit& u) const {
        const long L = (long)i * G + c; if (L >= nwg) return false;
        int wgid = (int)L; { const int q = nwg / NXCD, r = nwg % NXCD, xcd = wgid % NXCD, off = wgid / NXCD; wgid = (xcd < r ? xcd * (q + 1) : r * (q + 1) + (xcd - r) * q) + off; }
        const int nig = WGM * nN, gid = wgid / nig, fm = gid * WGM, gsz = (nM - fm) < WGM ? (nM - fm) : WGM;
        u.pm = fm + ((wgid % nig) % gsz); u.pn = (wgid % nig) / gsz; return true;
    }
    __device__ __forceinline__ void a_ready(const Unit&) const {}
    __device__ __forceinline__ void done(const Unit&) const {}
};
__device__ __forceinline__ unsigned cvt_pk_bf16(float lo, float hi) { unsigned r; asm volatile("v_cvt_pk_bf16_f32 %0, %1, %2" : "=v"(r) : "v"(lo), "v"(hi)); return r; }
typedef float f32x2 __attribute__((ext_vector_type(2)));
template <class Epi, class Sched, bool ALIGN_EPI = false, bool SP2 = false>
__device__ __forceinline__ void gemm_phase(PG8_LAS unsigned char* lds, const Gemm g, const Sched& S, const Epi& E) {
    const int tid = threadIdx.x, wid = __builtin_amdgcn_readfirstlane(tid >> 6), lane = tid & 63, wr = wid >> 2, wc = wid & 3, fr = lane & 15, fq = lane >> 4;
    const int K = g.K, nt = K / BK;
    unsigned voffA[2], voffB[2];
#pragma unroll
    for (int i = 0; i < 2; ++i) { int R, C; stage_rc(tid * 16 + i * 8192, R, C); const int Rb = Epi::PERM ? ((R & ~31) + perm32(R & 31)) : R;
        voffA[i] = (unsigned)(R * K + C) * 2u; voffB[i] = (unsigned)(Rb * K + C) * 2u; }
    const size_t kstep = (size_t)(BK * 2);
    const size_t hstep = (size_t)HALF * K * 2;
    const size_t tstep = 2 * hstep;
    const unsigned ldsw = (unsigned)wid * 1024u;
    const int aoff = lds_byte(wr * 64 + fr, fq * 8), boff = lds_byte(wc * 32 + fr, fq * 8);
#define PG8_SA(b, h) (((b) * 2 + (h)) * HTB)
#define PG8_SB(b, h) ((4 + (b) * 2 + (h)) * HTB)
#define PG8_STAGE(bufoff, gbase, voff) do { _Pragma("unroll") for (int _i = 0; _i < 2; ++_i) \
        __builtin_amdgcn_global_load_lds((const unsigned*)((const char*)(gbase) + (voff)[_i]), (PG8_LAS unsigned*)(lds + (bufoff) + ldsw + _i * 8192), 16, 0, 0); } while (0)
#define PG8_LDA(dst, b, h) do { _Pragma("unroll") for (int m = 0; m < 4; ++m) _Pragma("unroll") for (int k = 0; k < 2; ++k) dst[m][k] = *(const PG8_LAS bf16x8*)(lds + PG8_SA(b, h) + aoff + m * 2048 + k * 1024); } while (0)
#define PG8_LDB(dst, b, h) do { _Pragma("unroll") for (int n = 0; n < 2; ++n) _Pragma("unroll") for (int k = 0; k < 2; ++k) dst[n][k] = *(const PG8_LAS bf16x8*)(lds + PG8_SB(b, h) + boff + n * 2048 + k * 1024); } while (0)
#define PG8_MMA(ai, bj, At, Bt) do { __builtin_amdgcn_s_setprio(1); _Pragma("unroll") for (int m = 0; m < 4; ++m) _Pragma("unroll") for (int n = 0; n < 2; ++n) _Pragma("unroll") for (int k = 0; k < 2; ++k) \
        acc[ai][bj][m][n] = __builtin_amdgcn_mfma_f32_16x16x32_bf16(Bt[n][k], At[m][k], acc[ai][bj][m][n], 0, 0, 0); __builtin_amdgcn_s_setprio(0); } while (0)
#define PG8_WAIT_V(n) asm volatile("s_waitcnt vmcnt(" #n ")" ::: "memory")
#define PG8_WAIT_L(n) asm volatile("s_waitcnt lgkmcnt(" #n ")" ::: "memory")
#define PG8_BAR __builtin_amdgcn_s_barrier()
#define PG8_SCHED __builtin_amdgcn_sched_barrier(0)
    Unit cur, nxt; int ui = 0;
    if (!S.next(0, cur)) return;
    f32x4 acc[2][2][4][2];
#pragma unroll
    for (int a = 0; a < 2; ++a)
#pragma unroll
        for (int b = 0; b < 2; ++b)
#pragma unroll
            for (int m = 0; m < 4; ++m)
#pragma unroll
                for (int n = 0; n < 2; ++n) acc[a][b][m][n] = (f32x4){0.f, 0.f, 0.f, 0.f};
    bf16x8 At[4][2], B0[2][2], B1[2][2];
    const char* cA = (const char*)g.A + (size_t)cur.pm * tstep; const char* cB = (const char*)g.Bt + (size_t)cur.pn * tstep;
    S.a_ready(cur);
    if constexpr (SP2) {
        PG8_STAGE(PG8_SB(0, 0), cB, voffB); PG8_STAGE(PG8_SB(0, 1), cB + hstep, voffB); PG8_STAGE(PG8_SA(0, 0), cA, voffA); PG8_STAGE(PG8_SA(0, 1), cA + hstep, voffA);
        if (wr == 1) PG8_BAR;
        PG8_WAIT_V(2); PG8_BAR;
        PG8_STAGE(PG8_SB(1, 0), cB + kstep, voffB); PG8_STAGE(PG8_SA(1, 0), cA + kstep, voffA); PG8_STAGE(PG8_SB(1, 1), cB + hstep + kstep, voffB);
        PG8_WAIT_V(6); PG8_BAR;
    } else {
        PG8_STAGE(PG8_SB(0, 0), cB, voffB); PG8_STAGE(PG8_SA(0, 0), cA, voffA); PG8_STAGE(PG8_SB(0, 1), cB + hstep, voffB); PG8_STAGE(PG8_SA(0, 1), cA + hstep, voffA);
        if (wr == 1) PG8_BAR;
        PG8_WAIT_V(4); PG8_BAR;
        PG8_STAGE(PG8_SB(1, 0), cB + kstep, voffB); PG8_STAGE(PG8_SA(1, 0), cA + kstep, voffA); PG8_STAGE(PG8_SB(1, 1), cB + hstep + kstep, voffB);
        PG8_WAIT_V(6); PG8_BAR;
    }
    for (;;) {
        const bool has_next = S.next(ui + 1, nxt);
        const char* nA = has_next ? (const char*)g.A + (size_t)nxt.pm * tstep : cA; const char* nB = has_next ? (const char*)g.Bt + (size_t)nxt.pn * tstep : cB;
        for (int t = 0; t < nt; t += 2) {
            const bool last = (t == nt - 2);
            const char* a1 = cA + (size_t)(t + 1) * kstep;
            const char* a2 = last ? nA : cA + (size_t)(t + 2) * kstep; const char* b2 = last ? nB : cB + (size_t)(t + 2) * kstep;
            const char* a3 = a2 + kstep; const char* b3 = b2 + kstep;
            if (last && has_next) S.a_ready(nxt);
            if constexpr (Epi::MIDK) { if (t == nt / 2) E.mid(acc, cur, wr, wc, fr, fq); }
            if constexpr (SP2) {
            PG8_LDB(B0, 0, 0); PG8_LDB(B1, 0, 1); PG8_SCHED; PG8_LDA(At, 0, 0); PG8_STAGE(PG8_SA(1, 1), a1 + hstep, voffA);
            PG8_WAIT_V(8); PG8_WAIT_L(0); PG8_BAR; PG8_MMA(0, 0, At, B0); PG8_MMA(0, 1, At, B1); PG8_BAR; PG8_SCHED;
            PG8_LDA(At, 0, 1); PG8_STAGE(PG8_SB(0, 0), b2, voffB); PG8_STAGE(PG8_SB(0, 1), b2 + hstep, voffB); PG8_STAGE(PG8_SA(0, 0), a2, voffA);
            PG8_WAIT_V(8); PG8_WAIT_L(0); PG8_BAR; PG8_MMA(1, 0, At, B0); PG8_MMA(1, 1, At, B1); PG8_BAR; PG8_SCHED;
            PG8_LDB(B0, 1, 0); PG8_LDB(B1, 1, 1); PG8_SCHED; PG8_LDA(At, 1, 0); PG8_STAGE(PG8_SA(0, 1), a2 + hstep, voffA);
            PG8_WAIT_V(8); PG8_WAIT_L(0); PG8_BAR; PG8_MMA(0, 0, At, B0); PG8_MMA(0, 1, At, B1); PG8_BAR; PG8_SCHED;
            PG8_LDA(At, 1, 1); PG8_STAGE(PG8_SB(1, 0), b3, voffB); PG8_STAGE(PG8_SB(1, 1), b3 + hstep, voffB); PG8_STAGE(PG8_SA(1, 0), a3, voffA);
            PG8_WAIT_V(8); PG8_WAIT_L(0); PG8_BAR; PG8_MMA(1, 0, At, B0); PG8_MMA(1, 1, At, B1); PG8_BAR; PG8_SCHED;
            } else {
            PG8_LDB(B0, 0, 0); PG8_SCHED; PG8_LDA(At, 0, 0); PG8_STAGE(PG8_SA(1, 1), a1 + hstep, voffA);
            PG8_WAIT_L(8); PG8_BAR; PG8_WAIT_L(0); PG8_MMA(0, 0, At, B0); PG8_BAR; PG8_SCHED;
            PG8_LDB(B1, 0, 1); PG8_STAGE(PG8_SB(0, 0), b2, voffB);
            PG8_BAR; PG8_WAIT_L(0); PG8_MMA(0, 1, At, B1); PG8_BAR;
            PG8_LDA(At, 0, 1); PG8_STAGE(PG8_SA(0, 0), a2, voffA);
            PG8_BAR; PG8_WAIT_L(0); PG8_MMA(1, 0, At, B0); PG8_BAR; PG8_SCHED;
            PG8_STAGE(PG8_SB(0, 1), b2 + hstep, voffB);
            PG8_WAIT_V(6); PG8_BAR; PG8_MMA(1, 1, At, B1); PG8_BAR;
            PG8_LDB(B0, 1, 0); PG8_SCHED; PG8_LDA(At, 1, 0); PG8_STAGE(PG8_SA(0, 1), a2 + hstep, voffA);
            PG8_WAIT_L(8); PG8_BAR; PG8_WAIT_L(0); PG8_MMA(0, 0, At, B0); PG8_BAR; PG8_SCHED;
            PG8_LDB(B1, 1, 1); PG8_STAGE(PG8_SB(1, 0), b3, voffB);
            PG8_BAR; PG8_WAIT_L(0); PG8_MMA(0, 1, At, B1); PG8_BAR;
            PG8_LDA(At, 1, 1); PG8_STAGE(PG8_SA(1, 0), a3, voffA);
            PG8_BAR; PG8_WAIT_L(0); PG8_MMA(1, 0, At, B0); PG8_BAR; PG8_SCHED;
            PG8_STAGE(PG8_SB(1, 1), b3 + hstep, voffB);
            PG8_WAIT_V(6); PG8_BAR; PG8_MMA(1, 1, At, B1); PG8_BAR;
            }
        }
        if constexpr (ALIGN_EPI) { if (wr == 0) PG8_BAR; }
        if constexpr (!Epi::AFTER_DRAIN) { E(acc, cur, wr, wc, fr, fq); S.done(cur); }
        if (!has_next) break;
#pragma unroll
        for (int a = 0; a < 2; ++a)
#pragma unroll
            for (int b = 0; b < 2; ++b)
#pragma unroll
                for (int m = 0; m < 4; ++m)
#pragma unroll
                    for (int n = 0; n < 2; ++n) acc[a][b][m][n] = (f32x4){0.f, 0.f, 0.f, 0.f};
        cur = nxt; cA = nA; cB = nB; ++ui;
        if constexpr (ALIGN_EPI) { if (wr == 1) PG8_BAR; }
    }
    PG8_WAIT_V(0);
    if constexpr (!ALIGN_EPI) { if (wr == 0) PG8_BAR; }
    PG8_BAR;
    if constexpr (Epi::AFTER_DRAIN) { E.fused(acc, cur, wr, wc, fr, fq, lds, wid, lane); S.done(cur); }
#undef PG8_SA
#undef PG8_SB
#undef PG8_STAGE
#undef PG8_LDA
#undef PG8_LDB
#undef PG8_MMA
#undef PG8_WAIT_V
#undef PG8_WAIT_L
#undef PG8_BAR
#undef PG8_SCHED
}
}

namespace at2 {
constexpr float SCALE = 0.08838834764831845f;
constexpr float THR = 8.f;
constexpr int NW = 8, QBLK = 32, KVBLK = 64, QB = NW * QBLK, D = 128, PITCH = 1024;
constexpr int SHM_V = KVBLK * D * 2, SHM_K = KVBLK * D * 2;
constexpr int BT_OFF = 2 * SHM_V + 2 * SHM_K + NW * 64 * 4;
constexpr int LDS_BYTES = BT_OFF + 320 * 4;
typedef short bf16x8 __attribute__((ext_vector_type(8)));
typedef short s16x4 __attribute__((ext_vector_type(4)));
typedef float f32x16 __attribute__((ext_vector_type(16)));
typedef float f32x4 __attribute__((ext_vector_type(4)));
typedef unsigned u32x4 __attribute__((ext_vector_type(4)));
typedef unsigned short bf16;

#define KSWZ(row, colB) ((row) * 256 + ((colB) ^ (((row) & 7) << 4)))
#define SBAR() __builtin_amdgcn_sched_barrier(0)
__device__ __forceinline__ int v_st(int k, int c) { const int kk = (k & ~0xC) | ((k & 4) << 1) | ((k & 8) >> 1); return ((kk >> 3) * 4 + (c >> 5)) * 512 + ((kk & 7) * 32 + (c & 31)) * 2; }
__device__ __forceinline__ int v_rd_base(int lane) { return ((lane & 3) << 3) | (((lane >> 2) & 3) << 6) | (((lane >> 4) & 1) << 5) | (((lane >> 5) & 1) << 8); }
constexpr int v_rd_off(int d0, int ks, int half) { return d0 * 512 + ks * 4096 + half * 2048; }
__device__ __forceinline__ int crow(int r, int hi) { return (r & 3) + 8 * (r >> 2) + 4 * hi; }
__device__ __forceinline__ unsigned cvtpk(float lo, float hi) { unsigned r; asm volatile("v_cvt_pk_bf16_f32 %0, %1, %2" : "=v"(r) : "v"(lo), "v"(hi)); return r; }
__device__ __forceinline__ bf16x8 load8(const bf16* p) { return *reinterpret_cast<const bf16x8*>(p); }

typedef __attribute__((address_space(3))) const float* lds_cf32;
__device__ __forceinline__ unsigned mask_compact(unsigned long long mw, int hi) { return ((unsigned)(mw >> (4 * hi)) & 0x0f0f0f0fu) | (((unsigned)(mw >> (32 + 4 * hi)) & 0x0f0f0f0fu) << 4); }
__device__ __forceinline__ void mask_bias(f32x16& p0, f32x16& p1, unsigned mwc, lds_cf32 bt, int idx0, bool far, float cfar, int hi) {
    const float NEG = -__builtin_inff();
    const unsigned w0 = mwc, w1 = mwc >> 4;
    if (far) {
#pragma unroll
        for (int r = 0; r < 16; ++r) { const int c = (r & 3) + 8 * (r >> 2);
            p0[r] = ((w0 >> c) & 1u) ? p0[r] + cfar : NEG; p1[r] = ((w1 >> c) & 1u) ? p1[r] + cfar : NEG; }
    } else { lds_cf32 b = bt + idx0;
#pragma unroll
        for (int r = 0; r < 16; ++r) { const int c = (r & 3) + 8 * (r >> 2);
            p0[r] = ((w0 >> c) & 1u) ? p0[r] + b[c] : NEG; p1[r] = ((w1 >> c) & 1u) ? p1[r] + b[c + 32] : NEG;
            if ((r & 3) == 3) asm volatile("" ::: "memory"); }
    }
}
__device__ __forceinline__ void partialSM(f32x16& p0, f32x16& p1, float& m_reg, float& mn, float& alpha) {
    float pmax = p0[0]; for (int r = 1; r < 16; ++r) pmax = fmaxf(pmax, p0[r]); for (int r = 0; r < 16; ++r) pmax = fmaxf(pmax, p1[r]);
    { auto rr = __builtin_amdgcn_permlane32_swap(__float_as_uint(pmax), __float_as_uint(pmax), false, false);
      pmax = fmaxf(__uint_as_float(rr[0]), __uint_as_float(rr[1])); }
    constexpr float C2 = 1.4426950408889634f * SCALE;
    if (__builtin_expect(__all((pmax - m_reg) * SCALE <= THR), 1)) { mn = m_reg; alpha = 1.f; }
    else { mn = fmaxf(m_reg, pmax); alpha = __builtin_amdgcn_exp2f((m_reg - mn) * C2); m_reg = mn; }
    const float mnL = -mn * C2;
    for (int r = 0; r < 16; ++r) p0[r] = fmaf(p0[r], C2, mnL); for (int r = 0; r < 16; ++r) p1[r] = fmaf(p1[r], C2, mnL);
    for (int r = 0; r < 16; ++r) p0[r] = __builtin_amdgcn_exp2f(p0[r]);
}
__device__ __forceinline__ void finishSM(f32x16& p0, f32x16& p1, float alpha, float& l_reg, bf16x8& pa0, bf16x8& pa1, bf16x8& pa2, bf16x8& pa3) {
    for (int r = 0; r < 16; ++r) p1[r] = __builtin_amdgcn_exp2f(p1[r]);
    float ps = 0; for (int r = 0; r < 16; ++r) ps += p0[r]; for (int r = 0; r < 16; ++r) ps += p1[r];
    { auto rr = __builtin_amdgcn_permlane32_swap(__float_as_uint(ps), __float_as_uint(ps), false, false);
      ps = __uint_as_float(rr[0]) + __uint_as_float(rr[1]); }
    l_reg = l_reg * alpha + ps;
#define PK4(P, B_, OUT) do { unsigned a0 = cvtpk(P[B_+0], P[B_+1]), a1 = cvtpk(P[B_+2], P[B_+3]);                          \
        unsigned b0 = cvtpk(P[B_+4], P[B_+5]), b1 = cvtpk(P[B_+6], P[B_+7]);                                             \
        auto r0 = __builtin_amdgcn_permlane32_swap(a0, b0, false, false); auto r1 = __builtin_amdgcn_permlane32_swap(a1, b1, false, false); \
        u32x4 w = {r0[0], r1[0], r0[1], r1[1]}; OUT = *reinterpret_cast<bf16x8*>(&w); } while (0)
    PK4(p0, 0, pa0); PK4(p0, 8, pa1); PK4(p1, 0, pa2); PK4(p1, 8, pa3);
#undef PK4
}
template <int KB, bool SK>
__device__ __forceinline__ void qkt(f32x16& p0, f32x16& p1, const char* K_lds, int r32, int hi, const bf16x8* qr, bool act) {
    if (SK && !act) { const float NEG = -__builtin_inff();
#pragma unroll
        for (int r = 0; r < 16; ++r) { p0[r] = NEG; p1[r] = NEG; } return; }
    p0 = f32x16{}; p1 = f32x16{};
    int r32_ = r32, hi_ = hi; asm volatile("" : "+v"(r32_), "+v"(hi_));
    const char* kb[4];
#pragma unroll
    for (int dd = 0; dd < 4; ++dd) kb[dd] = K_lds + KB * SHM_K + KSWZ(r32_, (dd * 16 + hi_ * 8) * 2);
#pragma unroll
    for (int d0 = 0; d0 < 8; ++d0) { const char* a = kb[d0 & 3] + (d0 >> 2) * 128;
        bf16x8 b0 = *reinterpret_cast<const bf16x8*>(a);
        bf16x8 b1 = *reinterpret_cast<const bf16x8*>(a + 32 * 256);
        p0 = __builtin_amdgcn_mfma_f32_32x32x16_bf16(b0, qr[d0], p0, 0, 0, 0);
        p1 = __builtin_amdgcn_mfma_f32_32x32x16_bf16(b1, qr[d0], p1, 0, 0, 0); }
}
template <int VB, bool SK>
__device__ __forceinline__ void pv_tile(f32x16* o, int vb0, bf16x8 pa0, bf16x8 pa1, bf16x8 pa2, bf16x8 pa3, bool act) {
    if (SK && !act) return;
#define TRRD(dst, off) asm volatile("ds_read_b64_tr_b16 %0, %1 offset:%2" : "=&v"(dst) : "v"(vb0), "i"(off) : "memory")
#define PV_D0(d0) do { s16x4 l0, l1, l2, l3, h0, h1, h2, h3; constexpr int b_ = VB * SHM_V + v_rd_off(d0, 0, 0); \
        TRRD(l0, b_); TRRD(h0, b_ + 2048); TRRD(l1, b_ + 4096); TRRD(h1, b_ + 6144); TRRD(l2, b_ + 8192); TRRD(h2, b_ + 10240); TRRD(l3, b_ + 12288); TRRD(h3, b_ + 14336); \
        asm volatile("s_waitcnt lgkmcnt(0)" ::: "memory"); SBAR();   \
        o[d0] = __builtin_amdgcn_mfma_f32_32x32x16_bf16(pa0, (bf16x8){l0[0], l0[1], l0[2], l0[3], h0[0], h0[1], h0[2], h0[3]}, o[d0], 0, 0, 0);   \
        o[d0] = __builtin_amdgcn_mfma_f32_32x32x16_bf16(pa1, (bf16x8){l1[0], l1[1], l1[2], l1[3], h1[0], h1[1], h1[2], h1[3]}, o[d0], 0, 0, 0);   \
        o[d0] = __builtin_amdgcn_mfma_f32_32x32x16_bf16(pa2, (bf16x8){l2[0], l2[1], l2[2], l2[3], h2[0], h2[1], h2[2], h2[3]}, o[d0], 0, 0, 0);   \
        o[d0] = __builtin_amdgcn_mfma_f32_32x32x16_bf16(pa3, (bf16x8){l3[0], l3[1], l3[2], l3[3], h3[0], h3[1], h3[2], h3[3]}, o[d0], 0, 0, 0); } while (0)
    PV_D0(0); PV_D0(1); PV_D0(2); PV_D0(3);
#undef PV_D0
#undef TRRD
}

struct Ctx { __amdgpu_buffer_rsrc_t Q, K, V, M, O; };
typedef unsigned v4u32 __attribute__((ext_vector_type(4))); typedef unsigned v2u32 __attribute__((ext_vector_type(2)));
#define LD16(rs, vo, so) __builtin_bit_cast(bf16x8, __builtin_amdgcn_raw_buffer_load_b128((rs), (int)(vo), (int)(so), 0))
struct Seam { bf16x8 qr[8]; bf16x8 st_v0, st_v1, st_k0, st_k1; };
#define VMW() asm volatile("s_waitcnt vmcnt(0)" ::: "memory")
#define VMWN(n) asm volatile("s_waitcnt vmcnt(%0)" :: "i"(n) : "memory")
#define SLOAD_H(k0) do { S.st_v0 = LD16(C.V, kvoff, (k0) * (PITCH * 2)); S.st_v1 = LD16(C.V, kvoff, ((k0) + 32) * (PITCH * 2));              \
                         S.st_k0 = LD16(C.K, kvoff, (k0) * (PITCH * 2)); S.st_k1 = LD16(C.K, kvoff, ((k0) + 32) * (PITCH * 2)); } while (0)
#define SW_TID int t_ = threadIdx.x; asm volatile("" : "+v"(t_)); const int sr_ = t_ >> 4, sc_ = (t_ & 15) * 8
#define SWRITE_HK(bf) do { SW_TID; const int kws_ = KSWZ(sr_, sc_ * 2); *(bf16x8*)(K_lds + (bf) * SHM_K + kws_) = S.st_k0; *(bf16x8*)(K_lds + (bf) * SHM_K + kws_ + 32 * 256) = S.st_k1; } while (0)
#define SWRITE_HV(bf) do { SW_TID; *(bf16x8*)(V_lds + (bf) * SHM_V + v_st(sr_, sc_)) = S.st_v0; *(bf16x8*)(V_lds + (bf) * SHM_V + v_st(32 + sr_, sc_)) = S.st_v1; } while (0)
#define SWRITE_H(bf) do { SWRITE_HV(bf); SWRITE_HK(bf); } while (0)
__device__ __forceinline__ void dsa_prime(const Ctx& C, int P0, char* lds, Seam& S) {
    int tid = threadIdx.x; asm volatile("" : "+v"(tid));
    const int wid = __builtin_amdgcn_readfirstlane(tid >> 6), lane = tid & 63, r32 = lane & 31, hi = lane >> 5;
    const int sr = tid >> 4, sc = (tid & 15) * 8; char* K_lds = lds + 2 * SHM_V;
    const unsigned kvoff = (unsigned)(sr * PITCH + sc) * 2u, qoff = (unsigned)((wid * QBLK + r32) * PITCH + hi * 8) * 2u;
    for (int d0 = 0; d0 < 8; ++d0) S.qr[d0] = LD16(C.Q, qoff + d0 * 32, P0 * (PITCH * 2));
    SLOAD_H(0); VMW(); SWRITE_HK(0);
    __syncthreads();
}
__device__ __forceinline__ void dsa_block(const Ctx& C, int P0, int P0n, char* lds, Seam& S, float cfar) {
    int tid = threadIdx.x; asm volatile("" : "+v"(tid));
    const int wid = __builtin_amdgcn_readfirstlane(tid >> 6), lane = tid & 63, r32 = lane & 31, hi = lane >> 5;
    const int NT = P0 / KVBLK + QB / KVBLK;
    const int qlo = P0 + wid * QBLK;
    const int limw = ((qlo >> 6) + 1) * 64;
    char* V_lds = lds; char* K_lds = lds + 2 * SHM_V;
    float* wsc = (float*)(lds + 2 * SHM_V + 2 * SHM_K) + wid * 64; float* li_l = wsc, * al_l = wsc + 32;
    lds_cf32 bt = (lds_cf32)((__attribute__((address_space(3))) char*)lds + BT_OFF);
    float m_reg = -1e30f, l_reg = 0; f32x16 o[4] = {};
    const int sr = tid >> 4, sc = (tid & 15) * 8;
    const int vb0 = (int)(uintptr_t)V_lds + v_rd_base(lane);
    const unsigned kvoff = (unsigned)(sr * PITCH + sc) * 2u, qoff = (unsigned)((wid * QBLK + r32) * PITCH + hi * 8) * 2u, moff = (unsigned)((wid * QBLK + r32) * 32) * 8u;
#define MROW(t) mask_compact(__builtin_bit_cast(unsigned long long, __builtin_amdgcn_raw_buffer_load_b64(C.M, (int)moff, (P0 * 32 + (t)) * 8, 0)), hi)
    const int rel0 = 256 + 4 * hi - (qlo + r32);
#define RESC(a) do { if (__any((a) < 1.f)) { if (hi == 0) al_l[r32] = (a); asm volatile("s_waitcnt lgkmcnt(0)" ::: "memory");              \
                     for (int d_ = 0; d_ < 4; ++d_) for (int r = 0; r < 16; ++r) o[d_][r] *= al_l[crow(r, hi)]; } } while (0)
#define KBASE(t) ((t) * KVBLK)
#define ACT(t) (KBASE(t) < limw)
#define MASKT(P0_, P1_, mw_, t) do { const int kb_ = KBASE(t); if (ACT(t)) mask_bias(P0_, P1_, mw_, bt, kb_ + rel0, kb_ + KVBLK - 1 - qlo <= -128, cfar, hi); } while (0)
    constexpr int NQL = 8; constexpr bool SK = true;
#define SEAM_K0() do { VMWN(NQL); SWRITE_HK(0); SBAR(); } while (0)
    f32x16 pA0, pA1, pB0, pB1; float mnA, mnB, alA, alB; bf16x8 pa0, pa1, pa2, pa3; unsigned mw;
    SWRITE_HV(0); SBAR();
    if (NT > 1) SLOAD_H(KBASE(1));
    mw = MROW(0);
    SBAR(); qkt<0, SK>(pA0, pA1, K_lds, r32, hi, S.qr, ACT(0));
    MASKT(pA0, pA1, mw, 0); partialSM(pA0, pA1, m_reg, mnA, alA);
    if (NT > 1) { VMW(); SWRITE_H(1); }
    __syncthreads();
#define HALF_STEP(PX0, PX1, mnX, alX, PY0, PY1, alY, t, KB, VB, SB) do {                                                      \
        SBAR(); mw = MROW(t); qkt<KB, SK>(PX0, PX1, K_lds, r32, hi, S.qr, ACT(t));                                          \
        finishSM(PY0, PY1, alY, l_reg, pa0, pa1, pa2, pa3); SBAR();                                                           \
        if ((t) + 1 < NT) { SLOAD_H(KBASE((t) + 1)); SBAR(); }                                                        \
        pv_tile<VB, SK>(o, vb0, pa0, pa1, pa2, pa3, ACT((t) - 1)); MASKT(PX0, PX1, mw, (t)); partialSM(PX0, PX1, m_reg, mnX, alX); \
        __syncthreads();                                                                                                      \
        if ((t) + 1 < NT) { VMW(); SWRITE_H(SB); }                                                                            \
        RESC(alX); __syncthreads(); } while (0)
    for (int t = 1; t + 1 < NT; t += 2) {
        HALF_STEP(pB0, pB1, mnB, alB, pA0, pA1, alA, t, 1, 0, 0);
        HALF_STEP(pA0, pA1, mnA, alA, pB0, pB1, alB, t + 1, 0, 1, 1);
    }
    const bool even = (NT & 1) == 0;
    if (even) { SBAR(); mw = MROW(NT - 1); qkt<1, SK>(pB0, pB1, K_lds, r32, hi, S.qr, ACT(NT - 1)); SBAR(); }
    SLOAD_H(0); SBAR();
#pragma unroll
    for (int d0 = 0; d0 < 8; ++d0) S.qr[d0] = LD16(C.Q, qoff + d0 * 32, P0n * (PITCH * 2));
    SBAR();
    finishSM(pA0, pA1, alA, l_reg, pa0, pa1, pa2, pa3); SBAR();
    pv_tile<0, SK>(o, vb0, pa0, pa1, pa2, pa3, ACT(even ? NT - 2 : NT - 1));
    if (even) { MASKT(pB0, pB1, mw, NT - 1); partialSM(pB0, pB1, m_reg, mnB, alB); __syncthreads(); RESC(alB);
        finishSM(pB0, pB1, alB, l_reg, pa0, pa1, pa2, pa3); SBAR(); pv_tile<1, SK>(o, vb0, pa0, pa1, pa2, pa3, ACT(NT - 1)); }
    SBAR(); SEAM_K0();
    if (hi == 0) li_l[r32] = l_reg; asm volatile("s_waitcnt lgkmcnt(0)" ::: "memory");
    float rli[16];
#pragma unroll
    for (int r = 0; r < 16; ++r) rli[r] = __builtin_amdgcn_rcpf(li_l[crow(r, hi)]);
    const unsigned ooff = (unsigned)((wid * QBLK + 4 * hi) * PITCH + r32) * 2u;
#pragma unroll
    for (int r = 0; r < 16; ++r) { const int so = (P0 + (r & 3) + 8 * (r >> 2)) * (PITCH * 2);
#pragma unroll
        for (int d0 = 0; d0 < 4; ++d0) { const float v = o[d0][r] * rli[r];
            const float vn = __shfl_xor(v, 1);
            if ((r32 & 1) == 0) __builtin_amdgcn_raw_buffer_store_b32(cvtpk(v, vn), C.O, (int)(ooff + d0 * 64), so, 0); } }
    __syncthreads();
#undef RESC
#undef MROW
#undef KBASE
#undef ACT
#undef MASKT
#undef SEAM_K0
#undef HALF_STEP
}
#undef VMW
#undef VMWN
#undef SLOAD_H
#undef SWRITE_HK
#undef SWRITE_HV
#undef SWRITE_H
#undef SW_TID
#undef KSWZ
#undef SBAR
}

constexpr int NWAVES = 8;
constexpr int NTP = BATCH * SEQ, NTS = DEC_BATCH * DEC_SEQ, NTOK = NTP + NTS;
constexpr int NPM = NTOK / 256;
constexpr int N_MIX = 27 * 256, N_M1A = 12 * 256, N_M1B = 8 * 256;
static_assert(NTP % 256 == 0 && NTS % 256 == 0 && D_MODEL == 1024 && A_WIDTH == 1024 && B_WIDTH == 1024, "geometry");

constexpr size_t MiB = 1u << 20;
constexpr size_t WS_CTL = 0, CTL_ZERO_BYTES = 1 * MiB;
constexpr size_t WS_WMIX = 1 * MiB;
constexpr size_t WS_WMRG = WS_WMIX + 14 * MiB;
constexpr size_t WS_WAB  = WS_WMRG + 10 * MiB;
constexpr size_t WS_WO   = WS_WAB + 4 * MiB;
constexpr size_t WS_XB   = WS_WO + 2 * MiB;
constexpr size_t ROWBUF  = (size_t)NTOK * 1024 * 2;
constexpr size_t WS_QA   = WS_XB + ROWBUF;
constexpr size_t WS_KA   = WS_QA + ROWBUF;
constexpr size_t WS_VA   = WS_KA + ROWBUF;
constexpr size_t WS_QB   = WS_VA + ROWBUF;
constexpr size_t WS_QI   = WS_QB + ROWBUF;
constexpr size_t WS_KI   = WS_QI + 65 * MiB;
constexpr size_t WS_SM   = WS_KI + 9 * MiB;
constexpr size_t WS_MASK = WS_SM + 5 * MiB;
constexpr size_t WS_HST  = WS_MASK + 16 * MiB;
constexpr size_t WS_NAIVE = WS_HST + 3 * MiB;
constexpr size_t WS_NEED = WS_NAIVE;
static_assert(WS_WMIX + (size_t)N_MIX * 1024 * 2 <= WS_WMRG && WS_QI + (size_t)NTOK * 512 * 2 <= WS_KI && WS_KI + (size_t)NTOK * 64 * 2 <= WS_SM && WS_SM + (size_t)NTOK * 64 <= WS_MASK
              && WS_HST + (size_t)NTOK * 32 <= WS_NAIVE, "d_ws map");
constexpr int CW_BAR = 4096;
constexpr int RING_OFF = 0, RING_BYTES = 131072;
constexpr int LDS_BYTES = 147456;
constexpr int LDSCTL_OFF = LDS_BYTES - 512, MISC_OFF = LDSCTL_OFF + 320;

struct Args { const float* in[17]; float* out; unsigned char* ws; int ph_lo, ph_hi; };

__device__ __forceinline__ float bf2f(bf16 v) { return __uint_as_float((unsigned)v << 16); }
__device__ __forceinline__ float sigm(float x) { return 1.0f / (1.0f + __expf(-x)); }

__device__ __forceinline__ void tr_item(const float* W, int ldw, int c0, int nv, int k0, bf16* WT, int ldt, int r0, int kofs, LAS float* scr, int lane) {
    const int n_ = lane & 31;
#pragma unroll 8
    for (int i = 0; i < 32; ++i) { const int kk = 2 * i + (lane >> 5); scr[kk * 33 + n_] = (n_ < nv) ? W[(size_t)(k0 + kk) * ldw + c0 + n_] : 0.f; }
    LDS_WAIT(); asm volatile("" ::: "memory");
    const int c = lane & 7;
#pragma unroll
    for (int j = 0; j < 4; ++j) { const int n = (lane >> 3) + 8 * j; const LAS float* s = scr + (8 * c) * 33 + n;
        v4u o; o.x = pk2(s[0 * 33], s[1 * 33]); o.y = pk2(s[2 * 33], s[3 * 33]); o.z = pk2(s[4 * 33], s[5 * 33]); o.w = pk2(s[6 * 33], s[7 * 33]);
        if (n < nv) *(GAS v4u*)(WT + (size_t)(r0 + n) * ldt + kofs + k0 + 8 * c) = o; }
    LDS_WAIT(); asm volatile("" ::: "memory");
}
struct Seg { int src, n, dst; };
__device__ __forceinline__ Seg win_seg(int s) {
    switch (s) {
        case 0: return Seg{C_QA, 1024, 0};      case 1: return Seg{C_KA, 1024, 1024};  case 2: return Seg{C_VA, 1024, 2048};
        case 3: return Seg{C_QB, 1024, 3072};   case 4: return Seg{C_KB, 1024, 4096};  case 5: return Seg{C_VB, 1024, 5120};
        case 6: return Seg{C_QI, 512, 6144};    case 7: return Seg{C_KI, 64, 6656};    case 8: return Seg{C_WI, 8, 6720};
        case 9: return Seg{C_IA, 4, 6728};      case 10: return Seg{C_FA, 4, 6732};
        case 27: return Seg{C_ZB, 1024, 2048};  case 28: return Seg{C_GA, 1024, 3072}; case 29: return Seg{C_GB, 1024, 4096};
        default: { const int j = (s - 11) >> 1; return (s & 1) ? Seg{C_OA + 128 * j, 128, 256 * j} : Seg{C_ZA + 128 * j, 128, 256 * j + 128}; }
    }
}
struct P0Args { const float *xp, *xs, *w_in, *w_out_a, *w_out_b, *w_o; bf16 *XB, *WMIX, *WMRG, *WAB, *WO; };
__device__ __forceinline__ void p0_prologue(const P0Args& a, LAS unsigned char* lds, int vcu, int G, int wave, int lane) {
    LAS float* scr = (LAS float*)(lds + RING_OFF + wave * 16384);
    const int gw = vcu * NWAVES + wave, NGW = G * NWAVES;
    int base = 0;
    for (int s = 0; s < 30; ++s) {
        const Seg sg = win_seg(s); const int nblk = (sg.n + 31) / 32, nit = nblk * 16;
        bf16* WT = s < 11 ? a.WMIX : a.WMRG;
        for (int it = gw - (base % NGW); it < nit; it += NGW) { if (it < 0) continue; const int kb = it / nblk, nb = it % nblk; const int nv = sg.n - 32 * nb < 32 ? sg.n - 32 * nb : 32;
            tr_item(a.w_in, IN_COLS, sg.src + 32 * nb, nv, 64 * kb, WT, 1024, sg.dst + 32 * nb, 0, scr, lane); }
        base += nit;
    }
    for (int i = gw * 64 + lane; i < 176 * 128; i += NGW * 64) ((GAS v4u*)(a.WMIX + (size_t)6736 * 1024))[i] = (v4u){0u, 0u, 0u, 0u};
    for (int it = gw; it < 3 * 512; it += NGW) { const int w = it / 512, r = it % 512, kb = r / 32, nb = r % 32;
        if (w == 0) tr_item(a.w_out_a, 1024, 32 * nb, 32, 64 * kb, a.WAB, 2048, 32 * nb, 0, scr, lane);
        else if (w == 1) tr_item(a.w_out_b, 1024, 32 * nb, 32, 64 * kb, a.WAB, 2048, 32 * nb, 1024, scr, lane);
        else tr_item(a.w_o, 1024, 32 * nb, 32, 64 * kb, a.WO, 1024, 32 * nb, 0, scr, lane); }
    for (int m0 = gw * 2; m0 < NTOK; m0 += NGW * 2) { f32x4 v[2][4];
#pragma unroll
        for (int q = 0; q < 2; ++q) { const int m = m0 + q; const float* xr = m < NTP ? a.xp + (size_t)m * 1024 : a.xs + (size_t)(m - NTP) * 1024; const GAS f32x4* xv = (const GAS f32x4*)xr + lane;
#pragma unroll
            for (int j = 0; j < 4; ++j) v[q][j] = xv[64 * j]; }
#pragma unroll
        for (int q = 0; q < 2; ++q) { GAS unsigned long long* o8 = (GAS unsigned long long*)(a.XB + (size_t)(m0 + q) * 1024) + lane;
#pragma unroll
            for (int j = 0; j < 4; ++j) o8[64 * j] = (unsigned long long)pk2(v[q][j].x, v[q][j].y) | ((unsigned long long)pk2(v[q][j].z, v[q][j].w) << 32); }
    }
}

namespace pg8 {
struct EpiMix {
    static constexpr bool PERM = true, AFTER_DRAIN = false, MIDK = false;
    bf16_t* QA4;
    bf16_t* KVc;
    bf16_t *QI, *KI; float* SM;
    float *okvp, *okvs;
    float *oikp, *oiks;
    __device__ __forceinline__ void mid(f32x4 (&)[2][2][4][2], const Unit&, int, int, int, int) const {}
    __device__ __forceinline__ void operator()(const f32x4 (&acc)[2][2][4][2], const Unit& u, int wr, int wc, int fr, int fq) const {
        const int pn = u.pn; const bool samp = u.pm >= NTP / 256;
        const int row0 = u.pm * BM + wr * 64 + fr, cl = wc * 32 + 8 * fq;
        if (pn < 16) {
            bf16_t* base = QA4 + (size_t)(pn >> 2) * ((size_t)NTOK * 1024); const float sc = (pn >= 4 && pn < 8) ? 0.0625f : 1.0f;
            const int col0 = (pn & 3) * 256 + cl;
#pragma unroll
            for (int ai = 0; ai < 2; ++ai)
#pragma unroll
                for (int m = 0; m < 4; ++m) { bf16_t* rowp = base + (size_t)(row0 + ai * HALF + m * 16) * 1024 + col0;
#pragma unroll
                    for (int bj = 0; bj < 2; ++bj) { const f32x4 v0 = acc[ai][bj][m][0] * sc, v1 = acc[ai][bj][m][1] * sc;
                        u32x4 w; w.x = cvt_pk_bf16(v0[0], v0[1]); w.y = cvt_pk_bf16(v0[2], v0[3]); w.z = cvt_pk_bf16(v1[0], v1[1]); w.w = cvt_pk_bf16(v1[2], v1[3]);
                        *(u32x4*)(rowp + bj * HALF) = w; } }
        } else if (pn < 24) {
            const int isV = pn >= 20 ? 1 : 0; const int col0 = (pn & 3) * 256 + cl;
            float* of = samp ? okvs + (size_t)isV * ((size_t)NTS * 1024) : okvp + (size_t)isV * ((size_t)NTP * 1024);
            bf16_t* cb = KVc + (size_t)isV * ((size_t)NTP * 1024);
#pragma unroll
            for (int ai = 0; ai < 2; ++ai)
#pragma unroll
                for (int m = 0; m < 4; ++m) { const int r = row0 + ai * HALF + m * 16; const int rr = samp ? r - NTP : r;
#pragma unroll
                    for (int bj = 0; bj < 2; ++bj) { const f32x4 v0 = acc[ai][bj][m][0], v1 = acc[ai][bj][m][1];
                        float* fp = of + (size_t)rr * 1024 + col0 + bj * HALF; *(f32x4*)fp = v0; *(f32x4*)(fp + 4) = v1;
                        if (!samp) { u32x4 w; w.x = cvt_pk_bf16(v0[0], v0[1]); w.y = cvt_pk_bf16(v0[2], v0[3]); w.z = cvt_pk_bf16(v1[0], v1[1]); w.w = cvt_pk_bf16(v1[2], v1[3]);
                            *(u32x4*)(cb + (size_t)r * 1024 + col0 + bj * HALF) = w; } } }
        } else if (pn < 26) {
            const int col0 = (pn - 24) * 256 + cl;
#pragma unroll
            for (int ai = 0; ai < 2; ++ai)
#pragma unroll
                for (int m = 0; m < 4; ++m) { bf16_t* rowp = QI + (size_t)(row0 + ai * HALF + m * 16) * 512 + col0;
#pragma unroll
                    for (int bj = 0; bj < 2; ++bj) { const f32x4 v0 = acc[ai][bj][m][0] * 0.125f, v1 = acc[ai][bj][m][1] * 0.125f;
                        u32x4 w; w.x = cvt_pk_bf16(v0[0], v0[1]); w.y = cvt_pk_bf16(v0[2], v0[3]); w.z = cvt_pk_bf16(v1[0], v1[1]); w.w = cvt_pk_bf16(v1[2], v1[3]);
                        *(u32x4*)(rowp + bj * HALF) = w; } }
        } else {
            float* oik = samp ? oiks : oikp;
#pragma unroll
            for (int ai = 0; ai < 2; ++ai)
#pragma unroll
                for (int m = 0; m < 4; ++m) { const int r = row0 + ai * HALF + m * 16; const int rr = samp ? r - NTP : r; const f32x4 v0 = acc[ai][0][m][0], v1 = acc[ai][0][m][1];
                    if (wc < 2) { float* fp = oik + (size_t)rr * 64 + cl; *(f32x4*)fp = v0; *(f32x4*)(fp + 4) = v1;
                        u32x4 w; w.x = cvt_pk_bf16(v0[0], v0[1]); w.y = cvt_pk_bf16(v0[2], v0[3]); w.z = cvt_pk_bf16(v1[0], v1[1]); w.w = cvt_pk_bf16(v1[2], v1[3]);
                        *(u32x4*)(KI + (size_t)r * 64 + cl) = w; }
                    else if (wc == 2 && fq < 2) { float* fp = SM + (size_t)r * 16 + 8 * fq; *(f32x4*)fp = v0; *(f32x4*)(fp + 4) = v1; } }
        }
    }
};
}


namespace ml {
typedef short bfx8 __attribute__((ext_vector_type(8)));
typedef short s16x4 __attribute__((ext_vector_type(4)));
typedef float f32x16 __attribute__((ext_vector_type(16)));
typedef float f32x2_t __attribute__((ext_vector_type(2))); typedef __bf16 bf16x2_t __attribute__((ext_vector_type(2)));
typedef short v4i16_t __attribute__((ext_vector_type(4)));
typedef unsigned u32x4 __attribute__((ext_vector_type(4)));
typedef unsigned u32x2 __attribute__((ext_vector_type(2)));
typedef float f32x4 __attribute__((ext_vector_type(4)));
#define MLAS __attribute__((address_space(3)))
constexpr int QP = 528, VP = 272;
constexpr int L_Q = 0, L_K = 64 * QP, L_V = 2 * 64 * QP, L_VW = L_V + 64 * VP, L_EX = L_VW + 64 * VP;
constexpr int L_G = L_EX + 32768;
constexpr int L_GW = L_G, L_GM = L_G + 256, L_GI = L_G + 512, L_GE = L_G + 768, L_GS = L_G + 1024;
constexpr int L_NV = L_G + 1280;
constexpr int L_QN = L_NV + 1024;
constexpr int L_DP = L_QN + 256;
constexpr int L_END = L_DP + 384;
__device__ __forceinline__ unsigned cvtpk(float lo, float hi) { f32x2_t v = {lo, hi}; bf16x2_t b = __builtin_convertvector(v, bf16x2_t); return __builtin_bit_cast(unsigned, b); }
__device__ __forceinline__ bfx8 pack_step(const f32x16& x, int s) {
    u32x4 p; p.x = cvtpk(x[8 * s + 0], x[8 * s + 1]); p.y = cvtpk(x[8 * s + 2], x[8 * s + 3]); p.z = cvtpk(x[8 * s + 4], x[8 * s + 5]); p.w = cvtpk(x[8 * s + 6], x[8 * s + 7]);
    return __builtin_bit_cast(bfx8, p);
}
__device__ __forceinline__ s16x4 vtr(MLAS const unsigned char* p) { return __builtin_bit_cast(s16x4, __builtin_amdgcn_ds_read_tr16_b64_v4i16((MLAS v4i16_t*)p)); }
__device__ __forceinline__ bfx8 cat8(s16x4 lo, s16x4 hi) { return (bfx8){lo[0], lo[1], lo[2], lo[3], hi[0], hi[1], hi[2], hi[3]}; }
__device__ __forceinline__ int crow(int r, int hi) { return (r & 3) + 8 * (r >> 2) + 4 * hi; }
__device__ __forceinline__ float logsig_(float x) { return fminf(x, 0.0f) - log1pf(__expf(-fabsf(x))); }
__device__ __forceinline__ float wsum_(float v) {
#pragma unroll
    for (int o = 1; o < 64; o <<= 1) v += __shfl_xor(v, o);
    return v; }
#define ML_MFMA(a, b, c) __builtin_amdgcn_mfma_f32_32x32x16_bf16((a), (b), (c), 0, 0, 0)

struct Item {
    __amdgpu_buffer_rsrc_t hout;
    __amdgpu_buffer_rsrc_t q, k, v;
    __amdgpu_buffer_rsrc_t sm;
    __amdgpu_buffer_rsrc_t C0, Cout;
    const float* n0; float m0; bool has0;
    float* nout; float* mout;
    int head, nchunk, L; float bi, bf;
};
#define ML_LD16(rs, vo, so) __builtin_bit_cast(u32x4, __builtin_amdgcn_raw_buffer_load_b128((rs), (int)(vo), (int)(so), 0))
#define ML_LDF(rs, vo, so) __builtin_bit_cast(float, __builtin_amdgcn_raw_buffer_load_b32((rs), (int)(vo), (int)(so), 0))

__device__ __forceinline__ void run_item(MLAS unsigned char* lds, const Item& it) {
    int tid = threadIdx.x; asm volatile("" : "+v"(tid));
    const int wave = __builtin_amdgcn_readfirstlane(tid >> 6), lane0 = tid & 63, g = wave >> 2, cb = wave & 3;
#define ML_LANE int lane = lane0; asm volatile("" : "+v"(lane)); const int r32 = lane & 31, hi = lane >> 5; (void)r32; (void)hi
    const int L = it.L, h = it.head;
    const unsigned coff = (unsigned)((lane0 >> 5) * 4096 + (lane0 & 31) * 4), qkoff = (unsigned)((tid >> 5) * 2048 + (tid & 31) * 16), voff = (unsigned)((tid >> 4) * 2048 + (tid & 15) * 16), hoff = (unsigned)((4 * (lane0 >> 5) * 1024 + (lane0 & 31)) * 2);
    f32x16 Cacc[4];
#pragma unroll
    for (int j = 0; j < 4; ++j)
#pragma unroll
        for (int i = 0; i < 16; ++i) Cacc[j][i] = it.has0 ? ML_LDF(it.C0, coff, ((128 * g + 32 * j + (i & 3) + 8 * (i >> 2)) * 256 + 32 * cb) * 4) : 0.f;
    if (tid < 256) ((MLAS float*)(lds + L_NV))[tid] = it.has0 ? it.n0[tid] : 0.f;
    float m = it.m0;
    u32x4 pq[4], pk[4], pv[2]; float pia, pfa;
#define ML_PREFETCH(c_) do { const int t0_ = (c_) * L; \
        _Pragma("unroll") for (int i = 0; i < 4; ++i) { const bool ok_ = 16 * i < L;     \
            pq[i] = ok_ ? ML_LD16(it.q, qkoff, (t0_ + 16 * i) * 2048) : (u32x4){0u, 0u, 0u, 0u}; pk[i] = ok_ ? ML_LD16(it.k, qkoff, (t0_ + 16 * i) * 2048) : (u32x4){0u, 0u, 0u, 0u}; } \
        _Pragma("unroll") for (int i = 0; i < 2; ++i) pv[i] = (32 * i < L) ? ML_LD16(it.v, voff, (t0_ + 32 * i) * 2048) : (u32x4){0u, 0u, 0u, 0u}; \
        { const int lane = lane0; const bool ok_ = lane < L; const float a_ = ML_LDF(it.sm, lane * 64, t0_ * 64 + (8 + h) * 4), f_ = ML_LDF(it.sm, lane * 64, t0_ * 64 + (12 + h) * 4); pia = ok_ ? a_ : 0.f; pfa = ok_ ? f_ : 0.f; } } while (0)
    ML_PREFETCH(0);
    for (int c = 0; c < it.nchunk; ++c) {
        float wsl, decay, mnext;
        { ML_LANE;
        float lf = (lane < L) ? logsig_(pfa + it.bf) : 0.f; float cum = lf;
#pragma unroll
        for (int o = 1; o < 64; o <<= 1) { const float t_ = __shfl_up(cum, o); if (lane >= o) cum += t_; }
        const float wv = (lane < L) ? (pia + it.bi) - cum : -INFINITY; float cmx = wv;
#pragma unroll
        for (int o = 1; o < 64; o <<= 1) { const float t_ = __shfl_up(cmx, o); if (lane >= o) cmx = fmaxf(cmx, t_); }
        const float Ml = fmaxf(m, cmx); const float M63 = __shfl(Ml, 63), cum63 = __shfl(cum, 63);
        wsl = __expf(wv - M63); decay = __expf(m - M63); mnext = cum63 + M63;
        if (wave == 0) { ((MLAS float*)(lds + L_GW))[lane] = wv; ((MLAS float*)(lds + L_GM))[lane] = Ml; ((MLAS float*)(lds + L_GI))[lane] = __expf(m - Ml);
                         ((MLAS float*)(lds + L_GE))[lane] = __expf(-(cum + Ml)); ((MLAS float*)(lds + L_GS))[lane] = wsl; } }
#pragma unroll
        for (int i = 0; i < 4; ++i) { const int p_ = tid + 512 * i, row_ = p_ >> 5, cp_ = p_ & 31;
            *(MLAS u32x4*)(lds + L_Q + row_ * QP + cp_ * 16) = pq[i]; *(MLAS u32x4*)(lds + L_K + row_ * QP + cp_ * 16) = pk[i]; }
#pragma unroll
        for (int i = 0; i < 2; ++i) { const int p_ = tid + 512 * i, row_ = p_ >> 4, cp_ = p_ & 15; const float wr_ = __shfl(wsl, row_ & 63);
            *(MLAS u32x4*)(lds + L_V + row_ * VP + cp_ * 16) = pv[i];
            u32x4 o_;
#pragma unroll
            for (int e = 0; e < 4; ++e) o_[e] = cvtpk(__uint_as_float(pv[i][e] << 16) * wr_, __uint_as_float(pv[i][e] & 0xffff0000u) * wr_);
            *(MLAS u32x4*)(lds + L_VW + row_ * VP + cp_ * 16) = o_; }
        __syncthreads();
        const int sb = g; f32x16 S0 = {}, S1 = {};
        { ML_LANE;
            MLAS const unsigned char* kp = lds + L_K + (32 * sb + r32) * QP + hi * 16; MLAS const unsigned char* q0 = lds + L_Q + r32 * QP + hi * 16; MLAS const unsigned char* q1 = q0 + 32 * QP;
#pragma unroll 4
            for (int ks = 0; ks < 16; ++ks) { const bfx8 ka = *(MLAS const bfx8*)(kp + ks * 32); const bfx8 qb1 = *(MLAS const bfx8*)(q1 + ks * 32);
                S1 = ML_MFMA(ka, qb1, S1);
                if (g == 0) { const bfx8 qb0 = *(MLAS const bfx8*)(q0 + ks * 32); S0 = ML_MFMA(ka, qb0, S0); } }
        }
        { ML_LANE;
            const float M1 = ((MLAS const float*)(lds + L_GM))[32 + r32], M0 = ((MLAS const float*)(lds + L_GM))[r32]; float d0 = 0.f, d1 = 0.f;
#pragma unroll
            for (int i = 0; i < 16; ++i) { const int sl = crow(i, hi); const float ws_ = ((MLAS const float*)(lds + L_GW))[32 * sb + sl];
                const int s_ = 32 * sb + sl;
                S1[i] = (s_ <= 32 + r32) ? S1[i] * __expf(ws_ - M1) : 0.f; d1 += S1[i];
                if (g == 0) { S0[i] = (s_ <= r32) ? S0[i] * __expf(ws_ - M0) : 0.f; d0 += S0[i]; } }
            { auto rr = __builtin_amdgcn_permlane32_swap(__float_as_uint(d1), __float_as_uint(d1), false, false); d1 = __uint_as_float(rr[0]) + __uint_as_float(rr[1]); }
            { auto rr = __builtin_amdgcn_permlane32_swap(__float_as_uint(d0), __float_as_uint(d0), false, false); d0 = __uint_as_float(rr[0]) + __uint_as_float(rr[1]); }
            if (cb == 0 && hi == 0) { if (g == 0) { ((MLAS float*)(lds + L_DP))[r32] = d0; ((MLAS float*)(lds + L_DP))[32 + r32] = d1; } else ((MLAS float*)(lds + L_DP))[64 + r32] = d1; }
        }
        f32x16 Y0 = {}, Y1 = {};
        { ML_LANE;
#pragma unroll
        for (int j = 0; j < 4; ++j)
#pragma unroll
            for (int ks = 0; ks < 2; ++ks) { const bfx8 xs = pack_step(Cacc[j], ks);
                MLAS const unsigned char* qa = lds + L_Q + r32 * QP + (128 * g + 32 * j + 16 * ks + 4 * hi) * 2;
                const u32x2 a0l = *(MLAS const u32x2*)(qa), a0h = *(MLAS const u32x2*)(qa + 16), a1l = *(MLAS const u32x2*)(qa + 32 * QP), a1h = *(MLAS const u32x2*)(qa + 32 * QP + 16);
                const bfx8 pa0 = __builtin_bit_cast(bfx8, (u32x4){a0l.x, a0l.y, a0h.x, a0h.y}), pa1 = __builtin_bit_cast(bfx8, (u32x4){a1l.x, a1l.y, a1h.x, a1h.y});
                Y0 = ML_MFMA(pa0, xs, Y0); Y1 = ML_MFMA(pa1, xs, Y1); }
#pragma unroll
        for (int i = 0; i < 16; ++i) { Y0[i] *= ((MLAS const float*)(lds + L_GI))[crow(i, hi)]; Y1[i] *= ((MLAS const float*)(lds + L_GI))[32 + crow(i, hi)]; } }
        { ML_LANE;
            const int i16 = lane & 15, q_ = i16 >> 2, p_ = i16 & 3, gi = lane >> 4;
            MLAS const unsigned char* vb = lds + L_V + (32 * sb + 4 * hi + q_) * VP + (32 * cb + 16 * (gi & 1) + 4 * p_) * 2;
#pragma unroll
            for (int ks = 0; ks < 2; ++ks) { const bfx8 pb = cat8(vtr(vb + (16 * ks) * VP), vtr(vb + (16 * ks + 8) * VP));
                Y1 = ML_MFMA(pack_step(S1, ks), pb, Y1);
                if (g == 0) Y0 = ML_MFMA(pack_step(S0, ks), pb, Y0); }
        }
        { ML_LANE;
            const f32x4 nv = *(MLAS const f32x4*)(lds + L_NV + lane * 16);
#pragma unroll
            for (int rr_ = 0; rr_ < 8; ++rr_) { const int l_ = 8 * wave + rr_; const u32x2 qw = *(MLAS const u32x2*)(lds + L_Q + l_ * QP + lane * 8);
                float d_ = __uint_as_float(qw.x << 16) * nv.x + __uint_as_float(qw.x & 0xffff0000u) * nv.y + __uint_as_float(qw.y << 16) * nv.z + __uint_as_float(qw.y & 0xffff0000u) * nv.w;
                d_ = wsum_(d_); if (lane == 0) ((MLAS float*)(lds + L_QN))[l_] = d_; }
        }
        { ML_LANE;
            MLAS float* ex = (MLAS float*)(lds + L_EX + ((1 - g) * 4 + cb) * 4096) + lane;
#pragma unroll
            for (int i = 0; i < 16; ++i) ex[i * 64] = (g == 0) ? Y1[i] : Y0[i];
        }
        __syncthreads();
        if (c + 1 < it.nchunk) ML_PREFETCH(c + 1);
        { ML_LANE;
            MLAS const float* ex = (MLAS const float*)(lds + L_EX + (g * 4 + cb) * 4096) + lane; f32x16 Y = (g == 0) ? Y0 : Y1;
#pragma unroll
            for (int i = 0; i < 16; ++i) Y[i] += ex[i * 64];
#pragma unroll
            for (int i = 0; i < 16; ++i) { const int l_ = 32 * g + crow(i, hi);
                const float dsum = (g == 0) ? ((MLAS const float*)(lds + L_DP))[l_] : ((MLAS const float*)(lds + L_DP))[l_] + ((MLAS const float*)(lds + L_DP))[32 + l_];
                const float den = dsum + ((MLAS const float*)(lds + L_GI))[l_] * ((MLAS const float*)(lds + L_QN))[l_];
                const float hv = Y[i] / fmaxf(fabsf(den), ((MLAS const float*)(lds + L_GE))[l_]);
                const float hn = __shfl_xor(hv, 1);
                if (32 * g < L && (r32 & 1) == 0) __builtin_amdgcn_raw_buffer_store_b32(cvtpk(hv, hn), it.hout, (int)hoff, ((c * L + 32 * g + (i & 3) + 8 * (i >> 2)) * 1024 + 32 * cb) * 2, 0); }
        }
        if (tid < 256) { float a_ = 0.f;
#pragma unroll 8
            for (int s = 0; s < 64; ++s) a_ += ((MLAS const float*)(lds + L_GS))[s] * bf2f(*(MLAS const unsigned short*)(lds + L_K + s * QP + tid * 2));
            ((MLAS float*)(lds + L_NV))[tid] = decay * ((MLAS const float*)(lds + L_NV))[tid] + a_; }
        { ML_LANE;
            const int i16 = lane & 15, q_ = i16 >> 2, p_ = i16 & 3, gi = lane >> 4;
            MLAS const unsigned char* kb_ = lds + L_K + (8 * hi + q_) * QP + (128 * g + 16 * (gi & 1) + 4 * p_) * 2;
            MLAS const unsigned char* vw_ = lds + L_VW + (8 * hi + q_) * VP + (32 * cb + 16 * (gi & 1) + 4 * p_) * 2;
#pragma unroll
            for (int j = 0; j < 4; ++j)
#pragma unroll
                for (int i = 0; i < 16; ++i) Cacc[j][i] *= decay;
#pragma unroll
            for (int ks = 0; ks < 4; ++ks) { const bfx8 vb_ = cat8(vtr(vw_ + (16 * ks) * VP), vtr(vw_ + (16 * ks + 4) * VP));
#pragma unroll
                for (int j = 0; j < 4; ++j) { const bfx8 ka_ = cat8(vtr(kb_ + (16 * ks) * QP + 64 * j), vtr(kb_ + (16 * ks + 4) * QP + 64 * j));
                    Cacc[j] = ML_MFMA(ka_, vb_, Cacc[j]); } }
        }
        m = mnext;
        __syncthreads();
    }
#undef ML_PREFETCH
#undef ML_LANE
#pragma unroll
    for (int j = 0; j < 4; ++j)
#pragma unroll
        for (int i = 0; i < 16; ++i) __builtin_amdgcn_raw_buffer_store_b32(__float_as_uint(Cacc[j][i]), it.Cout, (int)coff, ((128 * g + 32 * j + (i & 3) + 8 * (i >> 2)) * 256 + 32 * cb) * 4, 0);
    if (it.nout && tid < 256) it.nout[tid] = ((MLAS const float*)(lds + L_NV))[tid];
    if (it.mout && tid == 0) *it.mout = m;
    __syncthreads();
}
#undef ML_MFMA
#undef ML_LD16
#undef ML_LDF
#undef MLAS
}

constexpr size_t WS_BC = WS_NAIVE, WS_WV = WS_BC + 2 * MiB, WS_CMX = WS_WV + 2 * MiB;
constexpr size_t WS_CHS = WS_CMX + 2 * MiB;
constexpr size_t WS_SMAT = WS_CHS + 1 * MiB;
constexpr size_t WS_CB = WS_SMAT + 3 * MiB;
constexpr size_t WS_NB = WS_CB + 64 * MiB;
constexpr size_t WS_MASKS = WS_NB + 1 * MiB;
constexpr size_t WS_HA = WS_MASKS + 1 * MiB;
constexpr size_t WS_END = WS_HA + ROWBUF;
constexpr int NCHK = BATCH * 4 * 32 + DEC_BATCH * 4;

__device__ __forceinline__ float logsig(float x) { return fminf(x, 0.0f) - log1pf(__expf(-fabsf(x))); }
__device__ __forceinline__ float siluf(float x) { return x / (1.0f + __expf(-x)); }
__device__ __forceinline__ int t5b(int rel) { const int n = rel < 0 ? -rel : rel; const int v = n < 8 ? n : 8 + (n >= 12) + (n >= 16) + (n >= 23) + (n >= 32) + (n >= 46) + (n >= 64) + (n >= 91); return (rel > 0 ? 16 : 0) + v; }

namespace pg8 {
__device__ __forceinline__ void unpack8(u32x4 w, float (&f)[8]) {
    f[0] = __uint_as_float(w.x << 16); f[1] = __uint_as_float(w.x & 0xffff0000u); f[2] = __uint_as_float(w.y << 16); f[3] = __uint_as_float(w.y & 0xffff0000u);
    f[4] = __uint_as_float(w.z << 16); f[5] = __uint_as_float(w.z & 0xffff0000u); f[6] = __uint_as_float(w.w << 16); f[7] = __uint_as_float(w.w & 0xffff0000u);
}
__device__ __forceinline__ u32x4 pack8f(const float (&f)[8]) { u32x4 w; w.x = cvt_pk_bf16(f[0], f[1]); w.y = cvt_pk_bf16(f[2], f[3]); w.z = cvt_pk_bf16(f[4], f[5]); w.w = cvt_pk_bf16(f[6], f[7]); return w; }
__device__ __forceinline__ float sg_(float x) { return 1.0f / (1.0f + __expf(-x)); }
struct EpiM1a {
    static constexpr bool PERM = true, AFTER_DRAIN = false, MIDK = false;
    const bf16_t* HA; const bf16_t* OB; const float* HST; const float* ang; bf16_t* BR;
    __device__ __forceinline__ void mid(f32x4 (&)[2][2][4][2], const Unit&, int, int, int, int) const {}
    __device__ __forceinline__ void operator()(const f32x4 (&acc)[2][2][4][2], const Unit& u, int wr, int wc, int fr, int fq) const {
        const int pn = u.pn; const int row0 = u.pm * BM + wr * 64 + fr, cl = wc * 32 + 8 * fq;
        if (pn < 8) {
            const int ch0 = 128 * pn + cl, head = pn >> 1;
            const f32x4 g0 = *(const f32x4*)(ang + ch0), g1 = *(const f32x4*)(ang + ch0 + 4);
            const float g[8] = {g0[0], g0[1], g0[2], g0[3], g1[0], g1[1], g1[2], g1[3]};
#pragma unroll
            for (int ai = 0; ai < 2; ++ai)
#pragma unroll
                for (int m = 0; m < 4; ++m) { const int r = row0 + ai * HALF + m * 16;
                    float h[8]; unpack8(*(const u32x4*)(HA + (size_t)r * 1024 + ch0), h);
                    const float mean = HST[((size_t)r * 4 + head) * 2], rstd = HST[((size_t)r * 4 + head) * 2 + 1];
                    const f32x4 o0 = acc[ai][0][m][0], o1 = acc[ai][0][m][1], z0 = acc[ai][1][m][0], z1 = acc[ai][1][m][1];
                    const float oa[8] = {o0[0], o0[1], o0[2], o0[3], o1[0], o1[1], o1[2], o1[3]}, za[8] = {z0[0], z0[1], z0[2], z0[3], z1[0], z1[1], z1[2], z1[3]};
                    float o[8];
#pragma unroll
                    for (int i = 0; i < 8; ++i) o[i] = ((h[i] - mean) * rstd * g[i] * sg_(oa[i])) * (za[i] * sg_(za[i]));
                    *(u32x4*)(BR + (size_t)r * 2048 + ch0) = pack8f(o); }
        } else {
#pragma unroll
            for (int ai = 0; ai < 2; ++ai)
#pragma unroll
                for (int m = 0; m < 4; ++m) { const int r = row0 + ai * HALF + m * 16;
#pragma unroll
                    for (int bj = 0; bj < 2; ++bj) { const int ch0 = 256 * (pn - 8) + 128 * bj + cl;
                        float ob[8]; unpack8(*(const u32x4*)(OB + (size_t)r * 1024 + ch0), ob);
                        const f32x4 z0 = acc[ai][bj][m][0], z1 = acc[ai][bj][m][1]; const float zb[8] = {z0[0], z0[1], z0[2], z0[3], z1[0], z1[1], z1[2], z1[3]};
                        float o[8];
#pragma unroll
                        for (int i = 0; i < 8; ++i) o[i] = ob[i] * (zb[i] * sg_(zb[i]));
                        *(u32x4*)(BR + (size_t)r * 2048 + 1024 + ch0) = pack8f(o); } }
        }
    }
};
struct EpiM1b {
    static constexpr bool PERM = true, AFTER_DRAIN = false, MIDK = false;
    bf16_t* SGA; bf16_t* SGB;
    __device__ __forceinline__ void mid(f32x4 (&)[2][2][4][2], const Unit&, int, int, int, int) const {}
    __device__ __forceinline__ void operator()(const f32x4 (&acc)[2][2][4][2], const Unit& u, int wr, int wc, int fr, int fq) const {
        const int pn = u.pn; const int row0 = u.pm * BM + wr * 64 + fr, cl = wc * 32 + 8 * fq;
        bf16_t* base = pn < 4 ? SGA : SGB; const int col0 = (pn & 3) * 256 + cl;
#pragma unroll
        for (int ai = 0; ai < 2; ++ai)
#pragma unroll
            for (int m = 0; m < 4; ++m) { bf16_t* rowp = base + (size_t)(row0 + ai * HALF + m * 16) * 1024 + col0;
#pragma unroll
                for (int bj = 0; bj < 2; ++bj) { const f32x4 v0 = acc[ai][bj][m][0], v1 = acc[ai][bj][m][1];
                    const float o[8] = {sg_(v0[0]), sg_(v0[1]), sg_(v0[2]), sg_(v0[3]), sg_(v1[0]), sg_(v1[1]), sg_(v1[2]), sg_(v1[3])};
                    *(u32x4*)(rowp + bj * HALF) = pack8f(o); } }
    }
};
struct EpiM2 {
    static constexpr bool PERM = true, AFTER_DRAIN = false, MIDK = true;
    const bf16_t* SGA; const bf16_t* SGB; bf16_t* MX;
    __device__ __forceinline__ void mid(f32x4 (&acc)[2][2][4][2], const Unit& u, int wr, int wc, int fr, int fq) const {
        int fr_ = fr, fq_ = fq; asm volatile("" : "+v"(fr_), "+v"(fq_));
        const int row0 = u.pm * BM + wr * 64 + fr_, col0 = u.pn * BM + wc * 32 + 8 * fq_;
#pragma unroll
        for (int ai = 0; ai < 2; ++ai)
#pragma unroll
            for (int m = 0; m < 4; ++m) { const size_t ro = (size_t)(row0 + ai * HALF + m * 16) * 1024 + col0;
#pragma unroll
                for (int bj = 0; bj < 2; ++bj) { float a[8], b[8]; unpack8(*(const u32x4*)(SGA + ro + bj * HALF), a); unpack8(*(const u32x4*)(SGB + ro + bj * HALF), b);
#pragma unroll
                    for (int i = 0; i < 4; ++i) { acc[ai][bj][m][0][i] *= a[i] * __builtin_amdgcn_rcpf(b[i]); acc[ai][bj][m][1][i] *= a[4 + i] * __builtin_amdgcn_rcpf(b[4 + i]); } }
                asm volatile("" ::: "memory"); }
    }
    __device__ __forceinline__ void operator()(const f32x4 (&acc)[2][2][4][2], const Unit& u, int wr, int wc, int fr, int fq) const {
        int fr_ = fr, fq_ = fq; asm volatile("" : "+v"(fr_), "+v"(fq_));
        const int row0 = u.pm * BM + wr * 64 + fr_, col0 = u.pn * BM + wc * 32 + 8 * fq_;
#pragma unroll
        for (int ai = 0; ai < 2; ++ai)
#pragma unroll
            for (int m = 0; m < 4; ++m) { const size_t ro = (size_t)(row0 + ai * HALF + m * 16) * 1024 + col0;
#pragma unroll
                for (int bj = 0; bj < 2; ++bj) { float b[8]; unpack8(*(const u32x4*)(SGB + ro + bj * HALF), b);
                    const f32x4 v0 = acc[ai][bj][m][0], v1 = acc[ai][bj][m][1];
                    const float o[8] = {v0[0] * b[0], v0[1] * b[1], v0[2] * b[2], v0[3] * b[3], v1[0] * b[4], v1[1] * b[5], v1[2] * b[6], v1[3] * b[7]};
                    *(u32x4*)(MX + ro + bj * HALF) = pack8f(o); }
                asm volatile("" ::: "memory"); }
    }
};
struct EpiM3 {
    static constexpr bool PERM = true, AFTER_DRAIN = false, MIDK = false;
    const float* xp; const float* xs; float* yp; float* ys;
    __device__ __forceinline__ void mid(f32x4 (&)[2][2][4][2], const Unit&, int, int, int, int) const {}
    __device__ __forceinline__ void operator()(const f32x4 (&acc)[2][2][4][2], const Unit& u, int wr, int wc, int fr, int fq) const {
        const bool samp = u.pm >= NTP / 256; const int row0 = (samp ? u.pm - NTP / 256 : u.pm) * BM + wr * 64 + fr, col0 = u.pn * BM + wc * 32 + 8 * fq;
        const float* xb = samp ? xs : xp; float* yb = samp ? ys : yp;
#pragma unroll
        for (int ai = 0; ai < 2; ++ai)
#pragma unroll
            for (int m = 0; m < 4; ++m) { const size_t ro = (size_t)(row0 + ai * HALF + m * 16) * 1024 + col0;
#pragma unroll
                for (int bj = 0; bj < 2; ++bj) { const f32x4 x0 = *(const f32x4*)(xb + ro + bj * HALF), x1 = *(const f32x4*)(xb + ro + bj * HALF + 4);
                    *(f32x4*)(yb + ro + bj * HALF) = x0 * DN_ALPHA + acc[ai][bj][m][0]; *(f32x4*)(yb + ro + bj * HALF + 4) = x1 * DN_ALPHA + acc[ai][bj][m][1]; } }
    }
};
}

__device__ __forceinline__ float wave_sum(float v) {
#pragma unroll
    for (int o = 1; o < 64; o <<= 1) v += __shfl_xor(v, o);
    return v;
}

__device__ __forceinline__ void simple_select_row(LAS unsigned char* lds, int row, unsigned long long* mrow, const bf16* QI_, const float* SM_, const bf16* KI_, const float* cache_ik_) {
    const int tid_ = threadIdx.x, lane_ = tid_ & 63, wave_ = tid_ >> 6;
    LAS float* sc = (LAS float*)(lds + RING_OFF);
    LAS float* qv = (LAS float*)(lds + RING_OFF + 16384);
    const bool samp = row >= NTP; const int b = samp ? (row - NTP) / DEC_SEQ : row / SEQ; const int q = samp ? (row - NTP) % DEC_SEQ : row % SEQ;
    const int S = samp ? PAST_LEN + DEC_SEQ : ((q >> 6) + 1) * 64;
    if (S <= TOPK_MAX) { if (tid_ < 32) mrow[tid_] = (tid_ < (S >> 6)) ? ~0ull : 0ull; return; }
    qv[tid_] = bf2f(QI_[(size_t)row * 512 + tid_]); if (tid_ < 8) qv[512 + tid_] = SM_[(size_t)row * 16 + tid_] * 0.35355339059327373f;
    __syncthreads();
    const int nIt = (S + 511) / 512;
    for (int i = 0; i < nIt; ++i) { const int s = tid_ + 512 * i;
        if (s < S) { float kf[64];
            if (samp && s < PAST_LEN) { const float* kr = cache_ik_ + ((size_t)b * PAST_LEN + s) * 64;
#pragma unroll
                for (int j = 0; j < 64; ++j) kf[j] = kr[j]; }
            else { const bf16* kr = KI_ + (samp ? (size_t)NTP + (size_t)b * DEC_SEQ + (s - PAST_LEN) : (size_t)b * SEQ + s) * 64;
#pragma unroll
                for (int j = 0; j < 64; ++j) kf[j] = bf2f(kr[j]); }
            float a = 0.f;
#pragma unroll
            for (int h = 0; h < 8; ++h) { float d = 0.f;
#pragma unroll
                for (int j = 0; j < 64; ++j) d += qv[h * 64 + j] * kf[j];
                a += qv[512 + h] * fmaxf(d, 0.f); }
            sc[s] = a; } }
    __syncthreads();
    for (int i = 0; i < nIt; ++i) { const int s = tid_ + 512 * i; bool keep = false;
        if (s < S) { const int v = __float_as_int(sc[s]); const int vk = v ^ ((v >> 31) & 0x7fffffff); int rank = 0;
            for (int j = 0; j < S; ++j) { const int u = __float_as_int(sc[j]); const int uk = u ^ ((u >> 31) & 0x7fffffff); rank += (uk > vk) || (uk == vk && j < s); } keep = rank < TOPK_MAX; }
        const unsigned long long bm = __ballot(keep);
        if (lane_ == 0 && (wave_ + 8 * i) * 64 < S) mrow[wave_ + 8 * i] = bm; }
    if (!samp) { const int nw = S >> 6; if (tid_ >= nw && tid_ < 32) mrow[tid_] = 0ull; }
    __syncthreads();
}
__device__ __forceinline__ void simple_attn_task(int row, int h, int dc, const unsigned long long* mrow, const bf16* QB_, const bf16* KBc_, const bf16* VBc_, const float* cache_k_, const float* cache_v_,
                                                  const float* k_sample_, const float* v_sample_, const float* rel_bias_, bf16* orow) {
    const bool samp = row >= NTP; const int b = samp ? (row - NTP) / DEC_SEQ : row / SEQ; const int q = samp ? (row - NTP) % DEC_SEQ : row % SEQ;
    const int S = samp ? PAST_LEN + DEC_SEQ : ((q >> 6) + 1) * 64; const int qpos = samp ? PAST_LEN + q : q;
    const bf16* qr = QB_ + (size_t)row * 1024 + h * 128;
    float mx = -INFINITY, sum = 0.f, o[16];
#pragma unroll
    for (int i = 0; i < 16; ++i) o[i] = 0.f;
    for (int w = 0; w * 64 < S; ++w) { unsigned long long bits = mrow[w];
        while (bits) { const int s = w * 64 + __builtin_ctzll(bits); bits &= bits - 1;
            float d = 0.f; float vv[16];
            if (samp) { const float* kr = (s < PAST_LEN) ? cache_k_ + ((size_t)b * PAST_LEN + s) * 1024 + h * 128 : k_sample_ + ((size_t)b * DEC_SEQ + (s - PAST_LEN)) * 1024 + h * 128;
                const float* vr = (s < PAST_LEN) ? cache_v_ + ((size_t)b * PAST_LEN + s) * 1024 + h * 128 + dc * 16 : v_sample_ + ((size_t)b * DEC_SEQ + (s - PAST_LEN)) * 1024 + h * 128 + dc * 16;
#pragma unroll 8
                for (int j = 0; j < 128; ++j) d += bf2f(qr[j]) * kr[j];
#pragma unroll
                for (int i = 0; i < 16; ++i) vv[i] = vr[i]; }
            else { const bf16* kr = KBc_ + ((size_t)b * SEQ + s) * 1024 + h * 128; const bf16* vr = VBc_ + ((size_t)b * SEQ + s) * 1024 + h * 128 + dc * 16;
#pragma unroll 8
                for (int j = 0; j < 128; ++j) d += bf2f(qr[j]) * bf2f(kr[j]);
#pragma unroll
                for (int i = 0; i < 16; ++i) vv[i] = bf2f(vr[i]); }
            const float lg = d * 0.08838834764831845f + rel_bias_[t5b(s - qpos) * 8 + h];
            if (lg > mx) { const float f = __expf(mx - lg); sum *= f;
#pragma unroll
                for (int i = 0; i < 16; ++i) o[i] *= f; mx = lg; }
            const float p = __expf(lg - mx); sum += p;
#pragma unroll
            for (int i = 0; i < 16; ++i) o[i] += p * vv[i]; } }
    const float inv = 1.0f / sum;
#pragma unroll
    for (int i = 0; i < 16; ++i) orow[i] = (bf16)f2bf(o[i] * inv);
}


template <int NW>
__device__ __forceinline__ unsigned long long wave_select(LAS const int* row, int nW, int lane_) {
    static_assert(TOPK_MAX == 256, "the 4th-largest bracket assumes TOPK_MAX = 64 lanes x 4");
    int v[NW]; int t0 = (int)0x80000000, t1 = t0, t2 = t0, t3 = t0;
#pragma unroll
    for (int i = 0; i < NW; ++i) { v[i] = (i < nW) ? row[lane_ + 64 * i] : (int)0x80000000;
        int x = v[i], y; y = min(t0, x); t0 = max(t0, x); x = y; y = min(t1, x); t1 = max(t1, x); x = y; y = min(t2, x); t2 = max(t2, x); x = y; t3 = max(t3, x); }
    int vmx = t3, vmn = t3;
#pragma unroll
    for (int o_ = 1; o_ < 64; o_ <<= 1) { vmx = max(vmx, __shfl_xor(vmx, o_)); vmn = min(vmn, __shfl_xor(vmn, o_)); }
    int lo_ = __builtin_amdgcn_readfirstlane(vmn), hi_ = __builtin_amdgcn_readfirstlane(vmx); bool exact = false; int T = lo_;
    while (lo_ < hi_) { const int mid = lo_ + (int)((((unsigned)hi_ - (unsigned)lo_) + 1u) >> 1); int cnt = 0;
#pragma unroll
        for (int i = 0; i < NW; ++i) { cnt += __builtin_popcountll(__ballot(v[i] >= mid)); if ((i & 3) == 3) __builtin_amdgcn_sched_barrier(0); }
        if (cnt == TOPK_MAX) { exact = true; T = mid; break; }
        if (cnt > TOPK_MAX) lo_ = mid; else hi_ = mid - 1; }
    if (!exact) T = lo_;
    int need = TOPK_MAX;
    if (!exact) { int cgt = 0;
#pragma unroll
        for (int i = 0; i < NW; ++i) { cgt += __builtin_popcountll(__ballot(v[i] > T)); if ((i & 3) == 3) __builtin_amdgcn_sched_barrier(0); }
        need = TOPK_MAX - cgt; }
    unsigned long long myw = 0ull; int running = 0; const unsigned long long lt = (1ull << lane_) - 1ull;
#pragma unroll
    for (int i = 0; i < NW; ++i) { bool sel;
        if (exact) sel = v[i] >= T;
        else { const bool eq = v[i] == T; const unsigned long long em = __ballot(eq); sel = (v[i] > T) || (eq && running + __builtin_popcountll(em & lt) < need); running += __builtin_popcountll(em); }
        const unsigned long long wd = __ballot(sel); if (lane_ == i) myw = wd; __builtin_amdgcn_sched_barrier(0); }
    return myw;
}
__device__ __forceinline__ void sample_select_row(LAS unsigned char* lds, int row, unsigned long long* mrow, const bf16* QI_, const float* SM_, const bf16* KI_, const float* cache_ik_) {
    const int tid_ = threadIdx.x, lane_ = tid_ & 63, wave_ = __builtin_amdgcn_readfirstlane(tid_ >> 6);
    LAS int* sck = (LAS int*)(lds + RING_OFF);
    LAS float* qv = (LAS float*)(lds + RING_OFF + 16384);
    const int b = (row - NTP) / DEC_SEQ; constexpr int S = PAST_LEN + DEC_SEQ;
    qv[tid_] = bf2f(QI_[(size_t)row * 512 + tid_]); if (tid_ < 8) qv[512 + tid_] = SM_[(size_t)row * 16 + tid_] * 0.35355339059327373f;
    __syncthreads();
#pragma unroll 1
    for (int i = 0; i < 5; ++i) { const int s = tid_ + 512 * i;
        if (s < 2112) { int key = (int)0x80000000;
            if (s < S) { float kf[64];
                if (s < PAST_LEN) { const float* kr = cache_ik_ + ((size_t)b * PAST_LEN + s) * 64;
#pragma unroll
                    for (int j = 0; j < 64; ++j) kf[j] = kr[j]; }
                else { const bf16* kr = KI_ + ((size_t)NTP + (size_t)b * DEC_SEQ + (s - PAST_LEN)) * 64;
#pragma unroll
                    for (int j = 0; j < 64; ++j) kf[j] = bf2f(kr[j]); }
                float a = 0.f;
#pragma unroll
                for (int h = 0; h < 8; ++h) { float d = 0.f;
#pragma unroll
                    for (int j = 0; j < 64; ++j) d += qv[h * 64 + j] * kf[j];
                    a += qv[512 + h] * fmaxf(d, 0.f); }
                const int kb_ = __float_as_int(a); key = kb_ ^ ((kb_ >> 31) & 0x7fffffff); }
            sck[s] = key; } }
    __syncthreads();
    if (wave_ == 0) { const unsigned long long myw = wave_select<33>(sck, 33, lane_); if (lane_ < 33) mrow[lane_] = myw; }
    __syncthreads();
}
__device__ __forceinline__ void sample_attn_row(LAS unsigned char* lds, int b, int r, const unsigned long long* mrow, bf16* qo_row  , const float* cache_k_, const float* cache_v_,
                                                 const float* k_new, const float* v_new  , const float* rel_bias_) {
    const int tid_ = threadIdx.x, lane_ = tid_ & 63, h = __builtin_amdgcn_readfirstlane(tid_ >> 6);
    LAS int* idx = (LAS int*)(lds + RING_OFF);
    LAS float* qf = (LAS float*)(lds + RING_OFF + 1024) + h * 128;
    if (h == 0) { int base = 0; const unsigned long long lt = (1ull << lane_) - 1ull;
        for (int w = 0; w < 33; ++w) { const unsigned long long bits = mrow[w]; if ((bits >> lane_) & 1ull) idx[base + __builtin_popcountll(bits & lt)] = 64 * w + lane_; base += __builtin_popcountll(bits); } }
    qf[lane_] = bf2f(qo_row[h * 128 + lane_]); qf[64 + lane_] = bf2f(qo_row[h * 128 + 64 + lane_]);
    __syncthreads();
    const int qpos = PAST_LEN + r; float lg[4]; int sk[4];
#pragma unroll
    for (int rnd = 0; rnd < 4; ++rnd) { const int s = idx[64 * rnd + lane_]; sk[rnd] = s;
        const float* kr = (s < PAST_LEN) ? cache_k_ + ((size_t)b * PAST_LEN + s) * 1024 + h * 128 : k_new + (size_t)(s - PAST_LEN) * 1024 + h * 128;
        float d = 0.f;
#pragma unroll 8
        for (int d4 = 0; d4 < 32; ++d4) { const f32x4 kk = *(const f32x4*)(kr + 4 * d4); const f32x4 qq = *(LAS const f32x4*)(qf + 4 * d4); d += (kk.x * qq.x + kk.y * qq.y) + (kk.z * qq.z + kk.w * qq.w); }
        lg[rnd] = d * 0.08838834764831845f + rel_bias_[t5b(s - qpos) * 8 + h]; }
    float mx = fmaxf(fmaxf(lg[0], lg[1]), fmaxf(lg[2], lg[3]));
#pragma unroll
    for (int o_ = 1; o_ < 64; o_ <<= 1) mx = fmaxf(mx, __shfl_xor(mx, o_));
    float p[4], sum = 0.f;
#pragma unroll
    for (int rnd = 0; rnd < 4; ++rnd) { p[rnd] = __expf(lg[rnd] - mx); sum += p[rnd]; }
    sum = wave_sum(sum);
    float a0 = 0.f, a1 = 0.f;
#pragma unroll
    for (int rnd = 0; rnd < 4; ++rnd) {
#pragma unroll 8
        for (int j = 0; j < 64; ++j) { const float pj = __int_as_float(__builtin_amdgcn_readlane(__float_as_int(p[rnd]), j)); const int sj = __builtin_amdgcn_readlane(sk[rnd], j);
            const float* vr = (sj < PAST_LEN) ? cache_v_ + ((size_t)b * PAST_LEN + sj) * 1024 + h * 128 : v_new + (size_t)(sj - PAST_LEN) * 1024 + h * 128;
            const float2 vv = *(const float2*)(vr + 2 * lane_); a0 += pj * vv.x; a1 += pj * vv.y; } }
    const float inv = 1.0f / sum;
    *(unsigned*)(qo_row + h * 128 + 2 * lane_) = pk2(a0 * inv, a1 * inv);
    __syncthreads();
}

typedef const __attribute__((address_space(4))) Args* kargp_t;
#define MK_ARGS kargp_t ap_ = (kargp_t)__builtin_amdgcn_kernarg_segment_ptr(); asm volatile("" : "+s"(ap_))
#define args (*ap_)
__global__ void __launch_bounds__(NWAVES * 64, 2) mk_fwd(Args kargs_by_value) {
    extern __shared__ __attribute__((aligned(16))) unsigned char lds_raw[];
    LAS unsigned char* lds = (LAS unsigned char*)lds_raw;
    int lo, hi; unsigned* barw;
    { MK_ARGS; lo = args.ph_lo; hi = args.ph_hi; barw = (unsigned*)((gu32*)(args.ws + WS_CTL) + CW_BAR); }
    volatile LAS unsigned* MISC = (volatile LAS unsigned*)(lds + MISC_OFF);
    for (int u = threadIdx.x; u < (LDS_BYTES - LDSCTL_OFF) / 4; u += NWAVES * 64) ((LAS unsigned*)(lds + LDSCTL_OFF))[u] = 0u;
    __syncthreads();
    XcdBarrier bar = xcd_barrier_post(barw, MISC + 8);
#ifndef DUPMASK
#define DUPMASK 0
#endif
#ifndef PHMASK
#define PHMASK 0x3ff
#endif
#define IN(k) (((PHMASK >> (k)) & 1) && lo <= (k) && (k) < hi)
#define GBAR() xcd_barrier(bar)
#define WMIX ((bf16*)(args.ws + WS_WMIX))
#define WMRG ((bf16*)(args.ws + WS_WMRG))
#define WAB ((bf16*)(args.ws + WS_WAB))
#define WO ((bf16*)(args.ws + WS_WO))
#define XB ((bf16*)(args.ws + WS_XB))
#define QA ((bf16*)(args.ws + WS_QA))
#define KA ((bf16*)(args.ws + WS_KA))
#define VA ((bf16*)(args.ws + WS_VA))
#define QB ((bf16*)(args.ws + WS_QB))
#define QI ((bf16*)(args.ws + WS_QI))
#define KI ((bf16*)(args.ws + WS_KI))
#define SM ((float*)(args.ws + WS_SM))
#define MASK ((unsigned long long*)(args.ws + WS_MASK))
#define MASKS ((unsigned long long*)(args.ws + WS_MASKS))
#define HST ((float*)(args.ws + WS_HST))
#define BC ((float*)(args.ws + WS_BC))
#define WV ((float*)(args.ws + WS_WV))
#define CMX ((float*)(args.ws + WS_CMX))
#define CHS ((float*)(args.ws + WS_CHS))
#define MCH (CHS + 2 * NCHK)
#define SMATP ((float*)(args.ws + WS_SMAT))
#define SMATS (SMATP + 128 * 4096)
#define CB ((float*)(args.ws + WS_CB))
#define NBf ((float*)(args.ws + WS_NB))
#define HA VA
#define OB QB
#define BR QA
#define SGA VA
#define SGB QB
#define MX XB
#define y_prompt (args.out)
#define y_sample (y_prompt + (size_t)NTP * 1024)
#define k_prompt (y_sample + (size_t)NTS * 1024)
#define v_prompt (k_prompt + (size_t)NTP * 1024)
#define ik_prompt (v_prompt + (size_t)NTP * 1024)
#define C_prompt (ik_prompt + (size_t)NTP * 64)
#define n_prompt (C_prompt + (size_t)BATCH * 4 * 65536)
#define m_prompt (n_prompt + (size_t)BATCH * 1024)
#define k_sample (m_prompt + BATCH * 4)
#define v_sample (k_sample + (size_t)NTS * 1024)
#define ik_sample (v_sample + (size_t)NTS * 1024)
#define C_sample (ik_sample + (size_t)NTS * 64)
#define n_sample (C_sample + (size_t)DEC_BATCH * 4 * 65536)
#define m_sample (n_sample + (size_t)DEC_BATCH * 1024)
#define KBc ((bf16*)y_prompt)
#define VBc (KBc + (size_t)NTP * 1024)
#define cache_k (args.in[2])
#define cache_v (args.in[3])
#define cache_ik (args.in[4])
#define state_C (args.in[5])
#define state_n (args.in[6])
#define state_m (args.in[7])
#define b_gates (args.in[9])
#define a_norm_g (args.in[10])
#define rel_bias (args.in[14])
#define ln_g (args.in[15])
#define ln_b (args.in[16])
#define gtid ({ int t__ = (int)threadIdx.x; asm volatile("" : "+v"(t__)); (long)blockIdx.x * (NWAVES * 64) + (long)t__; })
#define GT ((long)gridDim.x * (NWAVES * 64))
#define gw (vcu * NWAVES + wave)
#define NGW ((int)gridDim.x * NWAVES)
#define tid ((int)threadIdx.x)
#define lane ((int)(threadIdx.x & 63))
#define wave (__builtin_amdgcn_readfirstlane((int)(threadIdx.x >> 6)))
#define G ((int)gridDim.x)
#define vcu ((G % 8 == 0) ? ((int)blockIdx.x % 8) * (G / 8) + (int)blockIdx.x / 8 : (int)blockIdx.x)

    if (IN(0))
#if (DUPMASK >> 0) & 1
    for (int rep_ = 0; rep_ < 2; ++rep_)
#endif
    { MK_ARGS;
        P0Args a{args.in[0], args.in[1], args.in[8], args.in[11], args.in[12], args.in[13], XB, WMIX, WMRG, WAB, WO};
        p0_prologue(a, lds, vcu, G, wave, lane);
        GBAR();
    }
    if (IN(1))
#if (DUPMASK >> 1) & 1
    for (int rep_ = 0; rep_ < 2; ++rep_)
#endif
    { MK_ARGS;
        pg8::Gemm g{XB, WMIX, NTOK, N_MIX, 1024}; pg8::StaticOrder S; S.init(NTOK, N_MIX, G, (int)blockIdx.x);
        pg8::EpiMix E{QA, KBc, QI, KI, SM, k_prompt, k_sample, ik_prompt, ik_sample};
        pg8::gemm_phase<pg8::EpiMix, pg8::StaticOrder, true, true>(lds + RING_OFF, g, S, E);
        GBAR();
    }
    if (IN(2))
#if (DUPMASK >> 2) & 1
    for (int rep_ = 0; rep_ < 2; ++rep_)
#endif
    { MK_ARGS;
        static_assert(ml::L_END <= LDSCTL_OFF, "mLSTM LDS image");
#ifdef PROBE_ML
#define HAREF ((bf16*)(args.ws + WS_HA))
        for (long t = gtid; t < NCHK; t += GT) {
            int h, L; long tok0;
            if (t < 4096) { const int b = (int)(t >> 7); h = (int)((t >> 5) & 3); const int c = (int)(t & 31); tok0 = (long)b * SEQ + c * 64; L = 64; }
            else { const int b = (int)((t - 4096) >> 2); h = (int)((t - 4096) & 3); tok0 = NTP + (long)b * DEC_SEQ; L = DEC_SEQ; }
            const float bi = b_gates[h], bfg = b_gates[4 + h]; float cum = 0.f, cmax = -INFINITY;
            for (int l = 0; l < L; ++l) { const long tok = tok0 + l; const float ig = SM[tok * 16 + 8 + h] + bi; const float lf = logsig(SM[tok * 16 + 12 + h] + bfg);
                cum += lf; const float w = ig - cum; cmax = fmaxf(cmax, w); BC[tok * 4 + h] = cum; WV[tok * 4 + h] = w; CMX[tok * 4 + h] = cmax; }
            CHS[2 * t] = cum; CHS[2 * t + 1] = cmax;
        }
        GBAR();
        for (long t = gtid; t < BATCH * 4 + DEC_BATCH * 4; t += GT) {
            if (t < BATCH * 4) { float m = 0.f; for (int c = 0; c < 32; ++c) { const long i = t * 32 + c; MCH[i] = m; m = CHS[2 * i] + fmaxf(m, CHS[2 * i + 1]); } m_prompt[t] = m; }
            else { const long j = t - BATCH * 4; const long i = 4096 + j; float m = state_m[j]; MCH[i] = m; m = CHS[2 * i] + fmaxf(m, CHS[2 * i + 1]); m_sample[j] = m; }
        }
        GBAR();
        for (int c = 0; c < 32; ++c) {
            const long nSp = 128L * 4096, nSs = (c == 0) ? 64L * 1024 : 0;
            for (long t = gtid; t < nSp + nSs; t += GT) {
                int bh, l, s, L; long tok0; float* dst;
                if (t < nSp) { bh = (int)(t >> 12); l = (int)((t >> 6) & 63); s = (int)(t & 63); L = 64; tok0 = (long)(bh >> 2) * SEQ + c * 64; dst = SMATP + t; }
                else { const long u = t - nSp; bh = (int)(u >> 10); l = (int)((u >> 5) & 31); s = (int)(u & 31); L = 32; tok0 = NTP + (long)(bh >> 2) * DEC_SEQ; dst = SMATS + u; }
                const int h = bh & 3; float val = 0.f;
                if (s <= l) { const long tl = tok0 + l, ts = tok0 + s; const bf16* q = QA + tl * 1024 + h * 256; const bf16* k = KA + ts * 1024 + h * 256;
                    float d = 0.f; for (int i = 0; i < 256; ++i) d += bf2f(q[i]) * bf2f(k[i]);
                    const long ci = (t < nSp) ? (long)bh * 32 + c : 4096 + bh;
                    val = d * __expf(WV[ts * 4 + h] - fmaxf(MCH[ci], CMX[tl * 4 + h])); }
                *dst = val;
            }
            GBAR();
            const long nHp = 32L * 64 * 1024, nHs = (c == 0) ? 16L * 32 * 1024 : 0, nCp = 128L * 65536, nCs = (c == 0) ? 64L * 65536 : 0;
            for (long t = gtid; t < nHp + nHs + nCp + nCs; t += GT) {
                if (t < nHp + nHs) {
                    int b, l, h, dv, L; long tok0, ci; const float* Sr; const float* Cm; const float* nv; bool zero = false;
                    if (t < nHp) { b = (int)(t >> 16); l = (int)((t >> 10) & 63); h = (int)((t >> 8) & 3); dv = (int)(t & 255); L = 64; tok0 = (long)b * SEQ + c * 64; ci = (long)(b * 4 + h) * 32 + c;
                        Sr = SMATP + ((long)(b * 4 + h) * 64 + l) * 64; Cm = CB + (size_t)(c & 1) * 128 * 65536 + (size_t)(b * 4 + h) * 65536; nv = NBf + (c & 1) * 128 * 256 + (b * 4 + h) * 256; zero = (c == 0); }
                    else { const long u = t - nHp; b = (int)(u >> 15); l = (int)((u >> 10) & 31); h = (int)((u >> 8) & 3); dv = (int)(u & 255); L = 32; tok0 = NTP + (long)b * DEC_SEQ; ci = 4096 + b * 4 + h;
                        Sr = SMATS + ((long)(b * 4 + h) * 32 + l) * 32; Cm = state_C + (size_t)(b * 4 + h) * 65536; nv = state_n + (b * 4 + h) * 256; }
                    const long tl = tok0 + l; const bf16* q = QA + tl * 1024 + h * 256;
                    const float mc = MCH[ci], Ml = fmaxf(mc, CMX[tl * 4 + h]), bl = BC[tl * 4 + h]; const float inter = __expf(mc - Ml);
                    float num = 0.f, den = 0.f;
                    for (int s = 0; s <= l; ++s) { const float sv = Sr[s]; num += sv * bf2f(VA[(tok0 + s) * 1024 + h * 256 + dv]); den += sv; }
                    if (!zero) { float qc = 0.f, qn = 0.f; for (int i = 0; i < 256; ++i) { const float qi_ = bf2f(q[i]); qc += qi_ * Cm[(size_t)i * 256 + dv]; qn += qi_ * nv[i]; } num += inter * qc; den += inter * qn; }
                    const float hv = num / fmaxf(fabsf(den), __expf(-(bl + Ml)));
                    HAREF[tl * 1024 + h * 256 + dv] = (bf16)f2bf(hv);
                } else {
                    const long u0 = t - (nHp + nHs); int bh, dk, dv, L; long tok0, ci; const float* Cs; const float* ns; float* Cd; float* nd; bool zero = false;
                    if (u0 < nCp) { bh = (int)(u0 >> 16); dk = (int)((u0 >> 8) & 255); dv = (int)(u0 & 255); L = 64; tok0 = (long)(bh >> 2) * SEQ + c * 64; ci = (long)bh * 32 + c; zero = (c == 0);
                        Cs = CB + (size_t)(c & 1) * 128 * 65536 + (size_t)bh * 65536; ns = NBf + (c & 1) * 128 * 256 + bh * 256;
                        Cd = (c == 31) ? C_prompt + (size_t)bh * 65536 : CB + (size_t)((c + 1) & 1) * 128 * 65536 + (size_t)bh * 65536; nd = (c == 31) ? n_prompt + bh * 256 : NBf + ((c + 1) & 1) * 128 * 256 + bh * 256; }
                    else { const long u = u0 - nCp; bh = (int)(u >> 16); dk = (int)((u >> 8) & 255); dv = (int)(u & 255); L = 32; tok0 = NTP + (long)(bh >> 2) * DEC_SEQ; ci = 4096 + bh;
                        Cs = state_C + (size_t)bh * 65536; ns = state_n + bh * 256; Cd = C_sample + (size_t)bh * 65536; nd = n_sample + bh * 256; }
                    const int h = bh & 3; const float mc = MCH[ci]; const float Mlast = fmaxf(mc, CMX[(tok0 + L - 1) * 4 + h]); const float decay = __expf(mc - Mlast);
                    float aC = 0.f, an = 0.f;
                    for (int s = 0; s < L; ++s) { const long ts = tok0 + s; const float wsv = __expf(WV[ts * 4 + h] - Mlast); const float kk = bf2f(KA[ts * 1024 + h * 256 + dk]);
                        aC += wsv * kk * bf2f(VA[ts * 1024 + h * 256 + dv]); an += wsv * kk; }
                    Cd[(size_t)dk * 256 + dv] = (zero ? 0.f : decay * Cs[(size_t)dk * 256 + dv]) + aC;
                    if (dv == 0) nd[dk] = (zero ? 0.f : decay * ns[dk]) + an;
                }
            }
            GBAR();
        }
#endif
#define ML_RS(p, bytes) __builtin_amdgcn_make_buffer_rsrc((void*)(p), (short)0, (int)(bytes), 0x00020000)
        if (vcu < BATCH * 8) { const int bh = vcu >> 1, dvh = vcu & 1, b = bh >> 2, h = bh & 3; const size_t t0 = (size_t)b * SEQ;
            ml::Item it; it.q = ML_RS(QA + t0 * 1024 + h * 256, SEQ * 2048); it.k = ML_RS(KA + t0 * 1024 + h * 256, SEQ * 2048); it.v = ML_RS(VA + t0 * 1024 + h * 256 + dvh * 128, SEQ * 2048); it.sm = ML_RS(SM + t0 * 16, SEQ * 64);
            it.C0 = ML_RS(C_prompt, 4); it.has0 = false; it.n0 = nullptr; it.m0 = 0.f; it.Cout = ML_RS(C_prompt + (size_t)bh * 65536 + dvh * 128, 65536 * 4);
            it.nout = dvh == 0 ? n_prompt + bh * 256 : nullptr; it.mout = dvh == 0 ? m_prompt + bh : nullptr;
            it.head = h; it.nchunk = SEQ / CHUNK; it.L = CHUNK; it.bi = b_gates[h]; it.bf = b_gates[4 + h]; it.hout = it.v;
#if (DUPMASK >> 2) & 1
            { float* no_ = it.nout; float* mo_ = it.mout;
              for (int dry_ = 1; dry_ >= 0; --dry_) { it.hout = dry_ ? ML_RS(args.ws + WS_HA, SEQ * 2048) : it.v; it.Cout = dry_ ? ML_RS(args.ws + WS_HA + 8 * MiB + (size_t)vcu * 65536 * 4, 65536 * 4) : ML_RS(C_prompt + (size_t)bh * 65536 + dvh * 128, 65536 * 4);
                  it.nout = dry_ ? nullptr : no_; it.mout = dry_ ? nullptr : mo_; ml::run_item(lds, it); } } }
#else
            ml::run_item(lds, it); }
#endif
        if (vcu < DEC_BATCH * 8) { const int bh = vcu >> 1, dvh = vcu & 1, b = bh >> 2, h = bh & 3; const size_t t0 = (size_t)NTP + (size_t)b * DEC_SEQ;
            ml::Item it; it.q = ML_RS(QA + t0 * 1024 + h * 256, DEC_SEQ * 2048); it.k = ML_RS(KA + t0 * 1024 + h * 256, DEC_SEQ * 2048); it.v = ML_RS(VA + t0 * 1024 + h * 256 + dvh * 128, DEC_SEQ * 2048); it.sm = ML_RS(SM + t0 * 16, DEC_SEQ * 64);
            it.C0 = ML_RS(state_C + (size_t)bh * 65536 + dvh * 128, 65536 * 4); it.has0 = true; it.n0 = state_n + bh * 256; it.m0 = state_m[bh]; it.Cout = ML_RS(C_sample + (size_t)bh * 65536 + dvh * 128, 65536 * 4);
            it.nout = dvh == 0 ? n_sample + bh * 256 : nullptr; it.mout = dvh == 0 ? m_sample + bh : nullptr;
            it.head = h; it.nchunk = 1; it.L = DEC_SEQ; it.bi = b_gates[h]; it.bf = b_gates[4 + h]; it.hout = it.v;
            ml::run_item(lds, it); }
#undef ML_RS
        GBAR();
#ifdef PROBE_ML
        { float num = 0.f, den = 0.f;
          for (long t = gtid; t < (long)NTOK * 1024; t += GT) { const float a = bf2f(HA[t]), r = bf2f(HAREF[t]); num += (a - r) * (a - r); den += r * r; }
          num = wave_sum(num); den = wave_sum(den);
          if (lane == 0) { atomicAdd((float*)(args.ws + WS_CTL) + 8, num); atomicAdd((float*)(args.ws + WS_CTL) + 9, den); } }
#endif
        { const int sub = lane >> 3, l8 = lane & 7;
          for (long t0 = (long)gw * 8; t0 < (long)NTOK * 4; t0 += (long)NGW * 8) { const long t = t0 + sub;
              const GAS v4u* src = (const GAS v4u*)(HA + t * 256 + l8 * 32); v4u w[4];
#pragma unroll
              for (int j = 0; j < 4; ++j) w[j] = src[j];
              float f[32];
#pragma unroll
              for (int j = 0; j < 4; ++j)
#pragma unroll
                  for (int e = 0; e < 4; ++e) { f[8 * j + 2 * e] = __uint_as_float(w[j][e] << 16); f[8 * j + 2 * e + 1] = __uint_as_float(w[j][e] & 0xffff0000u); }
              float s1 = 0.f;
#pragma unroll
              for (int e = 0; e < 32; ++e) s1 += f[e];
              s1 += __shfl_xor(s1, 1); s1 += __shfl_xor(s1, 2); s1 += __shfl_xor(s1, 4);
              const float mean = s1 * (1.0f / 256.0f); float s2 = 0.f;
#pragma unroll
              for (int e = 0; e < 32; ++e) { const float d = f[e] - mean; s2 += d * d; }
              s2 += __shfl_xor(s2, 1); s2 += __shfl_xor(s2, 2); s2 += __shfl_xor(s2, 4);
              if (l8 == 0) { HST[t * 2] = mean; HST[t * 2 + 1] = 1.0f / sqrtf(s2 * (1.0f / 256.0f) + HEAD_NORM_EPS); } } }
    }
    if (IN(3))
#if (DUPMASK >> 3) & 1
    for (int rep_ = 0; rep_ < 2; ++rep_)
#endif
    { MK_ARGS;
        {
            typedef short bfx8 __attribute__((ext_vector_type(8))); typedef float f16v __attribute__((ext_vector_type(16)));
            LAS int* sck = (LAS int*)(lds + RING_OFF);
            const int hi = lane >> 5, r32 = lane & 31;
            for (int w4 = 0; w4 < 4; ++w4) {
                const int bW = vcu >> 3, jW = vcu & 7; const int cW = (w4 == 0) ? jW : (w4 == 1) ? 15 - jW : (w4 == 2) ? 16 + jW : 31 - jW;
                if (vcu >= BATCH * 8) break;
                const int S = 64 * (cW + 1), nW = cW + 1; const long tok0 = (long)bW * SEQ + 64 * cW;
                if (S <= TOPK_MAX) {
                    for (int k = 0; k < 8; ++k) { if (lane < 32) MASK[(size_t)(tok0 + wave * 8 + k) * 32 + lane] = (lane < nW) ? ~0ull : 0ull; }
                    continue; }
                { LAS unsigned char* qil = lds + RING_OFF + 65536; LAS float* sml = (LAS float*)(lds + RING_OFF + 65536 + 73728);
#pragma unroll
                  for (int i = 0; i < 8; ++i) { const int p_ = tid + 512 * i, row_ = p_ >> 6, wi_ = p_ & 63;
                      *(LAS v4u*)(qil + row_ * 1152 + (wi_ >> 3) * 144 + (wi_ & 7) * 16) = *(const v4u*)(QI + (size_t)(tok0 + row_) * 512 + wi_ * 8); }
                  sml[tid] = SM[(size_t)(tok0 + (tid >> 3)) * 16 + (tid & 7)] * 0.35355339059327373f;
                  asm volatile("s_waitcnt vmcnt(0) lgkmcnt(0)" ::: "memory"); __builtin_amdgcn_s_barrier(); asm volatile("" ::: "memory"); }
                bfx8 bfr[8][4];
#pragma unroll
                for (int i = 0; i < 8; ++i) { const int kt = wave + 8 * i;
                    if (kt < 2 * nW) { const bf16* kp = KI + ((size_t)bW * SEQ + 32 * kt + r32) * 64 + hi * 8;
#pragma unroll
                        for (int ks = 0; ks < 4; ++ks) bfr[i][ks] = *(const bfx8*)(kp + ks * 16); }
                    else {
#pragma unroll
                        for (int ks = 0; ks < 4; ++ks) bfr[i][ks] = (bfx8){0, 0, 0, 0, 0, 0, 0, 0}; } }
                for (int rd = 0; rd < 8; ++rd) {
                    bfx8 afr[2][4]; float wgt[2][16];
                    { const int blk = r32 >> 2; const int qa_ = 2 * (blk & 1) + (blk >> 2), ha_ = 4 * ((blk >> 1) & 1) + (r32 & 3);
                      LAS const unsigned char* qil = lds + RING_OFF + 65536; LAS const float* sml = (LAS const float*)(lds + RING_OFF + 65536 + 73728);
#pragma unroll
                      for (int rt = 0; rt < 2; ++rt) { LAS const unsigned char* qp = qil + (8 * rd + 4 * rt + qa_) * 1152 + ha_ * 144 + hi * 16;
#pragma unroll
                          for (int ks = 0; ks < 4; ++ks) afr[rt][ks] = *(LAS const bfx8*)(qp + ks * 32);
#pragma unroll
                          for (int qq = 0; qq < 2; ++qq) { LAS const float* wp = sml + (8 * rd + 4 * rt + 2 * hi + qq) * 8;
                              const f32x4 w0 = *(LAS const f32x4*)wp, w1 = *(LAS const f32x4*)(wp + 4);
                              wgt[rt][8 * qq + 0] = w0[0]; wgt[rt][8 * qq + 1] = w0[1]; wgt[rt][8 * qq + 2] = w0[2]; wgt[rt][8 * qq + 3] = w0[3];
                              wgt[rt][8 * qq + 4] = w1[0]; wgt[rt][8 * qq + 5] = w1[1]; wgt[rt][8 * qq + 6] = w1[2]; wgt[rt][8 * qq + 7] = w1[3]; } } }
#pragma unroll
                    for (int i8 = 0; i8 < 8; ++i8) { const int kt = wave + 8 * i8; if (kt < 2 * nW) {
#pragma unroll
                        for (int rt = 0; rt < 2; ++rt) { f16v acc = {};
#pragma unroll
                            for (int ks = 0; ks < 4; ++ks) acc = __builtin_amdgcn_mfma_f32_32x32x16_bf16(afr[rt][ks], bfr[i8][ks], acc, 0, 0, 0);
                            float sA = 0.f, sB = 0.f;
#pragma unroll
                            for (int i = 0; i < 8; ++i) { sA += wgt[rt][i] * fmaxf(acc[i], 0.f); sB += wgt[rt][8 + i] * fmaxf(acc[8 + i], 0.f); }
                            const int kA = __float_as_int(sA), kB = __float_as_int(sB);
                            sck[(4 * rt + 2 * hi) * 2048 + 32 * kt + r32] = kA ^ ((kA >> 31) & 0x7fffffff);
                            sck[(4 * rt + 2 * hi + 1) * 2048 + 32 * kt + r32] = kB ^ ((kB >> 31) & 0x7fffffff); }
                    } }
                    asm volatile("s_waitcnt lgkmcnt(0)" ::: "memory"); __builtin_amdgcn_s_barrier(); asm volatile("" ::: "memory");
                    { const unsigned long long myw = (nW <= 16) ? wave_select<16>(sck + wave * 2048, nW, lane) : wave_select<32>(sck + wave * 2048, nW, lane); if (lane < 32) MASK[(size_t)(tok0 + 8 * rd + wave) * 32 + lane] = myw; }
                    asm volatile("s_waitcnt lgkmcnt(0)" ::: "memory"); __builtin_amdgcn_s_barrier(); asm volatile("" ::: "memory");
                }
            }
        }
        for (int row = NTP + vcu; row < NTOK; row += G) sample_select_row(lds, row, MASKS + (size_t)(row - NTP) * 40, QI, SM, KI, cache_ik);
        GBAR();
    }
#ifdef PROBE_ATT
    if (IN(4)) { MK_ARGS;
        unsigned long long* MREF = (unsigned long long*)(args.ws + WS_END); bf16* OREF = (bf16*)(args.ws + WS_END + 2 * MiB);
        for (int pr = vcu; pr < 4096; pr += G) { const int row = pr < 2048 ? pr : 31 * SEQ + (pr - 2048); simple_select_row(lds, row, MREF + (size_t)pr * 32, QI, SM, KI, cache_ik); }
        GBAR();
        for (long t = gtid; t < 4096L * 64; t += GT) { const int dc = (int)(t & 7), h = (int)((t >> 3) & 7); const int pr = (int)(t >> 6); const int row = pr < 2048 ? pr : 31 * SEQ + (pr - 2048);
            simple_attn_task(row, h, dc, MREF + (size_t)pr * 32, QB, KBc, VBc, cache_k, cache_v, k_sample, v_sample, rel_bias, OREF + (size_t)pr * 1024 + h * 128 + dc * 16); }
        GBAR();
    }
#endif
    if (IN(4)) { MK_ARGS;
        {
            char* alds = (char*)lds_raw;
            for (int bh = vcu; bh < BATCH * 8; bh += G) {
                const int b = bh >> 3, h = bh & 7;
                if (tid < 320) ((float*)(alds + at2::BT_OFF))[tid] = rel_bias[t5b(tid - 256) * 8 + h] * (1.0f / at2::SCALE);
                const float cfar = __int_as_float(__builtin_amdgcn_readfirstlane(__float_as_int(rel_bias[15 * 8 + h] * (1.0f / at2::SCALE))));
                at2::Ctx C;
                C.Q = __builtin_amdgcn_make_buffer_rsrc((void*)(QB + (size_t)b * SEQ * 1024 + h * 128), (short)0, SEQ * 1024 * 2, 0x00020000);
                C.K = __builtin_amdgcn_make_buffer_rsrc((void*)(KBc + (size_t)b * SEQ * 1024 + h * 128), (short)0, SEQ * 1024 * 2, 0x00020000);
                C.V = __builtin_amdgcn_make_buffer_rsrc((void*)(VBc + (size_t)b * SEQ * 1024 + h * 128), (short)0, SEQ * 1024 * 2, 0x00020000);
                C.M = __builtin_amdgcn_make_buffer_rsrc((void*)(MASK + (size_t)b * SEQ * 32), (short)0, SEQ * 32 * 8, 0x00020000);
                C.O = C.Q;
#if (DUPMASK >> 4) & 1
                for (int dry_ = 1; dry_ >= 0; --dry_) { C.O = dry_ ? __builtin_amdgcn_make_buffer_rsrc((void*)(args.ws + WS_HA), (short)0, SEQ * 1024 * 2, 0x00020000) : C.Q;
#endif
                at2::Seam S; at2::dsa_prime(C, 0, alds, S);
                for (int u = 0; u < 8; ++u) at2::dsa_block(C, u * 256, (u < 7 ? u + 1 : u) * 256, alds, S, cfar);
#if (DUPMASK >> 4) & 1
                }
#endif
            }
        }
#ifdef PROBE_SAMP
        { unsigned long long* MREF = (unsigned long long*)(args.ws + WS_END); bf16* OREF = (bf16*)(args.ws + WS_END + 2 * MiB);
          for (int row = NTP + vcu; row < NTOK; row += G) simple_select_row(lds, row, MREF + (size_t)(row - NTP) * 40, QI, SM, KI, cache_ik);
          GBAR();
          for (long t = gtid; t < (long)NTS * 64; t += GT) { const int dc = (int)(t & 7), h = (int)((t >> 3) & 7); const int pr = (int)(t >> 6);
              simple_attn_task(NTP + pr, h, dc, MREF + (size_t)pr * 40, QB, KBc, VBc, cache_k, cache_v, k_sample, v_sample, rel_bias, OREF + (size_t)pr * 1024 + h * 128 + dc * 16); }
          GBAR(); }
#endif
        for (int pr = vcu; pr < NTS; pr += G) { const int b = pr / DEC_SEQ, r = pr % DEC_SEQ;
            sample_attn_row(lds, b, r, MASKS + (size_t)pr * 40, OB + (size_t)(NTP + pr) * 1024, cache_k, cache_v, k_sample + (size_t)b * DEC_SEQ * 1024, v_sample + (size_t)b * DEC_SEQ * 1024, rel_bias); }
        GBAR();
#ifdef PROBE_SAMP
        { const unsigned long long* MREF = (const unsigned long long*)(args.ws + WS_END); const bf16* OREF = (const bf16*)(args.ws + WS_END + 2 * MiB); float num = 0.f, den = 0.f, dif = 0.f;
          for (long t = gtid; t < (long)NTS * 1024; t += GT) { const float a = bf2f(OB[(size_t)NTP * 1024 + t]), r_ = bf2f(OREF[t]); num += (a - r_) * (a - r_); den += r_ * r_; }
          for (long t = gtid; t < (long)NTS * 33; t += GT) { const int pr = (int)(t / 33), w = (int)(t % 33); dif += (float)__builtin_popcountll(MASKS[(size_t)pr * 40 + w] ^ MREF[(size_t)pr * 40 + w]); }
          num = wave_sum(num); den = wave_sum(den); dif = wave_sum(dif);
          if (lane == 0) { atomicAdd((float*)(args.ws + WS_CTL) + 8, num); atomicAdd((float*)(args.ws + WS_CTL) + 9, den); atomicAdd((float*)(args.ws + WS_CTL) + 10, dif); }
          GBAR(); }
#endif
    }
#ifdef PROBE_ATT
    if (IN(4)) { MK_ARGS;
        const bf16* OREF = (const bf16*)(args.ws + WS_END + 2 * MiB); float num = 0.f, den = 0.f;
        for (long t = gtid; t < 4096L * 1024; t += GT) { const int pr = (int)(t >> 10), c = (int)(t & 1023); const int row = pr < 2048 ? pr : 31 * SEQ + (pr - 2048);
            const float a = bf2f(OB[(size_t)row * 1024 + c]), r = bf2f(OREF[t]); num += (a - r) * (a - r); den += r * r; }
        num = wave_sum(num); den = wave_sum(den);
        if (lane == 0) { atomicAdd((float*)(args.ws + WS_CTL) + 8, num); atomicAdd((float*)(args.ws + WS_CTL) + 9, den); }
        GBAR();
    }
#endif
    if (IN(5))
#if (DUPMASK >> 5) & 1
    for (int rep_ = 0; rep_ < 2; ++rep_)
#endif
    { MK_ARGS;
        pg8::Gemm g{XB, WMRG, NTOK, N_M1A, 1024}; pg8::StaticOrder S; S.init(NTOK, N_M1A, G, (int)blockIdx.x);
        pg8::EpiM1a E{HA, OB, HST, a_norm_g, BR};
        pg8::gemm_phase<pg8::EpiM1a, pg8::StaticOrder, true, true>(lds + RING_OFF, g, S, E);
        GBAR();
    }
    if (IN(6))
#if (DUPMASK >> 6) & 1
    for (int rep_ = 0; rep_ < 2; ++rep_)
#endif
    { MK_ARGS;
        pg8::Gemm g{XB, WMRG + (size_t)N_M1A * 1024, NTOK, N_M1B, 1024}; pg8::StaticOrder S; S.init(NTOK, N_M1B, G, (int)blockIdx.x);
        pg8::EpiM1b E{SGA, SGB};
        pg8::gemm_phase<pg8::EpiM1b, pg8::StaticOrder, true, true>(lds + RING_OFF, g, S, E);
        GBAR();
    }
    if (IN(7))
#if (DUPMASK >> 7) & 1
    for (int rep_ = 0; rep_ < 2; ++rep_)
#endif
    { MK_ARGS;
        pg8::Gemm g{BR, WAB, NTOK, 1024, 2048}; pg8::StaticOrder S; S.init(NTOK, 1024, G, (int)blockIdx.x);
        pg8::EpiM2 E{SGA, SGB, MX};
        pg8::gemm_phase<pg8::EpiM2, pg8::StaticOrder, true, true>(lds + RING_OFF, g, S, E);
        GBAR();
    }
    if (IN(8))
#if (DUPMASK >> 8) & 1
    for (int rep_ = 0; rep_ < 2; ++rep_)
#endif
    { MK_ARGS;
        pg8::Gemm g{MX, WO, NTOK, 1024, 1024}; pg8::StaticOrder S; S.init(NTOK, 1024, G, (int)blockIdx.x);
        pg8::EpiM3 E{args.in[0], args.in[1], y_prompt, y_sample};
        pg8::gemm_phase<pg8::EpiM3, pg8::StaticOrder, true, true>(lds + RING_OFF, g, S, E);
        GBAR();
    }
    if (IN(9))
#if (DUPMASK >> 9) & 1
    for (int rep_ = 0; rep_ < 2; ++rep_)
#endif
    { MK_ARGS;
        for (int m0 = gw * 2; m0 < NTOK; m0 += NGW * 2) {
            GAS f32x4* yv[2]; f32x4 v[2][4]; float sm_[2] = {0.f, 0.f};
#pragma unroll
            for (int q = 0; q < 2; ++q) { const int m = m0 + q; float* yr = m < NTP ? y_prompt + (size_t)m * 1024 : y_sample + (size_t)(m - NTP) * 1024; yv[q] = (GAS f32x4*)yr + lane;
#pragma unroll
                for (int j = 0; j < 4; ++j) v[q][j] = yv[q][64 * j]; }
#pragma unroll
            for (int q = 0; q < 2; ++q) {
#pragma unroll
                for (int j = 0; j < 4; ++j) sm_[q] += (v[q][j].x + v[q][j].y) + (v[q][j].z + v[q][j].w);
                const float mean = wave_sum(sm_[q]) * (1.f / 1024.f); float s2 = 0.f;
#pragma unroll
                for (int j = 0; j < 4; ++j) { v[q][j] = v[q][j] - mean; s2 += (v[q][j].x * v[q][j].x + v[q][j].y * v[q][j].y) + (v[q][j].z * v[q][j].z + v[q][j].w * v[q][j].w); }
                const float rstd = 1.f / sqrtf(wave_sum(s2) * (1.f / 1024.f) + LN_EPS);
#pragma unroll
                for (int j = 0; j < 4; ++j) { const f32x4 gg = *((const GAS f32x4*)ln_g + lane + 64 * j), bb = *((const GAS f32x4*)ln_b + lane + 64 * j); yv[q][64 * j] = v[q][j] * rstd * gg + bb; } }
        }
    }
#if defined(PROBE_ATT) || defined(PROBE_ML) || defined(PROBE_SAMP)
    { MK_ARGS; GBAR();
      if (blockIdx.x == 0 && threadIdx.x < 64) { const float num = ((volatile float*)(args.ws + WS_CTL))[8], den = ((volatile float*)(args.ws + WS_CTL))[9];
          const float dif = ((volatile float*)(args.ws + WS_CTL))[10];
          m_sample[threadIdx.x] *= 1.0f + 30.0f * (sqrtf(num / den) + dif / (float)(NTS * TOPK_MAX)); } }
#endif
#undef IN
#undef GBAR
#undef args
#undef gtid
#undef GT
#undef gw
#undef NGW
#undef tid
#undef lane
#undef wave
#undef G
#undef vcu
}

extern "C" void kernel_launch(void* const* d_in, const int* in_sizes, int n_in, void* d_out, int out_size, void* d_ws, size_t ws_size, hipStream_t stream) {
    static int grid = 0;
    if (grid == 0) {
        int dev = 0, cus = 0;
        if (hipGetDevice(&dev) != hipSuccess || hipDeviceGetAttribute(&cus, hipDeviceAttributeMultiprocessorCount, dev) != hipSuccess) { grid = -1; return; }
        if (hipFuncSetAttribute((const void*)mk_fwd, hipFuncAttributeMaxDynamicSharedMemorySize, LDS_BYTES) != hipSuccess) { grid = -1; return; }
        (void)hipGetLastError();
        if (n_in != 17 || ws_size < WS_END) { fprintf(stderr, "kernel_launch: needs 17 inputs and %zu bytes of workspace (got %d, %zu)\n", (size_t)WS_END, n_in, ws_size); grid = -1; return; }
        grid = cus;
    }
    if (grid < 0) return;
    if (hipMemsetAsync((unsigned char*)d_ws + WS_CTL, 0, CTL_ZERO_BYTES, stream) != hipSuccess) return;
    Args a{};
    for (int i = 0; i < 17; ++i) a.in[i] = (const float*)d_in[i];
    a.out = (float*)d_out; a.ws = (unsigned char*)d_ws; a.ph_lo = 0; a.ph_hi = 10;
    hipLaunchKernelGGL(mk_fwd, dim3(grid), dim3(NWAVES * 64), LDS_BYTES, stream, a);
}
```

```cpp
#include <hip/hip_runtime.h>
#include <cstdio>
#include <cstdint>
#include <math.h>
#ifndef D_MODEL
#define D_MODEL 1024
#define BATCH 32
#define SEQ 2048
#define DEC_BATCH 16
#define DEC_SEQ 32
#define PAST_LEN 2048
#define CHUNK 64
#define A_HEADS 4
#define A_HEAD_DIM 256
#define B_HEADS 8
#define B_HEAD_DIM 128
#define IDX_HEADS 8
#define IDX_DIM 64
#define TOPK_MAX 256
#define GROUP_B 4
#endif
#define A_WIDTH (A_HEADS * A_HEAD_DIM)
#define B_WIDTH (B_HEADS * B_HEAD_DIM)
#define C_QA 0
#define C_KA (C_QA + A_WIDTH)
#define C_VA (C_KA + A_WIDTH)
#define C_OA (C_VA + A_WIDTH)
#define C_ZA (C_OA + A_WIDTH)
#define C_IA (C_ZA + A_WIDTH)
#define C_FA (C_IA + A_HEADS)
#define C_QB (C_FA + A_HEADS)
#define C_KB (C_QB + B_WIDTH)
#define C_VB (C_KB + B_WIDTH)
#define C_ZB (C_VB + B_WIDTH)
#define C_QI (C_ZB + B_WIDTH)
#define C_KI (C_QI + IDX_HEADS * IDX_DIM)
#define C_WI (C_KI + IDX_DIM)
#define C_GA (C_WI + IDX_HEADS)
#define C_GB (C_GA + D_MODEL)
#define IN_COLS (C_GB + D_MODEL)
#define LN_EPS 1e-5f
#define HEAD_NORM_EPS 1e-6f
#define DN_ALPHA 1.189207115002721f


#define GAS __attribute__((address_space(1)))
#define LAS __attribute__((address_space(3)))
typedef unsigned short bf16;
typedef unsigned v4u __attribute__((ext_vector_type(4)));
typedef float f32x4 __attribute__((ext_vector_type(4)));
typedef short bf16x8 __attribute__((ext_vector_type(8)));
typedef GAS unsigned gu32;
typedef GAS unsigned long long gu64;
#define RLX_AGENT __ATOMIC_RELAXED, __HIP_MEMORY_SCOPE_AGENT
#define LDS_WAIT() asm volatile("s_waitcnt lgkmcnt(0)" ::: "memory")
#define VM_WAIT() asm volatile("s_waitcnt vmcnt(0)" ::: "memory")
__device__ __forceinline__ unsigned long long rt() { return __builtin_amdgcn_s_memrealtime(); }
__device__ __forceinline__ unsigned f2bf(float f) { unsigned u = __builtin_bit_cast(unsigned, f); return (u + 0x7fffu + ((u >> 16) & 1u)) >> 16; }
__device__ __forceinline__ unsigned pk2(float lo, float hi) { return f2bf(lo) | (f2bf(hi) << 16); }

#define XB_TMO      128
#define XB_XCNT(j)  (256  + 64 * (j))
#define XB_XSUB(j)  (1280 + 64 * (j))
#define XB_XGEN(j)  (2304 + 64 * (j))
#define XB_TOP      3328
#define XB_TOPGEN   3392
#define XCD_BAR_WORDS 3456
#define XB_SPIN_CAP (1u << 18)

__device__ __forceinline__ unsigned xb_ld(unsigned* p)              { return __hip_atomic_load(p, __ATOMIC_RELAXED, __HIP_MEMORY_SCOPE_AGENT); }
__device__ __forceinline__ unsigned xb_add(unsigned* p, unsigned v) { return __hip_atomic_fetch_add(p, v, __ATOMIC_RELAXED, __HIP_MEMORY_SCOPE_AGENT); }
__device__ __forceinline__ unsigned xb_xcc_id() { return (unsigned)__builtin_amdgcn_s_getreg((3 << 11) | 20) & 0xFu; }
#define XB_SPIN(cond, bar) do { unsigned _sp = 0; while (cond) { __builtin_amdgcn_s_sleep(1); \
    if ((++_sp & 255u) == 0u) { if (xb_ld(&(bar)[XB_TMO])) break; if (_sp > XB_SPIN_CAP) { atomicAdd(&(bar)[XB_TMO], 1u); break; } } } } while (0)

struct XcdBarrier {
    unsigned* bar; unsigned x;
    volatile LAS unsigned* st;
};

__device__ __forceinline__ XcdBarrier xcd_barrier_post(unsigned* bar, volatile LAS unsigned* st) {
    XcdBarrier b; b.bar = bar; b.x = xb_xcc_id(); b.st = st;
    if (threadIdx.x == 0) (void)xb_add(&bar[XB_XCNT(b.x)], 1u);
    return b;
}
__device__ __forceinline__ void xcd_barrier_complete(unsigned* bar, unsigned x, unsigned& nloc, unsigned& nx) {
    const unsigned G = gridDim.x * gridDim.y * gridDim.z;
    unsigned sum, cnt, mine, sp = 0u;
    for (;;) {
        sum = 0u; cnt = 0u; mine = 0u;
#pragma unroll
        for (unsigned j = 0; j < 16; ++j) { const unsigned c = xb_ld(&bar[XB_XCNT(j)]); sum += c; cnt += (c > 0u) ? 1u : 0u; mine = (j == x) ? c : mine; }
        if (sum == G) break;
        __builtin_amdgcn_s_sleep(1);
        if ((++sp & 255u) == 0u) { if (xb_ld(&bar[XB_TMO])) break; if (sp > XB_SPIN_CAP) { atomicAdd(&bar[XB_TMO], 1u); break; } }
    }
    nloc = mine > 0u ? mine : 1u; nx = cnt > 0u ? cnt : 1u;
}

__device__ __forceinline__ void xcd_barrier(const XcdBarrier& b) {
    asm volatile("s_waitcnt vmcnt(0)" ::: "memory");
    __syncthreads();
    if (threadIdx.x == 0) {
        unsigned* bar = b.bar;
        __builtin_amdgcn_s_waitcnt(0);
        unsigned nloc = b.st[0], nx = b.st[1];
        if (nloc == 0u) { xcd_barrier_complete(bar, b.x, nloc, nx); b.st[0] = nloc; b.st[1] = nx; }
        const unsigned old = xb_add(&bar[XB_XSUB(b.x)], 1u);
        const unsigned gen = old / nloc;
        if (old + 1u == (gen + 1u) * nloc) {
            __builtin_amdgcn_fence(__ATOMIC_RELEASE, "agent");
            asm volatile("s_waitcnt vmcnt(0)" ::: "memory");
            const unsigned og = xb_add(&bar[XB_TOP], 1u);
            const unsigned tg = og / nx;
            if (og + 1u == (tg + 1u) * nx) xb_add(&bar[XB_TOPGEN], 1u);
            else XB_SPIN(xb_ld(&bar[XB_TOPGEN]) == tg, bar);
            __builtin_amdgcn_fence(__ATOMIC_ACQUIRE, "agent");
            xb_add(&bar[XB_XGEN(b.x)], 1u);
            asm volatile("s_waitcnt vmcnt(0)" ::: "memory");
        } else {
            XB_SPIN(xb_ld(&bar[XB_XGEN(b.x)]) == gen, bar);
            __builtin_amdgcn_fence(__ATOMIC_ACQUIRE, "agent");
            asm volatile("s_waitcnt vmcnt(0)" ::: "memory");
        }
    }
    __syncthreads();
}

namespace pg8 {
#define PG8_LAS __attribute__((address_space(3)))
typedef unsigned short bf16_t;
typedef short bf16x8 __attribute__((ext_vector_type(8)));
typedef float f32x4 __attribute__((ext_vector_type(4)));
typedef unsigned u32x4 __attribute__((ext_vector_type(4)));
constexpr int BM = 256, BK = 64, HALF = 128, HTB = HALF * BK * 2  , STAGE_BYTES = 8 * HTB, NXCD = 8, WGM = 8;

__host__ __device__ __forceinline__ int lds_byte(int r, int c) { const int st = (r >> 4) * 2 + (c >> 5), rr = r & 15, cc = c & 31, ob = rr * 64 + cc * 2; return st * 1024 + (ob ^ (((ob >> 9) & 1) << 5)); }
__host__ __device__ __forceinline__ void stage_rc(int b, int& R, int& C) { const int st = b / 1024, sb = b % 1024, swz = sb ^ (((sb >> 9) & 1) << 5); R = (st >> 1) * 16 + swz / 64; C = (st & 1) * 32 + (swz % 64) / 2; }
__host__ __device__ __forceinline__ int perm32(int rho) { const int n = rho >> 4, i = rho & 15; return 8 * (i >> 2) + 4 * n + (i & 3); }

struct Unit { int pm, pn; };
struct Gemm { const bf16_t* A; const bf16_t* Bt; int M, N, K; };

struct StaticOrder {
    int nM, nN, nwg, G, c;
    __host__ __device__ void init(int M, int N, int G_, int c_) { nM = M / BM; nN = N / BM; nwg = nM * nN; G = G_; c = c_; }
    __host__ __device__ bool next(int i, Unit& u) const {
        const long L = (long)i * G + c; if (L >= nwg) return false;
        int wgid = (int)L; { const int q = nwg / NXCD, r = nwg % NXCD, xcd = wgid % NXCD, off = wgid / NXCD; wgid = (xcd < r ? xcd * (q + 1) : r * (q + 1) + (xcd - r) * q) + off; }
        const int nig = WGM * nN, gid = wgid / nig, fm = gid * WGM, gsz = (nM - fm) < WGM ? (nM - fm) : WGM;
        u.pm = fm + ((wgid % nig) % gsz); u.pn = (wgid % nig) / gsz; return true;
    }
    __device__ __forceinline__ void a_ready(const Unit&) const {}
    __device__ __forceinline__ void done(const Unit&) const {}
};
__device__ __forceinline__ unsigned cvt_pk_bf16(float lo, float hi) { unsigned r; asm volatile("v_cvt_pk_bf16_f32 %0, %1, %2" : "=v"(r) : "v"(lo), "v"(hi)); return r; }
typedef float f32x2 __attribute__((ext_vector_type(2)));
template <class Epi, class Sched, bool ALIGN_EPI = false, bool SP2 = false>
__device__ __forceinline__ void gemm_phase(PG8_LAS unsigned char* lds, const Gemm g, const Sched& S, const Epi& E) {
    const int tid = threadIdx.x, wid = __builtin_amdgcn_readfirstlane(tid >> 6), lane = tid & 63, wr = wid >> 2, wc = wid & 3, fr = lane & 15, fq = lane >> 4;
    const int K = g.K, nt = K / BK;
    unsigned voffA[2], voffB[2];
#pragma unroll
    for (int i = 0; i < 2; ++i) { int R, C; stage_rc(tid * 16 + i * 8192, R, C); const int Rb = Epi::PERM ? ((R & ~31) + perm32(R & 31)) : R;
        voffA[i] = (unsigned)(R * K + C) * 2u; voffB[i] = (unsigned)(Rb * K + C) * 2u; }
    const size_t kstep = (size_t)(BK * 2);
    const size_t hstep = (size_t)HALF * K * 2;
    const size_t tstep = 2 * hstep;
    const unsigned ldsw = (unsigned)wid * 1024u;
    const int aoff = lds_byte(wr * 64 + fr, fq * 8), boff = lds_byte(wc * 32 + fr, fq * 8);
#define PG8_SA(b, h) (((b) * 2 + (h)) * HTB)
#define PG8_SB(b, h) ((4 + (b) * 2 + (h)) * HTB)
#define PG8_STAGE(bufoff, gbase, voff) do { _Pragma("unroll") for (int _i = 0; _i < 2; ++_i) \
        __builtin_amdgcn_global_load_lds((const unsigned*)((const char*)(gbase) + (voff)[_i]), (PG8_LAS unsigned*)(lds + (bufoff) + ldsw + _i * 8192), 16, 0, 0); } while (0)
#define PG8_LDA(dst, b, h) do { _Pragma("unroll") for (int m = 0; m < 4; ++m) _Pragma("unroll") for (int k = 0; k < 2; ++k) dst[m][k] = *(const PG8_LAS bf16x8*)(lds + PG8_SA(b, h) + aoff + m * 2048 + k * 1024); } while (0)
#define PG8_LDB(dst, b, h) do { _Pragma("unroll") for (int n = 0; n < 2; ++n) _Pragma("unroll") for (int k = 0; k < 2; ++k) dst[n][k] = *(const PG8_LAS bf16x8*)(lds + PG8_SB(b, h) + boff + n * 2048 + k * 1024); } while (0)
#define PG8_MMA(ai, bj, At, Bt) do { __builtin_amdgcn_s_setprio(1); _Pragma("unroll") for (int m = 0; m < 4; ++m) _Pragma("unroll") for (int n = 0; n < 2; ++n) _Pragma("unroll") for (int k = 0; k < 2; ++k) \
        acc[ai][bj][m][n] = __builtin_amdgcn_mfma_f32_16x16x32_bf16(Bt[n][k], At[m][k], acc[ai][bj][m][n], 0, 0, 0); __builtin_amdgcn_s_setprio(0); } while (0)
#define PG8_WAIT_V(n) asm volatile("s_waitcnt vmcnt(" #n ")" ::: "memory")
#define PG8_WAIT_L(n) asm volatile("s_waitcnt lgkmcnt(" #n ")" ::: "memory")
#define PG8_BAR __builtin_amdgcn_s_barrier()
#define PG8_SCHED __builtin_amdgcn_sched_barrier(0)
    Unit cur, nxt; int ui = 0;
    if (!S.next(0, cur)) return;
    f32x4 acc[2][2][4][2];
#pragma unroll
    for (int a = 0; a < 2; ++a)
#pragma unroll
        for (int b = 0; b < 2; ++b)
#pragma unroll
            for (int m = 0; m < 4; ++m)
#pragma unroll
                for (int n = 0; n < 2; ++n) acc[a][b][m][n] = (f32x4){0.f, 0.f, 0.f, 0.f};
    bf16x8 At[4][2], B0[2][2], B1[2][2];
    const char* cA = (const char*)g.A + (size_t)cur.pm * tstep; const char* cB = (const char*)g.Bt + (size_t)cur.pn * tstep;
    S.a_ready(cur);
    if constexpr (SP2) {
        PG8_STAGE(PG8_SB(0, 0), cB, voffB); PG8_STAGE(PG8_SB(0, 1), cB + hstep, voffB); PG8_STAGE(PG8_SA(0, 0), cA, voffA); PG8_STAGE(PG8_SA(0, 1), cA + hstep, voffA);
        if (wr == 1) PG8_BAR;
        PG8_WAIT_V(2); PG8_BAR;
        PG8_STAGE(PG8_SB(1, 0), cB + kstep, voffB); PG8_STAGE(PG8_SA(1, 0), cA + kstep, voffA); PG8_STAGE(PG8_SB(1, 1), cB + hstep + kstep, voffB);
        PG8_WAIT_V(6); PG8_BAR;
    } else {
        PG8_STAGE(PG8_SB(0, 0), cB, voffB); PG8_STAGE(PG8_SA(0, 0), cA, voffA); PG8_STAGE(PG8_SB(0, 1), cB + hstep, voffB); PG8_STAGE(PG8_SA(0, 1), cA + hstep, voffA);
        if (wr == 1) PG8_BAR;
        PG8_WAIT_V(4); PG8_BAR;
        PG8_STAGE(PG8_SB(1, 0), cB + kstep, voffB); PG8_STAGE(PG8_SA(1, 0), cA + kstep, voffA); PG8_STAGE(PG8_SB(1, 1), cB + hstep + kstep, voffB);
        PG8_WAIT_V(6); PG8_BAR;
    }
    for (;;) {
        const bool has_next = S.next(ui + 1, nxt);
        const char* nA = has_next ? (const char*)g.A + (size_t)nxt.pm * tstep : cA; const char* nB = has_next ? (const char*)g.Bt + (size_t)nxt.pn * tstep : cB;
        for (int t = 0; t < nt; t += 2) {
            const bool last = (t == nt - 2);
            const char* a1 = cA + (size_t)(t + 1) * kstep;
            const char* a2 = last ? nA : cA + (size_t)(t + 2) * kstep; const char* b2 = last ? nB : cB + (size_t)(t + 2) * kstep;
            const char* a3 = a2 + kstep; const char* b3 = b2 + kstep;
            if (last && has_next) S.a_ready(nxt);
            if constexpr (Epi::MIDK) { if (t == nt / 2) E.mid(acc, cur, wr, wc, fr, fq); }
            if constexpr (SP2) {
            PG8_LDB(B0, 0, 0); PG8_LDB(B1, 0, 1); PG8_SCHED; PG8_LDA(At, 0, 0); PG8_STAGE(PG8_SA(1, 1), a1 + hstep, voffA);
            PG8_WAIT_V(8); PG8_WAIT_L(0); PG8_BAR; PG8_MMA(0, 0, At, B0); PG8_MMA(0, 1, At, B1); PG8_BAR; PG8_SCHED;
            PG8_LDA(At, 0, 1); PG8_STAGE(PG8_SB(0, 0), b2, voffB); PG8_STAGE(PG8_SB(0, 1), b2 + hstep, voffB); PG8_STAGE(PG8_SA(0, 0), a2, voffA);
            PG8_WAIT_V(8); PG8_WAIT_L(0); PG8_BAR; PG8_MMA(1, 0, At, B0); PG8_MMA(1, 1, At, B1); PG8_BAR; PG8_SCHED;
            PG8_LDB(B0, 1, 0); PG8_LDB(B1, 1, 1); PG8_SCHED; PG8_LDA(At, 1, 0); PG8_STAGE(PG8_SA(0, 1), a2 + hstep, voffA);
            PG8_WAIT_V(8); PG8_WAIT_L(0); PG8_BAR; PG8_MMA(0, 0, At, B0); PG8_MMA(0, 1, At, B1); PG8_BAR; PG8_SCHED;
            PG8_LDA(At, 1, 1); PG8_STAGE(PG8_SB(1, 0), b3, voffB); PG8_STAGE(PG8_SB(1, 1), b3 + hstep, voffB); PG8_STAGE(PG8_SA(1, 0), a3, voffA);
            PG8_WAIT_V(8); PG8_WAIT_L(0); PG8_BAR; PG8_MMA(1, 0, At, B0); PG8_MMA(1, 1, At, B1); PG8_BAR; PG8_SCHED;
            } else {
            PG8_LDB(B0, 0, 0); PG8_SCHED; PG8_LDA(At, 0, 0); PG8_STAGE(PG8_SA(1, 1), a1 + hstep, voffA);
            PG8_WAIT_L(8); PG8_BAR; PG8_WAIT_L(0); PG8_MMA(0, 0, At, B0); PG8_BAR; PG8_SCHED;
            PG8_LDB(B1, 0, 1); PG8_STAGE(PG8_SB(0, 0), b2, voffB);
            PG8_BAR; PG8_WAIT_L(0); PG8_MMA(0, 1, At, B1); PG8_BAR;
            PG8_LDA(At, 0, 1); PG8_STAGE(PG8_SA(0, 0), a2, voffA);
            PG8_BAR; PG8_WAIT_L(0); PG8_MMA(1, 0, At, B0); PG8_BAR; PG8_SCHED;
            PG8_STAGE(PG8_SB(0, 1), b2 + hstep, voffB);
            PG8_WAIT_V(6); PG8_BAR; PG8_MMA(1, 1, At, B1); PG8_BAR;
            PG8_LDB(B0, 1, 0); PG8_SCHED; PG8_LDA(At, 1, 0); PG8_STAGE(PG8_SA(0, 1), a2 + hstep, voffA);
            PG8_WAIT_L(8); PG8_BAR; PG8_WAIT_L(0); PG8_MMA(0, 0, At, B0); PG8_BAR; PG8_SCHED;
            PG8_LDB(B1, 1, 1); PG8_STAGE(PG8_SB(1, 0), b3, voffB);
            PG8_BAR; PG8_WAIT_L(0); PG8_MMA(0, 1, At, B1); PG8_BAR;
            PG8_LDA(At, 1, 1); PG8_STAGE(PG8_SA(1, 0), a3, voffA);
            PG8_BAR; PG8_WAIT_L(0); PG8_MMA(1, 0, At, B0); PG8_BAR; PG8_SCHED;
            PG8_STAGE(PG8_SB(1, 1), b3 + hstep, voffB);
            PG8_WAIT_V(6); PG8_BAR; PG8_MMA(1, 1, At, B1); PG8_BAR;
            }
        }
        if constexpr (ALIGN_EPI) { if (wr == 0) PG8_BAR; }
        if constexpr (!Epi::AFTER_DRAIN) { E(acc, cur, wr, wc, fr, fq); S.done(cur); }
        if (!has_next) break;
#pragma unroll
        for (int a = 0; a < 2; ++a)
#pragma unroll
            for (int b = 0; b < 2; ++b)
#pragma unroll
                for (int m = 0; m < 4; ++m)
#pragma unroll
                    for (int n = 0; n < 2; ++n) acc[a][b][m][n] = (f32x4){0.f, 0.f, 0.f, 0.f};
        cur = nxt; cA = nA; cB = nB; ++ui;
        if constexpr (ALIGN_EPI) { if (wr == 1) PG8_BAR; }
    }
    PG8_WAIT_V(0);
    if constexpr (!ALIGN_EPI) { if (wr == 0) PG8_BAR; }
    PG8_BAR;
    if constexpr (Epi::AFTER_DRAIN) { E.fused(acc, cur, wr, wc, fr, fq, lds, wid, lane); S.done(cur); }
#undef PG8_SA
#undef PG8_SB
#undef PG8_STAGE
#undef PG8_LDA
#undef PG8_LDB
#undef PG8_MMA
#undef PG8_WAIT_V
#undef PG8_WAIT_L
#undef PG8_BAR
#undef PG8_SCHED
}
}

namespace at2 {
constexpr float SCALE = 0.08838834764831845f;
constexpr float THR = 8.f;
constexpr int NW = 8, QBLK = 32, KVBLK = 64, QB = NW * QBLK, D = 128, PITCH = 1024;
constexpr int SHM_V = KVBLK * D * 2, SHM_K = KVBLK * D * 2;
constexpr int BT_OFF = 2 * SHM_V + 2 * SHM_K + NW * 64 * 4;
constexpr int LDS_BYTES = BT_OFF + 320 * 4;
typedef short bf16x8 __attribute__((ext_vector_type(8)));
typedef short s16x4 __attribute__((ext_vector_type(4)));
typedef float f32x16 __attribute__((ext_vector_type(16)));
typedef float f32x4 __attribute__((ext_vector_type(4)));
typedef unsigned u32x4 __attribute__((ext_vector_type(4)));
typedef unsigned short bf16;

#define KSWZ(row, colB) ((row) * 256 + ((colB) ^ (((row) & 7) << 4)))
#define SBAR() __builtin_amdgcn_sched_barrier(0)
__device__ __forceinline__ int v_st(int k, int c) { const int kk = (k & ~0xC) | ((k & 4) << 1) | ((k & 8) >> 1); return ((kk >> 3) * 4 + (c >> 5)) * 512 + ((kk & 7) * 32 + (c & 31)) * 2; }
__device__ __forceinline__ int v_rd_base(int lane) { return ((lane & 3) << 3) | (((lane >> 2) & 3) << 6) | (((lane >> 4) & 1) << 5) | (((lane >> 5) & 1) << 8); }
constexpr int v_rd_off(int d0, int ks, int half) { return d0 * 512 + ks * 4096 + half * 2048; }
__device__ __forceinline__ int crow(int r, int hi) { return (r & 3) + 8 * (r >> 2) + 4 * hi; }
__device__ __forceinline__ unsigned cvtpk(float lo, float hi) { unsigned r; asm volatile("v_cvt_pk_bf16_f32 %0, %1, %2" : "=v"(r) : "v"(lo), "v"(hi)); return r; }
__device__ __forceinline__ bf16x8 load8(const bf16* p) { return *reinterpret_cast<const bf16x8*>(p); }

typedef __attribute__((address_space(3))) const float* lds_cf32;
__device__ __forceinline__ unsigned mask_compact(unsigned long long mw, int hi) { return ((unsigned)(mw >> (4 * hi)) & 0x0f0f0f0fu) | (((unsigned)(mw >> (32 + 4 * hi)) & 0x0f0f0f0fu) << 4); }
__device__ __forceinline__ void mask_bias(f32x16& p0, f32x16& p1, unsigned mwc, lds_cf32 bt, int idx0, bool far, float cfar, int hi) {
    const float NEG = -__builtin_inff();
    const unsigned w0 = mwc, w1 = mwc >> 4;
    if (far) {
#pragma unroll
        for (int r = 0; r < 16; ++r) { const int c = (r & 3) + 8 * (r >> 2);
            p0[r] = ((w0 >> c) & 1u) ? p0[r] + cfar : NEG; p1[r] = ((w1 >> c) & 1u) ? p1[r] + cfar : NEG; }
    } else { lds_cf32 b = bt + idx0;
#pragma unroll
        for (int r = 0; r < 16; ++r) { const int c = (r & 3) + 8 * (r >> 2);
            p0[r] = ((w0 >> c) & 1u) ? p0[r] + b[c] : NEG; p1[r] = ((w1 >> c) & 1u) ? p1[r] + b[c + 32] : NEG;
            if ((r & 3) == 3) asm volatile("" ::: "memory"); }
    }
}
__device__ __forceinline__ void partialSM(f32x16& p0, f32x16& p1, float& m_reg, float& mn, float& alpha) {
    float pmax = p0[0]; for (int r = 1; r < 16; ++r) pmax = fmaxf(pmax, p0[r]); for (int r = 0; r < 16; ++r) pmax = fmaxf(pmax, p1[r]);
    { auto rr = __builtin_amdgcn_permlane32_swap(__float_as_uint(pmax), __float_as_uint(pmax), false, false);
      pmax = fmaxf(__uint_as_float(rr[0]), __uint_as_float(rr[1])); }
    constexpr float C2 = 1.4426950408889634f * SCALE;
    if (__builtin_expect(__all((pmax - m_reg) * SCALE <= THR), 1)) { mn = m_reg; alpha = 1.f; }
    else { mn = fmaxf(m_reg, pmax); alpha = __builtin_amdgcn_exp2f((m_reg - mn) * C2); m_reg = mn; }
    const float mnL = -mn * C2;
    for (int r = 0; r < 16; ++r) p0[r] = fmaf(p0[r], C2, mnL); for (int r = 0; r < 16; ++r) p1[r] = fmaf(p1[r], C2, mnL);
    for (int r = 0; r < 16; ++r) p0[r] = __builtin_amdgcn_exp2f(p0[r]);
}
__device__ __forceinline__ void finishSM(f32x16& p0, f32x16& p1, float alpha, float& l_reg, bf16x8& pa0, bf16x8& pa1, bf16x8& pa2, bf16x8& pa3) {
    for (int r = 0; r < 16; ++r) p1[r] = __builtin_amdgcn_exp2f(p1[r]);
    float ps = 0; for (int r = 0; r < 16; ++r) ps += p0[r]; for (int r = 0; r < 16; ++r) ps += p1[r];
    { auto rr = __builtin_amdgcn_permlane32_swap(__float_as_uint(ps), __float_as_uint(ps), false, false);
      ps = __uint_as_float(rr[0]) + __uint_as_float(rr[1]); }
    l_reg = l_reg * alpha + ps;
#define PK4(P, B_, OUT) do { unsigned a0 = cvtpk(P[B_+0], P[B_+1]), a1 = cvtpk(P[B_+2], P[B_+3]);                          \
        unsigned b0 = cvtpk(P[B_+4], P[B_+5]), b1 = cvtpk(P[B_+6], P[B_+7]);                                             \
        auto r0 = __builtin_amdgcn_permlane32_swap(a0, b0, false, false); auto r1 = __builtin_amdgcn_permlane32_swap(a1, b1, false, false); \
        u32x4 w = {r0[0], r1[0], r0[1], r1[1]}; OUT = *reinterpret_cast<bf16x8*>(&w); } while (0)
    PK4(p0, 0, pa0); PK4(p0, 8, pa1); PK4(p1, 0, pa2); PK4(p1, 8, pa3);
#undef PK4
}
template <int KB, bool SK>
__device__ __forceinline__ void qkt(f32x16& p0, f32x16& p1, const char* K_lds, int r32, int hi, const bf16x8* qr, bool act) {
    if (SK && !act) { const float NEG = -__builtin_inff();
#pragma unroll
        for (int r = 0; r < 16; ++r) { p0[r] = NEG; p1[r] = NEG; } return; }
    p0 = f32x16{}; p1 = f32x16{};
    int r32_ = r32, hi_ = hi; asm volatile("" : "+v"(r32_), "+v"(hi_));
    const char* kb[4];
#pragma unroll
    for (int dd = 0; dd < 4; ++dd) kb[dd] = K_lds + KB * SHM_K + KSWZ(r32_, (dd * 16 + hi_ * 8) * 2);
#pragma unroll
    for (int d0 = 0; d0 < 8; ++d0) { const char* a = kb[d0 & 3] + (d0 >> 2) * 128;
        bf16x8 b0 = *reinterpret_cast<const bf16x8*>(a);
        bf16x8 b1 = *reinterpret_cast<const bf16x8*>(a + 32 * 256);
        p0 = __builtin_amdgcn_mfma_f32_32x32x16_bf16(b0, qr[d0], p0, 0, 0, 0);
        p1 = __builtin_amdgcn_mfma_f32_32x32x16_bf16(b1, qr[d0], p1, 0, 0, 0); }
}
template <int VB, bool SK>
__device__ __forceinline__ void pv_tile(f32x16* o, int vb0, bf16x8 pa0, bf16x8 pa1, bf16x8 pa2, bf16x8 pa3, bool act) {
    if (SK && !act) return;
#define TRRD(dst, off) asm volatile("ds_read_b64_tr_b16 %0, %1 offset:%2" : "=&v"(dst) : "v"(vb0), "i"(off) : "memory")
#define PV_D0(d0) do { s16x4 l0, l1, l2, l3, h0, h1, h2, h3; constexpr int b_ = VB * SHM_V + v_rd_off(d0, 0, 0); \
        TRRD(l0, b_); TRRD(h0, b_ + 2048); TRRD(l1, b_ + 4096); TRRD(h1, b_ + 6144); TRRD(l2, b_ + 8192); TRRD(h2, b_ + 10240); TRRD(l3, b_ + 12288); TRRD(h3, b_ + 14336); \
        asm volatile("s_waitcnt lgkmcnt(0)" ::: "memory"); SBAR();   \
        o[d0] = __builtin_amdgcn_mfma_f32_32x32x16_bf16(pa0, (bf16x8){l0[0], l0[1], l0[2], l0[3], h0[0], h0[1], h0[2], h0[3]}, o[d0], 0, 0, 0);   \
        o[d0] = __builtin_amdgcn_mfma_f32_32x32x16_bf16(pa1, (bf16x8){l1[0], l1[1], l1[2], l1[3], h1[0], h1[1], h1[2], h1[3]}, o[d0], 0, 0, 0);   \
        o[d0] = __builtin_amdgcn_mfma_f32_32x32x16_bf16(pa2, (bf16x8){l2[0], l2[1], l2[2], l2[3], h2[0], h2[1], h2[2], h2[3]}, o[d0], 0, 0, 0);   \
        o[d0] = __builtin_amdgcn_mfma_f32_32x32x16_bf16(pa3, (bf16x8){l3[0], l3[1], l3[2], l3[3], h3[0], h3[1], h3[2], h3[3]}, o[d0], 0, 0, 0); } while (0)
    PV_D0(0); PV_D0(1); PV_D0(2); PV_D0(3);
#undef PV_D0
#undef TRRD
}

struct Ctx { __amdgpu_buffer_rsrc_t Q, K, V, M, O; };
typedef unsigned v4u32 __attribute__((ext_vector_type(4))); typedef unsigned v2u32 __attribute__((ext_vector_type(2)));
#define LD16(rs, vo, so) __builtin_bit_cast(bf16x8, __builtin_amdgcn_raw_buffer_load_b128((rs), (int)(vo), (int)(so), 0))
struct Seam { bf16x8 qr[8]; bf16x8 st_v0, st_v1, st_k0, st_k1; };
#define VMW() asm volatile("s_waitcnt vmcnt(0)" ::: "memory")
#define VMWN(n) asm volatile("s_waitcnt vmcnt(%0)" :: "i"(n) : "memory")
#define SLOAD_H(k0) do { S.st_v0 = LD16(C.V, kvoff, (k0) * (PITCH * 2)); S.st_v1 = LD16(C.V, kvoff, ((k0) + 32) * (PITCH * 2));              \
                         S.st_k0 = LD16(C.K, kvoff, (k0) * (PITCH * 2)); S.st_k1 = LD16(C.K, kvoff, ((k0) + 32) * (PITCH * 2)); } while (0)
#define SW_TID int t_ = threadIdx.x; asm volatile("" : "+v"(t_)); const int sr_ = t_ >> 4, sc_ = (t_ & 15) * 8
#define SWRITE_HK(bf) do { SW_TID; const int kws_ = KSWZ(sr_, sc_ * 2); *(bf16x8*)(K_lds + (bf) * SHM_K + kws_) = S.st_k0; *(bf16x8*)(K_lds + (bf) * SHM_K + kws_ + 32 * 256) = S.st_k1; } while (0)
#define SWRITE_HV(bf) do { SW_TID; *(bf16x8*)(V_lds + (bf) * SHM_V + v_st(sr_, sc_)) = S.st_v0; *(bf16x8*)(V_lds + (bf) * SHM_V + v_st(32 + sr_, sc_)) = S.st_v1; } while (0)
#define SWRITE_H(bf) do { SWRITE_HV(bf); SWRITE_HK(bf); } while (0)
__device__ __forceinline__ void dsa_prime(const Ctx& C, int P0, char* lds, Seam& S) {
    int tid = threadIdx.x; asm volatile("" : "+v"(tid));
    const int wid = __builtin_amdgcn_readfirstlane(tid >> 6), lane = tid & 63, r32 = lane & 31, hi = lane >> 5;
    const int sr = tid >> 4, sc = (tid & 15) * 8; char* K_lds = lds + 2 * SHM_V;
    const unsigned kvoff = (unsigned)(sr * PITCH + sc) * 2u, qoff = (unsigned)((wid * QBLK + r32) * PITCH + hi * 8) * 2u;
    for (int d0 = 0; d0 < 8; ++d0) S.qr[d0] = LD16(C.Q, qoff + d0 * 32, P0 * (PITCH * 2));
    SLOAD_H(0); VMW(); SWRITE_HK(0);
    __syncthreads();
}
__device__ __forceinline__ void dsa_block(const Ctx& C, int P0, int P0n, char* lds, Seam& S, float cfar) {
    int tid = threadIdx.x; asm volatile("" : "+v"(tid));
    const int wid = __builtin_amdgcn_readfirstlane(tid >> 6), lane = tid & 63, r32 = lane & 31, hi = lane >> 5;
    const int NT = P0 / KVBLK + QB / KVBLK;
    const int qlo = P0 + wid * QBLK;
    const int limw = ((qlo >> 6) + 1) * 64;
    char* V_lds = lds; char* K_lds = lds + 2 * SHM_V;
    float* wsc = (float*)(lds + 2 * SHM_V + 2 * SHM_K) + wid * 64; float* li_l = wsc, * al_l = wsc + 32;
    lds_cf32 bt = (lds_cf32)((__attribute__((address_space(3))) char*)lds + BT_OFF);
    float m_reg = -1e30f, l_reg = 0; f32x16 o[4] = {};
    const int sr = tid >> 4, sc = (tid & 15) * 8;
    const int vb0 = (int)(uintptr_t)V_lds + v_rd_base(lane);
    const unsigned kvoff = (unsigned)(sr * PITCH + sc) * 2u, qoff = (unsigned)((wid * QBLK + r32) * PITCH + hi * 8) * 2u, moff = (unsigned)((wid * QBLK + r32) * 32) * 8u;
#define MROW(t) mask_compact(__builtin_bit_cast(unsigned long long, __builtin_amdgcn_raw_buffer_load_b64(C.M, (int)moff, (P0 * 32 + (t)) * 8, 0)), hi)
    const int rel0 = 256 + 4 * hi - (qlo + r32);
#define RESC(a) do { if (__any((a) < 1.f)) { if (hi == 0) al_l[r32] = (a); asm volatile("s_waitcnt lgkmcnt(0)" ::: "memory");              \
                     for (int d_ = 0; d_ < 4; ++d_) for (int r = 0; r < 16; ++r) o[d_][r] *= al_l[crow(r, hi)]; } } while (0)
#define KBASE(t) ((t) * KVBLK)
#define ACT(t) (KBASE(t) < limw)
#define MASKT(P0_, P1_, mw_, t) do { const int kb_ = KBASE(t); if (ACT(t)) mask_bias(P0_, P1_, mw_, bt, kb_ + rel0, kb_ + KVBLK - 1 - qlo <= -128, cfar, hi); } while (0)
    constexpr int NQL = 8; constexpr bool SK = true;
#define SEAM_K0() do { VMWN(NQL); SWRITE_HK(0); SBAR(); } while (0)
    f32x16 pA0, pA1, pB0, pB1; float mnA, mnB, alA, alB; bf16x8 pa0, pa1, pa2, pa3; unsigned mw;
    SWRITE_HV(0); SBAR();
    if (NT > 1) SLOAD_H(KBASE(1));
    mw = MROW(0);
    SBAR(); qkt<0, SK>(pA0, pA1, K_lds, r32, hi, S.qr, ACT(0));
    MASKT(pA0, pA1, mw, 0); partialSM(pA0, pA1, m_reg, mnA, alA);
    if (NT > 1) { VMW(); SWRITE_H(1); }
    __syncthreads();
#define HALF_STEP(PX0, PX1, mnX, alX, PY0, PY1, alY, t, KB, VB, SB) do {                                                      \
        SBAR(); mw = MROW(t); qkt<KB, SK>(PX0, PX1, K_lds, r32, hi, S.qr, ACT(t));                                          \
        finishSM(PY0, PY1, alY, l_reg, pa0, pa1, pa2, pa3); SBAR();                                                           \
        if ((t) + 1 < NT) { SLOAD_H(KBASE((t) + 1)); SBAR(); }                                                        \
        pv_tile<VB, SK>(o, vb0, pa0, pa1, pa2, pa3, ACT((t) - 1)); MASKT(PX0, PX1, mw, (t)); partialSM(PX0, PX1, m_reg, mnX, alX); \
        __syncthreads();                                                                                                      \
        if ((t) + 1 < NT) { VMW(); SWRITE_H(SB); }                                                                            \
        RESC(alX); __syncthreads(); } while (0)
    for (int t = 1; t + 1 < NT; t += 2) {
        HALF_STEP(pB0, pB1, mnB, alB, pA0, pA1, alA, t, 1, 0, 0);
        HALF_STEP(pA0, pA1, mnA, alA, pB0, pB1, alB, t + 1, 0, 1, 1);
    }
    const bool even = (NT & 1) == 0;
    if (even) { SBAR(); mw = MROW(NT - 1); qkt<1, SK>(pB0, pB1, K_lds, r32, hi, S.qr, ACT(NT - 1)); SBAR(); }
    SLOAD_H(0); SBAR();
#pragma unroll
    for (int d0 = 0; d0 < 8; ++d0) S.qr[d0] = LD16(C.Q, qoff + d0 * 32, P0n * (PITCH * 2));
    SBAR();
    finishSM(pA0, pA1, alA, l_reg, pa0, pa1, pa2, pa3); SBAR();
    pv_tile<0, SK>(o, vb0, pa0, pa1, pa2, pa3, ACT(even ? NT - 2 : NT - 1));
    if (even) { MASKT(pB0, pB1, mw, NT - 1); partialSM(pB0, pB1, m_reg, mnB, alB); __syncthreads(); RESC(alB);
        finishSM(pB0, pB1, alB, l_reg, pa0, pa1, pa2, pa3); SBAR(); pv_tile<1, SK>(o, vb0, pa0, pa1, pa2, pa3, ACT(NT - 1)); }
    SBAR(); SEAM_K0();
    if (hi == 0) li_l[r32] = l_reg; asm volatile("s_waitcnt lgkmcnt(0)" ::: "memory");
    float rli[16];
#pragma unroll
    for (int r = 0; r < 16; ++r) rli[r] = __builtin_amdgcn_rcpf(li_l[crow(r, hi)]);
    const unsigned ooff = (unsigned)((wid * QBLK + 4 * hi) * PITCH + r32) * 2u;
#pragma unroll
    for (int r = 0; r < 16; ++r) { const int so = (P0 + (r & 3) + 8 * (r >> 2)) * (PITCH * 2);
#pragma unroll
        for (int d0 = 0; d0 < 4; ++d0) { const float v = o[d0][r] * rli[r];
            const float vn = __shfl_xor(v, 1);
            if ((r32 & 1) == 0) __builtin_amdgcn_raw_buffer_store_b32(cvtpk(v, vn), C.O, (int)(ooff + d0 * 64), so, 0); } }
    __syncthreads();
#undef RESC
#undef MROW
#undef KBASE
#undef ACT
#undef MASKT
#undef SEAM_K0
#undef HALF_STEP
}
#undef VMW
#undef VMWN
#undef SLOAD_H
#undef SWRITE_HK
#undef SWRITE_HV
#undef SWRITE_H
#undef SW_TID
#undef KSWZ
#undef SBAR
}

constexpr int NWAVES = 8;
constexpr int NTP = BATCH * SEQ, NTS = DEC_BATCH * DEC_SEQ, NTOK = NTP + NTS;
constexpr int NPM = NTOK / 256;
constexpr int N_MIX = 27 * 256, N_M1A = 12 * 256, N_M1B = 8 * 256;
static_assert(NTP % 256 == 0 && NTS % 256 == 0 && D_MODEL == 1024 && A_WIDTH == 1024 && B_WIDTH == 1024, "geometry");

constexpr size_t MiB = 1u << 20;
constexpr size_t WS_CTL = 0, CTL_ZERO_BYTES = 1 * MiB;
constexpr size_t WS_WMIX = 1 * MiB;
constexpr size_t WS_WMRG = WS_WMIX + 14 * MiB;
constexpr size_t WS_WAB  = WS_WMRG + 10 * MiB;
constexpr size_t WS_WO   = WS_WAB + 4 * MiB;
constexpr size_t WS_XB   = WS_WO + 2 * MiB;
constexpr size_t ROWBUF  = (size_t)NTOK * 1024 * 2;
constexpr size_t WS_QA   = WS_XB + ROWBUF;
constexpr size_t WS_KA   = WS_QA + ROWBUF;
constexpr size_t WS_VA   = WS_KA + ROWBUF;
constexpr size_t WS_QB   = WS_VA + ROWBUF;
constexpr size_t WS_QI   = WS_QB + ROWBUF;
constexpr size_t WS_KI   = WS_QI + 65 * MiB;
constexpr size_t WS_SM   = WS_KI + 9 * MiB;
constexpr size_t WS_MASK = WS_SM + 5 * MiB;
constexpr size_t WS_HST  = WS_MASK + 16 * MiB;
constexpr size_t WS_NAIVE = WS_HST + 3 * MiB;
constexpr size_t WS_NEED = WS_NAIVE;
static_assert(WS_WMIX + (size_t)N_MIX * 1024 * 2 <= WS_WMRG && WS_QI + (size_t)NTOK * 512 * 2 <= WS_KI && WS_KI + (size_t)NTOK * 64 * 2 <= WS_SM && WS_SM + (size_t)NTOK * 64 <= WS_MASK
              && WS_HST + (size_t)NTOK * 32 <= WS_NAIVE, "d_ws map");
constexpr int CW_BAR = 4096;
constexpr int RING_OFF = 0, RING_BYTES = 131072;
constexpr int LDS_BYTES = 147456;
constexpr int LDSCTL_OFF = LDS_BYTES - 512, MISC_OFF = LDSCTL_OFF + 320;

struct Args { const float* in[17]; float* out; unsigned char* ws; int ph_lo, ph_hi; };

__device__ __forceinline__ float bf2f(bf16 v) { return __uint_as_float((unsigned)v << 16); }
__device__ __forceinline__ float sigm(float x) { return 1.0f / (1.0f + __expf(-x)); }

__device__ __forceinline__ void tr_item(const float* W, int ldw, int c0, int nv, int k0, bf16* WT, int ldt, int r0, int kofs, LAS float* scr, int lane) {
    const int n_ = lane & 31;
#pragma unroll 8
    for (int i = 0; i < 32; ++i) { const int kk = 2 * i + (lane >> 5); scr[kk * 33 + n_] = (n_ < nv) ? W[(size_t)(k0 + kk) * ldw + c0 + n_] : 0.f; }
    LDS_WAIT(); asm volatile("" ::: "memory");
    const int c = lane & 7;
#pragma unroll
    for (int j = 0; j < 4; ++j) { const int n = (lane >> 3) + 8 * j; const LAS float* s = scr + (8 * c) * 33 + n;
        v4u o; o.x = pk2(s[0 * 33], s[1 * 33]); o.y = pk2(s[2 * 33], s[3 * 33]); o.z = pk2(s[4 * 33], s[5 * 33]); o.w = pk2(s[6 * 33], s[7 * 33]);
        if (n < nv) *(GAS v4u*)(WT + (size_t)(r0 + n) * ldt + kofs + k0 + 8 * c) = o; }
    LDS_WAIT(); asm volatile("" ::: "memory");
}
struct Seg { int src, n, dst; };
__device__ __forceinline__ Seg win_seg(int s) {
    switch (s) {
        case 0: return Seg{C_QA, 1024, 0};      case 1: return Seg{C_KA, 1024, 1024};  case 2: return Seg{C_VA, 1024, 2048};
        case 3: return Seg{C_QB, 1024, 3072};   case 4: return Seg{C_KB, 1024, 4096};  case 5: return Seg{C_VB, 1024, 5120};
        case 6: return Seg{C_QI, 512, 6144};    case 7: return Seg{C_KI, 64, 6656};    case 8: return Seg{C_WI, 8, 6720};
        case 9: return Seg{C_IA, 4, 6728};      case 10: return Seg{C_FA, 4, 6732};
        case 27: return Seg{C_ZB, 1024, 2048};  case 28: return Seg{C_GA, 1024, 3072}; case 29: return Seg{C_GB, 1024, 4096};
        default: { const int j = (s - 11) >> 1; return (s & 1) ? Seg{C_OA + 128 * j, 128, 256 * j} : Seg{C_ZA + 128 * j, 128, 256 * j + 128}; }
    }
}
struct P0Args { const float *xp, *xs, *w_in, *w_out_a, *w_out_b, *w_o; bf16 *XB, *WMIX, *WMRG, *WAB, *WO; };
__device__ __forceinline__ void p0_prologue(const P0Args& a, LAS unsigned char* lds, int vcu, int G, int wave, int lane) {
    LAS float* scr = (LAS float*)(lds + RING_OFF + wave * 16384);
    const int gw = vcu * NWAVES + wave, NGW = G * NWAVES;
    int base = 0;
    for (int s = 0; s < 30; ++s) {
        const Seg sg = win_seg(s); const int nblk = (sg.n + 31) / 32, nit = nblk * 16;
        bf16* WT = s < 11 ? a.WMIX : a.WMRG;
        for (int it = gw - (base % NGW); it < nit; it += NGW) { if (it < 0) continue; const int kb = it / nblk, nb = it % nblk; const int nv = sg.n - 32 * nb < 32 ? sg.n - 32 * nb : 32;
            tr_item(a.w_in, IN_COLS, sg.src + 32 * nb, nv, 64 * kb, WT, 1024, sg.dst + 32 * nb, 0, scr, lane); }
        base += nit;
    }
    for (int i = gw * 64 + lane; i < 176 * 128; i += NGW * 64) ((GAS v4u*)(a.WMIX + (size_t)6736 * 1024))[i] = (v4u){0u, 0u, 0u, 0u};
    for (int it = gw; it < 3 * 512; it += NGW) { const int w = it / 512, r = it % 512, kb = r / 32, nb = r % 32;
        if (w == 0) tr_item(a.w_out_a, 1024, 32 * nb, 32, 64 * kb, a.WAB, 2048, 32 * nb, 0, scr, lane);
        else if (w == 1) tr_item(a.w_out_b, 1024, 32 * nb, 32, 64 * kb, a.WAB, 2048, 32 * nb, 1024, scr, lane);
        else tr_item(a.w_o, 1024, 32 * nb, 32, 64 * kb, a.WO, 1024, 32 * nb, 0, scr, lane); }
    for (int m0 = gw * 2; m0 < NTOK; m0 += NGW * 2) { f32x4 v[2][4];
#pragma unroll
        for (int q = 0; q < 2; ++q) { const int m = m0 + q; const float* xr = m < NTP ? a.xp + (size_t)m * 1024 : a.xs + (size_t)(m - NTP) * 1024; const GAS f32x4* xv = (const GAS f32x4*)xr + lane;
#pragma unroll
            for (int j = 0; j < 4; ++j) v[q][j] = xv[64 * j]; }
#pragma unroll
        for (int q = 0; q < 2; ++q) { GAS unsigned long long* o8 = (GAS unsigned long long*)(a.XB + (size_t)(m0 + q) * 1024) + lane;
#pragma unroll
            for (int j = 0; j < 4; ++j) o8[64 * j] = (unsigned long long)pk2(v[q][j].x, v[q][j].y) | ((unsigned long long)pk2(v[q][j].z, v[q][j].w) << 32); }
    }
}

namespace pg8 {
struct EpiMix {
    static constexpr bool PERM = true, AFTER_DRAIN = false, MIDK = false;
    bf16_t* QA4;
    bf16_t* KVc;
    bf16_t *QI, *KI; float* SM;
    float *okvp, *okvs;
    float *oikp, *oiks;
    __device__ __forceinline__ void mid(f32x4 (&)[2][2][4][2], const Unit&, int, int, int, int) const {}
    __device__ __forceinline__ void operator()(const f32x4 (&acc)[2][2][4][2], const Unit& u, int wr, int wc, int fr, int fq) const {
        const int pn = u.pn; const bool samp = u.pm >= NTP / 256;
        const int row0 = u.pm * BM + wr * 64 + fr, cl = wc * 32 + 8 * fq;
        if (pn < 16) {
            bf16_t* base = QA4 + (size_t)(pn >> 2) * ((size_t)NTOK * 1024); const float sc = (pn >= 4 && pn < 8) ? 0.0625f : 1.0f;
            const int col0 = (pn & 3) * 256 + cl;
#pragma unroll
            for (int ai = 0; ai < 2; ++ai)
#pragma unroll
                for (int m = 0; m < 4; ++m) { bf16_t* rowp = base + (size_t)(row0 + ai * HALF + m * 16) * 1024 + col0;
#pragma unroll
                    for (int bj = 0; bj < 2; ++bj) { const f32x4 v0 = acc[ai][bj][m][0] * sc, v1 = acc[ai][bj][m][1] * sc;
                        u32x4 w; w.x = cvt_pk_bf16(v0[0], v0[1]); w.y = cvt_pk_bf16(v0[2], v0[3]); w.z = cvt_pk_bf16(v1[0], v1[1]); w.w = cvt_pk_bf16(v1[2], v1[3]);
                        *(u32x4*)(rowp + bj * HALF) = w; } }
        } else if (pn < 24) {
            const int isV = pn >= 20 ? 1 : 0; const int col0 = (pn & 3) * 256 + cl;
            float* of = samp ? okvs + (size_t)isV * ((size_t)NTS * 1024) : okvp + (size_t)isV * ((size_t)NTP * 1024);
            bf16_t* cb = KVc + (size_t)isV * ((size_t)NTP * 1024);
#pragma unroll
            for (int ai = 0; ai < 2; ++ai)
#pragma unroll
                for (int m = 0; m < 4; ++m) { const int r = row0 + ai * HALF + m * 16; const int rr = samp ? r - NTP : r;
#pragma unroll
                    for (int bj = 0; bj < 2; ++bj) { const f32x4 v0 = acc[ai][bj][m][0], v1 = acc[ai][bj][m][1];
                        float* fp = of + (size_t)rr * 1024 + col0 + bj * HALF; *(f32x4*)fp = v0; *(f32x4*)(fp + 4) = v1;
                        if (!samp) { u32x4 w; w.x = cvt_pk_bf16(v0[0], v0[1]); w.y = cvt_pk_bf16(v0[2], v0[3]); w.z = cvt_pk_bf16(v1[0], v1[1]); w.w = cvt_pk_bf16(v1[2], v1[3]);
                            *(u32x4*)(cb + (size_t)r * 1024 + col0 + bj * HALF) = w; } } }
        } else if (pn < 26) {
            const int col0 = (pn - 24) * 256 + cl;
#pragma unroll
            for (int ai = 0; ai < 2; ++ai)
#pragma unroll
                for (int m = 0; m < 4; ++m) { bf16_t* rowp = QI + (size_t)(row0 + ai * HALF + m * 16) * 512 + col0;
#pragma unroll
                    for (int bj = 0; bj < 2; ++bj) { const f32x4 v0 = acc[ai][bj][m][0] * 0.125f, v1 = acc[ai][bj][m][1] * 0.125f;
                        u32x4 w; w.x = cvt_pk_bf16(v0[0], v0[1]); w.y = cvt_pk_bf16(v0[2], v0[3]); w.z = cvt_pk_bf16(v1[0], v1[1]); w.w = cvt_pk_bf16(v1[2], v1[3]);
                        *(u32x4*)(rowp + bj * HALF) = w; } }
        } else {
            float* oik = samp ? oiks : oikp;
#pragma unroll
            for (int ai = 0; ai < 2; ++ai)
#pragma unroll
                for (int m = 0; m < 4; ++m) { const int r = row0 + ai * HALF + m * 16; const int rr = samp ? r - NTP : r; const f32x4 v0 = acc[ai][0][m][0], v1 = acc[ai][0][m][1];
                    if (wc < 2) { float* fp = oik + (size_t)rr * 64 + cl; *(f32x4*)fp = v0; *(f32x4*)(fp + 4) = v1;
                        u32x4 w; w.x = cvt_pk_bf16(v0[0], v0[1]); w.y = cvt_pk_bf16(v0[2], v0[3]); w.z = cvt_pk_bf16(v1[0], v1[1]); w.w = cvt_pk_bf16(v1[2], v1[3]);
                        *(u32x4*)(KI + (size_t)r * 64 + cl) = w; }
                    else if (wc == 2 && fq < 2) { float* fp = SM + (size_t)r * 16 + 8 * fq; *(f32x4*)fp = v0; *(f32x4*)(fp + 4) = v1; } }
        }
    }
};
}


namespace ml {
typedef short bfx8 __attribute__((ext_vector_type(8)));
typedef short s16x4 __attribute__((ext_vector_type(4)));
typedef float f32x16 __attribute__((ext_vector_type(16)));
typedef float f32x2_t __attribute__((ext_vector_type(2))); typedef __bf16 bf16x2_t __attribute__((ext_vector_type(2)));
typedef short v4i16_t __attribute__((ext_vector_type(4)));
typedef unsigned u32x4 __attribute__((ext_vector_type(4)));
typedef unsigned u32x2 __attribute__((ext_vector_type(2)));
typedef float f32x4 __attribute__((ext_vector_type(4)));
#define MLAS __attribute__((address_space(3)))
constexpr int QP = 528, VP = 272;
constexpr int L_Q = 0, L_K = 64 * QP, L_V = 2 * 64 * QP, L_VW = L_V + 64 * VP, L_EX = L_VW + 64 * VP;
constexpr int L_G = L_EX + 32768;
constexpr int L_GW = L_G, L_GM = L_G + 256, L_GI = L_G + 512, L_GE = L_G + 768, L_GS = L_G + 1024;
constexpr int L_NV = L_G + 1280;
constexpr int L_QN = L_NV + 1024;
constexpr int L_DP = L_QN + 256;
constexpr int L_END = L_DP + 384;
__device__ __forceinline__ unsigned cvtpk(float lo, float hi) { f32x2_t v = {lo, hi}; bf16x2_t b = __builtin_convertvector(v, bf16x2_t); return __builtin_bit_cast(unsigned, b); }
__device__ __forceinline__ bfx8 pack_step(const f32x16& x, int s) {
    u32x4 p; p.x = cvtpk(x[8 * s + 0], x[8 * s + 1]); p.y = cvtpk(x[8 * s + 2], x[8 * s + 3]); p.z = cvtpk(x[8 * s + 4], x[8 * s + 5]); p.w = cvtpk(x[8 * s + 6], x[8 * s + 7]);
    return __builtin_bit_cast(bfx8, p);
}
__device__ __forceinline__ s16x4 vtr(MLAS const unsigned char* p) { return __builtin_bit_cast(s16x4, __builtin_amdgcn_ds_read_tr16_b64_v4i16((MLAS v4i16_t*)p)); }
__device__ __forceinline__ bfx8 cat8(s16x4 lo, s16x4 hi) { return (bfx8){lo[0], lo[1], lo[2], lo[3], hi[0], hi[1], hi[2], hi[3]}; }
__device__ __forceinline__ int crow(int r, int hi) { return (r & 3) + 8 * (r >> 2) + 4 * hi; }
__device__ __forceinline__ float logsig_(float x) { return fminf(x, 0.0f) - log1pf(__expf(-fabsf(x))); }
__device__ __forceinline__ float wsum_(float v) {
#pragma unroll
    for (int o = 1; o < 64; o <<= 1) v += __shfl_xor(v, o);
    return v; }
#define ML_MFMA(a, b, c) __builtin_amdgcn_mfma_f32_32x32x16_bf16((a), (b), (c), 0, 0, 0)

struct Item {
    __amdgpu_buffer_rsrc_t hout;
    __amdgpu_buffer_rsrc_t q, k, v;
    __amdgpu_buffer_rsrc_t sm;
    __amdgpu_buffer_rsrc_t C0, Cout;
    const float* n0; float m0; bool has0;
    float* nout; float* mout;
    int head, nchunk, L; float bi, bf;
};
#define ML_LD16(rs, vo, so) __builtin_bit_cast(u32x4, __builtin_amdgcn_raw_buffer_load_b128((rs), (int)(vo), (int)(so), 0))
#define ML_LDF(rs, vo, so) __builtin_bit_cast(float, __builtin_amdgcn_raw_buffer_load_b32((rs), (int)(vo), (int)(so), 0))

__device__ __forceinline__ void run_item(MLAS unsigned char* lds, const Item& it) {
    int tid = threadIdx.x; asm volatile("" : "+v"(tid));
    const int wave = __builtin_amdgcn_readfirstlane(tid >> 6), lane0 = tid & 63, g = wave >> 2, cb = wave & 3;
#define ML_LANE int lane = lane0; asm volatile("" : "+v"(lane)); const int r32 = lane & 31, hi = lane >> 5; (void)r32; (void)hi
    const int L = it.L, h = it.head;
    const unsigned coff = (unsigned)((lane0 >> 5) * 4096 + (lane0 & 31) * 4), qkoff = (unsigned)((tid >> 5) * 2048 + (tid & 31) * 16), voff = (unsigned)((tid >> 4) * 2048 + (tid & 15) * 16), hoff = (unsigned)((4 * (lane0 >> 5) * 1024 + (lane0 & 31)) * 2);
    f32x16 Cacc[4];
#pragma unroll
    for (int j = 0; j < 4; ++j)
#pragma unroll
        for (int i = 0; i < 16; ++i) Cacc[j][i] = it.has0 ? ML_LDF(it.C0, coff, ((128 * g + 32 * j + (i & 3) + 8 * (i >> 2)) * 256 + 32 * cb) * 4) : 0.f;
    if (tid < 256) ((MLAS float*)(lds + L_NV))[tid] = it.has0 ? it.n0[tid] : 0.f;
    float m = it.m0;
    u32x4 pq[4], pk[4], pv[2]; float pia, pfa;
#define ML_PREFETCH(c_) do { const int t0_ = (c_) * L; \
        _Pragma("unroll") for (int i = 0; i < 4; ++i) { const bool ok_ = 16 * i < L;     \
            pq[i] = ok_ ? ML_LD16(it.q, qkoff, (t0_ + 16 * i) * 2048) : (u32x4){0u, 0u, 0u, 0u}; pk[i] = ok_ ? ML_LD16(it.k, qkoff, (t0_ + 16 * i) * 2048) : (u32x4){0u, 0u, 0u, 0u}; } \
        _Pragma("unroll") for (int i = 0; i < 2; ++i) pv[i] = (32 * i < L) ? ML_LD16(it.v, voff, (t0_ + 32 * i) * 2048) : (u32x4){0u, 0u, 0u, 0u}; \
        { const int lane = lane0; const bool ok_ = lane < L; const float a_ = ML_LDF(it.sm, lane * 64, t0_ * 64 + (8 + h) * 4), f_ = ML_LDF(it.sm, lane * 64, t0_ * 64 + (12 + h) * 4); pia = ok_ ? a_ : 0.f; pfa = ok_ ? f_ : 0.f; } } while (0)
    ML_PREFETCH(0);
    for (int c = 0; c < it.nchunk; ++c) {
        float wsl, decay, mnext;
        { ML_LANE;
        float lf = (lane < L) ? logsig_(pfa + it.bf) : 0.f; float cum = lf;
#pragma unroll
        for (int o = 1; o < 64; o <<= 1) { const float t_ = __shfl_up(cum, o); if (lane >= o) cum += t_; }
        const float wv = (lane < L) ? (pia + it.bi) - cum : -INFINITY; float cmx = wv;
#pragma unroll
        for (int o = 1; o < 64; o <<= 1) { const float t_ = __shfl_up(cmx, o); if (lane >= o) cmx = fmaxf(cmx, t_); }
        const float Ml = fmaxf(m, cmx); const float M63 = __shfl(Ml, 63), cum63 = __shfl(cum, 63);
        wsl = __expf(wv - M63); decay = __expf(m - M63); mnext = cum63 + M63;
        if (wave == 0) { ((MLAS float*)(lds + L_GW))[lane] = wv; ((MLAS float*)(lds + L_GM))[lane] = Ml; ((MLAS float*)(lds + L_GI))[lane] = __expf(m - Ml);
                         ((MLAS float*)(lds + L_GE))[lane] = __expf(-(cum + Ml)); ((MLAS float*)(lds + L_GS))[lane] = wsl; } }
#pragma unroll
        for (int i = 0; i < 4; ++i) { const int p_ = tid + 512 * i, row_ = p_ >> 5, cp_ = p_ & 31;
            *(MLAS u32x4*)(lds + L_Q + row_ * QP + cp_ * 16) = pq[i]; *(MLAS u32x4*)(lds + L_K + row_ * QP + cp_ * 16) = pk[i]; }
#pragma unroll
        for (int i = 0; i < 2; ++i) { const int p_ = tid + 512 * i, row_ = p_ >> 4, cp_ = p_ & 15; const float wr_ = __shfl(wsl, row_ & 63);
            *(MLAS u32x4*)(lds + L_V + row_ * VP + cp_ * 16) = pv[i];
            u32x4 o_;
#pragma unroll
            for (int e = 0; e < 4; ++e) o_[e] = cvtpk(__uint_as_float(pv[i][e] << 16) * wr_, __uint_as_float(pv[i][e] & 0xffff0000u) * wr_);
            *(MLAS u32x4*)(lds + L_VW + row_ * VP + cp_ * 16) = o_; }
        __syncthreads();
        const int sb = g; f32x16 S0 = {}, S1 = {};
        { ML_LANE;
            MLAS const unsigned char* kp = lds + L_K + (32 * sb + r32) * QP + hi * 16; MLAS const unsigned char* q0 = lds + L_Q + r32 * QP + hi * 16; MLAS const unsigned char* q1 = q0 + 32 * QP;
#pragma unroll 4
            for (int ks = 0; ks < 16; ++ks) { const bfx8 ka = *(MLAS const bfx8*)(kp + ks * 32); const bfx8 qb1 = *(MLAS const bfx8*)(q1 + ks * 32);
                S1 = ML_MFMA(ka, qb1, S1);
                if (g == 0) { const bfx8 qb0 = *(MLAS const bfx8*)(q0 + ks * 32); S0 = ML_MFMA(ka, qb0, S0); } }
        }
        { ML_LANE;
            const float M1 = ((MLAS const float*)(lds + L_GM))[32 + r32], M0 = ((MLAS const float*)(lds + L_GM))[r32]; float d0 = 0.f, d1 = 0.f;
#pragma unroll
            for (int i = 0; i < 16; ++i) { const int sl = crow(i, hi); const float ws_ = ((MLAS const float*)(lds + L_GW))[32 * sb + sl];
                const int s_ = 32 * sb + sl;
                S1[i] = (s_ <= 32 + r32) ? S1[i] * __expf(ws_ - M1) : 0.f; d1 += S1[i];
                if (g == 0) { S0[i] = (s_ <= r32) ? S0[i] * __expf(ws_ - M0) : 0.f; d0 += S0[i]; } }
            { auto rr = __builtin_amdgcn_permlane32_swap(__float_as_uint(d1), __float_as_uint(d1), false, false); d1 = __uint_as_float(rr[0]) + __uint_as_float(rr[1]); }
            { auto rr = __builtin_amdgcn_permlane32_swap(__float_as_uint(d0), __float_as_uint(d0), false, false); d0 = __uint_as_float(rr[0]) + __uint_as_float(rr[1]); }
            if (cb == 0 && hi == 0) { if (g == 0) { ((MLAS float*)(lds + L_DP))[r32] = d0; ((MLAS float*)(lds + L_DP))[32 + r32] = d1; } else ((MLAS float*)(lds + L_DP))[64 + r32] = d1; }
        }
        f32x16 Y0 = {}, Y1 = {};
        { ML_LANE;
#pragma unroll
        for (int j = 0; j < 4; ++j)
#pragma unroll
            for (int ks = 0; ks < 2; ++ks) { const bfx8 xs = pack_step(Cacc[j], ks);
                MLAS const unsigned char* qa = lds + L_Q + r32 * QP + (128 * g + 32 * j + 16 * ks + 4 * hi) * 2;
                const u32x2 a0l = *(MLAS const u32x2*)(qa), a0h = *(MLAS const u32x2*)(qa + 16), a1l = *(MLAS const u32x2*)(qa + 32 * QP), a1h = *(MLAS const u32x2*)(qa + 32 * QP + 16);
                const bfx8 pa0 = __builtin_bit_cast(bfx8, (u32x4){a0l.x, a0l.y, a0h.x, a0h.y}), pa1 = __builtin_bit_cast(bfx8, (u32x4){a1l.x, a1l.y, a1h.x, a1h.y});
                Y0 = ML_MFMA(pa0, xs, Y0); Y1 = ML_MFMA(pa1, xs, Y1); }
#pragma unroll
        for (int i = 0; i < 16; ++i) { Y0[i] *= ((MLAS const float*)(lds + L_GI))[crow(i, hi)]; Y1[i] *= ((MLAS const float*)(lds + L_GI))[32 + crow(i, hi)]; } }
        { ML_LANE;
            const int i16 = lane & 15, q_ = i16 >> 2, p_ = i16 & 3, gi = lane >> 4;
            MLAS const unsigned char* vb = lds + L_V + (32 * sb + 4 * hi + q_) * VP + (32 * cb + 16 * (gi & 1) + 4 * p_) * 2;
#pragma unroll
            for (int ks = 0; ks < 2; ++ks) { const bfx8 pb = cat8(vtr(vb + (16 * ks) * VP), vtr(vb + (16 * ks + 8) * VP));
                Y1 = ML_MFMA(pack_step(S1, ks), pb, Y1);
                if (g == 0) Y0 = ML_MFMA(pack_step(S0, ks), pb, Y0); }
        }
        { ML_LANE;
            const f32x4 nv = *(MLAS const f32x4*)(lds + L_NV + lane * 16);
#pragma unroll
            for (int rr_ = 0; rr_ < 8; ++rr_) { const int l_ = 8 * wave + rr_; const u32x2 qw = *(MLAS const u32x2*)(lds + L_Q + l_ * QP + lane * 8);
                float d_ = __uint_as_float(qw.x << 16) * nv.x + __uint_as_float(qw.x & 0xffff0000u) * nv.y + __uint_as_float(qw.y << 16) * nv.z + __uint_as_float(qw.y & 0xffff0000u) * nv.w;
                d_ = wsum_(d_); if (lane == 0) ((MLAS float*)(lds + L_QN))[l_] = d_; }
        }
        { ML_LANE;
            MLAS float* ex = (MLAS float*)(lds + L_EX + ((1 - g) * 4 + cb) * 4096) + lane;
#pragma unroll
            for (int i = 0; i < 16; ++i) ex[i * 64] = (g == 0) ? Y1[i] : Y0[i];
        }
        __syncthreads();
        if (c + 1 < it.nchunk) ML_PREFETCH(c + 1);
        { ML_LANE;
            MLAS const float* ex = (MLAS const float*)(lds + L_EX + (g * 4 + cb) * 4096) + lane; f32x16 Y = (g == 0) ? Y0 : Y1;
#pragma unroll
            for (int i = 0; i < 16; ++i) Y[i] += ex[i * 64];
#pragma unroll
            for (int i = 0; i < 16; ++i) { const int l_ = 32 * g + crow(i, hi);
                const float dsum = (g == 0) ? ((MLAS const float*)(lds + L_DP))[l_] : ((MLAS const float*)(lds + L_DP))[l_] + ((MLAS const float*)(lds + L_DP))[32 + l_];
                const float den = dsum + ((MLAS const float*)(lds + L_GI))[l_] * ((MLAS const float*)(lds + L_QN))[l_];
                const float hv = Y[i] / fmaxf(fabsf(den), ((MLAS const float*)(lds + L_GE))[l_]);
                const float hn = __shfl_xor(hv, 1);
                if (32 * g < L && (r32 & 1) == 0) __builtin_amdgcn_raw_buffer_store_b32(cvtpk(hv, hn), it.hout, (int)hoff, ((c * L + 32 * g + (i & 3) + 8 * (i >> 2)) * 1024 + 32 * cb) * 2, 0); }
        }
        if (tid < 256) { float a_ = 0.f;
#pragma unroll 8
            for (int s = 0; s < 64; ++s) a_ += ((MLAS const float*)(lds + L_GS))[s] * bf2f(*(MLAS const unsigned short*)(lds + L_K + s * QP + tid * 2));
            ((MLAS float*)(lds + L_NV))[tid] = decay * ((MLAS const float*)(lds + L_NV))[tid] + a_; }
        { ML_LANE;
            const int i16 = lane & 15, q_ = i16 >> 2, p_ = i16 & 3, gi = lane >> 4;
            MLAS const unsigned char* kb_ = lds + L_K + (8 * hi + q_) * QP + (128 * g + 16 * (gi & 1) + 4 * p_) * 2;
            MLAS const unsigned char* vw_ = lds + L_VW + (8 * hi + q_) * VP + (32 * cb + 16 * (gi & 1) + 4 * p_) * 2;
#pragma unroll
            for (int j = 0; j < 4; ++j)
#pragma unroll
                for (int i = 0; i < 16; ++i) Cacc[j][i] *= decay;
#pragma unroll
            for (int ks = 0; ks < 4; ++ks) { const bfx8 vb_ = cat8(vtr(vw_ + (16 * ks) * VP), vtr(vw_ + (16 * ks + 4) * VP));
#pragma unroll
                for (int j = 0; j < 4; ++j) { const bfx8 ka_ = cat8(vtr(kb_ + (16 * ks) * QP + 64 * j), vtr(kb_ + (16 * ks + 4) * QP + 64 * j));
                    Cacc[j] = ML_MFMA(ka_, vb_, Cacc[j]); } }
        }
        m = mnext;
        __syncthreads();
    }
#undef ML_PREFETCH
#undef ML_LANE
#pragma unroll
    for (int j = 0; j < 4; ++j)
#pragma unroll
        for (int i = 0; i < 16; ++i) __builtin_amdgcn_raw_buffer_store_b32(__float_as_uint(Cacc[j][i]), it.Cout, (int)coff, ((128 * g + 32 * j + (i & 3) + 8 * (i >> 2)) * 256 + 32 * cb) * 4, 0);
    if (it.nout && tid < 256) it.nout[tid] = ((MLAS const float*)(lds + L_NV))[tid];
    if (it.mout && tid == 0) *it.mout = m;
    __syncthreads();
}
#undef ML_MFMA
#undef ML_LD16
#undef ML_LDF
#undef MLAS
}

constexpr size_t WS_BC = WS_NAIVE, WS_WV = WS_BC + 2 * MiB, WS_CMX = WS_WV + 2 * MiB;
constexpr size_t WS_CHS = WS_CMX + 2 * MiB;
constexpr size_t WS_SMAT = WS_CHS + 1 * MiB;
constexpr size_t WS_CB = WS_SMAT + 3 * MiB;
constexpr size_t WS_NB = WS_CB + 64 * MiB;
constexpr size_t WS_MASKS = WS_NB + 1 * MiB;
constexpr size_t WS_HA = WS_MASKS + 1 * MiB;
constexpr size_t WS_END = WS_HA + ROWBUF;
constexpr int NCHK = BATCH * 4 * 32 + DEC_BATCH * 4;

__device__ __forceinline__ float logsig(float x) { return fminf(x, 0.0f) - log1pf(__expf(-fabsf(x))); }
__device__ __forceinline__ float siluf(float x) { return x / (1.0f + __expf(-x)); }
__device__ __forceinline__ int t5b(int rel) { const int n = rel < 0 ? -rel : rel; const int v = n < 8 ? n : 8 + (n >= 12) + (n >= 16) + (n >= 23) + (n >= 32) + (n >= 46) + (n >= 64) + (n >= 91); return (rel > 0 ? 16 : 0) + v; }

namespace pg8 {
__device__ __forceinline__ void unpack8(u32x4 w, float (&f)[8]) {
    f[0] = __uint_as_float(w.x << 16); f[1] = __uint_as_float(w.x & 0xffff0000u); f[2] = __uint_as_float(w.y << 16); f[3] = __uint_as_float(w.y & 0xffff0000u);
    f[4] = __uint_as_float(w.z << 16); f[5] = __uint_as_float(w.z & 0xffff0000u); f[6] = __uint_as_float(w.w << 16); f[7] = __uint_as_float(w.w & 0xffff0000u);
}
__device__ __forceinline__ u32x4 pack8f(const float (&f)[8]) { u32x4 w; w.x = cvt_pk_bf16(f[0], f[1]); w.y = cvt_pk_bf16(f[2], f[3]); w.z = cvt_pk_bf16(f[4], f[5]); w.w = cvt_pk_bf16(f[6], f[7]); return w; }
__device__ __forceinline__ float sg_(float x) { return 1.0f / (1.0f + __expf(-x)); }
struct EpiM1a {
    static constexpr bool PERM = true, AFTER_DRAIN = false, MIDK = false;
    const bf16_t* HA; const bf16_t* OB; const float* HST; const float* ang; bf16_t* BR;
    __device__ __forceinline__ void mid(f32x4 (&)[2][2][4][2], const Unit&, int, int, int, int) const {}
    __device__ __forceinline__ void operator()(const f32x4 (&acc)[2][2][4][2], const Unit& u, int wr, int wc, int fr, int fq) const {
        const int pn = u.pn; const int row0 = u.pm * BM + wr * 64 + fr, cl = wc * 32 + 8 * fq;
        if (pn < 8) {
            const int ch0 = 128 * pn + cl, head = pn >> 1;
            const f32x4 g0 = *(const f32x4*)(ang + ch0), g1 = *(const f32x4*)(ang + ch0 + 4);
            const float g[8] = {g0[0], g0[1], g0[2], g0[3], g1[0], g1[1], g1[2], g1[3]};
#pragma unroll
            for (int ai = 0; ai < 2; ++ai)
#pragma unroll
                for (int m = 0; m < 4; ++m) { const int r = row0 + ai * HALF + m * 16;
                    float h[8]; unpack8(*(const u32x4*)(HA + (size_t)r * 1024 + ch0), h);
                    const float mean = HST[((size_t)r * 4 + head) * 2], rstd = HST[((size_t)r * 4 + head) * 2 + 1];
                    const f32x4 o0 = acc[ai][0][m][0], o1 = acc[ai][0][m][1], z0 = acc[ai][1][m][0], z1 = acc[ai][1][m][1];
                    const float oa[8] = {o0[0], o0[1], o0[2], o0[3], o1[0], o1[1], o1[2], o1[3]}, za[8] = {z0[0], z0[1], z0[2], z0[3], z1[0], z1[1], z1[2], z1[3]};
                    float o[8];
#pragma unroll
                    for (int i = 0; i < 8; ++i) o[i] = ((h[i] - mean) * rstd * g[i] * sg_(oa[i])) * (za[i] * sg_(za[i]));
                    *(u32x4*)(BR + (size_t)r * 2048 + ch0) = pack8f(o); }
        } else {
#pragma unroll
            for (int ai = 0; ai < 2; ++ai)
#pragma unroll
                for (int m = 0; m < 4; ++m) { const int r = row0 + ai * HALF + m * 16;
#pragma unroll
                    for (int bj = 0; bj < 2; ++bj) { const int ch0 = 256 * (pn - 8) + 128 * bj + cl;
                        float ob[8]; unpack8(*(const u32x4*)(OB + (size_t)r * 1024 + ch0), ob);
                        const f32x4 z0 = acc[ai][bj][m][0], z1 = acc[ai][bj][m][1]; const float zb[8] = {z0[0], z0[1], z0[2], z0[3], z1[0], z1[1], z1[2], z1[3]};
                        float o[8];
#pragma unroll
                        for (int i = 0; i < 8; ++i) o[i] = ob[i] * (zb[i] * sg_(zb[i]));
                        *(u32x4*)(BR + (size_t)r * 2048 + 1024 + ch0) = pack8f(o); } }
        }
    }
};
struct EpiM1b {
    static constexpr bool PERM = true, AFTER_DRAIN = false, MIDK = false;
    bf16_t* SGA; bf16_t* SGB;
    __device__ __forceinline__ void mid(f32x4 (&)[2][2][4][2], const Unit&, int, int, int, int) const {}
    __device__ __forceinline__ void operator()(const f32x4 (&acc)[2][2][4][2], const Unit& u, int wr, int wc, int fr, int fq) const {
        const int pn = u.pn; const int row0 = u.pm * BM + wr * 64 + fr, cl = wc * 32 + 8 * fq;
        bf16_t* base = pn < 4 ? SGA : SGB; const int col0 = (pn & 3) * 256 + cl;
#pragma unroll
        for (int ai = 0; ai < 2; ++ai)
#pragma unroll
            for (int m = 0; m < 4; ++m) { bf16_t* rowp = base + (size_t)(row0 + ai * HALF + m * 16) * 1024 + col0;
#pragma unroll
                for (int bj = 0; bj < 2; ++bj) { const f32x4 v0 = acc[ai][bj][m][0], v1 = acc[ai][bj][m][1];
                    const float o[8] = {sg_(v0[0]), sg_(v0[1]), sg_(v0[2]), sg_(v0[3]), sg_(v1[0]), sg_(v1[1]), sg_(v1[2]), sg_(v1[3])};
                    *(u32x4*)(rowp + bj * HALF) = pack8f(o); } }
    }
};
struct EpiM1 {
    static constexpr bool PERM = true, AFTER_DRAIN = false, MIDK = false;
    EpiM1a a; EpiM1b b;
    __device__ __forceinline__ void mid(f32x4 (&)[2][2][4][2], const Unit&, int, int, int, int) const {}
    __device__ __forceinline__ void operator()(const f32x4 (&acc)[2][2][4][2], const Unit& u, int wr, int wc, int fr, int fq) const {
        if (u.pn < 12) a(acc, u, wr, wc, fr, fq); else { Unit v = u; v.pn = u.pn - 12; b(acc, v, wr, wc, fr, fq); }
    }
};
struct EpiM2 {
    static constexpr bool PERM = true, AFTER_DRAIN = false, MIDK = true;
    const bf16_t* SGA; const bf16_t* SGB; bf16_t* MX;
    __device__ __forceinline__ void mid(f32x4 (&acc)[2][2][4][2], const Unit& u, int wr, int wc, int fr, int fq) const {
        int fr_ = fr, fq_ = fq; asm volatile("" : "+v"(fr_), "+v"(fq_));
        const int row0 = u.pm * BM + wr * 64 + fr_, col0 = u.pn * BM + wc * 32 + 8 * fq_;
#pragma unroll
        for (int ai = 0; ai < 2; ++ai)
#pragma unroll
            for (int m = 0; m < 4; ++m) { const size_t ro = (size_t)(row0 + ai * HALF + m * 16) * 1024 + col0;
#pragma unroll
                for (int bj = 0; bj < 2; ++bj) { float a[8], b[8]; unpack8(*(const u32x4*)(SGA + ro + bj * HALF), a); unpack8(*(const u32x4*)(SGB + ro + bj * HALF), b);
#pragma unroll
                    for (int i = 0; i < 4; ++i) { acc[ai][bj][m][0][i] *= a[i] * __builtin_amdgcn_rcpf(b[i]); acc[ai][bj][m][1][i] *= a[4 + i] * __builtin_amdgcn_rcpf(b[4 + i]); } }
                asm volatile("" ::: "memory"); }
    }
    __device__ __forceinline__ void operator()(const f32x4 (&acc)[2][2][4][2], const Unit& u, int wr, int wc, int fr, int fq) const {
        int fr_ = fr, fq_ = fq; asm volatile("" : "+v"(fr_), "+v"(fq_));
        const int row0 = u.pm * BM + wr * 64 + fr_, col0 = u.pn * BM + wc * 32 + 8 * fq_;
#pragma unroll
        for (int ai = 0; ai < 2; ++ai)
#pragma unroll
            for (int m = 0; m < 4; ++m) { const size_t ro = (size_t)(row0 + ai * HALF + m * 16) * 1024 + col0;
#pragma unroll
                for (int bj = 0; bj < 2; ++bj) { float b[8]; unpack8(*(const u32x4*)(SGB + ro + bj * HALF), b);
                    const f32x4 v0 = acc[ai][bj][m][0], v1 = acc[ai][bj][m][1];
                    const float o[8] = {v0[0] * b[0], v0[1] * b[1], v0[2] * b[2], v0[3] * b[3], v1[0] * b[4], v1[1] * b[5], v1[2] * b[6], v1[3] * b[7]};
                    *(u32x4*)(MX + ro + bj * HALF) = pack8f(o); }
                asm volatile("" ::: "memory"); }
    }
};
struct EpiM3 {
    static constexpr bool PERM = true, AFTER_DRAIN = false, MIDK = false;
    const float* xp; const float* xs; float* yp; float* ys;
    __device__ __forceinline__ void mid(f32x4 (&)[2][2][4][2], const Unit&, int, int, int, int) const {}
    __device__ __forceinline__ void operator()(const f32x4 (&acc)[2][2][4][2], const Unit& u, int wr, int wc, int fr, int fq) const {
        const bool samp = u.pm >= NTP / 256; const int row0 = (samp ? u.pm - NTP / 256 : u.pm) * BM + wr * 64 + fr, col0 = u.pn * BM + wc * 32 + 8 * fq;
        const float* xb = samp ? xs : xp; float* yb = samp ? ys : yp;
#pragma unroll
        for (int ai = 0; ai < 2; ++ai)
#pragma unroll
            for (int m = 0; m < 4; ++m) { const size_t ro = (size_t)(row0 + ai * HALF + m * 16) * 1024 + col0;
#pragma unroll
                for (int bj = 0; bj < 2; ++bj) { const f32x4 x0 = *(const f32x4*)(xb + ro + bj * HALF), x1 = *(const f32x4*)(xb + ro + bj * HALF + 4);
                    *(f32x4*)(yb + ro + bj * HALF) = x0 * DN_ALPHA + acc[ai][bj][m][0]; *(f32x4*)(yb + ro + bj * HALF + 4) = x1 * DN_ALPHA + acc[ai][bj][m][1]; } }
    }
};
}

__device__ __forceinline__ float wave_sum(float v) {
#pragma unroll
    for (int o = 1; o < 64; o <<= 1) v += __shfl_xor(v, o);
    return v;
}

__device__ __forceinline__ void simple_select_row(LAS unsigned char* lds, int row, unsigned long long* mrow, const bf16* QI_, const float* SM_, const bf16* KI_, const float* cache_ik_) {
    const int tid_ = threadIdx.x, lane_ = tid_ & 63, wave_ = tid_ >> 6;
    LAS float* sc = (LAS float*)(lds + RING_OFF);
    LAS float* qv = (LAS float*)(lds + RING_OFF + 16384);
    const bool samp = row >= NTP; const int b = samp ? (row - NTP) / DEC_SEQ : row / SEQ; const int q = samp ? (row - NTP) % DEC_SEQ : row % SEQ;
    const int S = samp ? PAST_LEN + DEC_SEQ : ((q >> 6) + 1) * 64;
    if (S <= TOPK_MAX) { if (tid_ < 32) mrow[tid_] = (tid_ < (S >> 6)) ? ~0ull : 0ull; return; }
    qv[tid_] = bf2f(QI_[(size_t)row * 512 + tid_]); if (tid_ < 8) qv[512 + tid_] = SM_[(size_t)row * 16 + tid_] * 0.35355339059327373f;
    __syncthreads();
    const int nIt = (S + 511) / 512;
    for (int i = 0; i < nIt; ++i) { const int s = tid_ + 512 * i;
        if (s < S) { float kf[64];
            if (samp && s < PAST_LEN) { const float* kr = cache_ik_ + ((size_t)b * PAST_LEN + s) * 64;
#pragma unroll
                for (int j = 0; j < 64; ++j) kf[j] = kr[j]; }
            else { const bf16* kr = KI_ + (samp ? (size_t)NTP + (size_t)b * DEC_SEQ + (s - PAST_LEN) : (size_t)b * SEQ + s) * 64;
#pragma unroll
                for (int j = 0; j < 64; ++j) kf[j] = bf2f(kr[j]); }
            float a = 0.f;
#pragma unroll
            for (int h = 0; h < 8; ++h) { float d = 0.f;
#pragma unroll
                for (int j = 0; j < 64; ++j) d += qv[h * 64 + j] * kf[j];
                a += qv[512 + h] * fmaxf(d, 0.f); }
            sc[s] = a; } }
    __syncthreads();
    for (int i = 0; i < nIt; ++i) { const int s = tid_ + 512 * i; bool keep = false;
        if (s < S) { const int v = __float_as_int(sc[s]); const int vk = v ^ ((v >> 31) & 0x7fffffff); int rank = 0;
            for (int j = 0; j < S; ++j) { const int u = __float_as_int(sc[j]); const int uk = u ^ ((u >> 31) & 0x7fffffff); rank += (uk > vk) || (uk == vk && j < s); } keep = rank < TOPK_MAX; }
        const unsigned long long bm = __ballot(keep);
        if (lane_ == 0 && (wave_ + 8 * i) * 64 < S) mrow[wave_ + 8 * i] = bm; }
    if (!samp) { const int nw = S >> 6; if (tid_ >= nw && tid_ < 32) mrow[tid_] = 0ull; }
    __syncthreads();
}
__device__ __forceinline__ void simple_attn_task(int row, int h, int dc, const unsigned long long* mrow, const bf16* QB_, const bf16* KBc_, const bf16* VBc_, const float* cache_k_, const float* cache_v_,
                                                  const float* k_sample_, const float* v_sample_, const float* rel_bias_, bf16* orow) {
    const bool samp = row >= NTP; const int b = samp ? (row - NTP) / DEC_SEQ : row / SEQ; const int q = samp ? (row - NTP) % DEC_SEQ : row % SEQ;
    const int S = samp ? PAST_LEN + DEC_SEQ : ((q >> 6) + 1) * 64; const int qpos = samp ? PAST_LEN + q : q;
    const bf16* qr = QB_ + (size_t)row * 1024 + h * 128;
    float mx = -INFINITY, sum = 0.f, o[16];
#pragma unroll
    for (int i = 0; i < 16; ++i) o[i] = 0.f;
    for (int w = 0; w * 64 < S; ++w) { unsigned long long bits = mrow[w];
        while (bits) { const int s = w * 64 + __builtin_ctzll(bits); bits &= bits - 1;
            float d = 0.f; float vv[16];
            if (samp) { const float* kr = (s < PAST_LEN) ? cache_k_ + ((size_t)b * PAST_LEN + s) * 1024 + h * 128 : k_sample_ + ((size_t)b * DEC_SEQ + (s - PAST_LEN)) * 1024 + h * 128;
                const float* vr = (s < PAST_LEN) ? cache_v_ + ((size_t)b * PAST_LEN + s) * 1024 + h * 128 + dc * 16 : v_sample_ + ((size_t)b * DEC_SEQ + (s - PAST_LEN)) * 1024 + h * 128 + dc * 16;
#pragma unroll 8
                for (int j = 0; j < 128; ++j) d += bf2f(qr[j]) * kr[j];
#pragma unroll
                for (int i = 0; i < 16; ++i) vv[i] = vr[i]; }
            else { const bf16* kr = KBc_ + ((size_t)b * SEQ + s) * 1024 + h * 128; const bf16* vr = VBc_ + ((size_t)b * SEQ + s) * 1024 + h * 128 + dc * 16;
#pragma unroll 8
                for (int j = 0; j < 128; ++j) d += bf2f(qr[j]) * bf2f(kr[j]);
#pragma unroll
                for (int i = 0; i < 16; ++i) vv[i] = bf2f(vr[i]); }
            const float lg = d * 0.08838834764831845f + rel_bias_[t5b(s - qpos) * 8 + h];
            if (lg > mx) { const float f = __expf(mx - lg); sum *= f;
#pragma unroll
                for (int i = 0; i < 16; ++i) o[i] *= f; mx = lg; }
            const float p = __expf(lg - mx); sum += p;
#pragma unroll
            for (int i = 0; i < 16; ++i) o[i] += p * vv[i]; } }
    const float inv = 1.0f / sum;
#pragma unroll
    for (int i = 0; i < 16; ++i) orow[i] = (bf16)f2bf(o[i] * inv);
}


template <int NW>
__device__ __forceinline__ unsigned long long wave_select(LAS const int* row, int nW, int lane_) {
    static_assert(TOPK_MAX == 256, "the 4th-largest bracket assumes TOPK_MAX = 64 lanes x 4");
    int v[NW]; int t0 = (int)0x80000000, t1 = t0, t2 = t0, t3 = t0;
#pragma unroll
    for (int i = 0; i < NW; ++i) { v[i] = (i < nW) ? row[lane_ + 64 * i] : (int)0x80000000;
        int x = v[i], y; y = min(t0, x); t0 = max(t0, x); x = y; y = min(t1, x); t1 = max(t1, x); x = y; y = min(t2, x); t2 = max(t2, x); x = y; t3 = max(t3, x); }
    int vmx = t3, vmn = t3;
#pragma unroll
    for (int o_ = 1; o_ < 64; o_ <<= 1) { vmx = max(vmx, __shfl_xor(vmx, o_)); vmn = min(vmn, __shfl_xor(vmn, o_)); }
    int lo_ = __builtin_amdgcn_readfirstlane(vmn), hi_ = __builtin_amdgcn_readfirstlane(vmx); bool exact = false; int T = lo_;
    while (lo_ < hi_) { const int mid = lo_ + (int)((((unsigned)hi_ - (unsigned)lo_) + 1u) >> 1); int cnt = 0;
#pragma unroll
        for (int i = 0; i < NW; ++i) { cnt += __builtin_popcountll(__ballot(v[i] >= mid)); if ((i & 3) == 3) __builtin_amdgcn_sched_barrier(0); }
        if (cnt == TOPK_MAX) { exact = true; T = mid; break; }
        if (cnt > TOPK_MAX) lo_ = mid; else hi_ = mid - 1; }
    if (!exact) T = lo_;
    int need = TOPK_MAX;
    if (!exact) { int cgt = 0;
#pragma unroll
        for (int i = 0; i < NW; ++i) { cgt += __builtin_popcountll(__ballot(v[i] > T)); if ((i & 3) == 3) __builtin_amdgcn_sched_barrier(0); }
        need = TOPK_MAX - cgt; }
    unsigned long long myw = 0ull; int running = 0; const unsigned long long lt = (1ull << lane_) - 1ull;
#pragma unroll
    for (int i = 0; i < NW; ++i) { bool sel;
        if (exact) sel = v[i] >= T;
        else { const bool eq = v[i] == T; const unsigned long long em = __ballot(eq); sel = (v[i] > T) || (eq && running + __builtin_popcountll(em & lt) < need); running += __builtin_popcountll(em); }
        const unsigned long long wd = __ballot(sel); if (lane_ == i) myw = wd; __builtin_amdgcn_sched_barrier(0); }
    return myw;
}
__device__ __forceinline__ void sample_select_row(LAS unsigned char* lds, int row, unsigned long long* mrow, const bf16* QI_, const float* SM_, const bf16* KI_, const float* cache_ik_) {
    const int tid_ = threadIdx.x, lane_ = tid_ & 63, wave_ = __builtin_amdgcn_readfirstlane(tid_ >> 6);
    LAS int* sck = (LAS int*)(lds + RING_OFF);
    LAS float* qv = (LAS float*)(lds + RING_OFF + 16384);
    const int b = (row - NTP) / DEC_SEQ; constexpr int S = PAST_LEN + DEC_SEQ;
    qv[tid_] = bf2f(QI_[(size_t)row * 512 + tid_]); if (tid_ < 8) qv[512 + tid_] = SM_[(size_t)row * 16 + tid_] * 0.35355339059327373f;
    __syncthreads();
#pragma unroll 1
    for (int i = 0; i < 5; ++i) { const int s = tid_ + 512 * i;
        if (s < 2112) { int key = (int)0x80000000;
            if (s < S) { float kf[64];
                if (s < PAST_LEN) { const float* kr = cache_ik_ + ((size_t)b * PAST_LEN + s) * 64;
#pragma unroll
                    for (int j = 0; j < 64; ++j) kf[j] = kr[j]; }
                else { const bf16* kr = KI_ + ((size_t)NTP + (size_t)b * DEC_SEQ + (s - PAST_LEN)) * 64;
#pragma unroll
                    for (int j = 0; j < 64; ++j) kf[j] = bf2f(kr[j]); }
                float a = 0.f;
#pragma unroll
                for (int h = 0; h < 8; ++h) { float d = 0.f;
#pragma unroll
                    for (int j = 0; j < 64; ++j) d += qv[h * 64 + j] * kf[j];
                    a += qv[512 + h] * fmaxf(d, 0.f); }
                const int kb_ = __float_as_int(a); key = kb_ ^ ((kb_ >> 31) & 0x7fffffff); }
            sck[s] = key; } }
    __syncthreads();
    if (wave_ == 0) { const unsigned long long myw = wave_select<33>(sck, 33, lane_); if (lane_ < 33) mrow[lane_] = myw; }
    __syncthreads();
}
__device__ __forceinline__ void sample_attn_row(LAS unsigned char* lds, int b, int r, const unsigned long long* mrow, bf16* qo_row  , const float* cache_k_, const float* cache_v_,
                                                 const float* k_new, const float* v_new  , const float* rel_bias_) {
    const int tid_ = threadIdx.x, lane_ = tid_ & 63, h = __builtin_amdgcn_readfirstlane(tid_ >> 6);
    LAS int* idx = (LAS int*)(lds + RING_OFF);
    LAS float* qf = (LAS float*)(lds + RING_OFF + 1024) + h * 128;
    if (h == 0) { int base = 0; const unsigned long long lt = (1ull << lane_) - 1ull;
        for (int w = 0; w < 33; ++w) { const unsigned long long bits = mrow[w]; if ((bits >> lane_) & 1ull) idx[base + __builtin_popcountll(bits & lt)] = 64 * w + lane_; base += __builtin_popcountll(bits); } }
    qf[lane_] = bf2f(qo_row[h * 128 + lane_]); qf[64 + lane_] = bf2f(qo_row[h * 128 + 64 + lane_]);
    __syncthreads();
    const int qpos = PAST_LEN + r; float lg[4]; int sk[4];
#pragma unroll
    for (int rnd = 0; rnd < 4; ++rnd) { const int s = idx[64 * rnd + lane_]; sk[rnd] = s;
        const float* kr = (s < PAST_LEN) ? cache_k_ + ((size_t)b * PAST_LEN + s) * 1024 + h * 128 : k_new + (size_t)(s - PAST_LEN) * 1024 + h * 128;
        float d = 0.f;
#pragma unroll 8
        for (int d4 = 0; d4 < 32; ++d4) { const f32x4 kk = *(const f32x4*)(kr + 4 * d4); const f32x4 qq = *(LAS const f32x4*)(qf + 4 * d4); d += (kk.x * qq.x + kk.y * qq.y) + (kk.z * qq.z + kk.w * qq.w); }
        lg[rnd] = d * 0.08838834764831845f + rel_bias_[t5b(s - qpos) * 8 + h]; }
    float mx = fmaxf(fmaxf(lg[0], lg[1]), fmaxf(lg[2], lg[3]));
#pragma unroll
    for (int o_ = 1; o_ < 64; o_ <<= 1) mx = fmaxf(mx, __shfl_xor(mx, o_));
    float p[4], sum = 0.f;
#pragma unroll
    for (int rnd = 0; rnd < 4; ++rnd) { p[rnd] = __expf(lg[rnd] - mx); sum += p[rnd]; }
    sum = wave_sum(sum);
    float a0 = 0.f, a1 = 0.f;
#pragma unroll
    for (int rnd = 0; rnd < 4; ++rnd) {
#pragma unroll 8
        for (int j = 0; j < 64; ++j) { const float pj = __int_as_float(__builtin_amdgcn_readlane(__float_as_int(p[rnd]), j)); const int sj = __builtin_amdgcn_readlane(sk[rnd], j);
            const float* vr = (sj < PAST_LEN) ? cache_v_ + ((size_t)b * PAST_LEN + sj) * 1024 + h * 128 : v_new + (size_t)(sj - PAST_LEN) * 1024 + h * 128;
            const float2 vv = *(const float2*)(vr + 2 * lane_); a0 += pj * vv.x; a1 += pj * vv.y; } }
    const float inv = 1.0f / sum;
    *(unsigned*)(qo_row + h * 128 + 2 * lane_) = pk2(a0 * inv, a1 * inv);
    __syncthreads();
}

typedef const __attribute__((address_space(4))) Args* kargp_t;
#define MK_ARGS kargp_t ap_ = (kargp_t)__builtin_amdgcn_kernarg_segment_ptr(); asm volatile("" : "+s"(ap_))
#define args (*ap_)
__global__ void __launch_bounds__(NWAVES * 64, 2) mk_fwd(Args kargs_by_value) {
    extern __shared__ __attribute__((aligned(16))) unsigned char lds_raw[];
    LAS unsigned char* lds = (LAS unsigned char*)lds_raw;
    int lo, hi; unsigned* barw;
    { MK_ARGS; lo = args.ph_lo; hi = args.ph_hi; barw = (unsigned*)((gu32*)(args.ws + WS_CTL) + CW_BAR); }
    volatile LAS unsigned* MISC = (volatile LAS unsigned*)(lds + MISC_OFF);
    for (int u = threadIdx.x; u < (LDS_BYTES - LDSCTL_OFF) / 4; u += NWAVES * 64) ((LAS unsigned*)(lds + LDSCTL_OFF))[u] = 0u;
    __syncthreads();
    XcdBarrier bar = xcd_barrier_post(barw, MISC + 8);
#ifndef DUPMASK
#define DUPMASK 0
#endif
#ifndef PHMASK
#define PHMASK 0x3ff
#endif
#define IN(k) (((PHMASK >> (k)) & 1) && lo <= (k) && (k) < hi)
#define GBAR() xcd_barrier(bar)
#define WMIX ((bf16*)(args.ws + WS_WMIX))
#define WMRG ((bf16*)(args.ws + WS_WMRG))
#define WAB ((bf16*)(args.ws + WS_WAB))
#define WO ((bf16*)(args.ws + WS_WO))
#define XB ((bf16*)(args.ws + WS_XB))
#define QA ((bf16*)(args.ws + WS_QA))
#define KA ((bf16*)(args.ws + WS_KA))
#define VA ((bf16*)(args.ws + WS_VA))
#define QB ((bf16*)(args.ws + WS_QB))
#define QI ((bf16*)(args.ws + WS_QI))
#define KI ((bf16*)(args.ws + WS_KI))
#define SM ((float*)(args.ws + WS_SM))
#define MASK ((unsigned long long*)(args.ws + WS_MASK))
#define MASKS ((unsigned long long*)(args.ws + WS_MASKS))
#define HST ((float*)(args.ws + WS_HST))
#define BC ((float*)(args.ws + WS_BC))
#define WV ((float*)(args.ws + WS_WV))
#define CMX ((float*)(args.ws + WS_CMX))
#define CHS ((float*)(args.ws + WS_CHS))
#define MCH (CHS + 2 * NCHK)
#define SMATP ((float*)(args.ws + WS_SMAT))
#define SMATS (SMATP + 128 * 4096)
#define CB ((float*)(args.ws + WS_CB))
#define NBf ((float*)(args.ws + WS_NB))
#define HA VA
#define OB QB
#define BR QA
#define SGA ((bf16*)(args.ws + WS_HA))
#define SGB KBc
#define MX XB
#define y_prompt (args.out)
#define y_sample (y_prompt + (size_t)NTP * 1024)
#define k_prompt (y_sample + (size_t)NTS * 1024)
#define v_prompt (k_prompt + (size_t)NTP * 1024)
#define ik_prompt (v_prompt + (size_t)NTP * 1024)
#define C_prompt (ik_prompt + (size_t)NTP * 64)
#define n_prompt (C_prompt + (size_t)BATCH * 4 * 65536)
#define m_prompt (n_prompt + (size_t)BATCH * 1024)
#define k_sample (m_prompt + BATCH * 4)
#define v_sample (k_sample + (size_t)NTS * 1024)
#define ik_sample (v_sample + (size_t)NTS * 1024)
#define C_sample (ik_sample + (size_t)NTS * 64)
#define n_sample (C_sample + (size_t)DEC_BATCH * 4 * 65536)
#define m_sample (n_sample + (size_t)DEC_BATCH * 1024)
#define KBc ((bf16*)y_prompt)
#define VBc (KBc + (size_t)NTP * 1024)
#define cache_k (args.in[2])
#define cache_v (args.in[3])
#define cache_ik (args.in[4])
#define state_C (args.in[5])
#define state_n (args.in[6])
#define state_m (args.in[7])
#define b_gates (args.in[9])
#define a_norm_g (args.in[10])
#define rel_bias (args.in[14])
#define ln_g (args.in[15])
#define ln_b (args.in[16])
#define gtid ({ int t__ = (int)threadIdx.x; asm volatile("" : "+v"(t__)); (long)blockIdx.x * (NWAVES * 64) + (long)t__; })
#define GT ((long)gridDim.x * (NWAVES * 64))
#define gw (vcu * NWAVES + wave)
#define NGW ((int)gridDim.x * NWAVES)
#define tid ((int)threadIdx.x)
#define lane ((int)(threadIdx.x & 63))
#define wave (__builtin_amdgcn_readfirstlane((int)(threadIdx.x >> 6)))
#define G ((int)gridDim.x)
#define vcu ((G % 8 == 0) ? ((int)blockIdx.x % 8) * (G / 8) + (int)blockIdx.x / 8 : (int)blockIdx.x)

    if (IN(0))
#if (DUPMASK >> 0) & 1
    for (int rep_ = 0; rep_ < 2; ++rep_)
#endif
    { MK_ARGS;
        P0Args a{args.in[0], args.in[1], args.in[8], args.in[11], args.in[12], args.in[13], XB, WMIX, WMRG, WAB, WO};
        p0_prologue(a, lds, vcu, G, wave, lane);
        GBAR();
    }
    if (IN(1))
#if (DUPMASK >> 1) & 1
    for (int rep_ = 0; rep_ < 2; ++rep_)
#endif
    { MK_ARGS;
        pg8::Gemm g{XB, WMIX, NTOK, N_MIX, 1024}; pg8::StaticOrder S; S.init(NTOK, N_MIX, G, (int)blockIdx.x);
        pg8::EpiMix E{QA, KBc, QI, KI, SM, k_prompt, k_sample, ik_prompt, ik_sample};
        pg8::gemm_phase<pg8::EpiMix, pg8::StaticOrder, true, true>(lds + RING_OFF, g, S, E);
        GBAR();
    }
    if (IN(2))
#if (DUPMASK >> 2) & 1
    for (int rep_ = 0; rep_ < 2; ++rep_)
#endif
    { MK_ARGS;
        static_assert(ml::L_END <= LDSCTL_OFF, "mLSTM LDS image");
#ifdef PROBE_ML
#define HAREF ((bf16*)(args.ws + WS_HA))
        for (long t = gtid; t < NCHK; t += GT) {
            int h, L; long tok0;
            if (t < 4096) { const int b = (int)(t >> 7); h = (int)((t >> 5) & 3); const int c = (int)(t & 31); tok0 = (long)b * SEQ + c * 64; L = 64; }
            else { const int b = (int)((t - 4096) >> 2); h = (int)((t - 4096) & 3); tok0 = NTP + (long)b * DEC_SEQ; L = DEC_SEQ; }
            const float bi = b_gates[h], bfg = b_gates[4 + h]; float cum = 0.f, cmax = -INFINITY;
            for (int l = 0; l < L; ++l) { const long tok = tok0 + l; const float ig = SM[tok * 16 + 8 + h] + bi; const float lf = logsig(SM[tok * 16 + 12 + h] + bfg);
                cum += lf; const float w = ig - cum; cmax = fmaxf(cmax, w); BC[tok * 4 + h] = cum; WV[tok * 4 + h] = w; CMX[tok * 4 + h] = cmax; }
            CHS[2 * t] = cum; CHS[2 * t + 1] = cmax;
        }
        GBAR();
        for (long t = gtid; t < BATCH * 4 + DEC_BATCH * 4; t += GT) {
            if (t < BATCH * 4) { float m = 0.f; for (int c = 0; c < 32; ++c) { const long i = t * 32 + c; MCH[i] = m; m = CHS[2 * i] + fmaxf(m, CHS[2 * i + 1]); } m_prompt[t] = m; }
            else { const long j = t - BATCH * 4; const long i = 4096 + j; float m = state_m[j]; MCH[i] = m; m = CHS[2 * i] + fmaxf(m, CHS[2 * i + 1]); m_sample[j] = m; }
        }
        GBAR();
        for (int c = 0; c < 32; ++c) {
            const long nSp = 128L * 4096, nSs = (c == 0) ? 64L * 1024 : 0;
            for (long t = gtid; t < nSp + nSs; t += GT) {
                int bh, l, s, L; long tok0; float* dst;
                if (t < nSp) { bh = (int)(t >> 12); l = (int)((t >> 6) & 63); s = (int)(t & 63); L = 64; tok0 = (long)(bh >> 2) * SEQ + c * 64; dst = SMATP + t; }
                else { const long u = t - nSp; bh = (int)(u >> 10); l = (int)((u >> 5) & 31); s = (int)(u & 31); L = 32; tok0 = NTP + (long)(bh >> 2) * DEC_SEQ; dst = SMATS + u; }
                const int h = bh & 3; float val = 0.f;
                if (s <= l) { const long tl = tok0 + l, ts = tok0 + s; const bf16* q = QA + tl * 1024 + h * 256; const bf16* k = KA + ts * 1024 + h * 256;
                    float d = 0.f; for (int i = 0; i < 256; ++i) d += bf2f(q[i]) * bf2f(k[i]);
                    const long ci = (t < nSp) ? (long)bh * 32 + c : 4096 + bh;
                    val = d * __expf(WV[ts * 4 + h] - fmaxf(MCH[ci], CMX[tl * 4 + h])); }
                *dst = val;
            }
            GBAR();
            const long nHp = 32L * 64 * 1024, nHs = (c == 0) ? 16L * 32 * 1024 : 0, nCp = 128L * 65536, nCs = (c == 0) ? 64L * 65536 : 0;
            for (long t = gtid; t < nHp + nHs + nCp + nCs; t += GT) {
                if (t < nHp + nHs) {
                    int b, l, h, dv, L; long tok0, ci; const float* Sr; const float* Cm; const float* nv; bool zero = false;
                    if (t < nHp) { b = (int)(t >> 16); l = (int)((t >> 10) & 63); h = (int)((t >> 8) & 3); dv = (int)(t & 255); L = 64; tok0 = (long)b * SEQ + c * 64; ci = (long)(b * 4 + h) * 32 + c;
                        Sr = SMATP + ((long)(b * 4 + h) * 64 + l) * 64; Cm = CB + (size_t)(c & 1) * 128 * 65536 + (size_t)(b * 4 + h) * 65536; nv = NBf + (c & 1) * 128 * 256 + (b * 4 + h) * 256; zero = (c == 0); }
                    else { const long u = t - nHp; b = (int)(u >> 15); l = (int)((u >> 10) & 31); h = (int)((u >> 8) & 3); dv = (int)(u & 255); L = 32; tok0 = NTP + (long)b * DEC_SEQ; ci = 4096 + b * 4 + h;
                        Sr = SMATS + ((long)(b * 4 + h) * 32 + l) * 32; Cm = state_C + (size_t)(b * 4 + h) * 65536; nv = state_n + (b * 4 + h) * 256; }
                    const long tl = tok0 + l; const bf16* q = QA + tl * 1024 + h * 256;
                    const float mc = MCH[ci], Ml = fmaxf(mc, CMX[tl * 4 + h]), bl = BC[tl * 4 + h]; const float inter = __expf(mc - Ml);
                    float num = 0.f, den = 0.f;
                    for (int s = 0; s <= l; ++s) { const float sv = Sr[s]; num += sv * bf2f(VA[(tok0 + s) * 1024 + h * 256 + dv]); den += sv; }
                    if (!zero) { float qc = 0.f, qn = 0.f; for (int i = 0; i < 256; ++i) { const float qi_ = bf2f(q[i]); qc += qi_ * Cm[(size_t)i * 256 + dv]; qn += qi_ * nv[i]; } num += inter * qc; den += inter * qn; }
                    const float hv = num / fmaxf(fabsf(den), __expf(-(bl + Ml)));
                    HAREF[tl * 1024 + h * 256 + dv] = (bf16)f2bf(hv);
                } else {
                    const long u0 = t - (nHp + nHs); int bh, dk, dv, L; long tok0, ci; const float* Cs; const float* ns; float* Cd; float* nd; bool zero = false;
                    if (u0 < nCp) { bh = (int)(u0 >> 16); dk = (int)((u0 >> 8) & 255); dv = (int)(u0 & 255); L = 64; tok0 = (long)(bh >> 2) * SEQ + c * 64; ci = (long)bh * 32 + c; zero = (c == 0);
                        Cs = CB + (size_t)(c & 1) * 128 * 65536 + (size_t)bh * 65536; ns = NBf + (c & 1) * 128 * 256 + bh * 256;
                        Cd = (c == 31) ? C_prompt + (size_t)bh * 65536 : CB + (size_t)((c + 1) & 1) * 128 * 65536 + (size_t)bh * 65536; nd = (c == 31) ? n_prompt + bh * 256 : NBf + ((c + 1) & 1) * 128 * 256 + bh * 256; }
                    else { const long u = u0 - nCp; bh = (int)(u >> 16); dk = (int)((u >> 8) & 255); dv = (int)(u & 255); L = 32; tok0 = NTP + (long)(bh >> 2) * DEC_SEQ; ci = 4096 + bh;
                        Cs = state_C + (size_t)bh * 65536; ns = state_n + bh * 256; Cd = C_sample + (size_t)bh * 65536; nd = n_sample + bh * 256; }
                    const int h = bh & 3; const float mc = MCH[ci]; const float Mlast = fmaxf(mc, CMX[(tok0 + L - 1) * 4 + h]); const float decay = __expf(mc - Mlast);
                    float aC = 0.f, an = 0.f;
                    for (int s = 0; s < L; ++s) { const long ts = tok0 + s; const float wsv = __expf(WV[ts * 4 + h] - Mlast); const float kk = bf2f(KA[ts * 1024 + h * 256 + dk]);
                        aC += wsv * kk * bf2f(VA[ts * 1024 + h * 256 + dv]); an += wsv * kk; }
                    Cd[(size_t)dk * 256 + dv] = (zero ? 0.f : decay * Cs[(size_t)dk * 256 + dv]) + aC;
                    if (dv == 0) nd[dk] = (zero ? 0.f : decay * ns[dk]) + an;
                }
            }
            GBAR();
        }
#endif
#define ML_RS(p, bytes) __builtin_amdgcn_make_buffer_rsrc((void*)(p), (short)0, (int)(bytes), 0x00020000)
        if (vcu < BATCH * 8) { const int bh = vcu >> 1, dvh = vcu & 1, b = bh >> 2, h = bh & 3; const size_t t0 = (size_t)b * SEQ;
            ml::Item it; it.q = ML_RS(QA + t0 * 1024 + h * 256, SEQ * 2048); it.k = ML_RS(KA + t0 * 1024 + h * 256, SEQ * 2048); it.v = ML_RS(VA + t0 * 1024 + h * 256 + dvh * 128, SEQ * 2048); it.sm = ML_RS(SM + t0 * 16, SEQ * 64);
            it.C0 = ML_RS(C_prompt, 4); it.has0 = false; it.n0 = nullptr; it.m0 = 0.f; it.Cout = ML_RS(C_prompt + (size_t)bh * 65536 + dvh * 128, 65536 * 4);
            it.nout = dvh == 0 ? n_prompt + bh * 256 : nullptr; it.mout = dvh == 0 ? m_prompt + bh : nullptr;
            it.head = h; it.nchunk = SEQ / CHUNK; it.L = CHUNK; it.bi = b_gates[h]; it.bf = b_gates[4 + h]; it.hout = it.v;
#if (DUPMASK >> 2) & 1
            { float* no_ = it.nout; float* mo_ = it.mout;
              for (int dry_ = 1; dry_ >= 0; --dry_) { it.hout = dry_ ? ML_RS(args.ws + WS_HA, SEQ * 2048) : it.v; it.Cout = dry_ ? ML_RS(args.ws + WS_HA + 8 * MiB + (size_t)vcu * 65536 * 4, 65536 * 4) : ML_RS(C_prompt + (size_t)bh * 65536 + dvh * 128, 65536 * 4);
                  it.nout = dry_ ? nullptr : no_; it.mout = dry_ ? nullptr : mo_; ml::run_item(lds, it); } } }
#else
            ml::run_item(lds, it); }
#endif
        if (vcu < DEC_BATCH * 8) { const int bh = vcu >> 1, dvh = vcu & 1, b = bh >> 2, h = bh & 3; const size_t t0 = (size_t)NTP + (size_t)b * DEC_SEQ;
            ml::Item it; it.q = ML_RS(QA + t0 * 1024 + h * 256, DEC_SEQ * 2048); it.k = ML_RS(KA + t0 * 1024 + h * 256, DEC_SEQ * 2048); it.v = ML_RS(VA + t0 * 1024 + h * 256 + dvh * 128, DEC_SEQ * 2048); it.sm = ML_RS(SM + t0 * 16, DEC_SEQ * 64);
            it.C0 = ML_RS(state_C + (size_t)bh * 65536 + dvh * 128, 65536 * 4); it.has0 = true; it.n0 = state_n + bh * 256; it.m0 = state_m[bh]; it.Cout = ML_RS(C_sample + (size_t)bh * 65536 + dvh * 128, 65536 * 4);
            it.nout = dvh == 0 ? n_sample + bh * 256 : nullptr; it.mout = dvh == 0 ? m_sample + bh : nullptr;
            it.head = h; it.nchunk = 1; it.L = DEC_SEQ; it.bi = b_gates[h]; it.bf = b_gates[4 + h]; it.hout = it.v;
            ml::run_item(lds, it); }
#undef ML_RS
        GBAR();
#ifdef PROBE_ML
        { float num = 0.f, den = 0.f;
          for (long t = gtid; t < (long)NTOK * 1024; t += GT) { const float a = bf2f(HA[t]), r = bf2f(HAREF[t]); num += (a - r) * (a - r); den += r * r; }
          num = wave_sum(num); den = wave_sum(den);
          if (lane == 0) { atomicAdd((float*)(args.ws + WS_CTL) + 8, num); atomicAdd((float*)(args.ws + WS_CTL) + 9, den); } }
#endif
        { const int sub = lane >> 3, l8 = lane & 7;
          for (long t0 = (long)gw * 8; t0 < (long)NTOK * 4; t0 += (long)NGW * 8) { const long t = t0 + sub;
              const GAS v4u* src = (const GAS v4u*)(HA + t * 256 + l8 * 32); v4u w[4];
#pragma unroll
              for (int j = 0; j < 4; ++j) w[j] = src[j];
              float f[32];
#pragma unroll
              for (int j = 0; j < 4; ++j)
#pragma unroll
                  for (int e = 0; e < 4; ++e) { f[8 * j + 2 * e] = __uint_as_float(w[j][e] << 16); f[8 * j + 2 * e + 1] = __uint_as_float(w[j][e] & 0xffff0000u); }
              float s1 = 0.f;
#pragma unroll
              for (int e = 0; e < 32; ++e) s1 += f[e];
              s1 += __shfl_xor(s1, 1); s1 += __shfl_xor(s1, 2); s1 += __shfl_xor(s1, 4);
              const float mean = s1 * (1.0f / 256.0f); float s2 = 0.f;
#pragma unroll
              for (int e = 0; e < 32; ++e) { const float d = f[e] - mean; s2 += d * d; }
              s2 += __shfl_xor(s2, 1); s2 += __shfl_xor(s2, 2); s2 += __shfl_xor(s2, 4);
              if (l8 == 0) { HST[t * 2] = mean; HST[t * 2 + 1] = 1.0f / sqrtf(s2 * (1.0f / 256.0f) + HEAD_NORM_EPS); } } }
    }
    if (IN(3))
#if (DUPMASK >> 3) & 1
    for (int rep_ = 0; rep_ < 2; ++rep_)
#endif
    { MK_ARGS;
        {
            typedef short bfx8 __attribute__((ext_vector_type(8))); typedef float f16v __attribute__((ext_vector_type(16)));
            LAS int* sck = (LAS int*)(lds + RING_OFF);
            const int hi = lane >> 5, r32 = lane & 31;
            for (int w4 = 0; w4 < 4; ++w4) {
                const int bW = vcu >> 3, jW = vcu & 7; const int cW = (w4 == 0) ? jW : (w4 == 1) ? 15 - jW : (w4 == 2) ? 16 + jW : 31 - jW;
                if (vcu >= BATCH * 8) break;
                const int S = 64 * (cW + 1), nW = cW + 1; const long tok0 = (long)bW * SEQ + 64 * cW;
                if (S <= TOPK_MAX) {
                    for (int k = 0; k < 8; ++k) { if (lane < 32) MASK[(size_t)(tok0 + wave * 8 + k) * 32 + lane] = (lane < nW) ? ~0ull : 0ull; }
                    continue; }
                { LAS unsigned char* qil = lds + RING_OFF + 65536; LAS float* sml = (LAS float*)(lds + RING_OFF + 65536 + 73728);
#pragma unroll
                  for (int i = 0; i < 8; ++i) { const int p_ = tid + 512 * i, row_ = p_ >> 6, wi_ = p_ & 63;
                      *(LAS v4u*)(qil + row_ * 1152 + (wi_ >> 3) * 144 + (wi_ & 7) * 16) = *(const v4u*)(QI + (size_t)(tok0 + row_) * 512 + wi_ * 8); }
                  sml[tid] = SM[(size_t)(tok0 + (tid >> 3)) * 16 + (tid & 7)] * 0.35355339059327373f;
                  asm volatile("s_waitcnt vmcnt(0) lgkmcnt(0)" ::: "memory"); __builtin_amdgcn_s_barrier(); asm volatile("" ::: "memory"); }
                bfx8 bfr[8][4];
#pragma unroll
                for (int i = 0; i < 8; ++i) { const int kt = wave + 8 * i;
                    if (kt < 2 * nW) { const bf16* kp = KI + ((size_t)bW * SEQ + 32 * kt + r32) * 64 + hi * 8;
#pragma unroll
                        for (int ks = 0; ks < 4; ++ks) bfr[i][ks] = *(const bfx8*)(kp + ks * 16); }
                    else {
#pragma unroll
                        for (int ks = 0; ks < 4; ++ks) bfr[i][ks] = (bfx8){0, 0, 0, 0, 0, 0, 0, 0}; } }
                for (int rd = 0; rd < 8; ++rd) {
                    bfx8 afr[2][4]; float wgt[2][16];
                    { const int blk = r32 >> 2; const int qa_ = 2 * (blk & 1) + (blk >> 2), ha_ = 4 * ((blk >> 1) & 1) + (r32 & 3);
                      LAS const unsigned char* qil = lds + RING_OFF + 65536; LAS const float* sml = (LAS const float*)(lds + RING_OFF + 65536 + 73728);
#pragma unroll
                      for (int rt = 0; rt < 2; ++rt) { LAS const unsigned char* qp = qil + (8 * rd + 4 * rt + qa_) * 1152 + ha_ * 144 + hi * 16;
#pragma unroll
                          for (int ks = 0; ks < 4; ++ks) afr[rt][ks] = *(LAS const bfx8*)(qp + ks * 32);
#pragma unroll
                          for (int qq = 0; qq < 2; ++qq) { LAS const float* wp = sml + (8 * rd + 4 * rt + 2 * hi + qq) * 8;
                              const f32x4 w0 = *(LAS const f32x4*)wp, w1 = *(LAS const f32x4*)(wp + 4);
                              wgt[rt][8 * qq + 0] = w0[0]; wgt[rt][8 * qq + 1] = w0[1]; wgt[rt][8 * qq + 2] = w0[2]; wgt[rt][8 * qq + 3] = w0[3];
                              wgt[rt][8 * qq + 4] = w1[0]; wgt[rt][8 * qq + 5] = w1[1]; wgt[rt][8 * qq + 6] = w1[2]; wgt[rt][8 * qq + 7] = w1[3]; } } }
#pragma unroll
                    for (int i8 = 0; i8 < 8; ++i8) { const int kt = wave + 8 * i8; if (kt < 2 * nW) {
#pragma unroll
                        for (int rt = 0; rt < 2; ++rt) { f16v acc = {};
#pragma unroll
                            for (int ks = 0; ks < 4; ++ks) acc = __builtin_amdgcn_mfma_f32_32x32x16_bf16(afr[rt][ks], bfr[i8][ks], acc, 0, 0, 0);
                            float sA = 0.f, sB = 0.f;
#pragma unroll
                            for (int i = 0; i < 8; ++i) { sA += wgt[rt][i] * fmaxf(acc[i], 0.f); sB += wgt[rt][8 + i] * fmaxf(acc[8 + i], 0.f); }
                            const int kA = __float_as_int(sA), kB = __float_as_int(sB);
                            sck[(4 * rt + 2 * hi) * 2048 + 32 * kt + r32] = kA ^ ((kA >> 31) & 0x7fffffff);
                            sck[(4 * rt + 2 * hi + 1) * 2048 + 32 * kt + r32] = kB ^ ((kB >> 31) & 0x7fffffff); }
                    } }
                    asm volatile("s_waitcnt lgkmcnt(0)" ::: "memory"); __builtin_amdgcn_s_barrier(); asm volatile("" ::: "memory");
                    { const unsigned long long myw = (nW <= 16) ? wave_select<16>(sck + wave * 2048, nW, lane) : wave_select<32>(sck + wave * 2048, nW, lane); if (lane < 32) MASK[(size_t)(tok0 + 8 * rd + wave) * 32 + lane] = myw; }
                    asm volatile("s_waitcnt lgkmcnt(0)" ::: "memory"); __builtin_amdgcn_s_barrier(); asm volatile("" ::: "memory");
                }
            }
        }
        for (int row = NTP + vcu; row < NTOK; row += G) sample_select_row(lds, row, MASKS + (size_t)(row - NTP) * 40, QI, SM, KI, cache_ik);
        GBAR();
    }
#ifdef PROBE_ATT
    if (IN(4)) { MK_ARGS;
        unsigned long long* MREF = (unsigned long long*)(args.ws + WS_END); bf16* OREF = (bf16*)(args.ws + WS_END + 2 * MiB);
        for (int pr = vcu; pr < 4096; pr += G) { const int row = pr < 2048 ? pr : 31 * SEQ + (pr - 2048); simple_select_row(lds, row, MREF + (size_t)pr * 32, QI, SM, KI, cache_ik); }
        GBAR();
        for (long t = gtid; t < 4096L * 64; t += GT) { const int dc = (int)(t & 7), h = (int)((t >> 3) & 7); const int pr = (int)(t >> 6); const int row = pr < 2048 ? pr : 31 * SEQ + (pr - 2048);
            simple_attn_task(row, h, dc, MREF + (size_t)pr * 32, QB, KBc, VBc, cache_k, cache_v, k_sample, v_sample, rel_bias, OREF + (size_t)pr * 1024 + h * 128 + dc * 16); }
        GBAR();
    }
#endif
    if (IN(4)) { MK_ARGS;
        {
            char* alds = (char*)lds_raw;
            for (int bh = vcu; bh < BATCH * 8; bh += G) {
                const int b = bh >> 3, h = bh & 7;
                if (tid < 320) ((float*)(alds + at2::BT_OFF))[tid] = rel_bias[t5b(tid - 256) * 8 + h] * (1.0f / at2::SCALE);
                const float cfar = __int_as_float(__builtin_amdgcn_readfirstlane(__float_as_int(rel_bias[15 * 8 + h] * (1.0f / at2::SCALE))));
                at2::Ctx C;
                C.Q = __builtin_amdgcn_make_buffer_rsrc((void*)(QB + (size_t)b * SEQ * 1024 + h * 128), (short)0, SEQ * 1024 * 2, 0x00020000);
                C.K = __builtin_amdgcn_make_buffer_rsrc((void*)(KBc + (size_t)b * SEQ * 1024 + h * 128), (short)0, SEQ * 1024 * 2, 0x00020000);
                C.V = __builtin_amdgcn_make_buffer_rsrc((void*)(VBc + (size_t)b * SEQ * 1024 + h * 128), (short)0, SEQ * 1024 * 2, 0x00020000);
                C.M = __builtin_amdgcn_make_buffer_rsrc((void*)(MASK + (size_t)b * SEQ * 32), (short)0, SEQ * 32 * 8, 0x00020000);
                C.O = C.Q;
#if (DUPMASK >> 4) & 1
                for (int dry_ = 1; dry_ >= 0; --dry_) { C.O = dry_ ? __builtin_amdgcn_make_buffer_rsrc((void*)(args.ws + WS_HA), (short)0, SEQ * 1024 * 2, 0x00020000) : C.Q;
#endif
                at2::Seam S; at2::dsa_prime(C, 0, alds, S);
                for (int u = 0; u < 8; ++u) at2::dsa_block(C, u * 256, (u < 7 ? u + 1 : u) * 256, alds, S, cfar);
#if (DUPMASK >> 4) & 1
                }
#endif
            }
        }
#ifdef PROBE_SAMP
        { unsigned long long* MREF = (unsigned long long*)(args.ws + WS_END); bf16* OREF = (bf16*)(args.ws + WS_END + 2 * MiB);
          for (int row = NTP + vcu; row < NTOK; row += G) simple_select_row(lds, row, MREF + (size_t)(row - NTP) * 40, QI, SM, KI, cache_ik);
          GBAR();
          for (long t = gtid; t < (long)NTS * 64; t += GT) { const int dc = (int)(t & 7), h = (int)((t >> 3) & 7); const int pr = (int)(t >> 6);
              simple_attn_task(NTP + pr, h, dc, MREF + (size_t)pr * 40, QB, KBc, VBc, cache_k, cache_v, k_sample, v_sample, rel_bias, OREF + (size_t)pr * 1024 + h * 128 + dc * 16); }
          GBAR(); }
#endif
        for (int pr = vcu; pr < NTS; pr += G) { const int b = pr / DEC_SEQ, r = pr % DEC_SEQ;
            sample_attn_row(lds, b, r, MASKS + (size_t)pr * 40, OB + (size_t)(NTP + pr) * 1024, cache_k, cache_v, k_sample + (size_t)b * DEC_SEQ * 1024, v_sample + (size_t)b * DEC_SEQ * 1024, rel_bias); }
        GBAR();
#ifdef PROBE_SAMP
        { const unsigned long long* MREF = (const unsigned long long*)(args.ws + WS_END); const bf16* OREF = (const bf16*)(args.ws + WS_END + 2 * MiB); float num = 0.f, den = 0.f, dif = 0.f;
          for (long t = gtid; t < (long)NTS * 1024; t += GT) { const float a = bf2f(OB[(size_t)NTP * 1024 + t]), r_ = bf2f(OREF[t]); num += (a - r_) * (a - r_); den += r_ * r_; }
          for (long t = gtid; t < (long)NTS * 33; t += GT) { const int pr = (int)(t / 33), w = (int)(t % 33); dif += (float)__builtin_popcountll(MASKS[(size_t)pr * 40 + w] ^ MREF[(size_t)pr * 40 + w]); }
          num = wave_sum(num); den = wave_sum(den); dif = wave_sum(dif);
          if (lane == 0) { atomicAdd((float*)(args.ws + WS_CTL) + 8, num); atomicAdd((float*)(args.ws + WS_CTL) + 9, den); atomicAdd((float*)(args.ws + WS_CTL) + 10, dif); }
          GBAR(); }
#endif
    }
#ifdef PROBE_ATT
    if (IN(4)) { MK_ARGS;
        const bf16* OREF = (const bf16*)(args.ws + WS_END + 2 * MiB); float num = 0.f, den = 0.f;
        for (long t = gtid; t < 4096L * 1024; t += GT) { const int pr = (int)(t >> 10), c = (int)(t & 1023); const int row = pr < 2048 ? pr : 31 * SEQ + (pr - 2048);
            const float a = bf2f(OB[(size_t)row * 1024 + c]), r = bf2f(OREF[t]); num += (a - r) * (a - r); den += r * r; }
        num = wave_sum(num); den = wave_sum(den);
        if (lane == 0) { atomicAdd((float*)(args.ws + WS_CTL) + 8, num); atomicAdd((float*)(args.ws + WS_CTL) + 9, den); }
        GBAR();
    }
#endif
    if (IN(5))
#if (DUPMASK >> 5) & 1
    for (int rep_ = 0; rep_ < 2; ++rep_)
#endif
    { MK_ARGS;
        pg8::Gemm g{XB, WMRG, NTOK, N_M1A + N_M1B, 1024}; pg8::StaticOrder S; S.init(NTOK, N_M1A + N_M1B, G, (int)blockIdx.x);
        pg8::EpiM1 E{pg8::EpiM1a{HA, OB, HST, a_norm_g, BR}, pg8::EpiM1b{SGA, SGB}};
        pg8::gemm_phase<pg8::EpiM1, pg8::StaticOrder, true, true>(lds + RING_OFF, g, S, E);
        GBAR();
    }
    if (IN(7))
#if (DUPMASK >> 7) & 1
    for (int rep_ = 0; rep_ < 2; ++rep_)
#endif
    { MK_ARGS;
        pg8::Gemm g{BR, WAB, NTOK, 1024, 2048}; pg8::StaticOrder S; S.init(NTOK, 1024, G, (int)blockIdx.x);
        pg8::EpiM2 E{SGA, SGB, MX};
        pg8::gemm_phase<pg8::EpiM2, pg8::StaticOrder, true, true>(lds + RING_OFF, g, S, E);
        GBAR();
    }
    if (IN(8))
#if (DUPMASK >> 8) & 1
    for (int rep_ = 0; rep_ < 2; ++rep_)
#endif
    { MK_ARGS;
        pg8::Gemm g{MX, WO, NTOK, 1024, 1024}; pg8::StaticOrder S; S.init(NTOK, 1024, G, (int)blockIdx.x);
        pg8::EpiM3 E{args.in[0], args.in[1], y_prompt, y_sample};
        pg8::gemm_phase<pg8::EpiM3, pg8::StaticOrder, true, true>(lds + RING_OFF, g, S, E);
        GBAR();
    }
    if (IN(9))
#if (DUPMASK >> 9) & 1
    for (int rep_ = 0; rep_ < 2; ++rep_)
#endif
    { MK_ARGS;
        for (int m0 = gw * 2; m0 < NTOK; m0 += NGW * 2) {
            GAS f32x4* yv[2]; f32x4 v[2][4]; float sm_[2] = {0.f, 0.f};
#pragma unroll
            for (int q = 0; q < 2; ++q) { const int m = m0 + q; float* yr = m < NTP ? y_prompt + (size_t)m * 1024 : y_sample + (size_t)(m - NTP) * 1024; yv[q] = (GAS f32x4*)yr + lane;
#pragma unroll
                for (int j = 0; j < 4; ++j) v[q][j] = yv[q][64 * j]; }
#pragma unroll
            for (int q = 0; q < 2; ++q) {
#pragma unroll
                for (int j = 0; j < 4; ++j) sm_[q] += (v[q][j].x + v[q][j].y) + (v[q][j].z + v[q][j].w);
                const float mean = wave_sum(sm_[q]) * (1.f / 1024.f); float s2 = 0.f;
#pragma unroll
                for (int j = 0; j < 4; ++j) { v[q][j] = v[q][j] - mean; s2 += (v[q][j].x * v[q][j].x + v[q][j].y * v[q][j].y) + (v[q][j].z * v[q][j].z + v[q][j].w * v[q][j].w); }
                const float rstd = 1.f / sqrtf(wave_sum(s2) * (1.f / 1024.f) + LN_EPS);
#pragma unroll
                for (int j = 0; j < 4; ++j) { const f32x4 gg = *((const GAS f32x4*)ln_g + lane + 64 * j), bb = *((const GAS f32x4*)ln_b + lane + 64 * j); yv[q][64 * j] = v[q][j] * rstd * gg + bb; } }
        }
    }
#if defined(PROBE_ATT) || defined(PROBE_ML) || defined(PROBE_SAMP)
    { MK_ARGS; GBAR();
      if (blockIdx.x == 0 && threadIdx.x < 64) { const float num = ((volatile float*)(args.ws + WS_CTL))[8], den = ((volatile float*)(args.ws + WS_CTL))[9];
          const float dif = ((volatile float*)(args.ws + WS_CTL))[10];
          m_sample[threadIdx.x] *= 1.0f + 30.0f * (sqrtf(num / den) + dif / (float)(NTS * TOPK_MAX)); } }
#endif
#undef IN
#undef GBAR
#undef args
#undef gtid
#undef GT
#undef gw
#undef NGW
#undef tid
#undef lane
#undef wave
#undef G
#undef vcu
}

extern "C" void kernel_launch(void* const* d_in, const int* in_sizes, int n_in, void* d_out, int out_size, void* d_ws, size_t ws_size, hipStream_t stream) {
    static int grid = 0;
    if (grid == 0) {
        int dev = 0, cus = 0;
        if (hipGetDevice(&dev) != hipSuccess || hipDeviceGetAttribute(&cus, hipDeviceAttributeMultiprocessorCount, dev) != hipSuccess) { grid = -1; return; }
        if (hipFuncSetAttribute((const void*)mk_fwd, hipFuncAttributeMaxDynamicSharedMemorySize, LDS_BYTES) != hipSuccess) { grid = -1; return; }
        (void)hipGetLastError();
        if (n_in != 17 || ws_size < WS_END) { fprintf(stderr, "kernel_launch: needs 17 inputs and %zu bytes of workspace (got %d, %zu)\n", (size_t)WS_END, n_in, ws_size); grid = -1; return; }
        grid = cus;
    }
    if (grid < 0) return;
    if (hipMemsetAsync((unsigned char*)d_ws + WS_CTL, 0, CTL_ZERO_BYTES, stream) != hipSuccess) return;
    Args a{};
    for (int i = 0; i < 17; ++i) a.in[i] = (const float*)d_in[i];
    a.out = (float*)d_out; a.ws = (unsigned char*)d_ws; a.ph_lo = 0; a.ph_hi = 10;
    hipLaunchKernelGGL(mk_fwd, dim3(grid), dim3(NWAVES * 64), LDS_BYTES, stream, a);
}
```

```cpp
#include <hip/hip_runtime.h>
#include <cstdio>
#include <cstdint>
#include <math.h>
#ifndef D_MODEL
#define D_MODEL 1024
#define BATCH 32
#define SEQ 2048
#define DEC_BATCH 16
#define DEC_SEQ 32
#define PAST_LEN 2048
#define CHUNK 64
#define A_HEADS 4
#define A_HEAD_DIM 256
#define B_HEADS 8
#define B_HEAD_DIM 128
#define IDX_HEADS 8
#define IDX_DIM 64
#define TOPK_MAX 256
#define GROUP_B 4
#endif
#define A_WIDTH (A_HEADS * A_HEAD_DIM)
#define B_WIDTH (B_HEADS * B_HEAD_DIM)
#define C_QA 0
#define C_KA (C_QA + A_WIDTH)
#define C_VA (C_KA + A_WIDTH)
#define C_OA (C_VA + A_WIDTH)
#define C_ZA (C_OA + A_WIDTH)
#define C_IA (C_ZA + A_WIDTH)
#define C_FA (C_IA + A_HEADS)
#define C_QB (C_FA + A_HEADS)
#define C_KB (C_QB + B_WIDTH)
#define C_VB (C_KB + B_WIDTH)
#define C_ZB (C_VB + B_WIDTH)
#define C_QI (C_ZB + B_WIDTH)
#define C_KI (C_QI + IDX_HEADS * IDX_DIM)
#define C_WI (C_KI + IDX_DIM)
#define C_GA (C_WI + IDX_HEADS)
#define C_GB (C_GA + D_MODEL)
#define IN_COLS (C_GB + D_MODEL)
#define LN_EPS 1e-5f
#define HEAD_NORM_EPS 1e-6f
#define DN_ALPHA 1.189207115002721f


#define GAS __attribute__((address_space(1)))
#define LAS __attribute__((address_space(3)))
typedef unsigned short bf16;
typedef unsigned v4u __attribute__((ext_vector_type(4)));
typedef float f32x4 __attribute__((ext_vector_type(4)));
typedef short bf16x8 __attribute__((ext_vector_type(8)));
typedef GAS unsigned gu32;
typedef GAS unsigned long long gu64;
#define RLX_AGENT __ATOMIC_RELAXED, __HIP_MEMORY_SCOPE_AGENT
#define LDS_WAIT() asm volatile("s_waitcnt lgkmcnt(0)" ::: "memory")
#define VM_WAIT() asm volatile("s_waitcnt vmcnt(0)" ::: "memory")
__device__ __forceinline__ unsigned long long rt() { return __builtin_amdgcn_s_memrealtime(); }
__device__ __forceinline__ unsigned f2bf(float f) { unsigned u = __builtin_bit_cast(unsigned, f); return (u + 0x7fffu + ((u >> 16) & 1u)) >> 16; }
__device__ __forceinline__ unsigned pk2(float lo, float hi) { return f2bf(lo) | (f2bf(hi) << 16); }

#define XB_TMO      128
#define XB_XCNT(j)  (256  + 64 * (j))
#define XB_XSUB(j)  (1280 + 64 * (j))
#define XB_XGEN(j)  (2304 + 64 * (j))
#define XB_TOP      3328
#define XB_TOPGEN   3392
#define XCD_BAR_WORDS 3456
#define XB_SPIN_CAP (1u << 18)

__device__ __forceinline__ unsigned xb_ld(unsigned* p)              { return __hip_atomic_load(p, __ATOMIC_RELAXED, __HIP_MEMORY_SCOPE_AGENT); }
__device__ __forceinline__ unsigned xb_add(unsigned* p, unsigned v) { return __hip_atomic_fetch_add(p, v, __ATOMIC_RELAXED, __HIP_MEMORY_SCOPE_AGENT); }
__device__ __forceinline__ unsigned xb_xcc_id() { return (unsigned)__builtin_amdgcn_s_getreg((3 << 11) | 20) & 0xFu; }
#define XB_SPIN(cond, bar) do { unsigned _sp = 0; while (cond) { __builtin_amdgcn_s_sleep(1); \
    if ((++_sp & 255u) == 0u) { if (xb_ld(&(bar)[XB_TMO])) break; if (_sp > XB_SPIN_CAP) { atomicAdd(&(bar)[XB_TMO], 1u); break; } } } } while (0)

struct XcdBarrier {
    unsigned* bar; unsigned x;
    volatile LAS unsigned* st;
};

__device__ __forceinline__ XcdBarrier xcd_barrier_post(unsigned* bar, volatile LAS unsigned* st) {
    XcdBarrier b; b.bar = bar; b.x = xb_xcc_id(); b.st = st;
    if (threadIdx.x == 0) (void)xb_add(&bar[XB_XCNT(b.x)], 1u);
    return b;
}
__device__ __forceinline__ void xcd_barrier_complete(unsigned* bar, unsigned x, unsigned& nloc, unsigned& nx) {
    const unsigned G = gridDim.x * gridDim.y * gridDim.z;
    unsigned sum, cnt, mine, sp = 0u;
    for (;;) {
        sum = 0u; cnt = 0u; mine = 0u;
#pragma unroll
        for (unsigned j = 0; j < 16; ++j) { const unsigned c = xb_ld(&bar[XB_XCNT(j)]); sum += c; cnt += (c > 0u) ? 1u : 0u; mine = (j == x) ? c : mine; }
        if (sum == G) break;
        __builtin_amdgcn_s_sleep(1);
        if ((++sp & 255u) == 0u) { if (xb_ld(&bar[XB_TMO])) break; if (sp > XB_SPIN_CAP) { atomicAdd(&bar[XB_TMO], 1u); break; } }
    }
    nloc = mine > 0u ? mine : 1u; nx = cnt > 0u ? cnt : 1u;
}

__device__ __forceinline__ void xcd_barrier(const XcdBarrier& b) {
    asm volatile("s_waitcnt vmcnt(0)" ::: "memory");
    __syncthreads();
    if (threadIdx.x == 0) {
        unsigned* bar = b.bar;
        __builtin_amdgcn_s_waitcnt(0);
        unsigned nloc = b.st[0], nx = b.st[1];
        if (nloc == 0u) { xcd_barrier_complete(bar, b.x, nloc, nx); b.st[0] = nloc; b.st[1] = nx; }
        const unsigned old = xb_add(&bar[XB_XSUB(b.x)], 1u);
        const unsigned gen = old / nloc;
        if (old + 1u == (gen + 1u) * nloc) {
            __builtin_amdgcn_fence(__ATOMIC_RELEASE, "agent");
            asm volatile("s_waitcnt vmcnt(0)" ::: "memory");
            const unsigned og = xb_add(&bar[XB_TOP], 1u);
            const unsigned tg = og / nx;
            if (og + 1u == (tg + 1u) * nx) xb_add(&bar[XB_TOPGEN], 1u);
            else XB_SPIN(xb_ld(&bar[XB_TOPGEN]) == tg, bar);
            __builtin_amdgcn_fence(__ATOMIC_ACQUIRE, "agent");
            xb_add(&bar[XB_XGEN(b.x)], 1u);
            asm volatile("s_waitcnt vmcnt(0)" ::: "memory");
        } else {
            XB_SPIN(xb_ld(&bar[XB_XGEN(b.x)]) == gen, bar);
            __builtin_amdgcn_fence(__ATOMIC_ACQUIRE, "agent");
            asm volatile("s_waitcnt vmcnt(0)" ::: "memory");
        }
    }
    __syncthreads();
}

namespace pg8 {
#define PG8_LAS __attribute__((address_space(3)))
typedef unsigned short bf16_t;
typedef short bf16x8 __attribute__((ext_vector_type(8)));
typedef float f32x4 __attribute__((ext_vector_type(4)));
typedef unsigned u32x4 __attribute__((ext_vector_type(4)));
constexpr int BM = 256, BK = 64, HALF = 128, HTB = HALF * BK * 2  , STAGE_BYTES = 8 * HTB, NXCD = 8, WGM = 8;

__host__ __device__ __forceinline__ int lds_byte(int r, int c) { const int st = (r >> 4) * 2 + (c >> 5), rr = r & 15, cc = c & 31, ob = rr * 64 + cc * 2; return st * 1024 + (ob ^ (((ob >> 9) & 1) << 5)); }
__host__ __device__ __forceinline__ void stage_rc(int b, int& R, int& C) { const int st = b / 1024, sb = b % 1024, swz = sb ^ (((sb >> 9) & 1) << 5); R = (st >> 1) * 16 + swz / 64; C = (st & 1) * 32 + (swz % 64) / 2; }
__host__ __device__ __forceinline__ int perm32(int rho) { const int n = rho >> 4, i = rho & 15; return 8 * (i >> 2) + 4 * n + (i & 3); }

struct Unit { int pm, pn; };
struct Gemm { const bf16_t* A; const bf16_t* Bt; int M, N, K; };

struct StaticOrder {
    int nM, nN, nwg, G, c;
    __host__ __device__ void init(int M, int N, int G_, int c_) { nM = M / BM; nN = N / BM; nwg = nM * nN; G = G_; c = c_; }
    __host__ __device__ bool next(int i, Unit& u) const {
        const long L = (long)i * G + c; if (L >= nwg) return false;
        int wgid = (int)L; { const int q = nwg / NXCD, r = nwg % NXCD, xcd = wgid % NXCD, off = wgid / NXCD; wgid = (xcd < r ? xcd * (q + 1) : r * (q + 1) + (xcd - r) * q) + off; }
        const int nig = WGM * nN, gid = wgid / nig, fm = gid * WGM, gsz = (nM - fm) < WGM ? (nM - fm) : WGM;
        u.pm = fm + ((wgid % nig) % gsz); u.pn = (wgid % nig) / gsz; return true;
    }
    __device__ __forceinline__ void a_ready(const Unit&) const {}
    __device__ __forceinline__ void done(const Unit&) const {}
};
__device__ __forceinline__ unsigned cvt_pk_bf16(float lo, float hi) { unsigned r; asm volatile("v_cvt_pk_bf16_f32 %0, %1, %2" : "=v"(r) : "v"(lo), "v"(hi)); return r; }
typedef float f32x2 __attribute__((ext_vector_type(2)));
template <class Epi, class Sched, bool ALIGN_EPI = false, bool SP2 = false>
__device__ __forceinline__ void gemm_phase(PG8_LAS unsigned char* lds, const Gemm g, const Sched& S, const Epi& E) {
    const int tid = threadIdx.x, wid = __builtin_amdgcn_readfirstlane(tid >> 6), lane = tid & 63, wr = wid >> 2, wc = wid & 3, fr = lane & 15, fq = lane >> 4;
    const int K = g.K, nt = K / BK;
    unsigned voffA[2], voffB[2];
#pragma unroll
    for (int i = 0; i < 2; ++i) { int R, C; stage_rc(tid * 16 + i * 8192, R, C); const int Rb = Epi::PERM ? ((R & ~31) + perm32(R & 31)) : R;
        voffA[i] = (unsigned)(R * K + C) * 2u; voffB[i] = (unsigned)(Rb * K + C) * 2u; }
    const size_t kstep = (size_t)(BK * 2);
    const size_t hstep = (size_t)HALF * K * 2;
    const size_t tstep = 2 * hstep;
    const unsigned ldsw = (unsigned)wid * 1024u;
    const int aoff = lds_byte(wr * 64 + fr, fq * 8), boff = lds_byte(wc * 32 + fr, fq * 8);
#define PG8_SA(b, h) (((b) * 2 + (h)) * HTB)
#define PG8_SB(b, h) ((4 + (b) * 2 + (h)) * HTB)
#define PG8_STAGE(bufoff, gbase, voff) do { _Pragma("unroll") for (int _i = 0; _i < 2; ++_i) \
        __builtin_amdgcn_global_load_lds((const unsigned*)((const char*)(gbase) + (voff)[_i]), (PG8_LAS unsigned*)(lds + (bufoff) + ldsw + _i * 8192), 16, 0, 0); } while (0)
#define PG8_LDA(dst, b, h) do { _Pragma("unroll") for (int m = 0; m < 4; ++m) _Pragma("unroll") for (int k = 0; k < 2; ++k) dst[m][k] = *(const PG8_LAS bf16x8*)(lds + PG8_SA(b, h) + aoff + m * 2048 + k * 1024); } while (0)
#define PG8_LDB(dst, b, h) do { _Pragma("unroll") for (int n = 0; n < 2; ++n) _Pragma("unroll") for (int k = 0; k < 2; ++k) dst[n][k] = *(const PG8_LAS bf16x8*)(lds + PG8_SB(b, h) + boff + n * 2048 + k * 1024); } while (0)
#define PG8_MMA(ai, bj, At, Bt) do { __builtin_amdgcn_s_setprio(1); _Pragma("unroll") for (int m = 0; m < 4; ++m) _Pragma("unroll") for (int n = 0; n < 2; ++n) _Pragma("unroll") for (int k = 0; k < 2; ++k) \
        acc[ai][bj][m][n] = __builtin_amdgcn_mfma_f32_16x16x32_bf16(Bt[n][k], At[m][k], acc[ai][bj][m][n], 0, 0, 0); __builtin_amdgcn_s_setprio(0); } while (0)
#define PG8_WAIT_V(n) asm volatile("s_waitcnt vmcnt(" #n ")" ::: "memory")
#define PG8_WAIT_L(n) asm volatile("s_waitcnt lgkmcnt(" #n ")" ::: "memory")
#define PG8_BAR __builtin_amdgcn_s_barrier()
#define PG8_SCHED __builtin_amdgcn_sched_barrier(0)
    Unit cur, nxt; int ui = 0;
    if (!S.next(0, cur)) return;
    f32x4 acc[2][2][4][2];
#pragma unroll
    for (int a = 0; a < 2; ++a)
#pragma unroll
        for (int b = 0; b < 2; ++b)
#pragma unroll
            for (int m = 0; m < 4; ++m)
#pragma unroll
                for (int n = 0; n < 2; ++n) acc[a][b][m][n] = (f32x4){0.f, 0.f, 0.f, 0.f};
    bf16x8 At[4][2], B0[2][2], B1[2][2];
    const char* cA = (const char*)g.A + (size_t)cur.pm * tstep; const char* cB = (const char*)g.Bt + (size_t)cur.pn * tstep;
    S.a_ready(cur);
    if constexpr (SP2) {
        PG8_STAGE(PG8_SB(0, 0), cB, voffB); PG8_STAGE(PG8_SB(0, 1), cB + hstep, voffB); PG8_STAGE(PG8_SA(0, 0), cA, voffA); PG8_STAGE(PG8_SA(0, 1), cA + hstep, voffA);
        if (wr == 1) PG8_BAR;
        PG8_WAIT_V(2); PG8_BAR;
        PG8_STAGE(PG8_SB(1, 0), cB + kstep, voffB); PG8_STAGE(PG8_SA(1, 0), cA + kstep, voffA); PG8_STAGE(PG8_SB(1, 1), cB + hstep + kstep, voffB);
        PG8_WAIT_V(6); PG8_BAR;
    } else {
        PG8_STAGE(PG8_SB(0, 0), cB, voffB); PG8_STAGE(PG8_SA(0, 0), cA, voffA); PG8_STAGE(PG8_SB(0, 1), cB + hstep, voffB); PG8_STAGE(PG8_SA(0, 1), cA + hstep, voffA);
        if (wr == 1) PG8_BAR;
        PG8_WAIT_V(4); PG8_BAR;
        PG8_STAGE(PG8_SB(1, 0), cB + kstep, voffB); PG8_STAGE(PG8_SA(1, 0), cA + kstep, voffA); PG8_STAGE(PG8_SB(1, 1), cB + hstep + kstep, voffB);
        PG8_WAIT_V(6); PG8_BAR;
    }
    for (;;) {
        const bool has_next = S.next(ui + 1, nxt);
        const char* nA = has_next ? (const char*)g.A + (size_t)nxt.pm * tstep : cA; const char* nB = has_next ? (const char*)g.Bt + (size_t)nxt.pn * tstep : cB;
        for (int t = 0; t < nt; t += 2) {
            const bool last = (t == nt - 2);
            const char* a1 = cA + (size_t)(t + 1) * kstep;
            const char* a2 = last ? nA : cA + (size_t)(t + 2) * kstep; const char* b2 = last ? nB : cB + (size_t)(t + 2) * kstep;
            const char* a3 = a2 + kstep; const char* b3 = b2 + kstep;
            if (last && has_next) S.a_ready(nxt);
            if constexpr (Epi::MIDK) { if (t == nt / 2) E.mid(acc, cur, wr, wc, fr, fq); }
            if constexpr (SP2) {
            PG8_LDB(B0, 0, 0); PG8_LDB(B1, 0, 1); PG8_SCHED; PG8_LDA(At, 0, 0); PG8_STAGE(PG8_SA(1, 1), a1 + hstep, voffA);
            PG8_WAIT_V(8); PG8_WAIT_L(0); PG8_BAR; PG8_MMA(0, 0, At, B0); PG8_MMA(0, 1, At, B1); PG8_BAR; PG8_SCHED;
            PG8_LDA(At, 0, 1); PG8_STAGE(PG8_SB(0, 0), b2, voffB); PG8_STAGE(PG8_SB(0, 1), b2 + hstep, voffB); PG8_STAGE(PG8_SA(0, 0), a2, voffA);
            PG8_WAIT_V(8); PG8_WAIT_L(0); PG8_BAR; PG8_MMA(1, 0, At, B0); PG8_MMA(1, 1, At, B1); PG8_BAR; PG8_SCHED;
            PG8_LDB(B0, 1, 0); PG8_LDB(B1, 1, 1); PG8_SCHED; PG8_LDA(At, 1, 0); PG8_STAGE(PG8_SA(0, 1), a2 + hstep, voffA);
            PG8_WAIT_V(8); PG8_WAIT_L(0); PG8_BAR; PG8_MMA(0, 0, At, B0); PG8_MMA(0, 1, At, B1); PG8_BAR; PG8_SCHED;
            PG8_LDA(At, 1, 1); PG8_STAGE(PG8_SB(1, 0), b3, voffB); PG8_STAGE(PG8_SB(1, 1), b3 + hstep, voffB); PG8_STAGE(PG8_SA(1, 0), a3, voffA);
            PG8_WAIT_V(8); PG8_WAIT_L(0); PG8_BAR; PG8_MMA(1, 0, At, B0); PG8_MMA(1, 1, At, B1); PG8_BAR; PG8_SCHED;
            } else {
            PG8_LDB(B0, 0, 0); PG8_SCHED; PG8_LDA(At, 0, 0); PG8_STAGE(PG8_SA(1, 1), a1 + hstep, voffA);
            PG8_WAIT_L(8); PG8_BAR; PG8_WAIT_L(0); PG8_MMA(0, 0, At, B0); PG8_BAR; PG8_SCHED;
            PG8_LDB(B1, 0, 1); PG8_STAGE(PG8_SB(0, 0), b2, voffB);
            PG8_BAR; PG8_WAIT_L(0); PG8_MMA(0, 1, At, B1); PG8_BAR;
            PG8_LDA(At, 0, 1); PG8_STAGE(PG8_SA(0, 0), a2, voffA);
            PG8_BAR; PG8_WAIT_L(0); PG8_MMA(1, 0, At, B0); PG8_BAR; PG8_SCHED;
            PG8_STAGE(PG8_SB(0, 1), b2 + hstep, voffB);
            PG8_WAIT_V(6); PG8_BAR; PG8_MMA(1, 1, At, B1); PG8_BAR;
            PG8_LDB(B0, 1, 0); PG8_SCHED; PG8_LDA(At, 1, 0); PG8_STAGE(PG8_SA(0, 1), a2 + hstep, voffA);
            PG8_WAIT_L(8); PG8_BAR; PG8_WAIT_L(0); PG8_MMA(0, 0, At, B0); PG8_BAR; PG8_SCHED;
            PG8_LDB(B1, 1, 1); PG8_STAGE(PG8_SB(1, 0), b3, voffB);
            PG8_BAR; PG8_WAIT_L(0); PG8_MMA(0, 1, At, B1); PG8_BAR;
            PG8_LDA(At, 1, 1); PG8_STAGE(PG8_SA(1, 0), a3, voffA);
            PG8_BAR; PG8_WAIT_L(0); PG8_MMA(1, 0, At, B0); PG8_BAR; PG8_SCHED;
            PG8_STAGE(PG8_SB(1, 1), b3 + hstep, voffB);
            PG8_WAIT_V(6); PG8_BAR; PG8_MMA(1, 1, At, B1); PG8_BAR;
            }
        }
        if constexpr (ALIGN_EPI) { if (wr == 0) PG8_BAR; }
        if constexpr (!Epi::AFTER_DRAIN) { E(acc, cur, wr, wc, fr, fq); S.done(cur); }
        if (!has_next) break;
#pragma unroll
        for (int a = 0; a < 2; ++a)
#pragma unroll
            for (int b = 0; b < 2; ++b)
#pragma unroll
                for (int m = 0; m < 4; ++m)
#pragma unroll
                    for (int n = 0; n < 2; ++n) acc[a][b][m][n] = (f32x4){0.f, 0.f, 0.f, 0.f};
        cur = nxt; cA = nA; cB = nB; ++ui;
        if constexpr (ALIGN_EPI) { if (wr == 1) PG8_BAR; }
    }
    PG8_WAIT_V(0);
    if constexpr (!ALIGN_EPI) { if (wr == 0) PG8_BAR; }
    PG8_BAR;
    if constexpr (Epi::AFTER_DRAIN) { E.fused(acc, cur, wr, wc, fr, fq, lds, wid, lane); S.done(cur); }
#undef PG8_SA
#undef PG8_SB
#undef PG8_STAGE
#undef PG8_LDA
#undef PG8_LDB
#undef PG8_MMA
#undef PG8_WAIT_V
#undef PG8_WAIT_L
#undef PG8_BAR
#undef PG8_SCHED
}
}

namespace at2 {
constexpr float SCALE = 0.08838834764831845f;
constexpr float THR = 8.f;
constexpr int NW = 8, QBLK = 32, KVBLK = 64, QB = NW * QBLK, D = 128, PITCH = 1024;
constexpr int SHM_V = KVBLK * D * 2, SHM_K = KVBLK * D * 2;
constexpr int BT_OFF = 2 * SHM_V + 2 * SHM_K + NW * 64 * 4;
constexpr int LDS_BYTES = BT_OFF + 320 * 4;
typedef short bf16x8 __attribute__((ext_vector_type(8)));
typedef short s16x4 __attribute__((ext_vector_type(4)));
typedef float f32x16 __attribute__((ext_vector_type(16)));
typedef float f32x4 __attribute__((ext_vector_type(4)));
typedef unsigned u32x4 __attribute__((ext_vector_type(4)));
typedef unsigned short bf16;

#define KSWZ(row, colB) ((row) * 256 + ((colB) ^ (((row) & 7) << 4)))
#define SBAR() __builtin_amdgcn_sched_barrier(0)
__device__ __forceinline__ int v_st(int k, int c) { const int kk = (k & ~0xC) | ((k & 4) << 1) | ((k & 8) >> 1); return ((kk >> 3) * 4 + (c >> 5)) * 512 + ((kk & 7) * 32 + (c & 31)) * 2; }
__device__ __forceinline__ int v_rd_base(int lane) { return ((lane & 3) << 3) | (((lane >> 2) & 3) << 6) | (((lane >> 4) & 1) << 5) | (((lane >> 5) & 1) << 8); }
constexpr int v_rd_off(int d0, int ks, int half) { return d0 * 512 + ks * 4096 + half * 2048; }
__device__ __forceinline__ int crow(int r, int hi) { return (r & 3) + 8 * (r >> 2) + 4 * hi; }
__device__ __forceinline__ unsigned cvtpk(float lo, float hi) { unsigned r; asm volatile("v_cvt_pk_bf16_f32 %0, %1, %2" : "=v"(r) : "v"(lo), "v"(hi)); return r; }
__device__ __forceinline__ bf16x8 load8(const bf16* p) { return *reinterpret_cast<const bf16x8*>(p); }

typedef __attribute__((address_space(3))) const float* lds_cf32;
__device__ __forceinline__ unsigned mask_compact(unsigned long long mw, int hi) { return ((unsigned)(mw >> (4 * hi)) & 0x0f0f0f0fu) | (((unsigned)(mw >> (32 + 4 * hi)) & 0x0f0f0f0fu) << 4); }
__device__ __forceinline__ void mask_bias(f32x16& p0, f32x16& p1, unsigned mwc, lds_cf32 bt, int idx0, bool far, float cfar, int hi) {
    const float NEG = -__builtin_inff();
    const unsigned w0 = mwc, w1 = mwc >> 4;
    if (far) {
#pragma unroll
        for (int r = 0; r < 16; ++r) { const int c = (r & 3) + 8 * (r >> 2);
            p0[r] = ((w0 >> c) & 1u) ? p0[r] + cfar : NEG; p1[r] = ((w1 >> c) & 1u) ? p1[r] + cfar : NEG; }
    } else { lds_cf32 b = bt + idx0;
#pragma unroll
        for (int r = 0; r < 16; ++r) { const int c = (r & 3) + 8 * (r >> 2);
            p0[r] = ((w0 >> c) & 1u) ? p0[r] + b[c] : NEG; p1[r] = ((w1 >> c) & 1u) ? p1[r] + b[c + 32] : NEG;
            if ((r & 3) == 3) asm volatile("" ::: "memory"); }
    }
}
__device__ __forceinline__ void partialSM(f32x16& p0, f32x16& p1, float& m_reg, float& mn, float& alpha) {
    float pmax = p0[0]; for (int r = 1; r < 16; ++r) pmax = fmaxf(pmax, p0[r]); for (int r = 0; r < 16; ++r) pmax = fmaxf(pmax, p1[r]);
    { auto rr = __builtin_amdgcn_permlane32_swap(__float_as_uint(pmax), __float_as_uint(pmax), false, false);
      pmax = fmaxf(__uint_as_float(rr[0]), __uint_as_float(rr[1])); }
    constexpr float C2 = 1.4426950408889634f * SCALE;
    if (__builtin_expect(__all((pmax - m_reg) * SCALE <= THR), 1)) { mn = m_reg; alpha = 1.f; }
    else { mn = fmaxf(m_reg, pmax); alpha = __builtin_amdgcn_exp2f((m_reg - mn) * C2); m_reg = mn; }
    const float mnL = -mn * C2;
    for (int r = 0; r < 16; ++r) p0[r] = fmaf(p0[r], C2, mnL); for (int r = 0; r < 16; ++r) p1[r] = fmaf(p1[r], C2, mnL);
    for (int r = 0; r < 16; ++r) p0[r] = __builtin_amdgcn_exp2f(p0[r]);
}
__device__ __forceinline__ void finishSM(f32x16& p0, f32x16& p1, float alpha, float& l_reg, bf16x8& pa0, bf16x8& pa1, bf16x8& pa2, bf16x8& pa3) {
    for (int r = 0; r < 16; ++r) p1[r] = __builtin_amdgcn_exp2f(p1[r]);
    float ps = 0; for (int r = 0; r < 16; ++r) ps += p0[r]; for (int r = 0; r < 16; ++r) ps += p1[r];
    { auto rr = __builtin_amdgcn_permlane32_swap(__float_as_uint(ps), __float_as_uint(ps), false, false);
      ps = __uint_as_float(rr[0]) + __uint_as_float(rr[1]); }
    l_reg = l_reg * alpha + ps;
#define PK4(P, B_, OUT) do { unsigned a0 = cvtpk(P[B_+0], P[B_+1]), a1 = cvtpk(P[B_+2], P[B_+3]);                          \
        unsigned b0 = cvtpk(P[B_+4], P[B_+5]), b1 = cvtpk(P[B_+6], P[B_+7]);                                             \
        auto r0 = __builtin_amdgcn_permlane32_swap(a0, b0, false, false); auto r1 = __builtin_amdgcn_permlane32_swap(a1, b1, false, false); \
        u32x4 w = {r0[0], r1[0], r0[1], r1[1]}; OUT = *reinterpret_cast<bf16x8*>(&w); } while (0)
    PK4(p0, 0, pa0); PK4(p0, 8, pa1); PK4(p1, 0, pa2); PK4(p1, 8, pa3);
#undef PK4
}
template <int KB, bool SK>
__device__ __forceinline__ void qkt(f32x16& p0, f32x16& p1, const char* K_lds, int r32, int hi, const bf16x8* qr, bool act) {
    if (SK && !act) { const float NEG = -__builtin_inff();
#pragma unroll
        for (int r = 0; r < 16; ++r) { p0[r] = NEG; p1[r] = NEG; } return; }
    p0 = f32x16{}; p1 = f32x16{};
    int r32_ = r32, hi_ = hi; asm volatile("" : "+v"(r32_), "+v"(hi_));
    const char* kb[4];
#pragma unroll
    for (int dd = 0; dd < 4; ++dd) kb[dd] = K_lds + KB * SHM_K + KSWZ(r32_, (dd * 16 + hi_ * 8) * 2);
#pragma unroll
    for (int d0 = 0; d0 < 8; ++d0) { const char* a = kb[d0 & 3] + (d0 >> 2) * 128;
        bf16x8 b0 = *reinterpret_cast<const bf16x8*>(a);
        bf16x8 b1 = *reinterpret_cast<const bf16x8*>(a + 32 * 256);
        p0 = __builtin_amdgcn_mfma_f32_32x32x16_bf16(b0, qr[d0], p0, 0, 0, 0);
        p1 = __builtin_amdgcn_mfma_f32_32x32x16_bf16(b1, qr[d0], p1, 0, 0, 0); }
}
template <int VB, bool SK>
__device__ __forceinline__ void pv_tile(f32x16* o, int vb0, bf16x8 pa0, bf16x8 pa1, bf16x8 pa2, bf16x8 pa3, bool act) {
    if (SK && !act) return;
#define TRRD(dst, off) asm volatile("ds_read_b64_tr_b16 %0, %1 offset:%2" : "=&v"(dst) : "v"(vb0), "i"(off) : "memory")
#define PV_D0(d0) do { s16x4 l0, l1, l2, l3, h0, h1, h2, h3; constexpr int b_ = VB * SHM_V + v_rd_off(d0, 0, 0); \
        TRRD(l0, b_); TRRD(h0, b_ + 2048); TRRD(l1, b_ + 4096); TRRD(h1, b_ + 6144); TRRD(l2, b_ + 8192); TRRD(h2, b_ + 10240); TRRD(l3, b_ + 12288); TRRD(h3, b_ + 14336); \
        asm volatile("s_waitcnt lgkmcnt(0)" ::: "memory"); SBAR();   \
        o[d0] = __builtin_amdgcn_mfma_f32_32x32x16_bf16(pa0, (bf16x8){l0[0], l0[1], l0[2], l0[3], h0[0], h0[1], h0[2], h0[3]}, o[d0], 0, 0, 0);   \
        o[d0] = __builtin_amdgcn_mfma_f32_32x32x16_bf16(pa1, (bf16x8){l1[0], l1[1], l1[2], l1[3], h1[0], h1[1], h1[2], h1[3]}, o[d0], 0, 0, 0);   \
        o[d0] = __builtin_amdgcn_mfma_f32_32x32x16_bf16(pa2, (bf16x8){l2[0], l2[1], l2[2], l2[3], h2[0], h2[1], h2[2], h2[3]}, o[d0], 0, 0, 0);   \
        o[d0] = __builtin_amdgcn_mfma_f32_32x32x16_bf16(pa3, (bf16x8){l3[0], l3[1], l3[2], l3[3], h3[0], h3[1], h3[2], h3[3]}, o[d0], 0, 0, 0); } while (0)
    PV_D0(0); PV_D0(1); PV_D0(2); PV_D0(3);
#undef PV_D0
#undef TRRD
}

struct Ctx { __amdgpu_buffer_rsrc_t Q, K, V, M, O; };
typedef unsigned v4u32 __attribute__((ext_vector_type(4))); typedef unsigned v2u32 __attribute__((ext_vector_type(2)));
#define LD16(rs, vo, so) __builtin_bit_cast(bf16x8, __builtin_amdgcn_raw_buffer_load_b128((rs), (int)(vo), (int)(so), 0))
struct Seam { bf16x8 qr[8]; bf16x8 st_v0, st_v1, st_k0, st_k1; };
#define VMW() asm volatile("s_waitcnt vmcnt(0)" ::: "memory")
#define VMWN(n) asm volatile("s_waitcnt vmcnt(%0)" :: "i"(n) : "memory")
#define SLOAD_H(k0) do { S.st_v0 = LD16(C.V, kvoff, (k0) * (PITCH * 2)); S.st_v1 = LD16(C.V, kvoff, ((k0) + 32) * (PITCH * 2));              \
                         S.st_k0 = LD16(C.K, kvoff, (k0) * (PITCH * 2)); S.st_k1 = LD16(C.K, kvoff, ((k0) + 32) * (PITCH * 2)); } while (0)
#define SW_TID int t_ = threadIdx.x; asm volatile("" : "+v"(t_)); const int sr_ = t_ >> 4, sc_ = (t_ & 15) * 8
#define SWRITE_HK(bf) do { SW_TID; const int kws_ = KSWZ(sr_, sc_ * 2); *(bf16x8*)(K_lds + (bf) * SHM_K + kws_) = S.st_k0; *(bf16x8*)(K_lds + (bf) * SHM_K + kws_ + 32 * 256) = S.st_k1; } while (0)
#define SWRITE_HV(bf) do { SW_TID; *(bf16x8*)(V_lds + (bf) * SHM_V + v_st(sr_, sc_)) = S.st_v0; *(bf16x8*)(V_lds + (bf) * SHM_V + v_st(32 + sr_, sc_)) = S.st_v1; } while (0)
#define SWRITE_H(bf) do { SWRITE_HV(bf); SWRITE_HK(bf); } while (0)
__device__ __forceinline__ void dsa_prime(const Ctx& C, int P0, char* lds, Seam& S) {
    int tid = threadIdx.x; asm volatile("" : "+v"(tid));
    const int wid = __builtin_amdgcn_readfirstlane(tid >> 6), lane = tid & 63, r32 = lane & 31, hi = lane >> 5;
    const int sr = tid >> 4, sc = (tid & 15) * 8; char* K_lds = lds + 2 * SHM_V;
    const unsigned kvoff = (unsigned)(sr * PITCH + sc) * 2u, qoff = (unsigned)((wid * QBLK + r32) * PITCH + hi * 8) * 2u;
    for (int d0 = 0; d0 < 8; ++d0) S.qr[d0] = LD16(C.Q, qoff + d0 * 32, P0 * (PITCH * 2));
    SLOAD_H(0); VMW(); SWRITE_HK(0);
    __syncthreads();
}
__device__ __forceinline__ void dsa_block(const Ctx& C, int P0, int P0n, char* lds, Seam& S, float cfar) {
    int tid = threadIdx.x; asm volatile("" : "+v"(tid));
    const int wid = __builtin_amdgcn_readfirstlane(tid >> 6), lane = tid & 63, r32 = lane & 31, hi = lane >> 5;
    const int NT = P0 / KVBLK + QB / KVBLK;
    const int qlo = P0 + wid * QBLK;
    const int limw = ((qlo >> 6) + 1) * 64;
    char* V_lds = lds; char* K_lds = lds + 2 * SHM_V;
    float* wsc = (float*)(lds + 2 * SHM_V + 2 * SHM_K) + wid * 64; float* li_l = wsc, * al_l = wsc + 32;
    lds_cf32 bt = (lds_cf32)((__attribute__((address_space(3))) char*)lds + BT_OFF);
    float m_reg = -1e30f, l_reg = 0; f32x16 o[4] = {};
    const int sr = tid >> 4, sc = (tid & 15) * 8;
    const int vb0 = (int)(uintptr_t)V_lds + v_rd_base(lane);
    const unsigned kvoff = (unsigned)(sr * PITCH + sc) * 2u, qoff = (unsigned)((wid * QBLK + r32) * PITCH + hi * 8) * 2u, moff = (unsigned)((wid * QBLK + r32) * 32) * 8u;
#define MROW(t) mask_compact(__builtin_bit_cast(unsigned long long, __builtin_amdgcn_raw_buffer_load_b64(C.M, (int)moff, (P0 * 32 + (t)) * 8, 0)), hi)
    const int rel0 = 256 + 4 * hi - (qlo + r32);
#define RESC(a) do { if (__any((a) < 1.f)) { if (hi == 0) al_l[r32] = (a); asm volatile("s_waitcnt lgkmcnt(0)" ::: "memory");              \
                     for (int d_ = 0; d_ < 4; ++d_) for (int r = 0; r < 16; ++r) o[d_][r] *= al_l[crow(r, hi)]; } } while (0)
#define KBASE(t) ((t) * KVBLK)
#define ACT(t) (KBASE(t) < limw)
#define MASKT(P0_, P1_, mw_, t) do { const int kb_ = KBASE(t); if (ACT(t)) mask_bias(P0_, P1_, mw_, bt, kb_ + rel0, kb_ + KVBLK - 1 - qlo <= -128, cfar, hi); } while (0)
    constexpr int NQL = 8; constexpr bool SK = true;
#define SEAM_K0() do { VMWN(NQL); SWRITE_HK(0); SBAR(); } while (0)
    f32x16 pA0, pA1, pB0, pB1; float mnA, mnB, alA, alB; bf16x8 pa0, pa1, pa2, pa3; unsigned mw;
    SWRITE_HV(0); SBAR();
    if (NT > 1) SLOAD_H(KBASE(1));
    mw = MROW(0);
    SBAR(); qkt<0, SK>(pA0, pA1, K_lds, r32, hi, S.qr, ACT(0));
    MASKT(pA0, pA1, mw, 0); partialSM(pA0, pA1, m_reg, mnA, alA);
    if (NT > 1) { VMW(); SWRITE_H(1); }
    __syncthreads();
#define HALF_STEP(PX0, PX1, mnX, alX, PY0, PY1, alY, t, KB, VB, SB) do {                                                      \
        SBAR(); mw = MROW(t); qkt<KB, SK>(PX0, PX1, K_lds, r32, hi, S.qr, ACT(t));                                          \
        finishSM(PY0, PY1, alY, l_reg, pa0, pa1, pa2, pa3); SBAR();                                                           \
        if ((t) + 1 < NT) { SLOAD_H(KBASE((t) + 1)); SBAR(); }                                                        \
        pv_tile<VB, SK>(o, vb0, pa0, pa1, pa2, pa3, ACT((t) - 1)); MASKT(PX0, PX1, mw, (t)); partialSM(PX0, PX1, m_reg, mnX, alX); \
        __syncthreads();                                                                                                      \
        if ((t) + 1 < NT) { VMW(); SWRITE_H(SB); }                                                                            \
        RESC(alX); __syncthreads(); } while (0)
    for (int t = 1; t + 1 < NT; t += 2) {
        HALF_STEP(pB0, pB1, mnB, alB, pA0, pA1, alA, t, 1, 0, 0);
        HALF_STEP(pA0, pA1, mnA, alA, pB0, pB1, alB, t + 1, 0, 1, 1);
    }
    const bool even = (NT & 1) == 0;
    if (even) { SBAR(); mw = MROW(NT - 1); qkt<1, SK>(pB0, pB1, K_lds, r32, hi, S.qr, ACT(NT - 1)); SBAR(); }
    SLOAD_H(0); SBAR();
#pragma unroll
    for (int d0 = 0; d0 < 8; ++d0) S.qr[d0] = LD16(C.Q, qoff + d0 * 32, P0n * (PITCH * 2));
    SBAR();
    finishSM(pA0, pA1, alA, l_reg, pa0, pa1, pa2, pa3); SBAR();
    pv_tile<0, SK>(o, vb0, pa0, pa1, pa2, pa3, ACT(even ? NT - 2 : NT - 1));
    if (even) { MASKT(pB0, pB1, mw, NT - 1); partialSM(pB0, pB1, m_reg, mnB, alB); __syncthreads(); RESC(alB);
        finishSM(pB0, pB1, alB, l_reg, pa0, pa1, pa2, pa3); SBAR(); pv_tile<1, SK>(o, vb0, pa0, pa1, pa2, pa3, ACT(NT - 1)); }
    SBAR(); SEAM_K0();
    if (hi == 0) li_l[r32] = l_reg; asm volatile("s_waitcnt lgkmcnt(0)" ::: "memory");
    float rli[16];
#pragma unroll
    for (int r = 0; r < 16; ++r) rli[r] = __builtin_amdgcn_rcpf(li_l[crow(r, hi)]);
    const unsigned ooff = (unsigned)((wid * QBLK + 4 * hi) * PITCH + r32) * 2u;
#pragma unroll
    for (int r = 0; r < 16; ++r) { const int so = (P0 + (r & 3) + 8 * (r >> 2)) * (PITCH * 2);
#pragma unroll
        for (int d0 = 0; d0 < 4; ++d0) { const float v = o[d0][r] * rli[r];
            const float vn = __shfl_xor(v, 1);
            if ((r32 & 1) == 0) __builtin_amdgcn_raw_buffer_store_b32(cvtpk(v, vn), C.O, (int)(ooff + d0 * 64), so, 0); } }
    __syncthreads();
#undef RESC
#undef MROW
#undef KBASE
#undef ACT
#undef MASKT
#undef SEAM_K0
#undef HALF_STEP
}
#undef VMW
#undef VMWN
#undef SLOAD_H
#undef SWRITE_HK
#undef SWRITE_HV
#undef SWRITE_H
#undef SW_TID
#undef KSWZ
#undef SBAR
}

constexpr int NWAVES = 8;
constexpr int NTP = BATCH * SEQ, NTS = DEC_BATCH * DEC_SEQ, NTOK = NTP + NTS;
constexpr int NPM = NTOK / 256;
constexpr int N_MIX = 27 * 256, N_M1A = 12 * 256, N_M1B = 8 * 256;
static_assert(NTP % 256 == 0 && NTS % 256 == 0 && D_MODEL == 1024 && A_WIDTH == 1024 && B_WIDTH == 1024, "geometry");

constexpr size_t MiB = 1u << 20;
constexpr size_t WS_CTL = 0, CTL_ZERO_BYTES = 1 * MiB;
constexpr size_t WS_WMIX = 1 * MiB;
constexpr size_t WS_WMRG = WS_WMIX + 14 * MiB;
constexpr size_t WS_WAB  = WS_WMRG + 10 * MiB;
constexpr size_t WS_WO   = WS_WAB + 4 * MiB;
constexpr size_t WS_XB   = WS_WO + 2 * MiB;
constexpr size_t ROWBUF  = (size_t)NTOK * 1024 * 2;
constexpr size_t WS_QA   = WS_XB + ROWBUF;
constexpr size_t WS_KA   = WS_QA + ROWBUF;
constexpr size_t WS_VA   = WS_KA + ROWBUF;
constexpr size_t WS_QB   = WS_VA + ROWBUF;
constexpr size_t WS_QI   = WS_QB + ROWBUF;
constexpr size_t WS_KI   = WS_QI + 65 * MiB;
constexpr size_t WS_SM   = WS_KI + 9 * MiB;
constexpr size_t WS_MASK = WS_SM + 5 * MiB;
constexpr size_t WS_HST  = WS_MASK + 16 * MiB;
constexpr size_t WS_NAIVE = WS_HST + 3 * MiB;
constexpr size_t WS_NEED = WS_NAIVE;
static_assert(WS_WMIX + (size_t)N_MIX * 1024 * 2 <= WS_WMRG && WS_QI + (size_t)NTOK * 512 * 2 <= WS_KI && WS_KI + (size_t)NTOK * 64 * 2 <= WS_SM && WS_SM + (size_t)NTOK * 64 <= WS_MASK
              && WS_HST + (size_t)NTOK * 32 <= WS_NAIVE, "d_ws map");
constexpr int CW_BAR = 4096;
constexpr int RING_OFF = 0, RING_BYTES = 131072;
constexpr int LDS_BYTES = 147456;
constexpr int LDSCTL_OFF = LDS_BYTES - 512, MISC_OFF = LDSCTL_OFF + 320;

struct Args { const float* in[17]; float* out; unsigned char* ws; int ph_lo, ph_hi; };

__device__ __forceinline__ float bf2f(bf16 v) { return __uint_as_float((unsigned)v << 16); }
__device__ __forceinline__ float sigm(float x) { return 1.0f / (1.0f + __expf(-x)); }

__device__ __forceinline__ void tr_item(const float* W, int ldw, int c0, int nv, int k0, bf16* WT, int ldt, int r0, int kofs, LAS float* scr, int lane) {
    const int n_ = lane & 31;
#pragma unroll 8
    for (int i = 0; i < 32; ++i) { const int kk = 2 * i + (lane >> 5); scr[kk * 33 + n_] = (n_ < nv) ? W[(size_t)(k0 + kk) * ldw + c0 + n_] : 0.f; }
    LDS_WAIT(); asm volatile("" ::: "memory");
    const int c = lane & 7;
#pragma unroll
    for (int j = 0; j < 4; ++j) { const int n = (lane >> 3) + 8 * j; const LAS float* s = scr + (8 * c) * 33 + n;
        v4u o; o.x = pk2(s[0 * 33], s[1 * 33]); o.y = pk2(s[2 * 33], s[3 * 33]); o.z = pk2(s[4 * 33], s[5 * 33]); o.w = pk2(s[6 * 33], s[7 * 33]);
        if (n < nv) *(GAS v4u*)(WT + (size_t)(r0 + n) * ldt + kofs + k0 + 8 * c) = o; }
    LDS_WAIT(); asm volatile("" ::: "memory");
}
struct Seg { int src, n, dst; };
__device__ __forceinline__ Seg win_seg(int s) {
    switch (s) {
        case 0: return Seg{C_QA, 1024, 0};      case 1: return Seg{C_KA, 1024, 1024};  case 2: return Seg{C_VA, 1024, 2048};
        case 3: return Seg{C_QB, 1024, 3072};   case 4: return Seg{C_KB, 1024, 4096};  case 5: return Seg{C_VB, 1024, 5120};
        case 6: return Seg{C_QI, 512, 6144};    case 7: return Seg{C_KI, 64, 6656};    case 8: return Seg{C_WI, 8, 6720};
        case 9: return Seg{C_IA, 4, 6728};      case 10: return Seg{C_FA, 4, 6732};
        case 27: return Seg{C_ZB, 1024, 2048};  case 28: return Seg{C_GA, 1024, 3072}; case 29: return Seg{C_GB, 1024, 4096};
        default: { const int j = (s - 11) >> 1; return (s & 1) ? Seg{C_OA + 128 * j, 128, 256 * j} : Seg{C_ZA + 128 * j, 128, 256 * j + 128}; }
    }
}
struct P0Args { const float *xp, *xs, *w_in, *w_out_a, *w_out_b, *w_o; bf16 *XB, *WMIX, *WMRG, *WAB, *WO; };
__device__ __forceinline__ void p0_prologue(const P0Args& a, LAS unsigned char* lds, int vcu, int G, int wave, int lane) {
    LAS float* scr = (LAS float*)(lds + RING_OFF + wave * 16384);
    const int gw = vcu * NWAVES + wave, NGW = G * NWAVES;
    int base = 0;
    for (int s = 0; s < 30; ++s) {
        const Seg sg = win_seg(s); const int nblk = (sg.n + 31) / 32, nit = nblk * 16;
        bf16* WT = s < 11 ? a.WMIX : a.WMRG;
        for (int it = gw - (base % NGW); it < nit; it += NGW) { if (it < 0) continue; const int kb = it / nblk, nb = it % nblk; const int nv = sg.n - 32 * nb < 32 ? sg.n - 32 * nb : 32;
            tr_item(a.w_in, IN_COLS, sg.src + 32 * nb, nv, 64 * kb, WT, 1024, sg.dst + 32 * nb, 0, scr, lane); }
        base += nit;
    }
    for (int i = gw * 64 + lane; i < 176 * 128; i += NGW * 64) ((GAS v4u*)(a.WMIX + (size_t)6736 * 1024))[i] = (v4u){0u, 0u, 0u, 0u};
    for (int it = gw; it < 3 * 512; it += NGW) { const int w = it / 512, r = it % 512, kb = r / 32, nb = r % 32;
        if (w == 0) tr_item(a.w_out_a, 1024, 32 * nb, 32, 64 * kb, a.WAB, 2048, 32 * nb, 0, scr, lane);
        else if (w == 1) tr_item(a.w_out_b, 1024, 32 * nb, 32, 64 * kb, a.WAB, 2048, 32 * nb, 1024, scr, lane);
        else tr_item(a.w_o, 1024, 32 * nb, 32, 64 * kb, a.WO, 1024, 32 * nb, 0, scr, lane); }
    for (int m0 = gw * 2; m0 < NTOK; m0 += NGW * 2) { f32x4 v[2][4];
#pragma unroll
        for (int q = 0; q < 2; ++q) { const int m = m0 + q; const float* xr = m < NTP ? a.xp + (size_t)m * 1024 : a.xs + (size_t)(m - NTP) * 1024; const GAS f32x4* xv = (const GAS f32x4*)xr + lane;
#pragma unroll
            for (int j = 0; j < 4; ++j) v[q][j] = xv[64 * j]; }
#pragma unroll
        for (int q = 0; q < 2; ++q) { GAS unsigned long long* o8 = (GAS unsigned long long*)(a.XB + (size_t)(m0 + q) * 1024) + lane;
#pragma unroll
            for (int j = 0; j < 4; ++j) o8[64 * j] = (unsigned long long)pk2(v[q][j].x, v[q][j].y) | ((unsigned long long)pk2(v[q][j].z, v[q][j].w) << 32); }
    }
}

namespace pg8 {
struct EpiMix {
    static constexpr bool PERM = true, AFTER_DRAIN = false, MIDK = false;
    bf16_t* QA4;
    bf16_t* KVc;
    bf16_t *QI, *KI; float* SM;
    float *okvp, *okvs;
    float *oikp, *oiks;
    __device__ __forceinline__ void mid(f32x4 (&)[2][2][4][2], const Unit&, int, int, int, int) const {}
    __device__ __forceinline__ void operator()(const f32x4 (&acc)[2][2][4][2], const Unit& u, int wr, int wc, int fr, int fq) const {
        const int pn = u.pn; const bool samp = u.pm >= NTP / 256;
        const int row0 = u.pm * BM + wr * 64 + fr, cl = wc * 32 + 8 * fq;
        if (pn < 16) {
            bf16_t* base = QA4 + (size_t)(pn >> 2) * ((size_t)NTOK * 1024); const float sc = (pn >= 4 && pn < 8) ? 0.0625f : 1.0f;
            const int col0 = (pn & 3) * 256 + cl;
#pragma unroll
            for (int ai = 0; ai < 2; ++ai)
#pragma unroll
                for (int m = 0; m < 4; ++m) { bf16_t* rowp = base + (size_t)(row0 + ai * HALF + m * 16) * 1024 + col0;
#pragma unroll
                    for (int bj = 0; bj < 2; ++bj) { const f32x4 v0 = acc[ai][bj][m][0] * sc, v1 = acc[ai][bj][m][1] * sc;
                        u32x4 w; w.x = cvt_pk_bf16(v0[0], v0[1]); w.y = cvt_pk_bf16(v0[2], v0[3]); w.z = cvt_pk_bf16(v1[0], v1[1]); w.w = cvt_pk_bf16(v1[2], v1[3]);
                        *(u32x4*)(rowp + bj * HALF) = w; } }
        } else if (pn < 24) {
            const int isV = pn >= 20 ? 1 : 0; const int col0 = (pn & 3) * 256 + cl;
            float* of = samp ? okvs + (size_t)isV * ((size_t)NTS * 1024) : okvp + (size_t)isV * ((size_t)NTP * 1024);
            bf16_t* cb = KVc + (size_t)isV * ((size_t)NTP * 1024);
#pragma unroll
            for (int ai = 0; ai < 2; ++ai)
#pragma unroll
                for (int m = 0; m < 4; ++m) { const int r = row0 + ai * HALF + m * 16; const int rr = samp ? r - NTP : r;
#pragma unroll
                    for (int bj = 0; bj < 2; ++bj) { const f32x4 v0 = acc[ai][bj][m][0], v1 = acc[ai][bj][m][1];
                        float* fp = of + (size_t)rr * 1024 + col0 + bj * HALF; *(f32x4*)fp = v0; *(f32x4*)(fp + 4) = v1;
                        if (!samp) { u32x4 w; w.x = cvt_pk_bf16(v0[0], v0[1]); w.y = cvt_pk_bf16(v0[2], v0[3]); w.z = cvt_pk_bf16(v1[0], v1[1]); w.w = cvt_pk_bf16(v1[2], v1[3]);
                            *(u32x4*)(cb + (size_t)r * 1024 + col0 + bj * HALF) = w; } } }
        } else if (pn < 26) {
            const int col0 = (pn - 24) * 256 + cl;
#pragma unroll
            for (int ai = 0; ai < 2; ++ai)
#pragma unroll
                for (int m = 0; m < 4; ++m) { bf16_t* rowp = QI + (size_t)(row0 + ai * HALF + m * 16) * 512 + col0;
#pragma unroll
                    for (int bj = 0; bj < 2; ++bj) { const f32x4 v0 = acc[ai][bj][m][0] * 0.125f, v1 = acc[ai][bj][m][1] * 0.125f;
                        u32x4 w; w.x = cvt_pk_bf16(v0[0], v0[1]); w.y = cvt_pk_bf16(v0[2], v0[3]); w.z = cvt_pk_bf16(v1[0], v1[1]); w.w = cvt_pk_bf16(v1[2], v1[3]);
                        *(u32x4*)(rowp + bj * HALF) = w; } }
        } else {
            float* oik = samp ? oiks : oikp;
#pragma unroll
            for (int ai = 0; ai < 2; ++ai)
#pragma unroll
                for (int m = 0; m < 4; ++m) { const int r = row0 + ai * HALF + m * 16; const int rr = samp ? r - NTP : r; const f32x4 v0 = acc[ai][0][m][0], v1 = acc[ai][0][m][1];
                    if (wc < 2) { float* fp = oik + (size_t)rr * 64 + cl; *(f32x4*)fp = v0; *(f32x4*)(fp + 4) = v1;
                        u32x4 w; w.x = cvt_pk_bf16(v0[0], v0[1]); w.y = cvt_pk_bf16(v0[2], v0[3]); w.z = cvt_pk_bf16(v1[0], v1[1]); w.w = cvt_pk_bf16(v1[2], v1[3]);
                        *(u32x4*)(KI + (size_t)r * 64 + cl) = w; }
                    else if (wc == 2 && fq < 2) { float* fp = SM + (size_t)r * 16 + 8 * fq; *(f32x4*)fp = v0; *(f32x4*)(fp + 4) = v1; } }
        }
    }
};
}


namespace ml {
typedef short bfx8 __attribute__((ext_vector_type(8)));
typedef short s16x4 __attribute__((ext_vector_type(4)));
typedef float f32x16 __attribute__((ext_vector_type(16)));
typedef float f32x2_t __attribute__((ext_vector_type(2))); typedef __bf16 bf16x2_t __attribute__((ext_vector_type(2)));
typedef short v4i16_t __attribute__((ext_vector_type(4)));
typedef unsigned u32x4 __attribute__((ext_vector_type(4)));
typedef unsigned u32x2 __attribute__((ext_vector_type(2)));
typedef float f32x4 __attribute__((ext_vector_type(4)));
#define MLAS __attribute__((address_space(3)))
constexpr int QP = 528, VP = 272;
constexpr int L_Q = 0, L_K = 64 * QP, L_V = 2 * 64 * QP, L_VW = L_V + 64 * VP, L_EX = L_VW + 64 * VP;
constexpr int L_G = L_EX + 32768;
constexpr int L_GW = L_G, L_GM = L_G + 256, L_GI = L_G + 512, L_GE = L_G + 768, L_GS = L_G + 1024;
constexpr int L_NV = L_G + 1280;
constexpr int L_QN = L_NV + 1024;
constexpr int L_DP = L_QN + 256;
constexpr int L_END = L_DP + 384;
__device__ __forceinline__ unsigned cvtpk(float lo, float hi) { f32x2_t v = {lo, hi}; bf16x2_t b = __builtin_convertvector(v, bf16x2_t); return __builtin_bit_cast(unsigned, b); }
__device__ __forceinline__ bfx8 pack_step(const f32x16& x, int s) {
    u32x4 p; p.x = cvtpk(x[8 * s + 0], x[8 * s + 1]); p.y = cvtpk(x[8 * s + 2], x[8 * s + 3]); p.z = cvtpk(x[8 * s + 4], x[8 * s + 5]); p.w = cvtpk(x[8 * s + 6], x[8 * s + 7]);
    return __builtin_bit_cast(bfx8, p);
}
__device__ __forceinline__ s16x4 vtr(MLAS const unsigned char* p) { return __builtin_bit_cast(s16x4, __builtin_amdgcn_ds_read_tr16_b64_v4i16((MLAS v4i16_t*)p)); }
__device__ __forceinline__ bfx8 cat8(s16x4 lo, s16x4 hi) { return (bfx8){lo[0], lo[1], lo[2], lo[3], hi[0], hi[1], hi[2], hi[3]}; }
__device__ __forceinline__ int crow(int r, int hi) { return (r & 3) + 8 * (r >> 2) + 4 * hi; }
__device__ __forceinline__ float logsig_(float x) { return fminf(x, 0.0f) - log1pf(__expf(-fabsf(x))); }
__device__ __forceinline__ float wsum_(float v) {
#pragma unroll
    for (int o = 1; o < 64; o <<= 1) v += __shfl_xor(v, o);
    return v; }
#define ML_MFMA(a, b, c) __builtin_amdgcn_mfma_f32_32x32x16_bf16((a), (b), (c), 0, 0, 0)

struct Item {
    __amdgpu_buffer_rsrc_t hout;
    __amdgpu_buffer_rsrc_t q, k, v;
    __amdgpu_buffer_rsrc_t sm;
    __amdgpu_buffer_rsrc_t C0, Cout;
    const float* n0; float m0; bool has0;
    float* nout; float* mout;
    int head, nchunk, L; float bi, bf;
};
#define ML_LD16(rs, vo, so) __builtin_bit_cast(u32x4, __builtin_amdgcn_raw_buffer_load_b128((rs), (int)(vo), (int)(so), 0))
#define ML_LDF(rs, vo, so) __builtin_bit_cast(float, __builtin_amdgcn_raw_buffer_load_b32((rs), (int)(vo), (int)(so), 0))

__device__ __forceinline__ void run_item(MLAS unsigned char* lds, const Item& it) {
    int tid = threadIdx.x; asm volatile("" : "+v"(tid));
    const int wave = __builtin_amdgcn_readfirstlane(tid >> 6), lane0 = tid & 63, g = wave >> 2, cb = wave & 3;
#define ML_LANE int lane = lane0; asm volatile("" : "+v"(lane)); const int r32 = lane & 31, hi = lane >> 5; (void)r32; (void)hi
    const int L = it.L, h = it.head;
    const unsigned coff = (unsigned)((lane0 >> 5) * 4096 + (lane0 & 31) * 4), qkoff = (unsigned)((tid >> 5) * 2048 + (tid & 31) * 16), voff = (unsigned)((tid >> 4) * 2048 + (tid & 15) * 16), hoff = (unsigned)((4 * (lane0 >> 5) * 1024 + (lane0 & 31)) * 2);
    f32x16 Cacc[4];
#pragma unroll
    for (int j = 0; j < 4; ++j)
#pragma unroll
        for (int i = 0; i < 16; ++i) Cacc[j][i] = it.has0 ? ML_LDF(it.C0, coff, ((128 * g + 32 * j + (i & 3) + 8 * (i >> 2)) * 256 + 32 * cb) * 4) : 0.f;
    if (tid < 256) ((MLAS float*)(lds + L_NV))[tid] = it.has0 ? it.n0[tid] : 0.f;
    float m = it.m0;
    u32x4 pq[4], pk[4], pv[2]; float pia, pfa;
#define ML_PREFETCH(c_) do { const int t0_ = (c_) * L; \
        _Pragma("unroll") for (int i = 0; i < 4; ++i) { const bool ok_ = 16 * i < L;     \
            pq[i] = ok_ ? ML_LD16(it.q, qkoff, (t0_ + 16 * i) * 2048) : (u32x4){0u, 0u, 0u, 0u}; pk[i] = ok_ ? ML_LD16(it.k, qkoff, (t0_ + 16 * i) * 2048) : (u32x4){0u, 0u, 0u, 0u}; } \
        _Pragma("unroll") for (int i = 0; i < 2; ++i) pv[i] = (32 * i < L) ? ML_LD16(it.v, voff, (t0_ + 32 * i) * 2048) : (u32x4){0u, 0u, 0u, 0u}; \
        { const int lane = lane0; const bool ok_ = lane < L; const float a_ = ML_LDF(it.sm, lane * 64, t0_ * 64 + (8 + h) * 4), f_ = ML_LDF(it.sm, lane * 64, t0_ * 64 + (12 + h) * 4); pia = ok_ ? a_ : 0.f; pfa = ok_ ? f_ : 0.f; } } while (0)
    ML_PREFETCH(0);
    for (int c = 0; c < it.nchunk; ++c) {
        float wsl, decay, mnext;
        { ML_LANE;
        float lf = (lane < L) ? logsig_(pfa + it.bf) : 0.f; float cum = lf;
#pragma unroll
        for (int o = 1; o < 64; o <<= 1) { const float t_ = __shfl_up(cum, o); if (lane >= o) cum += t_; }
        const float wv = (lane < L) ? (pia + it.bi) - cum : -INFINITY; float cmx = wv;
#pragma unroll
        for (int o = 1; o < 64; o <<= 1) { const float t_ = __shfl_up(cmx, o); if (lane >= o) cmx = fmaxf(cmx, t_); }
        const float Ml = fmaxf(m, cmx); const float M63 = __shfl(Ml, 63), cum63 = __shfl(cum, 63);
        wsl = __expf(wv - M63); decay = __expf(m - M63); mnext = cum63 + M63;
        if (wave == 0) { ((MLAS float*)(lds + L_GW))[lane] = wv; ((MLAS float*)(lds + L_GM))[lane] = Ml; ((MLAS float*)(lds + L_GI))[lane] = __expf(m - Ml);
                         ((MLAS float*)(lds + L_GE))[lane] = __expf(-(cum + Ml)); ((MLAS float*)(lds + L_GS))[lane] = wsl; } }
#pragma unroll
        for (int i = 0; i < 4; ++i) { const int p_ = tid + 512 * i, row_ = p_ >> 5, cp_ = p_ & 31;
            *(MLAS u32x4*)(lds + L_Q + row_ * QP + cp_ * 16) = pq[i]; *(MLAS u32x4*)(lds + L_K + row_ * QP + cp_ * 16) = pk[i]; }
#pragma unroll
        for (int i = 0; i < 2; ++i) { const int p_ = tid + 512 * i, row_ = p_ >> 4, cp_ = p_ & 15; const float wr_ = __shfl(wsl, row_ & 63);
            *(MLAS u32x4*)(lds + L_V + row_ * VP + cp_ * 16) = pv[i];
            u32x4 o_;
#pragma unroll
            for (int e = 0; e < 4; ++e) o_[e] = cvtpk(__uint_as_float(pv[i][e] << 16) * wr_, __uint_as_float(pv[i][e] & 0xffff0000u) * wr_);
            *(MLAS u32x4*)(lds + L_VW + row_ * VP + cp_ * 16) = o_; }
        __syncthreads();
        const int sb = g; f32x16 S0 = {}, S1 = {};
        { ML_LANE;
            MLAS const unsigned char* kp = lds + L_K + (32 * sb + r32) * QP + hi * 16; MLAS const unsigned char* q0 = lds + L_Q + r32 * QP + hi * 16; MLAS const unsigned char* q1 = q0 + 32 * QP;
#pragma unroll 4
            for (int ks = 0; ks < 16; ++ks) { const bfx8 ka = *(MLAS const bfx8*)(kp + ks * 32); const bfx8 qb1 = *(MLAS const bfx8*)(q1 + ks * 32);
                S1 = ML_MFMA(ka, qb1, S1);
                if (g == 0) { const bfx8 qb0 = *(MLAS const bfx8*)(q0 + ks * 32); S0 = ML_MFMA(ka, qb0, S0); } }
        }
        { ML_LANE;
            const float M1 = ((MLAS const float*)(lds + L_GM))[32 + r32], M0 = ((MLAS const float*)(lds + L_GM))[r32]; float d0 = 0.f, d1 = 0.f;
#pragma unroll
            for (int i = 0; i < 16; ++i) { const int sl = crow(i, hi); const float ws_ = ((MLAS const float*)(lds + L_GW))[32 * sb + sl];
                const int s_ = 32 * sb + sl;
                S1[i] = (s_ <= 32 + r32) ? S1[i] * __expf(ws_ - M1) : 0.f; d1 += S1[i];
                if (g == 0) { S0[i] = (s_ <= r32) ? S0[i] * __expf(ws_ - M0) : 0.f; d0 += S0[i]; } }
            { auto rr = __builtin_amdgcn_permlane32_swap(__float_as_uint(d1), __float_as_uint(d1), false, false); d1 = __uint_as_float(rr[0]) + __uint_as_float(rr[1]); }
            { auto rr = __builtin_amdgcn_permlane32_swap(__float_as_uint(d0), __float_as_uint(d0), false, false); d0 = __uint_as_float(rr[0]) + __uint_as_float(rr[1]); }
            if (cb == 0 && hi == 0) { if (g == 0) { ((MLAS float*)(lds + L_DP))[r32] = d0; ((MLAS float*)(lds + L_DP))[32 + r32] = d1; } else ((MLAS float*)(lds + L_DP))[64 + r32] = d1; }
        }
        f32x16 Y0 = {}, Y1 = {};
        { ML_LANE;
#pragma unroll
        for (int j = 0; j < 4; ++j)
#pragma unroll
            for (int ks = 0; ks < 2; ++ks) { const bfx8 xs = pack_step(Cacc[j], ks);
                MLAS const unsigned char* qa = lds + L_Q + r32 * QP + (128 * g + 32 * j + 16 * ks + 4 * hi) * 2;
                const u32x2 a0l = *(MLAS const u32x2*)(qa), a0h = *(MLAS const u32x2*)(qa + 16), a1l = *(MLAS const u32x2*)(qa + 32 * QP), a1h = *(MLAS const u32x2*)(qa + 32 * QP + 16);
                const bfx8 pa0 = __builtin_bit_cast(bfx8, (u32x4){a0l.x, a0l.y, a0h.x, a0h.y}), pa1 = __builtin_bit_cast(bfx8, (u32x4){a1l.x, a1l.y, a1h.x, a1h.y});
                Y0 = ML_MFMA(pa0, xs, Y0); Y1 = ML_MFMA(pa1, xs, Y1); }
#pragma unroll
        for (int i = 0; i < 16; ++i) { Y0[i] *= ((MLAS const float*)(lds + L_GI))[crow(i, hi)]; Y1[i] *= ((MLAS const float*)(lds + L_GI))[32 + crow(i, hi)]; } }
        { ML_LANE;
            const int i16 = lane & 15, q_ = i16 >> 2, p_ = i16 & 3, gi = lane >> 4;
            MLAS const unsigned char* vb = lds + L_V + (32 * sb + 4 * hi + q_) * VP + (32 * cb + 16 * (gi & 1) + 4 * p_) * 2;
#pragma unroll
            for (int ks = 0; ks < 2; ++ks) { const bfx8 pb = cat8(vtr(vb + (16 * ks) * VP), vtr(vb + (16 * ks + 8) * VP));
                Y1 = ML_MFMA(pack_step(S1, ks), pb, Y1);
                if (g == 0) Y0 = ML_MFMA(pack_step(S0, ks), pb, Y0); }
        }
        { ML_LANE;
            const int sub = lane >> 3, part = lane & 7, l_ = 8 * wave + sub; float d_ = 0.f;
#pragma unroll
            for (int j = 0; j < 4; ++j) { const u32x4 qw = *(MLAS const u32x4*)(lds + L_Q + l_ * QP + part * 64 + j * 16);
                const f32x4 n0 = *(MLAS const f32x4*)(lds + L_NV + part * 128 + j * 32), n1 = *(MLAS const f32x4*)(lds + L_NV + part * 128 + j * 32 + 16);
                d_ += (__uint_as_float(qw.x << 16) * n0.x + __uint_as_float(qw.x & 0xffff0000u) * n0.y) + (__uint_as_float(qw.y << 16) * n0.z + __uint_as_float(qw.y & 0xffff0000u) * n0.w)
                    + (__uint_as_float(qw.z << 16) * n1.x + __uint_as_float(qw.z & 0xffff0000u) * n1.y) + (__uint_as_float(qw.w << 16) * n1.z + __uint_as_float(qw.w & 0xffff0000u) * n1.w); }
            d_ += __shfl_xor(d_, 1); d_ += __shfl_xor(d_, 2); d_ += __shfl_xor(d_, 4);
            if (part == 0) ((MLAS float*)(lds + L_QN))[l_] = d_;
        }
        { ML_LANE;
            MLAS float* ex = (MLAS float*)(lds + L_EX + ((1 - g) * 4 + cb) * 4096) + lane;
#pragma unroll
            for (int i = 0; i < 16; ++i) ex[i * 64] = (g == 0) ? Y1[i] : Y0[i];
        }
        __syncthreads();
        if (c + 1 < it.nchunk) ML_PREFETCH(c + 1);
        { ML_LANE;
            MLAS const float* ex = (MLAS const float*)(lds + L_EX + (g * 4 + cb) * 4096) + lane; f32x16 Y = (g == 0) ? Y0 : Y1;
#pragma unroll
            for (int i = 0; i < 16; ++i) Y[i] += ex[i * 64];
#pragma unroll
            for (int i = 0; i < 16; ++i) { const int l_ = 32 * g + crow(i, hi);
                const float dsum = (g == 0) ? ((MLAS const float*)(lds + L_DP))[l_] : ((MLAS const float*)(lds + L_DP))[l_] + ((MLAS const float*)(lds + L_DP))[32 + l_];
                const float den = dsum + ((MLAS const float*)(lds + L_GI))[l_] * ((MLAS const float*)(lds + L_QN))[l_];
                const float hv = Y[i] / fmaxf(fabsf(den), ((MLAS const float*)(lds + L_GE))[l_]);
                const float hn = __shfl_xor(hv, 1);
                if (32 * g < L && (r32 & 1) == 0) __builtin_amdgcn_raw_buffer_store_b32(cvtpk(hv, hn), it.hout, (int)hoff, ((c * L + 32 * g + (i & 3) + 8 * (i >> 2)) * 1024 + 32 * cb) * 2, 0); }
        }
        if (tid < 256) { float a_ = 0.f;
#pragma unroll 8
            for (int s = 0; s < 64; ++s) a_ += ((MLAS const float*)(lds + L_GS))[s] * bf2f(*(MLAS const unsigned short*)(lds + L_K + s * QP + tid * 2));
            ((MLAS float*)(lds + L_NV))[tid] = decay * ((MLAS const float*)(lds + L_NV))[tid] + a_; }
        { ML_LANE;
            const int i16 = lane & 15, q_ = i16 >> 2, p_ = i16 & 3, gi = lane >> 4;
            MLAS const unsigned char* kb_ = lds + L_K + (8 * hi + q_) * QP + (128 * g + 16 * (gi & 1) + 4 * p_) * 2;
            MLAS const unsigned char* vw_ = lds + L_VW + (8 * hi + q_) * VP + (32 * cb + 16 * (gi & 1) + 4 * p_) * 2;
#pragma unroll
            for (int j = 0; j < 4; ++j)
#pragma unroll
                for (int i = 0; i < 16; ++i) Cacc[j][i] *= decay;
#pragma unroll
            for (int ks = 0; ks < 4; ++ks) { const bfx8 vb_ = cat8(vtr(vw_ + (16 * ks) * VP), vtr(vw_ + (16 * ks + 4) * VP));
#pragma unroll
                for (int j = 0; j < 4; ++j) { const bfx8 ka_ = cat8(vtr(kb_ + (16 * ks) * QP + 64 * j), vtr(kb_ + (16 * ks + 4) * QP + 64 * j));
                    Cacc[j] = ML_MFMA(ka_, vb_, Cacc[j]); } }
        }
        m = mnext;
        __syncthreads();
    }
#undef ML_PREFETCH
#undef ML_LANE
#pragma unroll
    for (int j = 0; j < 4; ++j)
#pragma unroll
        for (int i = 0; i < 16; ++i) __builtin_amdgcn_raw_buffer_store_b32(__float_as_uint(Cacc[j][i]), it.Cout, (int)coff, ((128 * g + 32 * j + (i & 3) + 8 * (i >> 2)) * 256 + 32 * cb) * 4, 0);
    if (it.nout && tid < 256) it.nout[tid] = ((MLAS const float*)(lds + L_NV))[tid];
    if (it.mout && tid == 0) *it.mout = m;
    __syncthreads();
}
#undef ML_MFMA
#undef ML_LD16
#undef ML_LDF
#undef MLAS
}

constexpr size_t WS_BC = WS_NAIVE, WS_WV = WS_BC + 2 * MiB, WS_CMX = WS_WV + 2 * MiB;
constexpr size_t WS_CHS = WS_CMX + 2 * MiB;
constexpr size_t WS_SMAT = WS_CHS + 1 * MiB;
constexpr size_t WS_CB = WS_SMAT + 3 * MiB;
constexpr size_t WS_NB = WS_CB + 64 * MiB;
constexpr size_t WS_MASKS = WS_NB + 1 * MiB;
constexpr size_t WS_HA = WS_MASKS + 1 * MiB;
constexpr size_t WS_END = WS_HA + ROWBUF;
constexpr int NCHK = BATCH * 4 * 32 + DEC_BATCH * 4;

__device__ __forceinline__ float logsig(float x) { return fminf(x, 0.0f) - log1pf(__expf(-fabsf(x))); }
__device__ __forceinline__ float siluf(float x) { return x / (1.0f + __expf(-x)); }
__device__ __forceinline__ int t5b(int rel) { const int n = rel < 0 ? -rel : rel; const int v = n < 8 ? n : 8 + (n >= 12) + (n >= 16) + (n >= 23) + (n >= 32) + (n >= 46) + (n >= 64) + (n >= 91); return (rel > 0 ? 16 : 0) + v; }

namespace pg8 {
__device__ __forceinline__ void unpack8(u32x4 w, float (&f)[8]) {
    f[0] = __uint_as_float(w.x << 16); f[1] = __uint_as_float(w.x & 0xffff0000u); f[2] = __uint_as_float(w.y << 16); f[3] = __uint_as_float(w.y & 0xffff0000u);
    f[4] = __uint_as_float(w.z << 16); f[5] = __uint_as_float(w.z & 0xffff0000u); f[6] = __uint_as_float(w.w << 16); f[7] = __uint_as_float(w.w & 0xffff0000u);
}
__device__ __forceinline__ u32x4 pack8f(const float (&f)[8]) { u32x4 w; w.x = cvt_pk_bf16(f[0], f[1]); w.y = cvt_pk_bf16(f[2], f[3]); w.z = cvt_pk_bf16(f[4], f[5]); w.w = cvt_pk_bf16(f[6], f[7]); return w; }
__device__ __forceinline__ float sg_(float x) { return 1.0f / (1.0f + __expf(-x)); }
struct EpiM1a {
    static constexpr bool PERM = true, AFTER_DRAIN = false, MIDK = false;
    const bf16_t* HA; const bf16_t* OB; const float* HST; const float* ang; bf16_t* BR;
    __device__ __forceinline__ void mid(f32x4 (&)[2][2][4][2], const Unit&, int, int, int, int) const {}
    __device__ __forceinline__ void operator()(const f32x4 (&acc)[2][2][4][2], const Unit& u, int wr, int wc, int fr, int fq) const {
        const int pn = u.pn; const int row0 = u.pm * BM + wr * 64 + fr, cl = wc * 32 + 8 * fq;
        if (pn < 8) {
            const int ch0 = 128 * pn + cl, head = pn >> 1;
            const f32x4 g0 = *(const f32x4*)(ang + ch0), g1 = *(const f32x4*)(ang + ch0 + 4);
            const float g[8] = {g0[0], g0[1], g0[2], g0[3], g1[0], g1[1], g1[2], g1[3]};
#pragma unroll
            for (int ai = 0; ai < 2; ++ai)
#pragma unroll
                for (int m = 0; m < 4; ++m) { const int r = row0 + ai * HALF + m * 16;
                    float h[8]; unpack8(*(const u32x4*)(HA + (size_t)r * 1024 + ch0), h);
                    const float mean = HST[((size_t)r * 4 + head) * 2], rstd = HST[((size_t)r * 4 + head) * 2 + 1];
                    const f32x4 o0 = acc[ai][0][m][0], o1 = acc[ai][0][m][1], z0 = acc[ai][1][m][0], z1 = acc[ai][1][m][1];
                    const float oa[8] = {o0[0], o0[1], o0[2], o0[3], o1[0], o1[1], o1[2], o1[3]}, za[8] = {z0[0], z0[1], z0[2], z0[3], z1[0], z1[1], z1[2], z1[3]};
                    float o[8];
#pragma unroll
                    for (int i = 0; i < 8; ++i) o[i] = ((h[i] - mean) * rstd * g[i] * sg_(oa[i])) * (za[i] * sg_(za[i]));
                    *(u32x4*)(BR + (size_t)r * 2048 + ch0) = pack8f(o); }
        } else {
#pragma unroll
            for (int ai = 0; ai < 2; ++ai)
#pragma unroll
                for (int m = 0; m < 4; ++m) { const int r = row0 + ai * HALF + m * 16;
#pragma unroll
                    for (int bj = 0; bj < 2; ++bj) { const int ch0 = 256 * (pn - 8) + 128 * bj + cl;
                        float ob[8]; unpack8(*(const u32x4*)(OB + (size_t)r * 1024 + ch0), ob);
                        const f32x4 z0 = acc[ai][bj][m][0], z1 = acc[ai][bj][m][1]; const float zb[8] = {z0[0], z0[1], z0[2], z0[3], z1[0], z1[1], z1[2], z1[3]};
                        float o[8];
#pragma unroll
                        for (int i = 0; i < 8; ++i) o[i] = ob[i] * (zb[i] * sg_(zb[i]));
                        *(u32x4*)(BR + (size_t)r * 2048 + 1024 + ch0) = pack8f(o); } }
        }
    }
};
struct EpiM1b {
    static constexpr bool PERM = true, AFTER_DRAIN = false, MIDK = false;
    bf16_t* SGA; bf16_t* SGB;
    __device__ __forceinline__ void mid(f32x4 (&)[2][2][4][2], const Unit&, int, int, int, int) const {}
    __device__ __forceinline__ void operator()(const f32x4 (&acc)[2][2][4][2], const Unit& u, int wr, int wc, int fr, int fq) const {
        const int pn = u.pn; const int row0 = u.pm * BM + wr * 64 + fr, cl = wc * 32 + 8 * fq;
        bf16_t* base = pn < 4 ? SGA : SGB; const int col0 = (pn & 3) * 256 + cl;
#pragma unroll
        for (int ai = 0; ai < 2; ++ai)
#pragma unroll
            for (int m = 0; m < 4; ++m) { bf16_t* rowp = base + (size_t)(row0 + ai * HALF + m * 16) * 1024 + col0;
#pragma unroll
                for (int bj = 0; bj < 2; ++bj) { const f32x4 v0 = acc[ai][bj][m][0], v1 = acc[ai][bj][m][1];
                    const float o[8] = {sg_(v0[0]), sg_(v0[1]), sg_(v0[2]), sg_(v0[3]), sg_(v1[0]), sg_(v1[1]), sg_(v1[2]), sg_(v1[3])};
                    *(u32x4*)(rowp + bj * HALF) = pack8f(o); } }
    }
};
struct EpiM1 {
    static constexpr bool PERM = true, AFTER_DRAIN = false, MIDK = false;
    EpiM1a a; EpiM1b b;
    __device__ __forceinline__ void mid(f32x4 (&)[2][2][4][2], const Unit&, int, int, int, int) const {}
    __device__ __forceinline__ void operator()(const f32x4 (&acc)[2][2][4][2], const Unit& u, int wr, int wc, int fr, int fq) const {
        if (u.pn < 12) a(acc, u, wr, wc, fr, fq); else { Unit v = u; v.pn = u.pn - 12; b(acc, v, wr, wc, fr, fq); }
    }
};
struct EpiM2 {
    static constexpr bool PERM = true, AFTER_DRAIN = false, MIDK = true;
    const bf16_t* SGA; const bf16_t* SGB; bf16_t* MX;
    __device__ __forceinline__ void mid(f32x4 (&acc)[2][2][4][2], const Unit& u, int wr, int wc, int fr, int fq) const {
        int fr_ = fr, fq_ = fq; asm volatile("" : "+v"(fr_), "+v"(fq_));
        const int row0 = u.pm * BM + wr * 64 + fr_, col0 = u.pn * BM + wc * 32 + 8 * fq_;
#pragma unroll
        for (int ai = 0; ai < 2; ++ai)
#pragma unroll
            for (int m = 0; m < 4; ++m) { const size_t ro = (size_t)(row0 + ai * HALF + m * 16) * 1024 + col0;
#pragma unroll
                for (int bj = 0; bj < 2; ++bj) { float a[8], b[8]; unpack8(*(const u32x4*)(SGA + ro + bj * HALF), a); unpack8(*(const u32x4*)(SGB + ro + bj * HALF), b);
#pragma unroll
                    for (int i = 0; i < 4; ++i) { acc[ai][bj][m][0][i] *= a[i] * __builtin_amdgcn_rcpf(b[i]); acc[ai][bj][m][1][i] *= a[4 + i] * __builtin_amdgcn_rcpf(b[4 + i]); } }
                asm volatile("" ::: "memory"); }
    }
    __device__ __forceinline__ void operator()(const f32x4 (&acc)[2][2][4][2], const Unit& u, int wr, int wc, int fr, int fq) const {
        int fr_ = fr, fq_ = fq; asm volatile("" : "+v"(fr_), "+v"(fq_));
        const int row0 = u.pm * BM + wr * 64 + fr_, col0 = u.pn * BM + wc * 32 + 8 * fq_;
#pragma unroll
        for (int ai = 0; ai < 2; ++ai)
#pragma unroll
            for (int m = 0; m < 4; ++m) { const size_t ro = (size_t)(row0 + ai * HALF + m * 16) * 1024 + col0;
#pragma unroll
                for (int bj = 0; bj < 2; ++bj) { float b[8]; unpack8(*(const u32x4*)(SGB + ro + bj * HALF), b);
                    const f32x4 v0 = acc[ai][bj][m][0], v1 = acc[ai][bj][m][1];
                    const float o[8] = {v0[0] * b[0], v0[1] * b[1], v0[2] * b[2], v0[3] * b[3], v1[0] * b[4], v1[1] * b[5], v1[2] * b[6], v1[3] * b[7]};
                    *(u32x4*)(MX + ro + bj * HALF) = pack8f(o); }
                asm volatile("" ::: "memory"); }
    }
};
struct EpiM3 {
    static constexpr bool PERM = true, AFTER_DRAIN = false, MIDK = false;
    const float* xp; const float* xs; float* yp; float* ys;
    __device__ __forceinline__ void mid(f32x4 (&)[2][2][4][2], const Unit&, int, int, int, int) const {}
    __device__ __forceinline__ void operator()(const f32x4 (&acc)[2][2][4][2], const Unit& u, int wr, int wc, int fr, int fq) const {
        const bool samp = u.pm >= NTP / 256; const int row0 = (samp ? u.pm - NTP / 256 : u.pm) * BM + wr * 64 + fr, col0 = u.pn * BM + wc * 32 + 8 * fq;
        const float* xb = samp ? xs : xp; float* yb = samp ? ys : yp;
#pragma unroll
        for (int ai = 0; ai < 2; ++ai)
#pragma unroll
            for (int m = 0; m < 4; ++m) { const size_t ro = (size_t)(row0 + ai * HALF + m * 16) * 1024 + col0;
#pragma unroll
                for (int bj = 0; bj < 2; ++bj) { const f32x4 x0 = *(const f32x4*)(xb + ro + bj * HALF), x1 = *(const f32x4*)(xb + ro + bj * HALF + 4);
                    *(f32x4*)(yb + ro + bj * HALF) = x0 * DN_ALPHA + acc[ai][bj][m][0]; *(f32x4*)(yb + ro + bj * HALF + 4) = x1 * DN_ALPHA + acc[ai][bj][m][1]; } }
    }
};
}

__device__ __forceinline__ float wave_sum(float v) {
#pragma unroll
    for (int o = 1; o < 64; o <<= 1) v += __shfl_xor(v, o);
    return v;
}

__device__ __forceinline__ void simple_select_row(LAS unsigned char* lds, int row, unsigned long long* mrow, const bf16* QI_, const float* SM_, const bf16* KI_, const float* cache_ik_) {
    const int tid_ = threadIdx.x, lane_ = tid_ & 63, wave_ = tid_ >> 6;
    LAS float* sc = (LAS float*)(lds + RING_OFF);
    LAS float* qv = (LAS float*)(lds + RING_OFF + 16384);
    const bool samp = row >= NTP; const int b = samp ? (row - NTP) / DEC_SEQ : row / SEQ; const int q = samp ? (row - NTP) % DEC_SEQ : row % SEQ;
    const int S = samp ? PAST_LEN + DEC_SEQ : ((q >> 6) + 1) * 64;
    if (S <= TOPK_MAX) { if (tid_ < 32) mrow[tid_] = (tid_ < (S >> 6)) ? ~0ull : 0ull; return; }
    qv[tid_] = bf2f(QI_[(size_t)row * 512 + tid_]); if (tid_ < 8) qv[512 + tid_] = SM_[(size_t)row * 16 + tid_] * 0.35355339059327373f;
    __syncthreads();
    const int nIt = (S + 511) / 512;
    for (int i = 0; i < nIt; ++i) { const int s = tid_ + 512 * i;
        if (s < S) { float kf[64];
            if (samp && s < PAST_LEN) { const float* kr = cache_ik_ + ((size_t)b * PAST_LEN + s) * 64;
#pragma unroll
                for (int j = 0; j < 64; ++j) kf[j] = kr[j]; }
            else { const bf16* kr = KI_ + (samp ? (size_t)NTP + (size_t)b * DEC_SEQ + (s - PAST_LEN) : (size_t)b * SEQ + s) * 64;
#pragma unroll
                for (int j = 0; j < 64; ++j) kf[j] = bf2f(kr[j]); }
            float a = 0.f;
#pragma unroll
            for (int h = 0; h < 8; ++h) { float d = 0.f;
#pragma unroll
                for (int j = 0; j < 64; ++j) d += qv[h * 64 + j] * kf[j];
                a += qv[512 + h] * fmaxf(d, 0.f); }
            sc[s] = a; } }
    __syncthreads();
    for (int i = 0; i < nIt; ++i) { const int s = tid_ + 512 * i; bool keep = false;
        if (s < S) { const int v = __float_as_int(sc[s]); const int vk = v ^ ((v >> 31) & 0x7fffffff); int rank = 0;
            for (int j = 0; j < S; ++j) { const int u = __float_as_int(sc[j]); const int uk = u ^ ((u >> 31) & 0x7fffffff); rank += (uk > vk) || (uk == vk && j < s); } keep = rank < TOPK_MAX; }
        const unsigned long long bm = __ballot(keep);
        if (lane_ == 0 && (wave_ + 8 * i) * 64 < S) mrow[wave_ + 8 * i] = bm; }
    if (!samp) { const int nw = S >> 6; if (tid_ >= nw && tid_ < 32) mrow[tid_] = 0ull; }
    __syncthreads();
}
__device__ __forceinline__ void simple_attn_task(int row, int h, int dc, const unsigned long long* mrow, const bf16* QB_, const bf16* KBc_, const bf16* VBc_, const float* cache_k_, const float* cache_v_,
                                                  const float* k_sample_, const float* v_sample_, const float* rel_bias_, bf16* orow) {
    const bool samp = row >= NTP; const int b = samp ? (row - NTP) / DEC_SEQ : row / SEQ; const int q = samp ? (row - NTP) % DEC_SEQ : row % SEQ;
    const int S = samp ? PAST_LEN + DEC_SEQ : ((q >> 6) + 1) * 64; const int qpos = samp ? PAST_LEN + q : q;
    const bf16* qr = QB_ + (size_t)row * 1024 + h * 128;
    float mx = -INFINITY, sum = 0.f, o[16];
#pragma unroll
    for (int i = 0; i < 16; ++i) o[i] = 0.f;
    for (int w = 0; w * 64 < S; ++w) { unsigned long long bits = mrow[w];
        while (bits) { const int s = w * 64 + __builtin_ctzll(bits); bits &= bits - 1;
            float d = 0.f; float vv[16];
            if (samp) { const float* kr = (s < PAST_LEN) ? cache_k_ + ((size_t)b * PAST_LEN + s) * 1024 + h * 128 : k_sample_ + ((size_t)b * DEC_SEQ + (s - PAST_LEN)) * 1024 + h * 128;
                const float* vr = (s < PAST_LEN) ? cache_v_ + ((size_t)b * PAST_LEN + s) * 1024 + h * 128 + dc * 16 : v_sample_ + ((size_t)b * DEC_SEQ + (s - PAST_LEN)) * 1024 + h * 128 + dc * 16;
#pragma unroll 8
                for (int j = 0; j < 128; ++j) d += bf2f(qr[j]) * kr[j];
#pragma unroll
                for (int i = 0; i < 16; ++i) vv[i] = vr[i]; }
            else { const bf16* kr = KBc_ + ((size_t)b * SEQ + s) * 1024 + h * 128; const bf16* vr = VBc_ + ((size_t)b * SEQ + s) * 1024 + h * 128 + dc * 16;
#pragma unroll 8
                for (int j = 0; j < 128; ++j) d += bf2f(qr[j]) * bf2f(kr[j]);
#pragma unroll
                for (int i = 0; i < 16; ++i) vv[i] = bf2f(vr[i]); }
            const float lg = d * 0.08838834764831845f + rel_bias_[t5b(s - qpos) * 8 + h];
            if (lg > mx) { const float f = __expf(mx - lg); sum *= f;
#pragma unroll
                for (int i = 0; i < 16; ++i) o[i] *= f; mx = lg; }
            const float p = __expf(lg - mx); sum += p;
#pragma unroll
            for (int i = 0; i < 16; ++i) o[i] += p * vv[i]; } }
    const float inv = 1.0f / sum;
#pragma unroll
    for (int i = 0; i < 16; ++i) orow[i] = (bf16)f2bf(o[i] * inv);
}


template <int NW>
__device__ __forceinline__ unsigned long long wave_select(LAS const int* row, int nW, int lane_) {
    static_assert(TOPK_MAX == 256, "the 4th-largest bracket assumes TOPK_MAX = 64 lanes x 4");
    int v[NW]; int t0 = (int)0x80000000, t1 = t0, t2 = t0, t3 = t0;
#pragma unroll
    for (int i = 0; i < NW; ++i) { v[i] = (i < nW) ? row[lane_ + 64 * i] : (int)0x80000000;
        int x = v[i], y; y = min(t0, x); t0 = max(t0, x); x = y; y = min(t1, x); t1 = max(t1, x); x = y; y = min(t2, x); t2 = max(t2, x); x = y; t3 = max(t3, x); }
    int vmx = t3, vmn = t3;
#pragma unroll
    for (int o_ = 1; o_ < 64; o_ <<= 1) { vmx = max(vmx, __shfl_xor(vmx, o_)); vmn = min(vmn, __shfl_xor(vmn, o_)); }
    int lo_ = __builtin_amdgcn_readfirstlane(vmn), hi_ = __builtin_amdgcn_readfirstlane(vmx); bool exact = false; int T = lo_;
    while (lo_ < hi_) { const int mid = lo_ + (int)((((unsigned)hi_ - (unsigned)lo_) + 1u) >> 1); int cnt = 0;
#pragma unroll
        for (int i = 0; i < NW; ++i) { cnt += __builtin_popcountll(__ballot(v[i] >= mid)); if ((i & 3) == 3) __builtin_amdgcn_sched_barrier(0); }
        if (cnt == TOPK_MAX) { exact = true; T = mid; break; }
        if (cnt > TOPK_MAX) lo_ = mid; else hi_ = mid - 1; }
    if (!exact) T = lo_;
    int need = TOPK_MAX;
    if (!exact) { int cgt = 0;
#pragma unroll
        for (int i = 0; i < NW; ++i) { cgt += __builtin_popcountll(__ballot(v[i] > T)); if ((i & 3) == 3) __builtin_amdgcn_sched_barrier(0); }
        need = TOPK_MAX - cgt; }
    unsigned long long myw = 0ull; int running = 0; const unsigned long long lt = (1ull << lane_) - 1ull;
#pragma unroll
    for (int i = 0; i < NW; ++i) { bool sel;
        if (exact) sel = v[i] >= T;
        else { const bool eq = v[i] == T; const unsigned long long em = __ballot(eq); sel = (v[i] > T) || (eq && running + __builtin_popcountll(em & lt) < need); running += __builtin_popcountll(em); }
        const unsigned long long wd = __ballot(sel); if (lane_ == i) myw = wd; __builtin_amdgcn_sched_barrier(0); }
    return myw;
}
__device__ __forceinline__ void sample_select_row(LAS unsigned char* lds, int row, unsigned long long* mrow, const bf16* QI_, const float* SM_, const bf16* KI_, const float* cache_ik_) {
    const int tid_ = threadIdx.x, lane_ = tid_ & 63, wave_ = __builtin_amdgcn_readfirstlane(tid_ >> 6);
    LAS int* sck = (LAS int*)(lds + RING_OFF);
    LAS float* qv = (LAS float*)(lds + RING_OFF + 16384);
    const int b = (row - NTP) / DEC_SEQ; constexpr int S = PAST_LEN + DEC_SEQ;
    qv[tid_] = bf2f(QI_[(size_t)row * 512 + tid_]); if (tid_ < 8) qv[512 + tid_] = SM_[(size_t)row * 16 + tid_] * 0.35355339059327373f;
    __syncthreads();
#pragma unroll 1
    for (int i = 0; i < 5; ++i) { const int s = tid_ + 512 * i;
        if (s < 2112) { int key = (int)0x80000000;
            if (s < S) { float kf[64];
                if (s < PAST_LEN) { const float* kr = cache_ik_ + ((size_t)b * PAST_LEN + s) * 64;
#pragma unroll
                    for (int j = 0; j < 64; ++j) kf[j] = kr[j]; }
                else { const bf16* kr = KI_ + ((size_t)NTP + (size_t)b * DEC_SEQ + (s - PAST_LEN)) * 64;
#pragma unroll
                    for (int j = 0; j < 64; ++j) kf[j] = bf2f(kr[j]); }
                float a = 0.f;
#pragma unroll
                for (int h = 0; h < 8; ++h) { float d = 0.f;
#pragma unroll
                    for (int j = 0; j < 64; ++j) d += qv[h * 64 + j] * kf[j];
                    a += qv[512 + h] * fmaxf(d, 0.f); }
                const int kb_ = __float_as_int(a); key = kb_ ^ ((kb_ >> 31) & 0x7fffffff); }
            sck[s] = key; } }
    __syncthreads();
    if (wave_ == 0) { const unsigned long long myw = wave_select<33>(sck, 33, lane_); if (lane_ < 33) mrow[lane_] = myw; }
    __syncthreads();
}
__device__ __forceinline__ void sample_attn_row(LAS unsigned char* lds, int b, int r, const unsigned long long* mrow, bf16* qo_row  , const float* cache_k_, const float* cache_v_,
                                                 const float* k_new, const float* v_new  , const float* rel_bias_) {
    const int tid_ = threadIdx.x, lane_ = tid_ & 63, h = __builtin_amdgcn_readfirstlane(tid_ >> 6);
    LAS int* idx = (LAS int*)(lds + RING_OFF);
    LAS float* qf = (LAS float*)(lds + RING_OFF + 1024) + h * 128;
    if (h == 0) { int base = 0; const unsigned long long lt = (1ull << lane_) - 1ull;
        for (int w = 0; w < 33; ++w) { const unsigned long long bits = mrow[w]; if ((bits >> lane_) & 1ull) idx[base + __builtin_popcountll(bits & lt)] = 64 * w + lane_; base += __builtin_popcountll(bits); } }
    qf[lane_] = bf2f(qo_row[h * 128 + lane_]); qf[64 + lane_] = bf2f(qo_row[h * 128 + 64 + lane_]);
    __syncthreads();
    const int qpos = PAST_LEN + r; float lg[4]; int sk[4];
#pragma unroll
    for (int rnd = 0; rnd < 4; ++rnd) { const int s = idx[64 * rnd + lane_]; sk[rnd] = s;
        const float* kr = (s < PAST_LEN) ? cache_k_ + ((size_t)b * PAST_LEN + s) * 1024 + h * 128 : k_new + (size_t)(s - PAST_LEN) * 1024 + h * 128;
        float d = 0.f;
#pragma unroll 8
        for (int d4 = 0; d4 < 32; ++d4) { const f32x4 kk = *(const f32x4*)(kr + 4 * d4); const f32x4 qq = *(LAS const f32x4*)(qf + 4 * d4); d += (kk.x * qq.x + kk.y * qq.y) + (kk.z * qq.z + kk.w * qq.w); }
        lg[rnd] = d * 0.08838834764831845f + rel_bias_[t5b(s - qpos) * 8 + h]; }
    float mx = fmaxf(fmaxf(lg[0], lg[1]), fmaxf(lg[2], lg[3]));
#pragma unroll
    for (int o_ = 1; o_ < 64; o_ <<= 1) mx = fmaxf(mx, __shfl_xor(mx, o_));
    float p[4], sum = 0.f;
#pragma unroll
    for (int rnd = 0; rnd < 4; ++rnd) { p[rnd] = __expf(lg[rnd] - mx); sum += p[rnd]; }
    sum = wave_sum(sum);
    float a0 = 0.f, a1 = 0.f;
#pragma unroll
    for (int rnd = 0; rnd < 4; ++rnd) {
#pragma unroll 8
        for (int j = 0; j < 64; ++j) { const float pj = __int_as_float(__builtin_amdgcn_readlane(__float_as_int(p[rnd]), j)); const int sj = __builtin_amdgcn_readlane(sk[rnd], j);
            const float* vr = (sj < PAST_LEN) ? cache_v_ + ((size_t)b * PAST_LEN + sj) * 1024 + h * 128 : v_new + (size_t)(sj - PAST_LEN) * 1024 + h * 128;
            const float2 vv = *(const float2*)(vr + 2 * lane_); a0 += pj * vv.x; a1 += pj * vv.y; } }
    const float inv = 1.0f / sum;
    *(unsigned*)(qo_row + h * 128 + 2 * lane_) = pk2(a0 * inv, a1 * inv);
    __syncthreads();
}

typedef const __attribute__((address_space(4))) Args* kargp_t;
#define MK_ARGS kargp_t ap_ = (kargp_t)__builtin_amdgcn_kernarg_segment_ptr(); asm volatile("" : "+s"(ap_))
#define args (*ap_)
__global__ void __launch_bounds__(NWAVES * 64, 2) mk_fwd(Args kargs_by_value) {
    extern __shared__ __attribute__((aligned(16))) unsigned char lds_raw[];
    LAS unsigned char* lds = (LAS unsigned char*)lds_raw;
    int lo, hi; unsigned* barw;
    { MK_ARGS; lo = args.ph_lo; hi = args.ph_hi; barw = (unsigned*)((gu32*)(args.ws + WS_CTL) + CW_BAR); }
    volatile LAS unsigned* MISC = (volatile LAS unsigned*)(lds + MISC_OFF);
    for (int u = threadIdx.x; u < (LDS_BYTES - LDSCTL_OFF) / 4; u += NWAVES * 64) ((LAS unsigned*)(lds + LDSCTL_OFF))[u] = 0u;
    __syncthreads();
    XcdBarrier bar = xcd_barrier_post(barw, MISC + 8);
#ifndef DUPMASK
#define DUPMASK 0
#endif
#ifndef PHMASK
#define PHMASK 0x3ff
#endif
#define IN(k) (((PHMASK >> (k)) & 1) && lo <= (k) && (k) < hi)
#define GBAR() xcd_barrier(bar)
#define WMIX ((bf16*)(args.ws + WS_WMIX))
#define WMRG ((bf16*)(args.ws + WS_WMRG))
#define WAB ((bf16*)(args.ws + WS_WAB))
#define WO ((bf16*)(args.ws + WS_WO))
#define XB ((bf16*)(args.ws + WS_XB))
#define QA ((bf16*)(args.ws + WS_QA))
#define KA ((bf16*)(args.ws + WS_KA))
#define VA ((bf16*)(args.ws + WS_VA))
#define QB ((bf16*)(args.ws + WS_QB))
#define QI ((bf16*)(args.ws + WS_QI))
#define KI ((bf16*)(args.ws + WS_KI))
#define SM ((float*)(args.ws + WS_SM))
#define MASK ((unsigned long long*)(args.ws + WS_MASK))
#define MASKS ((unsigned long long*)(args.ws + WS_MASKS))
#define HST ((float*)(args.ws + WS_HST))
#define BC ((float*)(args.ws + WS_BC))
#define WV ((float*)(args.ws + WS_WV))
#define CMX ((float*)(args.ws + WS_CMX))
#define CHS ((float*)(args.ws + WS_CHS))
#define MCH (CHS + 2 * NCHK)
#define SMATP ((float*)(args.ws + WS_SMAT))
#define SMATS (SMATP + 128 * 4096)
#define CB ((float*)(args.ws + WS_CB))
#define NBf ((float*)(args.ws + WS_NB))
#define HA VA
#define OB QB
#define BR QA
#define SGA ((bf16*)(args.ws + WS_HA))
#define SGB KBc
#define MX XB
#define y_prompt (args.out)
#define y_sample (y_prompt + (size_t)NTP * 1024)
#define k_prompt (y_sample + (size_t)NTS * 1024)
#define v_prompt (k_prompt + (size_t)NTP * 1024)
#define ik_prompt (v_prompt + (size_t)NTP * 1024)
#define C_prompt (ik_prompt + (size_t)NTP * 64)
#define n_prompt (C_prompt + (size_t)BATCH * 4 * 65536)
#define m_prompt (n_prompt + (size_t)BATCH * 1024)
#define k_sample (m_prompt + BATCH * 4)
#define v_sample (k_sample + (size_t)NTS * 1024)
#define ik_sample (v_sample + (size_t)NTS * 1024)
#define C_sample (ik_sample + (size_t)NTS * 64)
#define n_sample (C_sample + (size_t)DEC_BATCH * 4 * 65536)
#define m_sample (n_sample + (size_t)DEC_BATCH * 1024)
#define KBc ((bf16*)y_prompt)
#define VBc (KBc + (size_t)NTP * 1024)
#define cache_k (args.in[2])
#define cache_v (args.in[3])
#define cache_ik (args.in[4])
#define state_C (args.in[5])
#define state_n (args.in[6])
#define state_m (args.in[7])
#define b_gates (args.in[9])
#define a_norm_g (args.in[10])
#define rel_bias (args.in[14])
#define ln_g (args.in[15])
#define ln_b (args.in[16])
#define gtid ({ int t__ = (int)threadIdx.x; asm volatile("" : "+v"(t__)); (long)blockIdx.x * (NWAVES * 64) + (long)t__; })
#define GT ((long)gridDim.x * (NWAVES * 64))
#define gw (vcu * NWAVES + wave)
#define NGW ((int)gridDim.x * NWAVES)
#define tid ((int)threadIdx.x)
#define lane ((int)(threadIdx.x & 63))
#define wave (__builtin_amdgcn_readfirstlane((int)(threadIdx.x >> 6)))
#define G ((int)gridDim.x)
#define vcu ((G % 8 == 0) ? ((int)blockIdx.x % 8) * (G / 8) + (int)blockIdx.x / 8 : (int)blockIdx.x)

    if (IN(0))
#if (DUPMASK >> 0) & 1
    for (int rep_ = 0; rep_ < 2; ++rep_)
#endif
    { MK_ARGS;
        P0Args a{args.in[0], args.in[1], args.in[8], args.in[11], args.in[12], args.in[13], XB, WMIX, WMRG, WAB, WO};
        p0_prologue(a, lds, vcu, G, wave, lane);
        GBAR();
    }
    if (IN(1))
#if (DUPMASK >> 1) & 1
    for (int rep_ = 0; rep_ < 2; ++rep_)
#endif
    { MK_ARGS;
        pg8::Gemm g{XB, WMIX, NTOK, N_MIX, 1024}; pg8::StaticOrder S; S.init(NTOK, N_MIX, G, (int)blockIdx.x);
        pg8::EpiMix E{QA, KBc, QI, KI, SM, k_prompt, k_sample, ik_prompt, ik_sample};
        pg8::gemm_phase<pg8::EpiMix, pg8::StaticOrder, true, true>(lds + RING_OFF, g, S, E);
        GBAR();
    }
    if (IN(2))
#if (DUPMASK >> 2) & 1
    for (int rep_ = 0; rep_ < 2; ++rep_)
#endif
    { MK_ARGS;
        static_assert(ml::L_END <= LDSCTL_OFF, "mLSTM LDS image");
#ifdef PROBE_ML
#define HAREF ((bf16*)(args.ws + WS_HA))
        for (long t = gtid; t < NCHK; t += GT) {
            int h, L; long tok0;
            if (t < 4096) { const int b = (int)(t >> 7); h = (int)((t >> 5) & 3); const int c = (int)(t & 31); tok0 = (long)b * SEQ + c * 64; L = 64; }
            else { const int b = (int)((t - 4096) >> 2); h = (int)((t - 4096) & 3); tok0 = NTP + (long)b * DEC_SEQ; L = DEC_SEQ; }
            const float bi = b_gates[h], bfg = b_gates[4 + h]; float cum = 0.f, cmax = -INFINITY;
            for (int l = 0; l < L; ++l) { const long tok = tok0 + l; const float ig = SM[tok * 16 + 8 + h] + bi; const float lf = logsig(SM[tok * 16 + 12 + h] + bfg);
                cum += lf; const float w = ig - cum; cmax = fmaxf(cmax, w); BC[tok * 4 + h] = cum; WV[tok * 4 + h] = w; CMX[tok * 4 + h] = cmax; }
            CHS[2 * t] = cum; CHS[2 * t + 1] = cmax;
        }
        GBAR();
        for (long t = gtid; t < BATCH * 4 + DEC_BATCH * 4; t += GT) {
            if (t < BATCH * 4) { float m = 0.f; for (int c = 0; c < 32; ++c) { const long i = t * 32 + c; MCH[i] = m; m = CHS[2 * i] + fmaxf(m, CHS[2 * i + 1]); } m_prompt[t] = m; }
            else { const long j = t - BATCH * 4; const long i = 4096 + j; float m = state_m[j]; MCH[i] = m; m = CHS[2 * i] + fmaxf(m, CHS[2 * i + 1]); m_sample[j] = m; }
        }
        GBAR();
        for (int c = 0; c < 32; ++c) {
            const long nSp = 128L * 4096, nSs = (c == 0) ? 64L * 1024 : 0;
            for (long t = gtid; t < nSp + nSs; t += GT) {
                int bh, l, s, L; long tok0; float* dst;
                if (t < nSp) { bh = (int)(t >> 12); l = (int)((t >> 6) & 63); s = (int)(t & 63); L = 64; tok0 = (long)(bh >> 2) * SEQ + c * 64; dst = SMATP + t; }
                else { const long u = t - nSp; bh = (int)(u >> 10); l = (int)((u >> 5) & 31); s = (int)(u & 31); L = 32; tok0 = NTP + (long)(bh >> 2) * DEC_SEQ; dst = SMATS + u; }
                const int h = bh & 3; float val = 0.f;
                if (s <= l) { const long tl = tok0 + l, ts = tok0 + s; const bf16* q = QA + tl * 1024 + h * 256; const bf16* k = KA + ts * 1024 + h * 256;
                    float d = 0.f; for (int i = 0; i < 256; ++i) d += bf2f(q[i]) * bf2f(k[i]);
                    const long ci = (t < nSp) ? (long)bh * 32 + c : 4096 + bh;
                    val = d * __expf(WV[ts * 4 + h] - fmaxf(MCH[ci], CMX[tl * 4 + h])); }
                *dst = val;
            }
            GBAR();
            const long nHp = 32L * 64 * 1024, nHs = (c == 0) ? 16L * 32 * 1024 : 0, nCp = 128L * 65536, nCs = (c == 0) ? 64L * 65536 : 0;
            for (long t = gtid; t < nHp + nHs + nCp + nCs; t += GT) {
                if (t < nHp + nHs) {
                    int b, l, h, dv, L; long tok0, ci; const float* Sr; const float* Cm; const float* nv; bool zero = false;
                    if (t < nHp) { b = (int)(t >> 16); l = (int)((t >> 10) & 63); h = (int)((t >> 8) & 3); dv = (int)(t & 255); L = 64; tok0 = (long)b * SEQ + c * 64; ci = (long)(b * 4 + h) * 32 + c;
                        Sr = SMATP + ((long)(b * 4 + h) * 64 + l) * 64; Cm = CB + (size_t)(c & 1) * 128 * 65536 + (size_t)(b * 4 + h) * 65536; nv = NBf + (c & 1) * 128 * 256 + (b * 4 + h) * 256; zero = (c == 0); }
                    else { const long u = t - nHp; b = (int)(u >> 15); l = (int)((u >> 10) & 31); h = (int)((u >> 8) & 3); dv = (int)(u & 255); L = 32; tok0 = NTP + (long)b * DEC_SEQ; ci = 4096 + b * 4 + h;
                        Sr = SMATS + ((long)(b * 4 + h) * 32 + l) * 32; Cm = state_C + (size_t)(b * 4 + h) * 65536; nv = state_n + (b * 4 + h) * 256; }
                    const long tl = tok0 + l; const bf16* q = QA + tl * 1024 + h * 256;
                    const float mc = MCH[ci], Ml = fmaxf(mc, CMX[tl * 4 + h]), bl = BC[tl * 4 + h]; const float inter = __expf(mc - Ml);
                    float num = 0.f, den = 0.f;
                    for (int s = 0; s <= l; ++s) { const float sv = Sr[s]; num += sv * bf2f(VA[(tok0 + s) * 1024 + h * 256 + dv]); den += sv; }
                    if (!zero) { float qc = 0.f, qn = 0.f; for (int i = 0; i < 256; ++i) { const float qi_ = bf2f(q[i]); qc += qi_ * Cm[(size_t)i * 256 + dv]; qn += qi_ * nv[i]; } num += inter * qc; den += inter * qn; }
                    const float hv = num / fmaxf(fabsf(den), __expf(-(bl + Ml)));
                    HAREF[tl * 1024 + h * 256 + dv] = (bf16)f2bf(hv);
                } else {
                    const long u0 = t - (nHp + nHs); int bh, dk, dv, L; long tok0, ci; const float* Cs; const float* ns; float* Cd; float* nd; bool zero = false;
                    if (u0 < nCp) { bh = (int)(u0 >> 16); dk = (int)((u0 >> 8) & 255); dv = (int)(u0 & 255); L = 64; tok0 = (long)(bh >> 2) * SEQ + c * 64; ci = (long)bh * 32 + c; zero = (c == 0);
                        Cs = CB + (size_t)(c & 1) * 128 * 65536 + (size_t)bh * 65536; ns = NBf + (c & 1) * 128 * 256 + bh * 256;
                        Cd = (c == 31) ? C_prompt + (size_t)bh * 65536 : CB + (size_t)((c + 1) & 1) * 128 * 65536 + (size_t)bh * 65536; nd = (c == 31) ? n_prompt + bh * 256 : NBf + ((c + 1) & 1) * 128 * 256 + bh * 256; }
                    else { const long u = u0 - nCp; bh = (int)(u >> 16); dk = (int)((u >> 8) & 255); dv = (int)(u & 255); L = 32; tok0 = NTP + (long)(bh >> 2) * DEC_SEQ; ci = 4096 + bh;
                        Cs = state_C + (size_t)bh * 65536; ns = state_n + bh * 256; Cd = C_sample + (size_t)bh * 65536; nd = n_sample + bh * 256; }
                    const int h = bh & 3; const float mc = MCH[ci]; const float Mlast = fmaxf(mc, CMX[(tok0 + L - 1) * 4 + h]); const float decay = __expf(mc - Mlast);
                    float aC = 0.f, an = 0.f;
                    for (int s = 0; s < L; ++s) { const long ts = tok0 + s; const float wsv = __expf(WV[ts * 4 + h] - Mlast); const float kk = bf2f(KA[ts * 1024 + h * 256 + dk]);
                        aC += wsv * kk * bf2f(VA[ts * 1024 + h * 256 + dv]); an += wsv * kk; }
                    Cd[(size_t)dk * 256 + dv] = (zero ? 0.f : decay * Cs[(size_t)dk * 256 + dv]) + aC;
                    if (dv == 0) nd[dk] = (zero ? 0.f : decay * ns[dk]) + an;
                }
            }
            GBAR();
        }
#endif
#define ML_RS(p, bytes) __builtin_amdgcn_make_buffer_rsrc((void*)(p), (short)0, (int)(bytes), 0x00020000)
        if (vcu < BATCH * 8) { const int bh = vcu >> 1, dvh = vcu & 1, b = bh >> 2, h = bh & 3; const size_t t0 = (size_t)b * SEQ;
            ml::Item it; it.q = ML_RS(QA + t0 * 1024 + h * 256, SEQ * 2048); it.k = ML_RS(KA + t0 * 1024 + h * 256, SEQ * 2048); it.v = ML_RS(VA + t0 * 1024 + h * 256 + dvh * 128, SEQ * 2048); it.sm = ML_RS(SM + t0 * 16, SEQ * 64);
            it.C0 = ML_RS(C_prompt, 4); it.has0 = false; it.n0 = nullptr; it.m0 = 0.f; it.Cout = ML_RS(C_prompt + (size_t)bh * 65536 + dvh * 128, 65536 * 4);
            it.nout = dvh == 0 ? n_prompt + bh * 256 : nullptr; it.mout = dvh == 0 ? m_prompt + bh : nullptr;
            it.head = h; it.nchunk = SEQ / CHUNK; it.L = CHUNK; it.bi = b_gates[h]; it.bf = b_gates[4 + h]; it.hout = it.v;
#if (DUPMASK >> 2) & 1
            { float* no_ = it.nout; float* mo_ = it.mout;
              for (int dry_ = 1; dry_ >= 0; --dry_) { it.hout = dry_ ? ML_RS(args.ws + WS_HA, SEQ * 2048) : it.v; it.Cout = dry_ ? ML_RS(args.ws + WS_HA + 8 * MiB + (size_t)vcu * 65536 * 4, 65536 * 4) : ML_RS(C_prompt + (size_t)bh * 65536 + dvh * 128, 65536 * 4);
                  it.nout = dry_ ? nullptr : no_; it.mout = dry_ ? nullptr : mo_; ml::run_item(lds, it); } } }
#else
            ml::run_item(lds, it); }
#endif
        if (vcu < DEC_BATCH * 8) { const int bh = vcu >> 1, dvh = vcu & 1, b = bh >> 2, h = bh & 3; const size_t t0 = (size_t)NTP + (size_t)b * DEC_SEQ;
            ml::Item it; it.q = ML_RS(QA + t0 * 1024 + h * 256, DEC_SEQ * 2048); it.k = ML_RS(KA + t0 * 1024 + h * 256, DEC_SEQ * 2048); it.v = ML_RS(VA + t0 * 1024 + h * 256 + dvh * 128, DEC_SEQ * 2048); it.sm = ML_RS(SM + t0 * 16, DEC_SEQ * 64);
            it.C0 = ML_RS(state_C + (size_t)bh * 65536 + dvh * 128, 65536 * 4); it.has0 = true; it.n0 = state_n + bh * 256; it.m0 = state_m[bh]; it.Cout = ML_RS(C_sample + (size_t)bh * 65536 + dvh * 128, 65536 * 4);
            it.nout = dvh == 0 ? n_sample + bh * 256 : nullptr; it.mout = dvh == 0 ? m_sample + bh : nullptr;
            it.head = h; it.nchunk = 1; it.L = DEC_SEQ; it.bi = b_gates[h]; it.bf = b_gates[4 + h]; it.hout = it.v;
            ml::run_item(lds, it); }
#undef ML_RS
#ifdef PROBE_ML
        GBAR();
#endif
#ifdef PROBE_ML
        { float num = 0.f, den = 0.f;
          for (long t = gtid; t < (long)NTOK * 1024; t += GT) { const float a = bf2f(HA[t]), r = bf2f(HAREF[t]); num += (a - r) * (a - r); den += r * r; }
          num = wave_sum(num); den = wave_sum(den);
          if (lane == 0) { atomicAdd((float*)(args.ws + WS_CTL) + 8, num); atomicAdd((float*)(args.ws + WS_CTL) + 9, den); } }
#endif
    }
    if (IN(3))
#if (DUPMASK >> 3) & 1
    for (int rep_ = 0; rep_ < 2; ++rep_)
#endif
    { MK_ARGS;
        {
            typedef short bfx8 __attribute__((ext_vector_type(8))); typedef float f16v __attribute__((ext_vector_type(16)));
            LAS int* sck = (LAS int*)(lds + RING_OFF);
            const int hi = lane >> 5, r32 = lane & 31;
            for (int w4 = 0; w4 < 4; ++w4) {
                const int bW = vcu >> 3, jW = vcu & 7; const int cW = (w4 == 0) ? jW : (w4 == 1) ? 15 - jW : (w4 == 2) ? 16 + jW : 31 - jW;
                if (vcu >= BATCH * 8) break;
                const int S = 64 * (cW + 1), nW = cW + 1; const long tok0 = (long)bW * SEQ + 64 * cW;
                if (S <= TOPK_MAX) {
                    for (int k = 0; k < 8; ++k) { if (lane < 32) MASK[(size_t)(tok0 + wave * 8 + k) * 32 + lane] = (lane < nW) ? ~0ull : 0ull; }
                    continue; }
                { LAS unsigned char* qil = lds + RING_OFF + 65536; LAS float* sml = (LAS float*)(lds + RING_OFF + 65536 + 73728);
#pragma unroll
                  for (int i = 0; i < 8; ++i) { const int p_ = tid + 512 * i, row_ = p_ >> 6, wi_ = p_ & 63;
                      *(LAS v4u*)(qil + row_ * 1152 + (wi_ >> 3) * 144 + (wi_ & 7) * 16) = *(const v4u*)(QI + (size_t)(tok0 + row_) * 512 + wi_ * 8); }
                  sml[tid] = SM[(size_t)(tok0 + (tid >> 3)) * 16 + (tid & 7)] * 0.35355339059327373f;
                  asm volatile("s_waitcnt vmcnt(0) lgkmcnt(0)" ::: "memory"); __builtin_amdgcn_s_barrier(); asm volatile("" ::: "memory"); }
                bfx8 bfr[8][4];
#pragma unroll
                for (int i = 0; i < 8; ++i) { const int kt = wave + 8 * i;
                    if (kt < 2 * nW) { const bf16* kp = KI + ((size_t)bW * SEQ + 32 * kt + r32) * 64 + hi * 8;
#pragma unroll
                        for (int ks = 0; ks < 4; ++ks) bfr[i][ks] = *(const bfx8*)(kp + ks * 16); }
                    else {
#pragma unroll
                        for (int ks = 0; ks < 4; ++ks) bfr[i][ks] = (bfx8){0, 0, 0, 0, 0, 0, 0, 0}; } }
                for (int rd = 0; rd < 8; ++rd) {
                    bfx8 afr[2][4]; float wgt[2][16];
                    { const int blk = r32 >> 2; const int qa_ = 2 * (blk & 1) + (blk >> 2), ha_ = 4 * ((blk >> 1) & 1) + (r32 & 3);
                      LAS const unsigned char* qil = lds + RING_OFF + 65536; LAS const float* sml = (LAS const float*)(lds + RING_OFF + 65536 + 73728);
#pragma unroll
                      for (int rt = 0; rt < 2; ++rt) { LAS const unsigned char* qp = qil + (8 * rd + 4 * rt + qa_) * 1152 + ha_ * 144 + hi * 16;
#pragma unroll
                          for (int ks = 0; ks < 4; ++ks) afr[rt][ks] = *(LAS const bfx8*)(qp + ks * 32);
#pragma unroll
                          for (int qq = 0; qq < 2; ++qq) { LAS const float* wp = sml + (8 * rd + 4 * rt + 2 * hi + qq) * 8;
                              const f32x4 w0 = *(LAS const f32x4*)wp, w1 = *(LAS const f32x4*)(wp + 4);
                              wgt[rt][8 * qq + 0] = w0[0]; wgt[rt][8 * qq + 1] = w0[1]; wgt[rt][8 * qq + 2] = w0[2]; wgt[rt][8 * qq + 3] = w0[3];
                              wgt[rt][8 * qq + 4] = w1[0]; wgt[rt][8 * qq + 5] = w1[1]; wgt[rt][8 * qq + 6] = w1[2]; wgt[rt][8 * qq + 7] = w1[3]; } } }
#pragma unroll
                    for (int i8 = 0; i8 < 8; ++i8) { const int kt = wave + 8 * i8; if (kt < 2 * nW) {
#pragma unroll
                        for (int rt = 0; rt < 2; ++rt) { f16v acc = {};
#pragma unroll
                            for (int ks = 0; ks < 4; ++ks) acc = __builtin_amdgcn_mfma_f32_32x32x16_bf16(afr[rt][ks], bfr[i8][ks], acc, 0, 0, 0);
                            float sA = 0.f, sB = 0.f;
#pragma unroll
                            for (int i = 0; i < 8; ++i) { sA += wgt[rt][i] * fmaxf(acc[i], 0.f); sB += wgt[rt][8 + i] * fmaxf(acc[8 + i], 0.f); }
                            const int kA = __float_as_int(sA), kB = __float_as_int(sB);
                            sck[(4 * rt + 2 * hi) * 2048 + 32 * kt + r32] = kA ^ ((kA >> 31) & 0x7fffffff);
                            sck[(4 * rt + 2 * hi + 1) * 2048 + 32 * kt + r32] = kB ^ ((kB >> 31) & 0x7fffffff); }
                    } }
                    asm volatile("s_waitcnt lgkmcnt(0)" ::: "memory"); __builtin_amdgcn_s_barrier(); asm volatile("" ::: "memory");
                    { const unsigned long long myw = (nW <= 16) ? wave_select<16>(sck + wave * 2048, nW, lane) : wave_select<32>(sck + wave * 2048, nW, lane); if (lane < 32) MASK[(size_t)(tok0 + 8 * rd + wave) * 32 + lane] = myw; }
                    asm volatile("s_waitcnt lgkmcnt(0)" ::: "memory"); __builtin_amdgcn_s_barrier(); asm volatile("" ::: "memory");
                }
            }
        }
        for (int row = NTP + vcu; row < NTOK; row += G) sample_select_row(lds, row, MASKS + (size_t)(row - NTP) * 40, QI, SM, KI, cache_ik);
        GBAR();
    }
#ifdef PROBE_ATT
    if (IN(4)) { MK_ARGS;
        unsigned long long* MREF = (unsigned long long*)(args.ws + WS_END); bf16* OREF = (bf16*)(args.ws + WS_END + 2 * MiB);
        for (int pr = vcu; pr < 4096; pr += G) { const int row = pr < 2048 ? pr : 31 * SEQ + (pr - 2048); simple_select_row(lds, row, MREF + (size_t)pr * 32, QI, SM, KI, cache_ik); }
        GBAR();
        for (long t = gtid; t < 4096L * 64; t += GT) { const int dc = (int)(t & 7), h = (int)((t >> 3) & 7); const int pr = (int)(t >> 6); const int row = pr < 2048 ? pr : 31 * SEQ + (pr - 2048);
            simple_attn_task(row, h, dc, MREF + (size_t)pr * 32, QB, KBc, VBc, cache_k, cache_v, k_sample, v_sample, rel_bias, OREF + (size_t)pr * 1024 + h * 128 + dc * 16); }
        GBAR();
    }
#endif
    if (IN(4)) { MK_ARGS;
        { const int sub = lane >> 3, l8 = lane & 7;
          for (long t0 = (long)gw * 8; t0 < (long)NTOK * 4; t0 += (long)NGW * 8) { const long t = t0 + sub;
              const GAS v4u* src = (const GAS v4u*)(HA + t * 256 + l8 * 32); v4u w[4];
#pragma unroll
              for (int j = 0; j < 4; ++j) w[j] = src[j];
              float f[32];
#pragma unroll
              for (int j = 0; j < 4; ++j)
#pragma unroll
                  for (int e = 0; e < 4; ++e) { f[8 * j + 2 * e] = __uint_as_float(w[j][e] << 16); f[8 * j + 2 * e + 1] = __uint_as_float(w[j][e] & 0xffff0000u); }
              float s1 = 0.f;
#pragma unroll
              for (int e = 0; e < 32; ++e) s1 += f[e];
              s1 += __shfl_xor(s1, 1); s1 += __shfl_xor(s1, 2); s1 += __shfl_xor(s1, 4);
              const float mean = s1 * (1.0f / 256.0f); float s2 = 0.f;
#pragma unroll
              for (int e = 0; e < 32; ++e) { const float d = f[e] - mean; s2 += d * d; }
              s2 += __shfl_xor(s2, 1); s2 += __shfl_xor(s2, 2); s2 += __shfl_xor(s2, 4);
              if (l8 == 0) { HST[t * 2] = mean; HST[t * 2 + 1] = 1.0f / sqrtf(s2 * (1.0f / 256.0f) + HEAD_NORM_EPS); } } }
        {
            char* alds = (char*)lds_raw;
            for (int bh = vcu; bh < BATCH * 8; bh += G) {
                const int b = bh >> 3, h = bh & 7;
                if (tid < 320) ((float*)(alds + at2::BT_OFF))[tid] = rel_bias[t5b(tid - 256) * 8 + h] * (1.0f / at2::SCALE);
                const float cfar = __int_as_float(__builtin_amdgcn_readfirstlane(__float_as_int(rel_bias[15 * 8 + h] * (1.0f / at2::SCALE))));
                at2::Ctx C;
                C.Q = __builtin_amdgcn_make_buffer_rsrc((void*)(QB + (size_t)b * SEQ * 1024 + h * 128), (short)0, SEQ * 1024 * 2, 0x00020000);
                C.K = __builtin_amdgcn_make_buffer_rsrc((void*)(KBc + (size_t)b * SEQ * 1024 + h * 128), (short)0, SEQ * 1024 * 2, 0x00020000);
                C.V = __builtin_amdgcn_make_buffer_rsrc((void*)(VBc + (size_t)b * SEQ * 1024 + h * 128), (short)0, SEQ * 1024 * 2, 0x00020000);
                C.M = __builtin_amdgcn_make_buffer_rsrc((void*)(MASK + (size_t)b * SEQ * 32), (short)0, SEQ * 32 * 8, 0x00020000);
                C.O = C.Q;
#if (DUPMASK >> 4) & 1
                for (int dry_ = 1; dry_ >= 0; --dry_) { C.O = dry_ ? __builtin_amdgcn_make_buffer_rsrc((void*)(args.ws + WS_HA), (short)0, SEQ * 1024 * 2, 0x00020000) : C.Q;
#endif
                at2::Seam S; at2::dsa_prime(C, 0, alds, S);
                for (int u = 0; u < 8; ++u) at2::dsa_block(C, u * 256, (u < 7 ? u + 1 : u) * 256, alds, S, cfar);
#if (DUPMASK >> 4) & 1
                }
#endif
            }
        }
#ifdef PROBE_SAMP
        { unsigned long long* MREF = (unsigned long long*)(args.ws + WS_END); bf16* OREF = (bf16*)(args.ws + WS_END + 2 * MiB);
          for (int row = NTP + vcu; row < NTOK; row += G) simple_select_row(lds, row, MREF + (size_t)(row - NTP) * 40, QI, SM, KI, cache_ik);
          GBAR();
          for (long t = gtid; t < (long)NTS * 64; t += GT) { const int dc = (int)(t & 7), h = (int)((t >> 3) & 7); const int pr = (int)(t >> 6);
              simple_attn_task(NTP + pr, h, dc, MREF + (size_t)pr * 40, QB, KBc, VBc, cache_k, cache_v, k_sample, v_sample, rel_bias, OREF + (size_t)pr * 1024 + h * 128 + dc * 16); }
          GBAR(); }
#endif
        for (int pr = vcu; pr < NTS; pr += G) { const int b = pr / DEC_SEQ, r = pr % DEC_SEQ;
            sample_attn_row(lds, b, r, MASKS + (size_t)pr * 40, OB + (size_t)(NTP + pr) * 1024, cache_k, cache_v, k_sample + (size_t)b * DEC_SEQ * 1024, v_sample + (size_t)b * DEC_SEQ * 1024, rel_bias); }
        GBAR();
#ifdef PROBE_SAMP
        { const unsigned long long* MREF = (const unsigned long long*)(args.ws + WS_END); const bf16* OREF = (const bf16*)(args.ws + WS_END + 2 * MiB); float num = 0.f, den = 0.f, dif = 0.f;
          for (long t = gtid; t < (long)NTS * 1024; t += GT) { const float a = bf2f(OB[(size_t)NTP * 1024 + t]), r_ = bf2f(OREF[t]); num += (a - r_) * (a - r_); den += r_ * r_; }
          for (long t = gtid; t < (long)NTS * 33; t += GT) { const int pr = (int)(t / 33), w = (int)(t % 33); dif += (float)__builtin_popcountll(MASKS[(size_t)pr * 40 + w] ^ MREF[(size_t)pr * 40 + w]); }
          num = wave_sum(num); den = wave_sum(den); dif = wave_sum(dif);
          if (lane == 0) { atomicAdd((float*)(args.ws + WS_CTL) + 8, num); atomicAdd((float*)(args.ws + WS_CTL) + 9, den); atomicAdd((float*)(args.ws + WS_CTL) + 10, dif); }
          GBAR(); }
#endif
    }
#ifdef PROBE_ATT
    if (IN(4)) { MK_ARGS;
        const bf16* OREF = (const bf16*)(args.ws + WS_END + 2 * MiB); float num = 0.f, den = 0.f;
        for (long t = gtid; t < 4096L * 1024; t += GT) { const int pr = (int)(t >> 10), c = (int)(t & 1023); const int row = pr < 2048 ? pr : 31 * SEQ + (pr - 2048);
            const float a = bf2f(OB[(size_t)row * 1024 + c]), r = bf2f(OREF[t]); num += (a - r) * (a - r); den += r * r; }
        num = wave_sum(num); den = wave_sum(den);
        if (lane == 0) { atomicAdd((float*)(args.ws + WS_CTL) + 8, num); atomicAdd((float*)(args.ws + WS_CTL) + 9, den); }
        GBAR();
    }
#endif
    if (IN(5))
#if (DUPMASK >> 5) & 1
    for (int rep_ = 0; rep_ < 2; ++rep_)
#endif
    { MK_ARGS;
        pg8::Gemm g{XB, WMRG, NTOK, N_M1A + N_M1B, 1024}; pg8::StaticOrder S; S.init(NTOK, N_M1A + N_M1B, G, (int)blockIdx.x);
        pg8::EpiM1 E{pg8::EpiM1a{HA, OB, HST, a_norm_g, BR}, pg8::EpiM1b{SGA, SGB}};
        pg8::gemm_phase<pg8::EpiM1, pg8::StaticOrder, true, true>(lds + RING_OFF, g, S, E);
        GBAR();
    }
    if (IN(7))
#if (DUPMASK >> 7) & 1
    for (int rep_ = 0; rep_ < 2; ++rep_)
#endif
    { MK_ARGS;
        pg8::Gemm g{BR, WAB, NTOK, 1024, 2048}; pg8::StaticOrder S; S.init(NTOK, 1024, G, (int)blockIdx.x);
        pg8::EpiM2 E{SGA, SGB, MX};
        pg8::gemm_phase<pg8::EpiM2, pg8::StaticOrder, true, true>(lds + RING_OFF, g, S, E);
        GBAR();
    }
    if (IN(8))
#if (DUPMASK >> 8) & 1
    for (int rep_ = 0; rep_ < 2; ++rep_)
#endif
    { MK_ARGS;
        pg8::Gemm g{MX, WO, NTOK, 1024, 1024}; pg8::StaticOrder S; S.init(NTOK, 1024, G, (int)blockIdx.x);
        pg8::EpiM3 E{args.in[0], args.in[1], y_prompt, y_sample};
        pg8::gemm_phase<pg8::EpiM3, pg8::StaticOrder, true, true>(lds + RING_OFF, g, S, E);
        GBAR();
    }
    if (IN(9))
#if (DUPMASK >> 9) & 1
    for (int rep_ = 0; rep_ < 2; ++rep_)
#endif
    { MK_ARGS;
        for (int m0 = gw * 2; m0 < NTOK; m0 += NGW * 2) {
            GAS f32x4* yv[2]; f32x4 v[2][4]; float sm_[2] = {0.f, 0.f};
#pragma unroll
            for (int q = 0; q < 2; ++q) { const int m = m0 + q; float* yr = m < NTP ? y_prompt + (size_t)m * 1024 : y_sample + (size_t)(m - NTP) * 1024; yv[q] = (GAS f32x4*)yr + lane;
#pragma unroll
                for (int j = 0; j < 4; ++j) v[q][j] = yv[q][64 * j]; }
#pragma unroll
            for (int q = 0; q < 2; ++q) {
#pragma unroll
                for (int j = 0; j < 4; ++j) sm_[q] += (v[q][j].x + v[q][j].y) + (v[q][j].z + v[q][j].w);
                const float mean = wave_sum(sm_[q]) * (1.f / 1024.f); float s2 = 0.f;
#pragma unroll
                for (int j = 0; j < 4; ++j) { v[q][j] = v[q][j] - mean; s2 += (v[q][j].x * v[q][j].x + v[q][j].y * v[q][j].y) + (v[q][j].z * v[q][j].z + v[q][j].w * v[q][j].w); }
                const float rstd = 1.f / sqrtf(wave_sum(s2) * (1.f / 1024.f) + LN_EPS);
#pragma unroll
                for (int j = 0; j < 4; ++j) { const f32x4 gg = *((const GAS f32x4*)ln_g + lane + 64 * j), bb = *((const GAS f32x4*)ln_b + lane + 64 * j); yv[q][64 * j] = v[q][j] * rstd * gg + bb; } }
        }
    }
#if defined(PROBE_ATT) || defined(PROBE_ML) || defined(PROBE_SAMP)
    { MK_ARGS; GBAR();
      if (blockIdx.x == 0 && threadIdx.x < 64) { const float num = ((volatile float*)(args.ws + WS_CTL))[8], den = ((volatile float*)(args.ws + WS_CTL))[9];
          const float dif = ((volatile float*)(args.ws + WS_CTL))[10];
          m_sample[threadIdx.x] *= 1.0f + 30.0f * (sqrtf(num / den) + dif / (float)(NTS * TOPK_MAX)); } }
#endif
#undef IN
#undef GBAR
#undef args
#undef gtid
#undef GT
#undef gw
#undef NGW
#undef tid
#undef lane
#undef wave
#undef G
#undef vcu
}

extern "C" void kernel_launch(void* const* d_in, const int* in_sizes, int n_in, void* d_out, int out_size, void* d_ws, size_t ws_size, hipStream_t stream) {
    static int grid = 0;
    if (grid == 0) {
        int dev = 0, cus = 0;
        if (hipGetDevice(&dev) != hipSuccess || hipDeviceGetAttribute(&cus, hipDeviceAttributeMultiprocessorCount, dev) != hipSuccess) { grid = -1; return; }
        if (hipFuncSetAttribute((const void*)mk_fwd, hipFuncAttributeMaxDynamicSharedMemorySize, LDS_BYTES) != hipSuccess) { grid = -1; return; }
        (void)hipGetLastError();
        if (n_in != 17 || ws_size < WS_END) { fprintf(stderr, "kernel_launch: needs 17 inputs and %zu bytes of workspace (got %d, %zu)\n", (size_t)WS_END, n_in, ws_size); grid = -1; return; }
        grid = cus;
    }
    if (grid < 0) return;
    if (hipMemsetAsync((unsigned char*)d_ws + WS_CTL, 0, CTL_ZERO_BYTES, stream) != hipSuccess) return;
    Args a{};
    for (int i = 0; i < 17; ++i) a.in[i] = (const float*)d_in[i];
    a.out = (float*)d_out; a.ws = (unsigned char*)d_ws; a.ph_lo = 0; a.ph_hi = 10;
    hipLaunchKernelGGL(mk_fwd, dim3(grid), dim3(NWAVES * 64), LDS_BYTES, stream, a);
}
```

```cpp
#include <hip/hip_runtime.h>
#include <cstdio>
#include <cstdint>
#include <math.h>
#ifndef D_MODEL
#define D_MODEL 1024
#define BATCH 32
#define SEQ 2048
#define DEC_BATCH 16
#define DEC_SEQ 32
#define PAST_LEN 2048
#define CHUNK 64
#define A_HEADS 4
#define A_HEAD_DIM 256
#define B_HEADS 8
#define B_HEAD_DIM 128
#define IDX_HEADS 8
#define IDX_DIM 64
#define TOPK_MAX 256
#define GROUP_B 4
#endif
#define A_WIDTH (A_HEADS * A_HEAD_DIM)
#define B_WIDTH (B_HEADS * B_HEAD_DIM)
#define C_QA 0
#define C_KA (C_QA + A_WIDTH)
#define C_VA (C_KA + A_WIDTH)
#define C_OA (C_VA + A_WIDTH)
#define C_ZA (C_OA + A_WIDTH)
#define C_IA (C_ZA + A_WIDTH)
#define C_FA (C_IA + A_HEADS)
#define C_QB (C_FA + A_HEADS)
#define C_KB (C_QB + B_WIDTH)
#define C_VB (C_KB + B_WIDTH)
#define C_ZB (C_VB + B_WIDTH)
#define C_QI (C_ZB + B_WIDTH)
#define C_KI (C_QI + IDX_HEADS * IDX_DIM)
#define C_WI (C_KI + IDX_DIM)
#define C_GA (C_WI + IDX_HEADS)
#define C_GB (C_GA + D_MODEL)
#define IN_COLS (C_GB + D_MODEL)
#define LN_EPS 1e-5f
#define HEAD_NORM_EPS 1e-6f
#define DN_ALPHA 1.189207115002721f


#define GAS __attribute__((address_space(1)))
#define LAS __attribute__((address_space(3)))
typedef unsigned short bf16;
typedef unsigned v4u __attribute__((ext_vector_type(4)));
typedef float f32x4 __attribute__((ext_vector_type(4)));
typedef short bf16x8 __attribute__((ext_vector_type(8)));
typedef GAS unsigned gu32;
typedef GAS unsigned long long gu64;
#define RLX_AGENT __ATOMIC_RELAXED, __HIP_MEMORY_SCOPE_AGENT
#define LDS_WAIT() asm volatile("s_waitcnt lgkmcnt(0)" ::: "memory")
#define VM_WAIT() asm volatile("s_waitcnt vmcnt(0)" ::: "memory")
__device__ __forceinline__ unsigned long long rt() { return __builtin_amdgcn_s_memrealtime(); }
__device__ __forceinline__ unsigned f2bf(float f) { unsigned u = __builtin_bit_cast(unsigned, f); return (u + 0x7fffu + ((u >> 16) & 1u)) >> 16; }
__device__ __forceinline__ unsigned pk2(float lo, float hi) { return f2bf(lo) | (f2bf(hi) << 16); }

#define XB_TMO      128
#define XB_XCNT(j)  (256  + 64 * (j))
#define XB_XSUB(j)  (1280 + 64 * (j))
#define XB_XGEN(j)  (2304 + 64 * (j))
#define XB_TOP      3328
#define XB_TOPGEN   3392
#define XCD_BAR_WORDS 3456
#define XB_SPIN_CAP (1u << 18)

__device__ __forceinline__ unsigned xb_ld(unsigned* p)              { return __hip_atomic_load(p, __ATOMIC_RELAXED, __HIP_MEMORY_SCOPE_AGENT); }
__device__ __forceinline__ unsigned xb_add(unsigned* p, unsigned v) { return __hip_atomic_fetch_add(p, v, __ATOMIC_RELAXED, __HIP_MEMORY_SCOPE_AGENT); }
__device__ __forceinline__ unsigned xb_xcc_id() { return (unsigned)__builtin_amdgcn_s_getreg((3 << 11) | 20) & 0xFu; }
#define XB_SPIN(cond, bar) do { unsigned _sp = 0; while (cond) { __builtin_amdgcn_s_sleep(1); \
    if ((++_sp & 255u) == 0u) { if (xb_ld(&(bar)[XB_TMO])) break; if (_sp > XB_SPIN_CAP) { atomicAdd(&(bar)[XB_TMO], 1u); break; } } } } while (0)

struct XcdBarrier {
    unsigned* bar; unsigned x;
    volatile LAS unsigned* st;
};

__device__ __forceinline__ XcdBarrier xcd_barrier_post(unsigned* bar, volatile LAS unsigned* st) {
    XcdBarrier b; b.bar = bar; b.x = xb_xcc_id(); b.st = st;
    if (threadIdx.x == 0) (void)xb_add(&bar[XB_XCNT(b.x)], 1u);
    return b;
}
__device__ __forceinline__ void xcd_barrier_complete(unsigned* bar, unsigned x, unsigned& nloc, unsigned& nx) {
    const unsigned G = gridDim.x * gridDim.y * gridDim.z;
    unsigned sum, cnt, mine, sp = 0u;
    for (;;) {
        sum = 0u; cnt = 0u; mine = 0u;
#pragma unroll
        for (unsigned j = 0; j < 16; ++j) { const unsigned c = xb_ld(&bar[XB_XCNT(j)]); sum += c; cnt += (c > 0u) ? 1u : 0u; mine = (j == x) ? c : mine; }
        if (sum == G) break;
        __builtin_amdgcn_s_sleep(1);
        if ((++sp & 255u) == 0u) { if (xb_ld(&bar[XB_TMO])) break; if (sp > XB_SPIN_CAP) { atomicAdd(&bar[XB_TMO], 1u); break; } }
    }
    nloc = mine > 0u ? mine : 1u; nx = cnt > 0u ? cnt : 1u;
}

__device__ __forceinline__ void xcd_barrier(const XcdBarrier& b) {
    asm volatile("s_waitcnt vmcnt(0)" ::: "memory");
    __syncthreads();
    if (threadIdx.x == 0) {
        unsigned* bar = b.bar;
        __builtin_amdgcn_s_waitcnt(0);
        unsigned nloc = b.st[0], nx = b.st[1];
        if (nloc == 0u) { xcd_barrier_complete(bar, b.x, nloc, nx); b.st[0] = nloc; b.st[1] = nx; }
        const unsigned old = xb_add(&bar[XB_XSUB(b.x)], 1u);
        const unsigned gen = old / nloc;
        if (old + 1u == (gen + 1u) * nloc) {
            __builtin_amdgcn_fence(__ATOMIC_RELEASE, "agent");
            asm volatile("s_waitcnt vmcnt(0)" ::: "memory");
            const unsigned og = xb_add(&bar[XB_TOP], 1u);
            const unsigned tg = og / nx;
            if (og + 1u == (tg + 1u) * nx) xb_add(&bar[XB_TOPGEN], 1u);
            else XB_SPIN(xb_ld(&bar[XB_TOPGEN]) == tg, bar);
            __builtin_amdgcn_fence(__ATOMIC_ACQUIRE, "agent");
            xb_add(&bar[XB_XGEN(b.x)], 1u);
            asm volatile("s_waitcnt vmcnt(0)" ::: "memory");
        } else {
            XB_SPIN(xb_ld(&bar[XB_XGEN(b.x)]) == gen, bar);
            __builtin_amdgcn_fence(__ATOMIC_ACQUIRE, "agent");
            asm volatile("s_waitcnt vmcnt(0)" ::: "memory");
        }
    }
    __syncthreads();
}

namespace pg8 {
#define PG8_LAS __attribute__((address_space(3)))
typedef unsigned short bf16_t;
typedef short bf16x8 __attribute__((ext_vector_type(8)));
typedef float f32x4 __attribute__((ext_vector_type(4)));
typedef unsigned u32x4 __attribute__((ext_vector_type(4)));
constexpr int BM = 256, BK = 64, HALF = 128, HTB = HALF * BK * 2  , STAGE_BYTES = 8 * HTB, NXCD = 8, WGM = 8;

__host__ __device__ __forceinline__ int lds_byte(int r, int c) { const int st = (r >> 4) * 2 + (c >> 5), rr = r & 15, cc = c & 31, ob = rr * 64 + cc * 2; return st * 1024 + (ob ^ (((ob >> 9) & 1) << 5)); }
__host__ __device__ __forceinline__ void stage_rc(int b, int& R, int& C) { const int st = b / 1024, sb = b % 1024, swz = sb ^ (((sb >> 9) & 1) << 5); R = (st >> 1) * 16 + swz / 64; C = (st & 1) * 32 + (swz % 64) / 2; }
__host__ __device__ __forceinline__ int perm32(int rho) { const int n = rho >> 4, i = rho & 15; return 8 * (i >> 2) + 4 * n + (i & 3); }

struct Unit { int pm, pn; };
struct Gemm { const bf16_t* A; const bf16_t* Bt; int M, N, K; };

struct StaticOrder {
    int nM, nN, nwg, G, c;
    __host__ __device__ void init(int M, int N, int G_, int c_) { nM = M / BM; nN = N / BM; nwg = nM * nN; G = G_; c = c_; }
    __host__ __device__ bool next(int i, Unit& u) const {
        const long L = (long)i * G + c; if (L >= nwg) return false;
        int wgid = (int)L; { const int q = nwg / NXCD, r = nwg % NXCD, xcd = wgid % NXCD, off = wgid / NXCD; wgid = (xcd < r ? xcd * (q + 1) : r * (q + 1) + (xcd - r) * q) + off; }
        const int nig = WGM * nN, gid = wgid / nig, fm = gid * WGM, gsz = (nM - fm) < WGM ? (nM - fm) : WGM;
        u.pm = fm + ((wgid % nig) % gsz); u.pn = (wgid % nig) / gsz; return true;
    }
    __device__ __forceinline__ void a_ready(const Unit&) const {}
    __device__ __forceinline__ void done(const Unit&) const {}
};
__device__ __forceinline__ unsigned cvt_pk_bf16(float lo, float hi) { unsigned r; asm volatile("v_cvt_pk_bf16_f32 %0, %1, %2" : "=v"(r) : "v"(lo), "v"(hi)); return r; }
typedef float f32x2 __attribute__((ext_vector_type(2)));
template <class Epi, class Sched, bool ALIGN_EPI = false, bool SP2 = false>
__device__ __forceinline__ void gemm_phase(PG8_LAS unsigned char* lds, const Gemm g, const Sched& S, const Epi& E) {
    const int tid = threadIdx.x, wid = __builtin_amdgcn_readfirstlane(tid >> 6), lane = tid & 63, wr = wid >> 2, wc = wid & 3, fr = lane & 15, fq = lane >> 4;
    const int K = g.K, nt = K / BK;
    unsigned voffA[2], voffB[2];
#pragma unroll
    for (int i = 0; i < 2; ++i) { int R, C; stage_rc(tid * 16 + i * 8192, R, C); const int Rb = Epi::PERM ? ((R & ~31) + perm32(R & 31)) : R;
        voffA[i] = (unsigned)(R * K + C) * 2u; voffB[i] = (unsigned)(Rb * K + C) * 2u; }
    const size_t kstep = (size_t)(BK * 2);
    const size_t hstep = (size_t)HALF * K * 2;
    const size_t tstep = 2 * hstep;
    const unsigned ldsw = (unsigned)wid * 1024u;
    const int aoff = lds_byte(wr * 64 + fr, fq * 8), boff = lds_byte(wc * 32 + fr, fq * 8);
#define PG8_SA(b, h) (((b) * 2 + (h)) * HTB)
#define PG8_SB(b, h) ((4 + (b) * 2 + (h)) * HTB)
#define PG8_STAGE(bufoff, gbase, voff) do { _Pragma("unroll") for (int _i = 0; _i < 2; ++_i) \
        __builtin_amdgcn_global_load_lds((const unsigned*)((const char*)(gbase) + (voff)[_i]), (PG8_LAS unsigned*)(lds + (bufoff) + ldsw + _i * 8192), 16, 0, 0); } while (0)
#define PG8_LDA(dst, b, h) do { _Pragma("unroll") for (int m = 0; m < 4; ++m) _Pragma("unroll") for (int k = 0; k < 2; ++k) dst[m][k] = *(const PG8_LAS bf16x8*)(lds + PG8_SA(b, h) + aoff + m * 2048 + k * 1024); } while (0)
#define PG8_LDB(dst, b, h) do { _Pragma("unroll") for (int n = 0; n < 2; ++n) _Pragma("unroll") for (int k = 0; k < 2; ++k) dst[n][k] = *(const PG8_LAS bf16x8*)(lds + PG8_SB(b, h) + boff + n * 2048 + k * 1024); } while (0)
#define PG8_MMA(ai, bj, At, Bt) do { __builtin_amdgcn_s_setprio(1); _Pragma("unroll") for (int m = 0; m < 4; ++m) _Pragma("unroll") for (int n = 0; n < 2; ++n) _Pragma("unroll") for (int k = 0; k < 2; ++k) \
        acc[ai][bj][m][n] = __builtin_amdgcn_mfma_f32_16x16x32_bf16(Bt[n][k], At[m][k], acc[ai][bj][m][n], 0, 0, 0); __builtin_amdgcn_s_setprio(0); } while (0)
#define PG8_WAIT_V(n) asm volatile("s_waitcnt vmcnt(" #n ")" ::: "memory")
#define PG8_WAIT_L(n) asm volatile("s_waitcnt lgkmcnt(" #n ")" ::: "memory")
#define PG8_BAR __builtin_amdgcn_s_barrier()
#define PG8_SCHED __builtin_amdgcn_sched_barrier(0)
    Unit cur, nxt; int ui = 0;
    if (!S.next(0, cur)) return;
    f32x4 acc[2][2][4][2];
#pragma unroll
    for (int a = 0; a < 2; ++a)
#pragma unroll
        for (int b = 0; b < 2; ++b)
#pragma unroll
            for (int m = 0; m < 4; ++m)
#pragma unroll
                for (int n = 0; n < 2; ++n) acc[a][b][m][n] = (f32x4){0.f, 0.f, 0.f, 0.f};
    bf16x8 At[4][2], B0[2][2], B1[2][2];
    const char* cA = (const char*)g.A + (size_t)cur.pm * tstep; const char* cB = (const char*)g.Bt + (size_t)cur.pn * tstep;
    S.a_ready(cur);
    if constexpr (SP2) {
        PG8_STAGE(PG8_SB(0, 0), cB, voffB); PG8_STAGE(PG8_SB(0, 1), cB + hstep, voffB); PG8_STAGE(PG8_SA(0, 0), cA, voffA); PG8_STAGE(PG8_SA(0, 1), cA + hstep, voffA);
        if (wr == 1) PG8_BAR;
        PG8_WAIT_V(2); PG8_BAR;
        PG8_STAGE(PG8_SB(1, 0), cB + kstep, voffB); PG8_STAGE(PG8_SA(1, 0), cA + kstep, voffA); PG8_STAGE(PG8_SB(1, 1), cB + hstep + kstep, voffB);
        PG8_WAIT_V(6); PG8_BAR;
    } else {
        PG8_STAGE(PG8_SB(0, 0), cB, voffB); PG8_STAGE(PG8_SA(0, 0), cA, voffA); PG8_STAGE(PG8_SB(0, 1), cB + hstep, voffB); PG8_STAGE(PG8_SA(0, 1), cA + hstep, voffA);
        if (wr == 1) PG8_BAR;
        PG8_WAIT_V(4); PG8_BAR;
        PG8_STAGE(PG8_SB(1, 0), cB + kstep, voffB); PG8_STAGE(PG8_SA(1, 0), cA + kstep, voffA); PG8_STAGE(PG8_SB(1, 1), cB + hstep + kstep, voffB);
        PG8_WAIT_V(6); PG8_BAR;
    }
    for (;;) {
        const bool has_next = S.next(ui + 1, nxt);
        const char* nA = has_next ? (const char*)g.A + (size_t)nxt.pm * tstep : cA; const char* nB = has_next ? (const char*)g.Bt + (size_t)nxt.pn * tstep : cB;
        for (int t = 0; t < nt; t += 2) {
            const bool last = (t == nt - 2);
            const char* a1 = cA + (size_t)(t + 1) * kstep;
            const char* a2 = last ? nA : cA + (size_t)(t + 2) * kstep; const char* b2 = last ? nB : cB + (size_t)(t + 2) * kstep;
            const char* a3 = a2 + kstep; const char* b3 = b2 + kstep;
            if (last && has_next) S.a_ready(nxt);
            if constexpr (Epi::MIDK) { if (t == nt / 2) E.mid(acc, cur, wr, wc, fr, fq); }
            if constexpr (SP2) {
            PG8_LDB(B0, 0, 0); PG8_LDB(B1, 0, 1); PG8_SCHED; PG8_LDA(At, 0, 0); PG8_STAGE(PG8_SA(1, 1), a1 + hstep, voffA);
            PG8_WAIT_V(8); PG8_WAIT_L(0); PG8_BAR; PG8_MMA(0, 0, At, B0); PG8_MMA(0, 1, At, B1); PG8_BAR; PG8_SCHED;
            PG8_LDA(At, 0, 1); PG8_STAGE(PG8_SB(0, 0), b2, voffB); PG8_STAGE(PG8_SB(0, 1), b2 + hstep, voffB); PG8_STAGE(PG8_SA(0, 0), a2, voffA);
            PG8_WAIT_V(8); PG8_WAIT_L(0); PG8_BAR; PG8_MMA(1, 0, At, B0); PG8_MMA(1, 1, At, B1); PG8_BAR; PG8_SCHED;
            PG8_LDB(B0, 1, 0); PG8_LDB(B1, 1, 1); PG8_SCHED; PG8_LDA(At, 1, 0); PG8_STAGE(PG8_SA(0, 1), a2 + hstep, voffA);
            PG8_WAIT_V(8); PG8_WAIT_L(0); PG8_BAR; PG8_MMA(0, 0, At, B0); PG8_MMA(0, 1, At, B1); PG8_BAR; PG8_SCHED;
            PG8_LDA(At, 1, 1); PG8_STAGE(PG8_SB(1, 0), b3, voffB); PG8_STAGE(PG8_SB(1, 1), b3 + hstep, voffB); PG8_STAGE(PG8_SA(1, 0), a3, voffA);
            PG8_WAIT_V(8); PG8_WAIT_L(0); PG8_BAR; PG8_MMA(1, 0, At, B0); PG8_MMA(1, 1, At, B1); PG8_BAR; PG8_SCHED;
            } else {
            PG8_LDB(B0, 0, 0); PG8_SCHED; PG8_LDA(At, 0, 0); PG8_STAGE(PG8_SA(1, 1), a1 + hstep, voffA);
            PG8_WAIT_L(8); PG8_BAR; PG8_WAIT_L(0); PG8_MMA(0, 0, At, B0); PG8_BAR; PG8_SCHED;
            PG8_LDB(B1, 0, 1); PG8_STAGE(PG8_SB(0, 0), b2, voffB);
            PG8_BAR; PG8_WAIT_L(0); PG8_MMA(0, 1, At, B1); PG8_BAR;
            PG8_LDA(At, 0, 1); PG8_STAGE(PG8_SA(0, 0), a2, voffA);
            PG8_BAR; PG8_WAIT_L(0); PG8_MMA(1, 0, At, B0); PG8_BAR; PG8_SCHED;
            PG8_STAGE(PG8_SB(0, 1), b2 + hstep, voffB);
            PG8_WAIT_V(6); PG8_BAR; PG8_MMA(1, 1, At, B1); PG8_BAR;
            PG8_LDB(B0, 1, 0); PG8_SCHED; PG8_LDA(At, 1, 0); PG8_STAGE(PG8_SA(0, 1), a2 + hstep, voffA);
            PG8_WAIT_L(8); PG8_BAR; PG8_WAIT_L(0); PG8_MMA(0, 0, At, B0); PG8_BAR; PG8_SCHED;
            PG8_LDB(B1, 1, 1); PG8_STAGE(PG8_SB(1, 0), b3, voffB);
            PG8_BAR; PG8_WAIT_L(0); PG8_MMA(0, 1, At, B1); PG8_BAR;
            PG8_LDA(At, 1, 1); PG8_STAGE(PG8_SA(1, 0), a3, voffA);
            PG8_BAR; PG8_WAIT_L(0); PG8_MMA(1, 0, At, B0); PG8_BAR; PG8_SCHED;
            PG8_STAGE(PG8_SB(1, 1), b3 + hstep, voffB);
            PG8_WAIT_V(6); PG8_BAR; PG8_MMA(1, 1, At, B1); PG8_BAR;
            }
        }
        if constexpr (ALIGN_EPI) { if (wr == 0) PG8_BAR; }
        if constexpr (!Epi::AFTER_DRAIN) { E(acc, cur, wr, wc, fr, fq); S.done(cur); }
        if (!has_next) break;
#pragma unroll
        for (int a = 0; a < 2; ++a)
#pragma unroll
            for (int b = 0; b < 2; ++b)
#pragma unroll
                for (int m = 0; m < 4; ++m)
#pragma unroll
                    for (int n = 0; n < 2; ++n) acc[a][b][m][n] = (f32x4){0.f, 0.f, 0.f, 0.f};
        cur = nxt; cA = nA; cB = nB; ++ui;
        if constexpr (ALIGN_EPI) { if (wr == 1) PG8_BAR; }
    }
    PG8_WAIT_V(0);
    if constexpr (!ALIGN_EPI) { if (wr == 0) PG8_BAR; }
    PG8_BAR;
    if constexpr (Epi::AFTER_DRAIN) { E.fused(acc, cur, wr, wc, fr, fq, lds, wid, lane); S.done(cur); }
#undef PG8_SA
#undef PG8_SB
#undef PG8_STAGE
#undef PG8_LDA
#undef PG8_LDB
#undef PG8_MMA
#undef PG8_WAIT_V
#undef PG8_WAIT_L
#undef PG8_BAR
#undef PG8_SCHED
}
}

namespace at2 {
constexpr float SCALE = 0.08838834764831845f;
constexpr float THR = 8.f;
constexpr int NW = 8, QBLK = 32, KVBLK = 64, QB = NW * QBLK, D = 128, PITCH = 1024;
constexpr int SHM_V = KVBLK * D * 2, SHM_K = KVBLK * D * 2;
constexpr int BT_OFF = 2 * SHM_V + 2 * SHM_K + NW * 64 * 4;
constexpr int LDS_BYTES = BT_OFF + 320 * 4;
typedef short bf16x8 __attribute__((ext_vector_type(8)));
typedef short s16x4 __attribute__((ext_vector_type(4)));
typedef float f32x16 __attribute__((ext_vector_type(16)));
typedef float f32x4 __attribute__((ext_vector_type(4)));
typedef unsigned u32x4 __attribute__((ext_vector_type(4)));
typedef unsigned short bf16;

#define KSWZ(row, colB) ((row) * 256 + ((colB) ^ (((row) & 7) << 4)))
#define SBAR() __builtin_amdgcn_sched_barrier(0)
__device__ __forceinline__ int v_st(int k, int c) { const int kk = (k & ~0xC) | ((k & 4) << 1) | ((k & 8) >> 1); return ((kk >> 3) * 4 + (c >> 5)) * 512 + ((kk & 7) * 32 + (c & 31)) * 2; }
__device__ __forceinline__ int v_rd_base(int lane) { return ((lane & 3) << 3) | (((lane >> 2) & 3) << 6) | (((lane >> 4) & 1) << 5) | (((lane >> 5) & 1) << 8); }
constexpr int v_rd_off(int d0, int ks, int half) { return d0 * 512 + ks * 4096 + half * 2048; }
__device__ __forceinline__ int crow(int r, int hi) { return (r & 3) + 8 * (r >> 2) + 4 * hi; }
__device__ __forceinline__ unsigned cvtpk(float lo, float hi) { unsigned r; asm volatile("v_cvt_pk_bf16_f32 %0, %1, %2" : "=v"(r) : "v"(lo), "v"(hi)); return r; }
__device__ __forceinline__ bf16x8 load8(const bf16* p) { return *reinterpret_cast<const bf16x8*>(p); }

typedef __attribute__((address_space(3))) const float* lds_cf32;
__device__ __forceinline__ unsigned mask_compact(unsigned long long mw, int hi) { return ((unsigned)(mw >> (4 * hi)) & 0x0f0f0f0fu) | (((unsigned)(mw >> (32 + 4 * hi)) & 0x0f0f0f0fu) << 4); }
__device__ __forceinline__ void mask_bias(f32x16& p0, f32x16& p1, unsigned mwc, lds_cf32 bt, int idx0, bool far, float cfar, int hi) {
    const float NEG = -__builtin_inff();
    const unsigned w0 = mwc, w1 = mwc >> 4;
    if (far) {
#pragma unroll
        for (int r = 0; r < 16; ++r) { const int c = (r & 3) + 8 * (r >> 2);
            p0[r] = ((w0 >> c) & 1u) ? p0[r] + cfar : NEG; p1[r] = ((w1 >> c) & 1u) ? p1[r] + cfar : NEG; }
    } else { lds_cf32 b = bt + idx0;
#pragma unroll
        for (int r = 0; r < 16; ++r) { const int c = (r & 3) + 8 * (r >> 2);
            p0[r] = ((w0 >> c) & 1u) ? p0[r] + b[c] : NEG; p1[r] = ((w1 >> c) & 1u) ? p1[r] + b[c + 32] : NEG;
            if ((r & 3) == 3) asm volatile("" ::: "memory"); }
    }
}
__device__ __forceinline__ void partialSM(f32x16& p0, f32x16& p1, float& m_reg, float& mn, float& alpha) {
    float pmax = p0[0]; for (int r = 1; r < 16; ++r) pmax = fmaxf(pmax, p0[r]); for (int r = 0; r < 16; ++r) pmax = fmaxf(pmax, p1[r]);
    { auto rr = __builtin_amdgcn_permlane32_swap(__float_as_uint(pmax), __float_as_uint(pmax), false, false);
      pmax = fmaxf(__uint_as_float(rr[0]), __uint_as_float(rr[1])); }
    constexpr float C2 = 1.4426950408889634f * SCALE;
    if (__builtin_expect(__all((pmax - m_reg) * SCALE <= THR), 1)) { mn = m_reg; alpha = 1.f; }
    else { mn = fmaxf(m_reg, pmax); alpha = __builtin_amdgcn_exp2f((m_reg - mn) * C2); m_reg = mn; }
    const float mnL = -mn * C2;
    for (int r = 0; r < 16; ++r) p0[r] = fmaf(p0[r], C2, mnL); for (int r = 0; r < 16; ++r) p1[r] = fmaf(p1[r], C2, mnL);
    for (int r = 0; r < 16; ++r) p0[r] = __builtin_amdgcn_exp2f(p0[r]);
}
__device__ __forceinline__ void finishSM(f32x16& p0, f32x16& p1, float alpha, float& l_reg, bf16x8& pa0, bf16x8& pa1, bf16x8& pa2, bf16x8& pa3) {
    for (int r = 0; r < 16; ++r) p1[r] = __builtin_amdgcn_exp2f(p1[r]);
    float ps = 0; for (int r = 0; r < 16; ++r) ps += p0[r]; for (int r = 0; r < 16; ++r) ps += p1[r];
    { auto rr = __builtin_amdgcn_permlane32_swap(__float_as_uint(ps), __float_as_uint(ps), false, false);
      ps = __uint_as_float(rr[0]) + __uint_as_float(rr[1]); }
    l_reg = l_reg * alpha + ps;
#define PK4(P, B_, OUT) do { unsigned a0 = cvtpk(P[B_+0], P[B_+1]), a1 = cvtpk(P[B_+2], P[B_+3]);                          \
        unsigned b0 = cvtpk(P[B_+4], P[B_+5]), b1 = cvtpk(P[B_+6], P[B_+7]);                                             \
        auto r0 = __builtin_amdgcn_permlane32_swap(a0, b0, false, false); auto r1 = __builtin_amdgcn_permlane32_swap(a1, b1, false, false); \
        u32x4 w = {r0[0], r1[0], r0[1], r1[1]}; OUT = *reinterpret_cast<bf16x8*>(&w); } while (0)
    PK4(p0, 0, pa0); PK4(p0, 8, pa1); PK4(p1, 0, pa2); PK4(p1, 8, pa3);
#undef PK4
}
template <int KB, bool SK>
__device__ __forceinline__ void qkt(f32x16& p0, f32x16& p1, const char* K_lds, int r32, int hi, const bf16x8* qr, bool act) {
    if (SK && !act) { const float NEG = -__builtin_inff();
#pragma unroll
        for (int r = 0; r < 16; ++r) { p0[r] = NEG; p1[r] = NEG; } return; }
    p0 = f32x16{}; p1 = f32x16{};
    int r32_ = r32, hi_ = hi; asm volatile("" : "+v"(r32_), "+v"(hi_));
    const char* kb[4];
#pragma unroll
    for (int dd = 0; dd < 4; ++dd) kb[dd] = K_lds + KB * SHM_K + KSWZ(r32_, (dd * 16 + hi_ * 8) * 2);
#pragma unroll
    for (int d0 = 0; d0 < 8; ++d0) { const char* a = kb[d0 & 3] + (d0 >> 2) * 128;
        bf16x8 b0 = *reinterpret_cast<const bf16x8*>(a);
        bf16x8 b1 = *reinterpret_cast<const bf16x8*>(a + 32 * 256);
        p0 = __builtin_amdgcn_mfma_f32_32x32x16_bf16(b0, qr[d0], p0, 0, 0, 0);
        p1 = __builtin_amdgcn_mfma_f32_32x32x16_bf16(b1, qr[d0], p1, 0, 0, 0); }
}
template <int VB, bool SK>
__device__ __forceinline__ void pv_tile(f32x16* o, int vb0, bf16x8 pa0, bf16x8 pa1, bf16x8 pa2, bf16x8 pa3, bool act) {
    if (SK && !act) return;
#define TRRD(dst, off) asm volatile("ds_read_b64_tr_b16 %0, %1 offset:%2" : "=&v"(dst) : "v"(vb0), "i"(off) : "memory")
#define PV_D0(d0) do { s16x4 l0, l1, l2, l3, h0, h1, h2, h3; constexpr int b_ = VB * SHM_V + v_rd_off(d0, 0, 0); \
        TRRD(l0, b_); TRRD(h0, b_ + 2048); TRRD(l1, b_ + 4096); TRRD(h1, b_ + 6144); TRRD(l2, b_ + 8192); TRRD(h2, b_ + 10240); TRRD(l3, b_ + 12288); TRRD(h3, b_ + 14336); \
        asm volatile("s_waitcnt lgkmcnt(0)" ::: "memory"); SBAR();   \
        o[d0] = __builtin_amdgcn_mfma_f32_32x32x16_bf16(pa0, (bf16x8){l0[0], l0[1], l0[2], l0[3], h0[0], h0[1], h0[2], h0[3]}, o[d0], 0, 0, 0);   \
        o[d0] = __builtin_amdgcn_mfma_f32_32x32x16_bf16(pa1, (bf16x8){l1[0], l1[1], l1[2], l1[3], h1[0], h1[1], h1[2], h1[3]}, o[d0], 0, 0, 0);   \
        o[d0] = __builtin_amdgcn_mfma_f32_32x32x16_bf16(pa2, (bf16x8){l2[0], l2[1], l2[2], l2[3], h2[0], h2[1], h2[2], h2[3]}, o[d0], 0, 0, 0);   \
        o[d0] = __builtin_amdgcn_mfma_f32_32x32x16_bf16(pa3, (bf16x8){l3[0], l3[1], l3[2], l3[3], h3[0], h3[1], h3[2], h3[3]}, o[d0], 0, 0, 0); } while (0)
    PV_D0(0); PV_D0(1); PV_D0(2); PV_D0(3);
#undef PV_D0
#undef TRRD
}

struct Ctx { __amdgpu_buffer_rsrc_t Q, K, V, M, O; };
typedef unsigned v4u32 __attribute__((ext_vector_type(4))); typedef unsigned v2u32 __attribute__((ext_vector_type(2)));
#define LD16(rs, vo, so) __builtin_bit_cast(bf16x8, __builtin_amdgcn_raw_buffer_load_b128((rs), (int)(vo), (int)(so), 0))
struct Seam { bf16x8 qr[8]; bf16x8 st_v0, st_v1, st_k0, st_k1; };
#define VMW() asm volatile("s_waitcnt vmcnt(0)" ::: "memory")
#define VMWN(n) asm volatile("s_waitcnt vmcnt(%0)" :: "i"(n) : "memory")
#define SLOAD_H(k0) do { S.st_v0 = LD16(C.V, kvoff, (k0) * (PITCH * 2)); S.st_v1 = LD16(C.V, kvoff, ((k0) + 32) * (PITCH * 2));              \
                         S.st_k0 = LD16(C.K, kvoff, (k0) * (PITCH * 2)); S.st_k1 = LD16(C.K, kvoff, ((k0) + 32) * (PITCH * 2)); } while (0)
#define SW_TID int t_ = threadIdx.x; asm volatile("" : "+v"(t_)); const int sr_ = t_ >> 4, sc_ = (t_ & 15) * 8
#define SWRITE_HK(bf) do { SW_TID; const int kws_ = KSWZ(sr_, sc_ * 2); *(bf16x8*)(K_lds + (bf) * SHM_K + kws_) = S.st_k0; *(bf16x8*)(K_lds + (bf) * SHM_K + kws_ + 32 * 256) = S.st_k1; } while (0)
#define SWRITE_HV(bf) do { SW_TID; *(bf16x8*)(V_lds + (bf) * SHM_V + v_st(sr_, sc_)) = S.st_v0; *(bf16x8*)(V_lds + (bf) * SHM_V + v_st(32 + sr_, sc_)) = S.st_v1; } while (0)
#define SWRITE_H(bf) do { SWRITE_HV(bf); SWRITE_HK(bf); } while (0)
__device__ __forceinline__ void dsa_prime(const Ctx& C, int P0, char* lds, Seam& S) {
    int tid = threadIdx.x; asm volatile("" : "+v"(tid));
    const int wid = __builtin_amdgcn_readfirstlane(tid >> 6), lane = tid & 63, r32 = lane & 31, hi = lane >> 5;
    const int sr = tid >> 4, sc = (tid & 15) * 8; char* K_lds = lds + 2 * SHM_V;
    const unsigned kvoff = (unsigned)(sr * PITCH + sc) * 2u, qoff = (unsigned)((wid * QBLK + r32) * PITCH + hi * 8) * 2u;
    for (int d0 = 0; d0 < 8; ++d0) S.qr[d0] = LD16(C.Q, qoff + d0 * 32, P0 * (PITCH * 2));
    SLOAD_H(0); VMW(); SWRITE_HK(0);
    __syncthreads();
}
__device__ __forceinline__ void dsa_block(const Ctx& C, int P0, int P0n, char* lds, Seam& S, float cfar) {
    int tid = threadIdx.x; asm volatile("" : "+v"(tid));
    const int wid = __builtin_amdgcn_readfirstlane(tid >> 6), lane = tid & 63, r32 = lane & 31, hi = lane >> 5;
    const int NT = P0 / KVBLK + QB / KVBLK;
    const int qlo = P0 + wid * QBLK;
    const int limw = ((qlo >> 6) + 1) * 64;
    char* V_lds = lds; char* K_lds = lds + 2 * SHM_V;
    float* wsc = (float*)(lds + 2 * SHM_V + 2 * SHM_K) + wid * 64; float* li_l = wsc, * al_l = wsc + 32;
    lds_cf32 bt = (lds_cf32)((__attribute__((address_space(3))) char*)lds + BT_OFF);
    float m_reg = -1e30f, l_reg = 0; f32x16 o[4] = {};
    const int sr = tid >> 4, sc = (tid & 15) * 8;
    const int vb0 = (int)(uintptr_t)V_lds + v_rd_base(lane);
    const unsigned kvoff = (unsigned)(sr * PITCH + sc) * 2u, qoff = (unsigned)((wid * QBLK + r32) * PITCH + hi * 8) * 2u, moff = (unsigned)((wid * QBLK + r32) * 32) * 8u;
#define MROW(t) mask_compact(__builtin_bit_cast(unsigned long long, __builtin_amdgcn_raw_buffer_load_b64(C.M, (int)moff, (P0 * 32 + (t)) * 8, 0)), hi)
    const int rel0 = 256 + 4 * hi - (qlo + r32);
#define RESC(a) do { if (__any((a) < 1.f)) { if (hi == 0) al_l[r32] = (a); asm volatile("s_waitcnt lgkmcnt(0)" ::: "memory");              \
                     for (int d_ = 0; d_ < 4; ++d_) for (int r = 0; r < 16; ++r) o[d_][r] *= al_l[crow(r, hi)]; } } while (0)
#define KBASE(t) ((t) * KVBLK)
#define ACT(t) (KBASE(t) < limw)
#define MASKT(P0_, P1_, mw_, t) do { const int kb_ = KBASE(t); if (ACT(t)) mask_bias(P0_, P1_, mw_, bt, kb_ + rel0, kb_ + KVBLK - 1 - qlo <= -128, cfar, hi); } while (0)
    constexpr int NQL = 8; constexpr bool SK = true;
#define SEAM_K0() do { VMWN(NQL); SWRITE_HK(0); SBAR(); } while (0)
    f32x16 pA0, pA1, pB0, pB1; float mnA, mnB, alA, alB; bf16x8 pa0, pa1, pa2, pa3; unsigned mw;
    SWRITE_HV(0); SBAR();
    if (NT > 1) SLOAD_H(KBASE(1));
    mw = MROW(0);
    SBAR(); qkt<0, SK>(pA0, pA1, K_lds, r32, hi, S.qr, ACT(0));
    MASKT(pA0, pA1, mw, 0); partialSM(pA0, pA1, m_reg, mnA, alA);
    if (NT > 1) { VMW(); SWRITE_H(1); }
    __syncthreads();
#define HALF_STEP(PX0, PX1, mnX, alX, PY0, PY1, alY, t, KB, VB, SB) do {                                                      \
        SBAR(); mw = MROW(t); qkt<KB, SK>(PX0, PX1, K_lds, r32, hi, S.qr, ACT(t));                                          \
        finishSM(PY0, PY1, alY, l_reg, pa0, pa1, pa2, pa3); SBAR();                                                           \
        if ((t) + 1 < NT) { SLOAD_H(KBASE((t) + 1)); SBAR(); }                                                        \
        pv_tile<VB, SK>(o, vb0, pa0, pa1, pa2, pa3, ACT((t) - 1)); MASKT(PX0, PX1, mw, (t)); partialSM(PX0, PX1, m_reg, mnX, alX); \
        __syncthreads();                                                                                                      \
        if ((t) + 1 < NT) { VMW(); SWRITE_H(SB); }                                                                            \
        RESC(alX); __syncthreads(); } while (0)
    for (int t = 1; t + 1 < NT; t += 2) {
        HALF_STEP(pB0, pB1, mnB, alB, pA0, pA1, alA, t, 1, 0, 0);
        HALF_STEP(pA0, pA1, mnA, alA, pB0, pB1, alB, t + 1, 0, 1, 1);
    }
    const bool even = (NT & 1) == 0;
    if (even) { SBAR(); mw = MROW(NT - 1); qkt<1, SK>(pB0, pB1, K_lds, r32, hi, S.qr, ACT(NT - 1)); SBAR(); }
    SLOAD_H(0); SBAR();
#pragma unroll
    for (int d0 = 0; d0 < 8; ++d0) S.qr[d0] = LD16(C.Q, qoff + d0 * 32, P0n * (PITCH * 2));
    SBAR();
    finishSM(pA0, pA1, alA, l_reg, pa0, pa1, pa2, pa3); SBAR();
    pv_tile<0, SK>(o, vb0, pa0, pa1, pa2, pa3, ACT(even ? NT - 2 : NT - 1));
    if (even) { MASKT(pB0, pB1, mw, NT - 1); partialSM(pB0, pB1, m_reg, mnB, alB); __syncthreads(); RESC(alB);
        finishSM(pB0, pB1, alB, l_reg, pa0, pa1, pa2, pa3); SBAR(); pv_tile<1, SK>(o, vb0, pa0, pa1, pa2, pa3, ACT(NT - 1)); }
    SBAR(); SEAM_K0();
    if (hi == 0) li_l[r32] = l_reg; asm volatile("s_waitcnt lgkmcnt(0)" ::: "memory");
    float rli[16];
#pragma unroll
    for (int r = 0; r < 16; ++r) rli[r] = __builtin_amdgcn_rcpf(li_l[crow(r, hi)]);
    const unsigned ooff = (unsigned)((wid * QBLK + 4 * hi) * PITCH + r32) * 2u;
#pragma unroll
    for (int r = 0; r < 16; ++r) { const int so = (P0 + (r & 3) + 8 * (r >> 2)) * (PITCH * 2);
#pragma unroll
        for (int d0 = 0; d0 < 4; ++d0) { const float v = o[d0][r] * rli[r];
            const float vn = __shfl_xor(v, 1);
            if ((r32 & 1) == 0) __builtin_amdgcn_raw_buffer_store_b32(cvtpk(v, vn), C.O, (int)(ooff + d0 * 64), so, 0); } }
    __syncthreads();
#undef RESC
#undef MROW
#undef KBASE
#undef ACT
#undef MASKT
#undef SEAM_K0
#undef HALF_STEP
}
#undef VMW
#undef VMWN
#undef SLOAD_H
#undef SWRITE_HK
#undef SWRITE_HV
#undef SWRITE_H
#undef SW_TID
#undef KSWZ
#undef SBAR
}

constexpr int NWAVES = 8;
constexpr int NTP = BATCH * SEQ, NTS = DEC_BATCH * DEC_SEQ, NTOK = NTP + NTS;
constexpr int NPM = NTOK / 256;
constexpr int N_MIX = 27 * 256, N_M1A = 12 * 256, N_M1B = 8 * 256;
static_assert(NTP % 256 == 0 && NTS % 256 == 0 && D_MODEL == 1024 && A_WIDTH == 1024 && B_WIDTH == 1024, "geometry");

constexpr size_t MiB = 1u << 20;
constexpr size_t WS_CTL = 0, CTL_ZERO_BYTES = 1 * MiB;
constexpr size_t WS_WMIX = 1 * MiB;
constexpr size_t WS_WMRG = WS_WMIX + 14 * MiB;
constexpr size_t WS_WAB  = WS_WMRG + 10 * MiB;
constexpr size_t WS_WO   = WS_WAB + 4 * MiB;
constexpr size_t WS_XB   = WS_WO + 2 * MiB;
constexpr size_t ROWBUF  = (size_t)NTOK * 1024 * 2;
constexpr size_t WS_QA   = WS_XB + ROWBUF;
constexpr size_t WS_KA   = WS_QA + ROWBUF;
constexpr size_t WS_VA   = WS_KA + ROWBUF;
constexpr size_t WS_QB   = WS_VA + ROWBUF;
constexpr size_t WS_QI   = WS_QB + ROWBUF;
constexpr size_t WS_KI   = WS_QI + 65 * MiB;
constexpr size_t WS_SM   = WS_KI + 9 * MiB;
constexpr size_t WS_MASK = WS_SM + 5 * MiB;
constexpr size_t WS_HST  = WS_MASK + 16 * MiB;
constexpr size_t WS_NAIVE = WS_HST + 3 * MiB;
constexpr size_t WS_NEED = WS_NAIVE;
static_assert(WS_WMIX + (size_t)N_MIX * 1024 * 2 <= WS_WMRG && WS_QI + (size_t)NTOK * 512 * 2 <= WS_KI && WS_KI + (size_t)NTOK * 64 * 2 <= WS_SM && WS_SM + (size_t)NTOK * 64 <= WS_MASK
              && WS_HST + (size_t)NTOK * 32 <= WS_NAIVE, "d_ws map");
constexpr int CW_BAR = 4096;
constexpr int RING_OFF = 0, RING_BYTES = 131072;
constexpr int LDS_BYTES = 147456;
constexpr int LDSCTL_OFF = LDS_BYTES - 512, MISC_OFF = LDSCTL_OFF + 320;

struct Args { const float* in[17]; float* out; unsigned char* ws; int ph_lo, ph_hi; };

__device__ __forceinline__ float bf2f(bf16 v) { return __uint_as_float((unsigned)v << 16); }
__device__ __forceinline__ float sigm(float x) { return 1.0f / (1.0f + __expf(-x)); }

__device__ __forceinline__ void tr_item(const float* W, int ldw, int c0, int nv, int k0, bf16* WT, int ldt, int r0, int kofs, LAS float* scr, int lane) {
    const int n_ = lane & 31;
#pragma unroll 8
    for (int i = 0; i < 32; ++i) { const int kk = 2 * i + (lane >> 5); scr[kk * 33 + n_] = (n_ < nv) ? W[(size_t)(k0 + kk) * ldw + c0 + n_] : 0.f; }
    LDS_WAIT(); asm volatile("" ::: "memory");
    const int c = lane & 7;
#pragma unroll
    for (int j = 0; j < 4; ++j) { const int n = (lane >> 3) + 8 * j; const LAS float* s = scr + (8 * c) * 33 + n;
        v4u o; o.x = pk2(s[0 * 33], s[1 * 33]); o.y = pk2(s[2 * 33], s[3 * 33]); o.z = pk2(s[4 * 33], s[5 * 33]); o.w = pk2(s[6 * 33], s[7 * 33]);
        if (n < nv) *(GAS v4u*)(WT + (size_t)(r0 + n) * ldt + kofs + k0 + 8 * c) = o; }
    LDS_WAIT(); asm volatile("" ::: "memory");
}
struct Seg { int src, n, dst; };
__device__ __forceinline__ Seg win_seg(int s) {
    switch (s) {
        case 0: return Seg{C_QA, 1024, 0};      case 1: return Seg{C_KA, 1024, 1024};  case 2: return Seg{C_VA, 1024, 2048};
        case 3: return Seg{C_QB, 1024, 3072};   case 4: return Seg{C_KB, 1024, 4096};  case 5: return Seg{C_VB, 1024, 5120};
        case 6: return Seg{C_QI, 512, 6144};    case 7: return Seg{C_KI, 64, 6656};    case 8: return Seg{C_WI, 8, 6720};
        case 9: return Seg{C_IA, 4, 6728};      case 10: return Seg{C_FA, 4, 6732};
        case 27: return Seg{C_ZB, 1024, 2048};  case 28: return Seg{C_GA, 1024, 3072}; case 29: return Seg{C_GB, 1024, 4096};
        default: { const int j = (s - 11) >> 1; return (s & 1) ? Seg{C_OA + 128 * j, 128, 256 * j} : Seg{C_ZA + 128 * j, 128, 256 * j + 128}; }
    }
}
struct P0Args { const float *xp, *xs, *w_in, *w_out_a, *w_out_b, *w_o; bf16 *XB, *WMIX, *WMRG, *WAB, *WO; };
__device__ __forceinline__ void p0_prologue(const P0Args& a, LAS unsigned char* lds, int vcu, int G, int wave, int lane) {
    LAS float* scr = (LAS float*)(lds + RING_OFF + wave * 16384);
    const int gw = vcu * NWAVES + wave, NGW = G * NWAVES;
    int base = 0;
    for (int s = 0; s < 30; ++s) {
        const Seg sg = win_seg(s); const int nblk = (sg.n + 31) / 32, nit = nblk * 16;
        bf16* WT = s < 11 ? a.WMIX : a.WMRG;
        for (int it = gw - (base % NGW); it < nit; it += NGW) { if (it < 0) continue; const int kb = it / nblk, nb = it % nblk; const int nv = sg.n - 32 * nb < 32 ? sg.n - 32 * nb : 32;
            tr_item(a.w_in, IN_COLS, sg.src + 32 * nb, nv, 64 * kb, WT, 1024, sg.dst + 32 * nb, 0, scr, lane); }
        base += nit;
    }
    for (int i = gw * 64 + lane; i < 176 * 128; i += NGW * 64) ((GAS v4u*)(a.WMIX + (size_t)6736 * 1024))[i] = (v4u){0u, 0u, 0u, 0u};
    for (int it = gw; it < 3 * 512; it += NGW) { const int w = it / 512, r = it % 512, kb = r / 32, nb = r % 32;
        if (w == 0) tr_item(a.w_out_a, 1024, 32 * nb, 32, 64 * kb, a.WAB, 2048, 32 * nb, 0, scr, lane);
        else if (w == 1) tr_item(a.w_out_b, 1024, 32 * nb, 32, 64 * kb, a.WAB, 2048, 32 * nb, 1024, scr, lane);
        else tr_item(a.w_o, 1024, 32 * nb, 32, 64 * kb, a.WO, 1024, 32 * nb, 0, scr, lane); }
    for (int m0 = gw * 2; m0 < NTOK; m0 += NGW * 2) { f32x4 v[2][4];
#pragma unroll
        for (int q = 0; q < 2; ++q) { const int m = m0 + q; const float* xr = m < NTP ? a.xp + (size_t)m * 1024 : a.xs + (size_t)(m - NTP) * 1024; const GAS f32x4* xv = (const GAS f32x4*)xr + lane;
#pragma unroll
            for (int j = 0; j < 4; ++j) v[q][j] = xv[64 * j]; }
#pragma unroll
        for (int q = 0; q < 2; ++q) { GAS unsigned long long* o8 = (GAS unsigned long long*)(a.XB + (size_t)(m0 + q) * 1024) + lane;
#pragma unroll
            for (int j = 0; j < 4; ++j) o8[64 * j] = (unsigned long long)pk2(v[q][j].x, v[q][j].y) | ((unsigned long long)pk2(v[q][j].z, v[q][j].w) << 32); }
    }
}

namespace pg8 {
struct EpiMix {
    static constexpr bool PERM = true, AFTER_DRAIN = false, MIDK = false;
    bf16_t* QA4;
    bf16_t* KVc;
    bf16_t *QI, *KI; float* SM;
    float *okvp, *okvs;
    float *oikp, *oiks;
    __device__ __forceinline__ void mid(f32x4 (&)[2][2][4][2], const Unit&, int, int, int, int) const {}
    __device__ __forceinline__ void operator()(const f32x4 (&acc)[2][2][4][2], const Unit& u, int wr, int wc, int fr, int fq) const {
        const int pn = u.pn; const bool samp = u.pm >= NTP / 256;
        const int row0 = u.pm * BM + wr * 64 + fr, cl = wc * 32 + 8 * fq;
        if (pn < 16) {
            bf16_t* base = QA4 + (size_t)(pn >> 2) * ((size_t)NTOK * 1024); const float sc = (pn >= 4 && pn < 8) ? 0.0625f : 1.0f;
            const int col0 = (pn & 3) * 256 + cl;
#pragma unroll
            for (int ai = 0; ai < 2; ++ai)
#pragma unroll
                for (int m = 0; m < 4; ++m) { bf16_t* rowp = base + (size_t)(row0 + ai * HALF + m * 16) * 1024 + col0;
#pragma unroll
                    for (int bj = 0; bj < 2; ++bj) { const f32x4 v0 = acc[ai][bj][m][0] * sc, v1 = acc[ai][bj][m][1] * sc;
                        u32x4 w; w.x = cvt_pk_bf16(v0[0], v0[1]); w.y = cvt_pk_bf16(v0[2], v0[3]); w.z = cvt_pk_bf16(v1[0], v1[1]); w.w = cvt_pk_bf16(v1[2], v1[3]);
                        *(u32x4*)(rowp + bj * HALF) = w; } }
        } else if (pn < 24) {
            const int isV = pn >= 20 ? 1 : 0; const int col0 = (pn & 3) * 256 + cl;
            float* of = samp ? okvs + (size_t)isV * ((size_t)NTS * 1024) : okvp + (size_t)isV * ((size_t)NTP * 1024);
            bf16_t* cb = KVc + (size_t)isV * ((size_t)NTP * 1024);
#pragma unroll
            for (int ai = 0; ai < 2; ++ai)
#pragma unroll
                for (int m = 0; m < 4; ++m) { const int r = row0 + ai * HALF + m * 16; const int rr = samp ? r - NTP : r;
#pragma unroll
                    for (int bj = 0; bj < 2; ++bj) { const f32x4 v0 = acc[ai][bj][m][0], v1 = acc[ai][bj][m][1];
                        float* fp = of + (size_t)rr * 1024 + col0 + bj * HALF; *(f32x4*)fp = v0; *(f32x4*)(fp + 4) = v1;
                        if (!samp) { u32x4 w; w.x = cvt_pk_bf16(v0[0], v0[1]); w.y = cvt_pk_bf16(v0[2], v0[3]); w.z = cvt_pk_bf16(v1[0], v1[1]); w.w = cvt_pk_bf16(v1[2], v1[3]);
                            *(u32x4*)(cb + (size_t)r * 1024 + col0 + bj * HALF) = w; } } }
        } else if (pn < 26) {
            const int col0 = (pn - 24) * 256 + cl;
#pragma unroll
            for (int ai = 0; ai < 2; ++ai)
#pragma unroll
                for (int m = 0; m < 4; ++m) { bf16_t* rowp = QI + (size_t)(row0 + ai * HALF + m * 16) * 512 + col0;
#pragma unroll
                    for (int bj = 0; bj < 2; ++bj) { const f32x4 v0 = acc[ai][bj][m][0] * 0.125f, v1 = acc[ai][bj][m][1] * 0.125f;
                        u32x4 w; w.x = cvt_pk_bf16(v0[0], v0[1]); w.y = cvt_pk_bf16(v0[2], v0[3]); w.z = cvt_pk_bf16(v1[0], v1[1]); w.w = cvt_pk_bf16(v1[2], v1[3]);
                        *(u32x4*)(rowp + bj * HALF) = w; } }
        } else {
            float* oik = samp ? oiks : oikp;
#pragma unroll
            for (int ai = 0; ai < 2; ++ai)
#pragma unroll
                for (int m = 0; m < 4; ++m) { const int r = row0 + ai * HALF + m * 16; const int rr = samp ? r - NTP : r; const f32x4 v0 = acc[ai][0][m][0], v1 = acc[ai][0][m][1];
                    if (wc < 2) { float* fp = oik + (size_t)rr * 64 + cl; *(f32x4*)fp = v0; *(f32x4*)(fp + 4) = v1;
                        u32x4 w; w.x = cvt_pk_bf16(v0[0], v0[1]); w.y = cvt_pk_bf16(v0[2], v0[3]); w.z = cvt_pk_bf16(v1[0], v1[1]); w.w = cvt_pk_bf16(v1[2], v1[3]);
                        *(u32x4*)(KI + (size_t)r * 64 + cl) = w; }
                    else if (wc == 2 && fq < 2) { float* fp = SM + (size_t)r * 16 + 8 * fq; *(f32x4*)fp = v0; *(f32x4*)(fp + 4) = v1; } }
        }
    }
};
}


namespace ml {
typedef short bfx8 __attribute__((ext_vector_type(8)));
typedef short s16x4 __attribute__((ext_vector_type(4)));
typedef float f32x16 __attribute__((ext_vector_type(16)));
typedef float f32x2_t __attribute__((ext_vector_type(2))); typedef __bf16 bf16x2_t __attribute__((ext_vector_type(2)));
typedef short v4i16_t __attribute__((ext_vector_type(4)));
typedef unsigned u32x4 __attribute__((ext_vector_type(4)));
typedef unsigned u32x2 __attribute__((ext_vector_type(2)));
typedef float f32x4 __attribute__((ext_vector_type(4)));
#define MLAS __attribute__((address_space(3)))
constexpr int QP = 528, VP = 272;
constexpr int L_Q = 0, L_K = 64 * QP, L_V = 2 * 64 * QP, L_VW = L_V + 64 * VP, L_EX = L_VW + 64 * VP;
constexpr int L_G = L_EX + 32768;
constexpr int L_GW = L_G, L_GM = L_G + 256, L_GI = L_G + 512, L_GE = L_G + 768, L_GS = L_G + 1024;
constexpr int L_NV = L_G + 1280;
constexpr int L_QN = L_NV + 1024;
constexpr int L_DP = L_QN + 256;
constexpr int L_END = L_DP + 384;
__device__ __forceinline__ unsigned cvtpk(float lo, float hi) { f32x2_t v = {lo, hi}; bf16x2_t b = __builtin_convertvector(v, bf16x2_t); return __builtin_bit_cast(unsigned, b); }
__device__ __forceinline__ bfx8 pack_step(const f32x16& x, int s) {
    u32x4 p; p.x = cvtpk(x[8 * s + 0], x[8 * s + 1]); p.y = cvtpk(x[8 * s + 2], x[8 * s + 3]); p.z = cvtpk(x[8 * s + 4], x[8 * s + 5]); p.w = cvtpk(x[8 * s + 6], x[8 * s + 7]);
    return __builtin_bit_cast(bfx8, p);
}
__device__ __forceinline__ s16x4 vtr(MLAS const unsigned char* p) { return __builtin_bit_cast(s16x4, __builtin_amdgcn_ds_read_tr16_b64_v4i16((MLAS v4i16_t*)p)); }
__device__ __forceinline__ bfx8 cat8(s16x4 lo, s16x4 hi) { return (bfx8){lo[0], lo[1], lo[2], lo[3], hi[0], hi[1], hi[2], hi[3]}; }
__device__ __forceinline__ int crow(int r, int hi) { return (r & 3) + 8 * (r >> 2) + 4 * hi; }
__device__ __forceinline__ float logsig_(float x) { return fminf(x, 0.0f) - log1pf(__expf(-fabsf(x))); }
__device__ __forceinline__ float wsum_(float v) {
#pragma unroll
    for (int o = 1; o < 64; o <<= 1) v += __shfl_xor(v, o);
    return v; }
#define ML_MFMA(a, b, c) __builtin_amdgcn_mfma_f32_32x32x16_bf16((a), (b), (c), 0, 0, 0)

struct Item {
    __amdgpu_buffer_rsrc_t hout;
    __amdgpu_buffer_rsrc_t q, k, v;
    __amdgpu_buffer_rsrc_t sm;
    __amdgpu_buffer_rsrc_t C0, Cout;
    const float* n0; float m0; bool has0;
    float* nout; float* mout;
    int head, nchunk, L; float bi, bf;
};
#define ML_LD16(rs, vo, so) __builtin_bit_cast(u32x4, __builtin_amdgcn_raw_buffer_load_b128((rs), (int)(vo), (int)(so), 0))
#define ML_LDF(rs, vo, so) __builtin_bit_cast(float, __builtin_amdgcn_raw_buffer_load_b32((rs), (int)(vo), (int)(so), 0))

__device__ __forceinline__ void run_item(MLAS unsigned char* lds, const Item& it) {
    int tid = threadIdx.x; asm volatile("" : "+v"(tid));
    const int wave = __builtin_amdgcn_readfirstlane(tid >> 6), lane0 = tid & 63, g = wave >> 2, cb = wave & 3;
#define ML_LANE int lane = lane0; asm volatile("" : "+v"(lane)); const int r32 = lane & 31, hi = lane >> 5; (void)r32; (void)hi
    const int L = it.L, h = it.head;
    const unsigned coff = (unsigned)((lane0 >> 5) * 4096 + (lane0 & 31) * 4), qkoff = (unsigned)((tid >> 5) * 2048 + (tid & 31) * 16), voff = (unsigned)((tid >> 4) * 2048 + (tid & 15) * 16), hoff = (unsigned)((4 * (lane0 >> 5) * 1024 + (lane0 & 31)) * 2);
    f32x16 Cacc[4];
#pragma unroll
    for (int j = 0; j < 4; ++j)
#pragma unroll
        for (int i = 0; i < 16; ++i) Cacc[j][i] = it.has0 ? ML_LDF(it.C0, coff, ((128 * g + 32 * j + (i & 3) + 8 * (i >> 2)) * 256 + 32 * cb) * 4) : 0.f;
    if (tid < 256) ((MLAS float*)(lds + L_NV))[tid] = it.has0 ? it.n0[tid] : 0.f;
    float m = it.m0;
    u32x4 pq[4], pk[4], pv[2]; float pia, pfa;
#define ML_PREFETCH(c_) do { const int t0_ = (c_) * L; \
        _Pragma("unroll") for (int i = 0; i < 4; ++i) { const bool ok_ = 16 * i < L;     \
            pq[i] = ok_ ? ML_LD16(it.q, qkoff, (t0_ + 16 * i) * 2048) : (u32x4){0u, 0u, 0u, 0u}; pk[i] = ok_ ? ML_LD16(it.k, qkoff, (t0_ + 16 * i) * 2048) : (u32x4){0u, 0u, 0u, 0u}; } \
        _Pragma("unroll") for (int i = 0; i < 2; ++i) pv[i] = (32 * i < L) ? ML_LD16(it.v, voff, (t0_ + 32 * i) * 2048) : (u32x4){0u, 0u, 0u, 0u}; \
        { const int lane = lane0; const bool ok_ = lane < L; const float a_ = ML_LDF(it.sm, lane * 64, t0_ * 64 + (8 + h) * 4), f_ = ML_LDF(it.sm, lane * 64, t0_ * 64 + (12 + h) * 4); pia = ok_ ? a_ : 0.f; pfa = ok_ ? f_ : 0.f; } } while (0)
    ML_PREFETCH(0);
    for (int c = 0; c < it.nchunk; ++c) {
        float wsl, decay, mnext;
        { ML_LANE;
        float lf = (lane < L) ? logsig_(pfa + it.bf) : 0.f; float cum = lf;
#pragma unroll
        for (int o = 1; o < 64; o <<= 1) { const float t_ = __shfl_up(cum, o); if (lane >= o) cum += t_; }
        const float wv = (lane < L) ? (pia + it.bi) - cum : -INFINITY; float cmx = wv;
#pragma unroll
        for (int o = 1; o < 64; o <<= 1) { const float t_ = __shfl_up(cmx, o); if (lane >= o) cmx = fmaxf(cmx, t_); }
        const float Ml = fmaxf(m, cmx); const float M63 = __shfl(Ml, 63), cum63 = __shfl(cum, 63);
        wsl = __expf(wv - M63); decay = __expf(m - M63); mnext = cum63 + M63;
        if (wave == 0) { ((MLAS float*)(lds + L_GW))[lane] = wv; ((MLAS float*)(lds + L_GM))[lane] = Ml; ((MLAS float*)(lds + L_GI))[lane] = __expf(m - Ml);
                         ((MLAS float*)(lds + L_GE))[lane] = __expf(-(cum + Ml)); ((MLAS float*)(lds + L_GS))[lane] = wsl; } }
#pragma unroll
        for (int i = 0; i < 4; ++i) { const int p_ = tid + 512 * i, row_ = p_ >> 5, cp_ = p_ & 31;
            *(MLAS u32x4*)(lds + L_Q + row_ * QP + cp_ * 16) = pq[i]; *(MLAS u32x4*)(lds + L_K + row_ * QP + cp_ * 16) = pk[i]; }
#pragma unroll
        for (int i = 0; i < 2; ++i) { const int p_ = tid + 512 * i, row_ = p_ >> 4, cp_ = p_ & 15; const float wr_ = __shfl(wsl, row_ & 63);
            *(MLAS u32x4*)(lds + L_V + row_ * VP + cp_ * 16) = pv[i];
            u32x4 o_;
#pragma unroll
            for (int e = 0; e < 4; ++e) o_[e] = cvtpk(__uint_as_float(pv[i][e] << 16) * wr_, __uint_as_float(pv[i][e] & 0xffff0000u) * wr_);
            *(MLAS u32x4*)(lds + L_VW + row_ * VP + cp_ * 16) = o_; }
        __syncthreads();
        const int sb = g; f32x16 S0 = {}, S1 = {};
        { ML_LANE;
            MLAS const unsigned char* kp = lds + L_K + (32 * sb + r32) * QP + hi * 16; MLAS const unsigned char* q0 = lds + L_Q + r32 * QP + hi * 16; MLAS const unsigned char* q1 = q0 + 32 * QP;
#pragma unroll 4
            for (int ks = 0; ks < 16; ++ks) { const bfx8 ka = *(MLAS const bfx8*)(kp + ks * 32); const bfx8 qb1 = *(MLAS const bfx8*)(q1 + ks * 32);
                S1 = ML_MFMA(ka, qb1, S1);
                if (g == 0) { const bfx8 qb0 = *(MLAS const bfx8*)(q0 + ks * 32); S0 = ML_MFMA(ka, qb0, S0); } }
        }
        { ML_LANE;
            const float M1 = ((MLAS const float*)(lds + L_GM))[32 + r32], M0 = ((MLAS const float*)(lds + L_GM))[r32]; float d0 = 0.f, d1 = 0.f;
#pragma unroll
            for (int i = 0; i < 16; ++i) { const int sl = crow(i, hi); const float ws_ = ((MLAS const float*)(lds + L_GW))[32 * sb + sl];
                const int s_ = 32 * sb + sl;
                S1[i] = (s_ <= 32 + r32) ? S1[i] * __expf(ws_ - M1) : 0.f; d1 += S1[i];
                if (g == 0) { S0[i] = (s_ <= r32) ? S0[i] * __expf(ws_ - M0) : 0.f; d0 += S0[i]; } }
            { auto rr = __builtin_amdgcn_permlane32_swap(__float_as_uint(d1), __float_as_uint(d1), false, false); d1 = __uint_as_float(rr[0]) + __uint_as_float(rr[1]); }
            { auto rr = __builtin_amdgcn_permlane32_swap(__float_as_uint(d0), __float_as_uint(d0), false, false); d0 = __uint_as_float(rr[0]) + __uint_as_float(rr[1]); }
            if (cb == 0 && hi == 0) { if (g == 0) { ((MLAS float*)(lds + L_DP))[r32] = d0; ((MLAS float*)(lds + L_DP))[32 + r32] = d1; } else ((MLAS float*)(lds + L_DP))[64 + r32] = d1; }
        }
        f32x16 Y0 = {}, Y1 = {};
        { ML_LANE;
#pragma unroll
        for (int j = 0; j < 4; ++j)
#pragma unroll
            for (int ks = 0; ks < 2; ++ks) { const bfx8 xs = pack_step(Cacc[j], ks);
                MLAS const unsigned char* qa = lds + L_Q + r32 * QP + (128 * g + 32 * j + 16 * ks + 4 * hi) * 2;
                const u32x2 a0l = *(MLAS const u32x2*)(qa), a0h = *(MLAS const u32x2*)(qa + 16), a1l = *(MLAS const u32x2*)(qa + 32 * QP), a1h = *(MLAS const u32x2*)(qa + 32 * QP + 16);
                const bfx8 pa0 = __builtin_bit_cast(bfx8, (u32x4){a0l.x, a0l.y, a0h.x, a0h.y}), pa1 = __builtin_bit_cast(bfx8, (u32x4){a1l.x, a1l.y, a1h.x, a1h.y});
                Y0 = ML_MFMA(pa0, xs, Y0); Y1 = ML_MFMA(pa1, xs, Y1); }
#pragma unroll
        for (int i = 0; i < 16; ++i) { Y0[i] *= ((MLAS const float*)(lds + L_GI))[crow(i, hi)]; Y1[i] *= ((MLAS const float*)(lds + L_GI))[32 + crow(i, hi)]; } }
        { ML_LANE;
            const int i16 = lane & 15, q_ = i16 >> 2, p_ = i16 & 3, gi = lane >> 4;
            MLAS const unsigned char* vb = lds + L_V + (32 * sb + 4 * hi + q_) * VP + (32 * cb + 16 * (gi & 1) + 4 * p_) * 2;
#pragma unroll
            for (int ks = 0; ks < 2; ++ks) { const bfx8 pb = cat8(vtr(vb + (16 * ks) * VP), vtr(vb + (16 * ks + 8) * VP));
                Y1 = ML_MFMA(pack_step(S1, ks), pb, Y1);
                if (g == 0) Y0 = ML_MFMA(pack_step(S0, ks), pb, Y0); }
        }
        { ML_LANE;
            const int sub = lane >> 3, part = lane & 7, l_ = 8 * wave + sub; float d_ = 0.f;
#pragma unroll
            for (int j = 0; j < 4; ++j) { const u32x4 qw = *(MLAS const u32x4*)(lds + L_Q + l_ * QP + part * 64 + j * 16);
                const f32x4 n0 = *(MLAS const f32x4*)(lds + L_NV + part * 128 + j * 32), n1 = *(MLAS const f32x4*)(lds + L_NV + part * 128 + j * 32 + 16);
                d_ += (__uint_as_float(qw.x << 16) * n0.x + __uint_as_float(qw.x & 0xffff0000u) * n0.y) + (__uint_as_float(qw.y << 16) * n0.z + __uint_as_float(qw.y & 0xffff0000u) * n0.w)
                    + (__uint_as_float(qw.z << 16) * n1.x + __uint_as_float(qw.z & 0xffff0000u) * n1.y) + (__uint_as_float(qw.w << 16) * n1.z + __uint_as_float(qw.w & 0xffff0000u) * n1.w); }
            d_ += __shfl_xor(d_, 1); d_ += __shfl_xor(d_, 2); d_ += __shfl_xor(d_, 4);
            if (part == 0) ((MLAS float*)(lds + L_QN))[l_] = d_;
        }
        { ML_LANE;
            MLAS float* ex = (MLAS float*)(lds + L_EX + ((1 - g) * 4 + cb) * 4096) + lane;
#pragma unroll
            for (int i = 0; i < 16; ++i) ex[i * 64] = (g == 0) ? Y1[i] : Y0[i];
        }
        __syncthreads();
        if (c + 1 < it.nchunk) ML_PREFETCH(c + 1);
        { ML_LANE;
            MLAS const float* ex = (MLAS const float*)(lds + L_EX + (g * 4 + cb) * 4096) + lane; f32x16 Y = (g == 0) ? Y0 : Y1;
#pragma unroll
            for (int i = 0; i < 16; ++i) Y[i] += ex[i * 64];
#pragma unroll
            for (int i = 0; i < 16; ++i) { const int l_ = 32 * g + crow(i, hi);
                const float dsum = (g == 0) ? ((MLAS const float*)(lds + L_DP))[l_] : ((MLAS const float*)(lds + L_DP))[l_] + ((MLAS const float*)(lds + L_DP))[32 + l_];
                const float den = dsum + ((MLAS const float*)(lds + L_GI))[l_] * ((MLAS const float*)(lds + L_QN))[l_];
                const float hv = Y[i] * __builtin_amdgcn_rcpf(fmaxf(fabsf(den), ((MLAS const float*)(lds + L_GE))[l_]));
                const float hn = __shfl_xor(hv, 1);
                if (32 * g < L && (r32 & 1) == 0) __builtin_amdgcn_raw_buffer_store_b32(cvtpk(hv, hn), it.hout, (int)hoff, ((c * L + 32 * g + (i & 3) + 8 * (i >> 2)) * 1024 + 32 * cb) * 2, 0); }
        }
        if (tid < 256) { float a_ = 0.f;
#pragma unroll 8
            for (int s = 0; s < 64; ++s) a_ += ((MLAS const float*)(lds + L_GS))[s] * bf2f(*(MLAS const unsigned short*)(lds + L_K + s * QP + tid * 2));
            ((MLAS float*)(lds + L_NV))[tid] = decay * ((MLAS const float*)(lds + L_NV))[tid] + a_; }
        { ML_LANE;
            const int i16 = lane & 15, q_ = i16 >> 2, p_ = i16 & 3, gi = lane >> 4;
            MLAS const unsigned char* kb_ = lds + L_K + (8 * hi + q_) * QP + (128 * g + 16 * (gi & 1) + 4 * p_) * 2;
            MLAS const unsigned char* vw_ = lds + L_VW + (8 * hi + q_) * VP + (32 * cb + 16 * (gi & 1) + 4 * p_) * 2;
#pragma unroll
            for (int j = 0; j < 4; ++j)
#pragma unroll
                for (int i = 0; i < 16; ++i) Cacc[j][i] *= decay;
#pragma unroll
            for (int ks = 0; ks < 4; ++ks) { const bfx8 vb_ = cat8(vtr(vw_ + (16 * ks) * VP), vtr(vw_ + (16 * ks + 4) * VP));
#pragma unroll
                for (int j = 0; j < 4; ++j) { const bfx8 ka_ = cat8(vtr(kb_ + (16 * ks) * QP + 64 * j), vtr(kb_ + (16 * ks + 4) * QP + 64 * j));
                    Cacc[j] = ML_MFMA(ka_, vb_, Cacc[j]); } }
        }
        m = mnext;
        __syncthreads();
    }
#undef ML_PREFETCH
#undef ML_LANE
#pragma unroll
    for (int j = 0; j < 4; ++j)
#pragma unroll
        for (int i = 0; i < 16; ++i) __builtin_amdgcn_raw_buffer_store_b32(__float_as_uint(Cacc[j][i]), it.Cout, (int)coff, ((128 * g + 32 * j + (i & 3) + 8 * (i >> 2)) * 256 + 32 * cb) * 4, 0);
    if (it.nout && tid < 256) it.nout[tid] = ((MLAS const float*)(lds + L_NV))[tid];
    if (it.mout && tid == 0) *it.mout = m;
    __syncthreads();
}
#undef ML_MFMA
#undef ML_LD16
#undef ML_LDF
#undef MLAS
}

constexpr size_t WS_BC = WS_NAIVE, WS_WV = WS_BC + 2 * MiB, WS_CMX = WS_WV + 2 * MiB;
constexpr size_t WS_CHS = WS_CMX + 2 * MiB;
constexpr size_t WS_SMAT = WS_CHS + 1 * MiB;
constexpr size_t WS_CB = WS_SMAT + 3 * MiB;
constexpr size_t WS_NB = WS_CB + 64 * MiB;
constexpr size_t WS_MASKS = WS_NB + 1 * MiB;
constexpr size_t WS_HA = WS_MASKS + 1 * MiB;
constexpr size_t WS_END = WS_HA + ROWBUF;
constexpr int NCHK = BATCH * 4 * 32 + DEC_BATCH * 4;

__device__ __forceinline__ float logsig(float x) { return fminf(x, 0.0f) - log1pf(__expf(-fabsf(x))); }
__device__ __forceinline__ float siluf(float x) { return x / (1.0f + __expf(-x)); }
__device__ __forceinline__ int t5b(int rel) { const int n = rel < 0 ? -rel : rel; const int v = n < 8 ? n : 8 + (n >= 12) + (n >= 16) + (n >= 23) + (n >= 32) + (n >= 46) + (n >= 64) + (n >= 91); return (rel > 0 ? 16 : 0) + v; }

namespace pg8 {
__device__ __forceinline__ void unpack8(u32x4 w, float (&f)[8]) {
    f[0] = __uint_as_float(w.x << 16); f[1] = __uint_as_float(w.x & 0xffff0000u); f[2] = __uint_as_float(w.y << 16); f[3] = __uint_as_float(w.y & 0xffff0000u);
    f[4] = __uint_as_float(w.z << 16); f[5] = __uint_as_float(w.z & 0xffff0000u); f[6] = __uint_as_float(w.w << 16); f[7] = __uint_as_float(w.w & 0xffff0000u);
}
__device__ __forceinline__ u32x4 pack8f(const float (&f)[8]) { u32x4 w; w.x = cvt_pk_bf16(f[0], f[1]); w.y = cvt_pk_bf16(f[2], f[3]); w.z = cvt_pk_bf16(f[4], f[5]); w.w = cvt_pk_bf16(f[6], f[7]); return w; }
__device__ __forceinline__ float sg_(float x) { return __builtin_amdgcn_rcpf(1.0f + __expf(-x)); }
struct EpiM1a {
    static constexpr bool PERM = true, AFTER_DRAIN = false, MIDK = false;
    const bf16_t* HA; const bf16_t* OB; const float* HST; const float* ang; bf16_t* BR;
    __device__ __forceinline__ void mid(f32x4 (&)[2][2][4][2], const Unit&, int, int, int, int) const {}
    __device__ __forceinline__ void operator()(const f32x4 (&acc)[2][2][4][2], const Unit& u, int wr, int wc, int fr, int fq) const {
        const int pn = u.pn; const int row0 = u.pm * BM + wr * 64 + fr, cl = wc * 32 + 8 * fq;
        if (pn < 8) {
            const int ch0 = 128 * pn + cl, head = pn >> 1;
            const f32x4 g0 = *(const f32x4*)(ang + ch0), g1 = *(const f32x4*)(ang + ch0 + 4);
            const float g[8] = {g0[0], g0[1], g0[2], g0[3], g1[0], g1[1], g1[2], g1[3]};
#pragma unroll
            for (int ai = 0; ai < 2; ++ai)
#pragma unroll
                for (int m = 0; m < 4; ++m) { const int r = row0 + ai * HALF + m * 16;
                    float h[8]; unpack8(*(const u32x4*)(HA + (size_t)r * 1024 + ch0), h);
                    const float mean = HST[((size_t)r * 4 + head) * 2], rstd = HST[((size_t)r * 4 + head) * 2 + 1];
                    const f32x4 o0 = acc[ai][0][m][0], o1 = acc[ai][0][m][1], z0 = acc[ai][1][m][0], z1 = acc[ai][1][m][1];
                    const float oa[8] = {o0[0], o0[1], o0[2], o0[3], o1[0], o1[1], o1[2], o1[3]}, za[8] = {z0[0], z0[1], z0[2], z0[3], z1[0], z1[1], z1[2], z1[3]};
                    float o[8];
#pragma unroll
                    for (int i = 0; i < 8; ++i) o[i] = ((h[i] - mean) * rstd * g[i] * sg_(oa[i])) * (za[i] * sg_(za[i]));
                    *(u32x4*)(BR + (size_t)r * 2048 + ch0) = pack8f(o); }
        } else {
#pragma unroll
            for (int ai = 0; ai < 2; ++ai)
#pragma unroll
                for (int m = 0; m < 4; ++m) { const int r = row0 + ai * HALF + m * 16;
#pragma unroll
                    for (int bj = 0; bj < 2; ++bj) { const int ch0 = 256 * (pn - 8) + 128 * bj + cl;
                        float ob[8]; unpack8(*(const u32x4*)(OB + (size_t)r * 1024 + ch0), ob);
                        const f32x4 z0 = acc[ai][bj][m][0], z1 = acc[ai][bj][m][1]; const float zb[8] = {z0[0], z0[1], z0[2], z0[3], z1[0], z1[1], z1[2], z1[3]};
                        float o[8];
#pragma unroll
                        for (int i = 0; i < 8; ++i) o[i] = ob[i] * (zb[i] * sg_(zb[i]));
                        *(u32x4*)(BR + (size_t)r * 2048 + 1024 + ch0) = pack8f(o); } }
        }
    }
};
struct EpiM1b {
    static constexpr bool PERM = true, AFTER_DRAIN = false, MIDK = false;
    bf16_t* SGA; bf16_t* SGB;
    __device__ __forceinline__ void mid(f32x4 (&)[2][2][4][2], const Unit&, int, int, int, int) const {}
    __device__ __forceinline__ void operator()(const f32x4 (&acc)[2][2][4][2], const Unit& u, int wr, int wc, int fr, int fq) const {
        const int pn = u.pn; const int row0 = u.pm * BM + wr * 64 + fr, cl = wc * 32 + 8 * fq;
        bf16_t* base = pn < 4 ? SGA : SGB; const int col0 = (pn & 3) * 256 + cl;
#pragma unroll
        for (int ai = 0; ai < 2; ++ai)
#pragma unroll
            for (int m = 0; m < 4; ++m) { bf16_t* rowp = base + (size_t)(row0 + ai * HALF + m * 16) * 1024 + col0;
#pragma unroll
                for (int bj = 0; bj < 2; ++bj) { const f32x4 v0 = acc[ai][bj][m][0], v1 = acc[ai][bj][m][1];
                    const float o[8] = {sg_(v0[0]), sg_(v0[1]), sg_(v0[2]), sg_(v0[3]), sg_(v1[0]), sg_(v1[1]), sg_(v1[2]), sg_(v1[3])};
                    *(u32x4*)(rowp + bj * HALF) = pack8f(o); } }
    }
};
struct EpiM1 {
    static constexpr bool PERM = true, AFTER_DRAIN = false, MIDK = false;
    EpiM1a a; EpiM1b b;
    __device__ __forceinline__ void mid(f32x4 (&)[2][2][4][2], const Unit&, int, int, int, int) const {}
    __device__ __forceinline__ void operator()(const f32x4 (&acc)[2][2][4][2], const Unit& u, int wr, int wc, int fr, int fq) const {
        if (u.pn < 12) a(acc, u, wr, wc, fr, fq); else { Unit v = u; v.pn = u.pn - 12; b(acc, v, wr, wc, fr, fq); }
    }
};
struct EpiM2 {
    static constexpr bool PERM = true, AFTER_DRAIN = false, MIDK = true;
    const bf16_t* SGA; const bf16_t* SGB; bf16_t* MX;
    __device__ __forceinline__ void mid(f32x4 (&acc)[2][2][4][2], const Unit& u, int wr, int wc, int fr, int fq) const {
        int fr_ = fr, fq_ = fq; asm volatile("" : "+v"(fr_), "+v"(fq_));
        const int row0 = u.pm * BM + wr * 64 + fr_, col0 = u.pn * BM + wc * 32 + 8 * fq_;
#pragma unroll
        for (int ai = 0; ai < 2; ++ai)
#pragma unroll
            for (int m = 0; m < 4; ++m) { const size_t ro = (size_t)(row0 + ai * HALF + m * 16) * 1024 + col0;
#pragma unroll
                for (int bj = 0; bj < 2; ++bj) { float a[8], b[8]; unpack8(*(const u32x4*)(SGA + ro + bj * HALF), a); unpack8(*(const u32x4*)(SGB + ro + bj * HALF), b);
#pragma unroll
                    for (int i = 0; i < 4; ++i) { acc[ai][bj][m][0][i] *= a[i] * __builtin_amdgcn_rcpf(b[i]); acc[ai][bj][m][1][i] *= a[4 + i] * __builtin_amdgcn_rcpf(b[4 + i]); } }
                asm volatile("" ::: "memory"); }
    }
    __device__ __forceinline__ void operator()(const f32x4 (&acc)[2][2][4][2], const Unit& u, int wr, int wc, int fr, int fq) const {
        int fr_ = fr, fq_ = fq; asm volatile("" : "+v"(fr_), "+v"(fq_));
        const int row0 = u.pm * BM + wr * 64 + fr_, col0 = u.pn * BM + wc * 32 + 8 * fq_;
#pragma unroll
        for (int ai = 0; ai < 2; ++ai)
#pragma unroll
            for (int m = 0; m < 4; ++m) { const size_t ro = (size_t)(row0 + ai * HALF + m * 16) * 1024 + col0;
#pragma unroll
                for (int bj = 0; bj < 2; ++bj) { float b[8]; unpack8(*(const u32x4*)(SGB + ro + bj * HALF), b);
                    const f32x4 v0 = acc[ai][bj][m][0], v1 = acc[ai][bj][m][1];
                    const float o[8] = {v0[0] * b[0], v0[1] * b[1], v0[2] * b[2], v0[3] * b[3], v1[0] * b[4], v1[1] * b[5], v1[2] * b[6], v1[3] * b[7]};
                    *(u32x4*)(MX + ro + bj * HALF) = pack8f(o); }
                asm volatile("" ::: "memory"); }
    }
};
struct EpiM3 {
    static constexpr bool PERM = true, AFTER_DRAIN = false, MIDK = false;
    const float* xp; const float* xs; float* yp; float* ys;
    __device__ __forceinline__ void mid(f32x4 (&)[2][2][4][2], const Unit&, int, int, int, int) const {}
    __device__ __forceinline__ void operator()(const f32x4 (&acc)[2][2][4][2], const Unit& u, int wr, int wc, int fr, int fq) const {
        const bool samp = u.pm >= NTP / 256; const int row0 = (samp ? u.pm - NTP / 256 : u.pm) * BM + wr * 64 + fr, col0 = u.pn * BM + wc * 32 + 8 * fq;
        const float* xb = samp ? xs : xp; float* yb = samp ? ys : yp;
#pragma unroll
        for (int ai = 0; ai < 2; ++ai)
#pragma unroll
            for (int m = 0; m < 4; ++m) { const size_t ro = (size_t)(row0 + ai * HALF + m * 16) * 1024 + col0;
#pragma unroll
                for (int bj = 0; bj < 2; ++bj) { const f32x4 x0 = *(const f32x4*)(xb + ro + bj * HALF), x1 = *(const f32x4*)(xb + ro + bj * HALF + 4);
                    *(f32x4*)(yb + ro + bj * HALF) = x0 * DN_ALPHA + acc[ai][bj][m][0]; *(f32x4*)(yb + ro + bj * HALF + 4) = x1 * DN_ALPHA + acc[ai][bj][m][1]; } }
    }
};
}

__device__ __forceinline__ float wave_sum(float v) {
#pragma unroll
    for (int o = 1; o < 64; o <<= 1) v += __shfl_xor(v, o);
    return v;
}

__device__ __forceinline__ void simple_select_row(LAS unsigned char* lds, int row, unsigned long long* mrow, const bf16* QI_, const float* SM_, const bf16* KI_, const float* cache_ik_) {
    const int tid_ = threadIdx.x, lane_ = tid_ & 63, wave_ = tid_ >> 6;
    LAS float* sc = (LAS float*)(lds + RING_OFF);
    LAS float* qv = (LAS float*)(lds + RING_OFF + 16384);
    const bool samp = row >= NTP; const int b = samp ? (row - NTP) / DEC_SEQ : row / SEQ; const int q = samp ? (row - NTP) % DEC_SEQ : row % SEQ;
    const int S = samp ? PAST_LEN + DEC_SEQ : ((q >> 6) + 1) * 64;
    if (S <= TOPK_MAX) { if (tid_ < 32) mrow[tid_] = (tid_ < (S >> 6)) ? ~0ull : 0ull; return; }
    qv[tid_] = bf2f(QI_[(size_t)row * 512 + tid_]); if (tid_ < 8) qv[512 + tid_] = SM_[(size_t)row * 16 + tid_] * 0.35355339059327373f;
    __syncthreads();
    const int nIt = (S + 511) / 512;
    for (int i = 0; i < nIt; ++i) { const int s = tid_ + 512 * i;
        if (s < S) { float kf[64];
            if (samp && s < PAST_LEN) { const float* kr = cache_ik_ + ((size_t)b * PAST_LEN + s) * 64;
#pragma unroll
                for (int j = 0; j < 64; ++j) kf[j] = kr[j]; }
            else { const bf16* kr = KI_ + (samp ? (size_t)NTP + (size_t)b * DEC_SEQ + (s - PAST_LEN) : (size_t)b * SEQ + s) * 64;
#pragma unroll
                for (int j = 0; j < 64; ++j) kf[j] = bf2f(kr[j]); }
            float a = 0.f;
#pragma unroll
            for (int h = 0; h < 8; ++h) { float d = 0.f;
#pragma unroll
                for (int j = 0; j < 64; ++j) d += qv[h * 64 + j] * kf[j];
                a += qv[512 + h] * fmaxf(d, 0.f); }
            sc[s] = a; } }
    __syncthreads();
    for (int i = 0; i < nIt; ++i) { const int s = tid_ + 512 * i; bool keep = false;
        if (s < S) { const int v = __float_as_int(sc[s]); const int vk = v ^ ((v >> 31) & 0x7fffffff); int rank = 0;
            for (int j = 0; j < S; ++j) { const int u = __float_as_int(sc[j]); const int uk = u ^ ((u >> 31) & 0x7fffffff); rank += (uk > vk) || (uk == vk && j < s); } keep = rank < TOPK_MAX; }
        const unsigned long long bm = __ballot(keep);
        if (lane_ == 0 && (wave_ + 8 * i) * 64 < S) mrow[wave_ + 8 * i] = bm; }
    if (!samp) { const int nw = S >> 6; if (tid_ >= nw && tid_ < 32) mrow[tid_] = 0ull; }
    __syncthreads();
}
__device__ __forceinline__ void simple_attn_task(int row, int h, int dc, const unsigned long long* mrow, const bf16* QB_, const bf16* KBc_, const bf16* VBc_, const float* cache_k_, const float* cache_v_,
                                                  const float* k_sample_, const float* v_sample_, const float* rel_bias_, bf16* orow) {
    const bool samp = row >= NTP; const int b = samp ? (row - NTP) / DEC_SEQ : row / SEQ; const int q = samp ? (row - NTP) % DEC_SEQ : row % SEQ;
    const int S = samp ? PAST_LEN + DEC_SEQ : ((q >> 6) + 1) * 64; const int qpos = samp ? PAST_LEN + q : q;
    const bf16* qr = QB_ + (size_t)row * 1024 + h * 128;
    float mx = -INFINITY, sum = 0.f, o[16];
#pragma unroll
    for (int i = 0; i < 16; ++i) o[i] = 0.f;
    for (int w = 0; w * 64 < S; ++w) { unsigned long long bits = mrow[w];
        while (bits) { const int s = w * 64 + __builtin_ctzll(bits); bits &= bits - 1;
            float d = 0.f; float vv[16];
            if (samp) { const float* kr = (s < PAST_LEN) ? cache_k_ + ((size_t)b * PAST_LEN + s) * 1024 + h * 128 : k_sample_ + ((size_t)b * DEC_SEQ + (s - PAST_LEN)) * 1024 + h * 128;
                const float* vr = (s < PAST_LEN) ? cache_v_ + ((size_t)b * PAST_LEN + s) * 1024 + h * 128 + dc * 16 : v_sample_ + ((size_t)b * DEC_SEQ + (s - PAST_LEN)) * 1024 + h * 128 + dc * 16;
#pragma unroll 8
                for (int j = 0; j < 128; ++j) d += bf2f(qr[j]) * kr[j];
#pragma unroll
                for (int i = 0; i < 16; ++i) vv[i] = vr[i]; }
            else { const bf16* kr = KBc_ + ((size_t)b * SEQ + s) * 1024 + h * 128; const bf16* vr = VBc_ + ((size_t)b * SEQ + s) * 1024 + h * 128 + dc * 16;
#pragma unroll 8
                for (int j = 0; j < 128; ++j) d += bf2f(qr[j]) * bf2f(kr[j]);
#pragma unroll
                for (int i = 0; i < 16; ++i) vv[i] = bf2f(vr[i]); }
            const float lg = d * 0.08838834764831845f + rel_bias_[t5b(s - qpos) * 8 + h];
            if (lg > mx) { const float f = __expf(mx - lg); sum *= f;
#pragma unroll
                for (int i = 0; i < 16; ++i) o[i] *= f; mx = lg; }
            const float p = __expf(lg - mx); sum += p;
#pragma unroll
            for (int i = 0; i < 16; ++i) o[i] += p * vv[i]; } }
    const float inv = 1.0f / sum;
#pragma unroll
    for (int i = 0; i < 16; ++i) orow[i] = (bf16)f2bf(o[i] * inv);
}


template <int NW>
__device__ __forceinline__ unsigned long long wave_select(LAS const int* row, int nW, int lane_) {
    static_assert(TOPK_MAX == 256, "the 4th-largest bracket assumes TOPK_MAX = 64 lanes x 4");
    int v[NW]; int t0 = (int)0x80000000, t1 = t0, t2 = t0, t3 = t0;
#pragma unroll
    for (int i = 0; i < NW; ++i) { v[i] = (i < nW) ? row[lane_ + 64 * i] : (int)0x80000000;
        int x = v[i], y; y = min(t0, x); t0 = max(t0, x); x = y; y = min(t1, x); t1 = max(t1, x); x = y; y = min(t2, x); t2 = max(t2, x); x = y; t3 = max(t3, x); }
    int vmx = t3, vmn = t3;
#pragma unroll
    for (int o_ = 1; o_ < 64; o_ <<= 1) { vmx = max(vmx, __shfl_xor(vmx, o_)); vmn = min(vmn, __shfl_xor(vmn, o_)); }
    int lo_ = __builtin_amdgcn_readfirstlane(vmn), hi_ = __builtin_amdgcn_readfirstlane(vmx); bool exact = false; int T = lo_;
    while (lo_ < hi_) { const int mid = lo_ + (int)((((unsigned)hi_ - (unsigned)lo_) + 1u) >> 1); int cnt = 0;
#pragma unroll
        for (int i = 0; i < NW; ++i) { cnt += __builtin_popcountll(__ballot(v[i] >= mid)); if ((i & 3) == 3) __builtin_amdgcn_sched_barrier(0); }
        if (cnt == TOPK_MAX) { exact = true; T = mid; break; }
        if (cnt > TOPK_MAX) lo_ = mid; else hi_ = mid - 1; }
    if (!exact) T = lo_;
    int need = TOPK_MAX;
    if (!exact) { int cgt = 0;
#pragma unroll
        for (int i = 0; i < NW; ++i) { cgt += __builtin_popcountll(__ballot(v[i] > T)); if ((i & 3) == 3) __builtin_amdgcn_sched_barrier(0); }
        need = TOPK_MAX - cgt; }
    unsigned long long myw = 0ull; int running = 0; const unsigned long long lt = (1ull << lane_) - 1ull;
#pragma unroll
    for (int i = 0; i < NW; ++i) { bool sel;
        if (exact) sel = v[i] >= T;
        else { const bool eq = v[i] == T; const unsigned long long em = __ballot(eq); sel = (v[i] > T) || (eq && running + __builtin_popcountll(em & lt) < need); running += __builtin_popcountll(em); }
        const unsigned long long wd = __ballot(sel); if (lane_ == i) myw = wd; __builtin_amdgcn_sched_barrier(0); }
    return myw;
}
__device__ __forceinline__ void sample_select_row(LAS unsigned char* lds, int row, unsigned long long* mrow, const bf16* QI_, const float* SM_, const bf16* KI_, const float* cache_ik_) {
    const int tid_ = threadIdx.x, lane_ = tid_ & 63, wave_ = __builtin_amdgcn_readfirstlane(tid_ >> 6);
    LAS int* sck = (LAS int*)(lds + RING_OFF);
    LAS float* qv = (LAS float*)(lds + RING_OFF + 16384);
    const int b = (row - NTP) / DEC_SEQ; constexpr int S = PAST_LEN + DEC_SEQ;
    qv[tid_] = bf2f(QI_[(size_t)row * 512 + tid_]); if (tid_ < 8) qv[512 + tid_] = SM_[(size_t)row * 16 + tid_] * 0.35355339059327373f;
    __syncthreads();
#pragma unroll 1
    for (int i = 0; i < 5; ++i) { const int s = tid_ + 512 * i;
        if (s < 2112) { int key = (int)0x80000000;
            if (s < S) { float kf[64];
                if (s < PAST_LEN) { const float* kr = cache_ik_ + ((size_t)b * PAST_LEN + s) * 64;
#pragma unroll
                    for (int j = 0; j < 64; ++j) kf[j] = kr[j]; }
                else { const bf16* kr = KI_ + ((size_t)NTP + (size_t)b * DEC_SEQ + (s - PAST_LEN)) * 64;
#pragma unroll
                    for (int j = 0; j < 64; ++j) kf[j] = bf2f(kr[j]); }
                float a = 0.f;
#pragma unroll
                for (int h = 0; h < 8; ++h) { float d = 0.f;
#pragma unroll
                    for (int j = 0; j < 64; ++j) d += qv[h * 64 + j] * kf[j];
                    a += qv[512 + h] * fmaxf(d, 0.f); }
                const int kb_ = __float_as_int(a); key = kb_ ^ ((kb_ >> 31) & 0x7fffffff); }
            sck[s] = key; } }
    __syncthreads();
    if (wave_ == 0) { const unsigned long long myw = wave_select<33>(sck, 33, lane_); if (lane_ < 33) mrow[lane_] = myw; }
    __syncthreads();
}
__device__ __forceinline__ void sample_attn_row(LAS unsigned char* lds, int b, int r, const unsigned long long* mrow, bf16* qo_row  , const float* cache_k_, const float* cache_v_,
                                                 const float* k_new, const float* v_new  , const float* rel_bias_) {
    const int tid_ = threadIdx.x, lane_ = tid_ & 63, h = __builtin_amdgcn_readfirstlane(tid_ >> 6);
    LAS int* idx = (LAS int*)(lds + RING_OFF);
    LAS float* qf = (LAS float*)(lds + RING_OFF + 1024) + h * 128;
    if (h == 0) { int base = 0; const unsigned long long lt = (1ull << lane_) - 1ull;
        for (int w = 0; w < 33; ++w) { const unsigned long long bits = mrow[w]; if ((bits >> lane_) & 1ull) idx[base + __builtin_popcountll(bits & lt)] = 64 * w + lane_; base += __builtin_popcountll(bits); } }
    qf[lane_] = bf2f(qo_row[h * 128 + lane_]); qf[64 + lane_] = bf2f(qo_row[h * 128 + 64 + lane_]);
    __syncthreads();
    const int qpos = PAST_LEN + r; float lg[4]; int sk[4];
#pragma unroll
    for (int rnd = 0; rnd < 4; ++rnd) { const int s = idx[64 * rnd + lane_]; sk[rnd] = s;
        const float* kr = (s < PAST_LEN) ? cache_k_ + ((size_t)b * PAST_LEN + s) * 1024 + h * 128 : k_new + (size_t)(s - PAST_LEN) * 1024 + h * 128;
        float d = 0.f;
#pragma unroll 8
        for (int d4 = 0; d4 < 32; ++d4) { const f32x4 kk = *(const f32x4*)(kr + 4 * d4); const f32x4 qq = *(LAS const f32x4*)(qf + 4 * d4); d += (kk.x * qq.x + kk.y * qq.y) + (kk.z * qq.z + kk.w * qq.w); }
        lg[rnd] = d * 0.08838834764831845f + rel_bias_[t5b(s - qpos) * 8 + h]; }
    float mx = fmaxf(fmaxf(lg[0], lg[1]), fmaxf(lg[2], lg[3]));
#pragma unroll
    for (int o_ = 1; o_ < 64; o_ <<= 1) mx = fmaxf(mx, __shfl_xor(mx, o_));
    float p[4], sum = 0.f;
#pragma unroll
    for (int rnd = 0; rnd < 4; ++rnd) { p[rnd] = __expf(lg[rnd] - mx); sum += p[rnd]; }
    sum = wave_sum(sum);
    float a0 = 0.f, a1 = 0.f;
#pragma unroll
    for (int rnd = 0; rnd < 4; ++rnd) {
#pragma unroll 8
        for (int j = 0; j < 64; ++j) { const float pj = __int_as_float(__builtin_amdgcn_readlane(__float_as_int(p[rnd]), j)); const int sj = __builtin_amdgcn_readlane(sk[rnd], j);
            const float* vr = (sj < PAST_LEN) ? cache_v_ + ((size_t)b * PAST_LEN + sj) * 1024 + h * 128 : v_new + (size_t)(sj - PAST_LEN) * 1024 + h * 128;
            const float2 vv = *(const float2*)(vr + 2 * lane_); a0 += pj * vv.x; a1 += pj * vv.y; } }
    const float inv = 1.0f / sum;
    *(unsigned*)(qo_row + h * 128 + 2 * lane_) = pk2(a0 * inv, a1 * inv);
    __syncthreads();
}

typedef const __attribute__((address_space(4))) Args* kargp_t;
#define MK_ARGS kargp_t ap_ = (kargp_t)__builtin_amdgcn_kernarg_segment_ptr(); asm volatile("" : "+s"(ap_))
#define args (*ap_)
__global__ void __launch_bounds__(NWAVES * 64, 2) mk_fwd(Args kargs_by_value) {
    extern __shared__ __attribute__((aligned(16))) unsigned char lds_raw[];
    LAS unsigned char* lds = (LAS unsigned char*)lds_raw;
    int lo, hi; unsigned* barw;
    { MK_ARGS; lo = args.ph_lo; hi = args.ph_hi; barw = (unsigned*)((gu32*)(args.ws + WS_CTL) + CW_BAR); }
    volatile LAS unsigned* MISC = (volatile LAS unsigned*)(lds + MISC_OFF);
    for (int u = threadIdx.x; u < (LDS_BYTES - LDSCTL_OFF) / 4; u += NWAVES * 64) ((LAS unsigned*)(lds + LDSCTL_OFF))[u] = 0u;
    __syncthreads();
    XcdBarrier bar = xcd_barrier_post(barw, MISC + 8);
#ifndef DUPMASK
#define DUPMASK 0
#endif
#ifndef PHMASK
#define PHMASK 0x3ff
#endif
#define IN(k) (((PHMASK >> (k)) & 1) && lo <= (k) && (k) < hi)
#define GBAR() xcd_barrier(bar)
#define WMIX ((bf16*)(args.ws + WS_WMIX))
#define WMRG ((bf16*)(args.ws + WS_WMRG))
#define WAB ((bf16*)(args.ws + WS_WAB))
#define WO ((bf16*)(args.ws + WS_WO))
#define XB ((bf16*)(args.ws + WS_XB))
#define QA ((bf16*)(args.ws + WS_QA))
#define KA ((bf16*)(args.ws + WS_KA))
#define VA ((bf16*)(args.ws + WS_VA))
#define QB ((bf16*)(args.ws + WS_QB))
#define QI ((bf16*)(args.ws + WS_QI))
#define KI ((bf16*)(args.ws + WS_KI))
#define SM ((float*)(args.ws + WS_SM))
#define MASK ((unsigned long long*)(args.ws + WS_MASK))
#define MASKS ((unsigned long long*)(args.ws + WS_MASKS))
#define HST ((float*)(args.ws + WS_HST))
#define BC ((float*)(args.ws + WS_BC))
#define WV ((float*)(args.ws + WS_WV))
#define CMX ((float*)(args.ws + WS_CMX))
#define CHS ((float*)(args.ws + WS_CHS))
#define MCH (CHS + 2 * NCHK)
#define SMATP ((float*)(args.ws + WS_SMAT))
#define SMATS (SMATP + 128 * 4096)
#define CB ((float*)(args.ws + WS_CB))
#define NBf ((float*)(args.ws + WS_NB))
#define HA VA
#define OB QB
#define BR QA
#define SGA ((bf16*)(args.ws + WS_HA))
#define SGB KBc
#define MX XB
#define y_prompt (args.out)
#define y_sample (y_prompt + (size_t)NTP * 1024)
#define k_prompt (y_sample + (size_t)NTS * 1024)
#define v_prompt (k_prompt + (size_t)NTP * 1024)
#define ik_prompt (v_prompt + (size_t)NTP * 1024)
#define C_prompt (ik_prompt + (size_t)NTP * 64)
#define n_prompt (C_prompt + (size_t)BATCH * 4 * 65536)
#define m_prompt (n_prompt + (size_t)BATCH * 1024)
#define k_sample (m_prompt + BATCH * 4)
#define v_sample (k_sample + (size_t)NTS * 1024)
#define ik_sample (v_sample + (size_t)NTS * 1024)
#define C_sample (ik_sample + (size_t)NTS * 64)
#define n_sample (C_sample + (size_t)DEC_BATCH * 4 * 65536)
#define m_sample (n_sample + (size_t)DEC_BATCH * 1024)
#define KBc ((bf16*)y_prompt)
#define VBc (KBc + (size_t)NTP * 1024)
#define cache_k (args.in[2])
#define cache_v (args.in[3])
#define cache_ik (args.in[4])
#define state_C (args.in[5])
#define state_n (args.in[6])
#define state_m (args.in[7])
#define b_gates (args.in[9])
#define a_norm_g (args.in[10])
#define rel_bias (args.in[14])
#define ln_g (args.in[15])
#define ln_b (args.in[16])
#define gtid ({ int t__ = (int)threadIdx.x; asm volatile("" : "+v"(t__)); (long)blockIdx.x * (NWAVES * 64) + (long)t__; })
#define GT ((long)gridDim.x * (NWAVES * 64))
#define gw (vcu * NWAVES + wave)
#define NGW ((int)gridDim.x * NWAVES)
#define tid ((int)threadIdx.x)
#define lane ((int)(threadIdx.x & 63))
#define wave (__builtin_amdgcn_readfirstlane((int)(threadIdx.x >> 6)))
#define G ((int)gridDim.x)
#define vcu ((G % 8 == 0) ? ((int)blockIdx.x % 8) * (G / 8) + (int)blockIdx.x / 8 : (int)blockIdx.x)

    if (IN(0))
#if (DUPMASK >> 0) & 1
    for (int rep_ = 0; rep_ < 2; ++rep_)
#endif
    { MK_ARGS;
        P0Args a{args.in[0], args.in[1], args.in[8], args.in[11], args.in[12], args.in[13], XB, WMIX, WMRG, WAB, WO};
        p0_prologue(a, lds, vcu, G, wave, lane);
        GBAR();
    }
    if (IN(1))
#if (DUPMASK >> 1) & 1
    for (int rep_ = 0; rep_ < 2; ++rep_)
#endif
    { MK_ARGS;
        pg8::Gemm g{XB, WMIX, NTOK, N_MIX, 1024}; pg8::StaticOrder S; S.init(NTOK, N_MIX, G, (int)blockIdx.x);
        pg8::EpiMix E{QA, KBc, QI, KI, SM, k_prompt, k_sample, ik_prompt, ik_sample};
        pg8::gemm_phase<pg8::EpiMix, pg8::StaticOrder, true, true>(lds + RING_OFF, g, S, E);
        GBAR();
    }
    if (IN(2))
#if (DUPMASK >> 2) & 1
    for (int rep_ = 0; rep_ < 2; ++rep_)
#endif
    { MK_ARGS;
        static_assert(ml::L_END <= LDSCTL_OFF, "mLSTM LDS image");
#ifdef PROBE_ML
#define HAREF ((bf16*)(args.ws + WS_HA))
        for (long t = gtid; t < NCHK; t += GT) {
            int h, L; long tok0;
            if (t < 4096) { const int b = (int)(t >> 7); h = (int)((t >> 5) & 3); const int c = (int)(t & 31); tok0 = (long)b * SEQ + c * 64; L = 64; }
            else { const int b = (int)((t - 4096) >> 2); h = (int)((t - 4096) & 3); tok0 = NTP + (long)b * DEC_SEQ; L = DEC_SEQ; }
            const float bi = b_gates[h], bfg = b_gates[4 + h]; float cum = 0.f, cmax = -INFINITY;
            for (int l = 0; l < L; ++l) { const long tok = tok0 + l; const float ig = SM[tok * 16 + 8 + h] + bi; const float lf = logsig(SM[tok * 16 + 12 + h] + bfg);
                cum += lf; const float w = ig - cum; cmax = fmaxf(cmax, w); BC[tok * 4 + h] = cum; WV[tok * 4 + h] = w; CMX[tok * 4 + h] = cmax; }
            CHS[2 * t] = cum; CHS[2 * t + 1] = cmax;
        }
        GBAR();
        for (long t = gtid; t < BATCH * 4 + DEC_BATCH * 4; t += GT) {
            if (t < BATCH * 4) { float m = 0.f; for (int c = 0; c < 32; ++c) { const long i = t * 32 + c; MCH[i] = m; m = CHS[2 * i] + fmaxf(m, CHS[2 * i + 1]); } m_prompt[t] = m; }
            else { const long j = t - BATCH * 4; const long i = 4096 + j; float m = state_m[j]; MCH[i] = m; m = CHS[2 * i] + fmaxf(m, CHS[2 * i + 1]); m_sample[j] = m; }
        }
        GBAR();
        for (int c = 0; c < 32; ++c) {
            const long nSp = 128L * 4096, nSs = (c == 0) ? 64L * 1024 : 0;
            for (long t = gtid; t < nSp + nSs; t += GT) {
                int bh, l, s, L; long tok0; float* dst;
                if (t < nSp) { bh = (int)(t >> 12); l = (int)((t >> 6) & 63); s = (int)(t & 63); L = 64; tok0 = (long)(bh >> 2) * SEQ + c * 64; dst = SMATP + t; }
                else { const long u = t - nSp; bh = (int)(u >> 10); l = (int)((u >> 5) & 31); s = (int)(u & 31); L = 32; tok0 = NTP + (long)(bh >> 2) * DEC_SEQ; dst = SMATS + u; }
                const int h = bh & 3; float val = 0.f;
                if (s <= l) { const long tl = tok0 + l, ts = tok0 + s; const bf16* q = QA + tl * 1024 + h * 256; const bf16* k = KA + ts * 1024 + h * 256;
                    float d = 0.f; for (int i = 0; i < 256; ++i) d += bf2f(q[i]) * bf2f(k[i]);
                    const long ci = (t < nSp) ? (long)bh * 32 + c : 4096 + bh;
                    val = d * __expf(WV[ts * 4 + h] - fmaxf(MCH[ci], CMX[tl * 4 + h])); }
                *dst = val;
            }
            GBAR();
            const long nHp = 32L * 64 * 1024, nHs = (c == 0) ? 16L * 32 * 1024 : 0, nCp = 128L * 65536, nCs = (c == 0) ? 64L * 65536 : 0;
            for (long t = gtid; t < nHp + nHs + nCp + nCs; t += GT) {
                if (t < nHp + nHs) {
                    int b, l, h, dv, L; long tok0, ci; const float* Sr; const float* Cm; const float* nv; bool zero = false;
                    if (t < nHp) { b = (int)(t >> 16); l = (int)((t >> 10) & 63); h = (int)((t >> 8) & 3); dv = (int)(t & 255); L = 64; tok0 = (long)b * SEQ + c * 64; ci = (long)(b * 4 + h) * 32 + c;
                        Sr = SMATP + ((long)(b * 4 + h) * 64 + l) * 64; Cm = CB + (size_t)(c & 1) * 128 * 65536 + (size_t)(b * 4 + h) * 65536; nv = NBf + (c & 1) * 128 * 256 + (b * 4 + h) * 256; zero = (c == 0); }
                    else { const long u = t - nHp; b = (int)(u >> 15); l = (int)((u >> 10) & 31); h = (int)((u >> 8) & 3); dv = (int)(u & 255); L = 32; tok0 = NTP + (long)b * DEC_SEQ; ci = 4096 + b * 4 + h;
                        Sr = SMATS + ((long)(b * 4 + h) * 32 + l) * 32; Cm = state_C + (size_t)(b * 4 + h) * 65536; nv = state_n + (b * 4 + h) * 256; }
                    const long tl = tok0 + l; const bf16* q = QA + tl * 1024 + h * 256;
                    const float mc = MCH[ci], Ml = fmaxf(mc, CMX[tl * 4 + h]), bl = BC[tl * 4 + h]; const float inter = __expf(mc - Ml);
                    float num = 0.f, den = 0.f;
                    for (int s = 0; s <= l; ++s) { const float sv = Sr[s]; num += sv * bf2f(VA[(tok0 + s) * 1024 + h * 256 + dv]); den += sv; }
                    if (!zero) { float qc = 0.f, qn = 0.f; for (int i = 0; i < 256; ++i) { const float qi_ = bf2f(q[i]); qc += qi_ * Cm[(size_t)i * 256 + dv]; qn += qi_ * nv[i]; } num += inter * qc; den += inter * qn; }
                    const float hv = num / fmaxf(fabsf(den), __expf(-(bl + Ml)));
                    HAREF[tl * 1024 + h * 256 + dv] = (bf16)f2bf(hv);
                } else {
                    const long u0 = t - (nHp + nHs); int bh, dk, dv, L; long tok0, ci; const float* Cs; const float* ns; float* Cd; float* nd; bool zero = false;
                    if (u0 < nCp) { bh = (int)(u0 >> 16); dk = (int)((u0 >> 8) & 255); dv = (int)(u0 & 255); L = 64; tok0 = (long)(bh >> 2) * SEQ + c * 64; ci = (long)bh * 32 + c; zero = (c == 0);
                        Cs = CB + (size_t)(c & 1) * 128 * 65536 + (size_t)bh * 65536; ns = NBf + (c & 1) * 128 * 256 + bh * 256;
                        Cd = (c == 31) ? C_prompt + (size_t)bh * 65536 : CB + (size_t)((c + 1) & 1) * 128 * 65536 + (size_t)bh * 65536; nd = (c == 31) ? n_prompt + bh * 256 : NBf + ((c + 1) & 1) * 128 * 256 + bh * 256; }
                    else { const long u = u0 - nCp; bh = (int)(u >> 16); dk = (int)((u >> 8) & 255); dv = (int)(u & 255); L = 32; tok0 = NTP + (long)(bh >> 2) * DEC_SEQ; ci = 4096 + bh;
                        Cs = state_C + (size_t)bh * 65536; ns = state_n + bh * 256; Cd = C_sample + (size_t)bh * 65536; nd = n_sample + bh * 256; }
                    const int h = bh & 3; const float mc = MCH[ci]; const float Mlast = fmaxf(mc, CMX[(tok0 + L - 1) * 4 + h]); const float decay = __expf(mc - Mlast);
                    float aC = 0.f, an = 0.f;
                    for (int s = 0; s < L; ++s) { const long ts = tok0 + s; const float wsv = __expf(WV[ts * 4 + h] - Mlast); const float kk = bf2f(KA[ts * 1024 + h * 256 + dk]);
                        aC += wsv * kk * bf2f(VA[ts * 1024 + h * 256 + dv]); an += wsv * kk; }
                    Cd[(size_t)dk * 256 + dv] = (zero ? 0.f : decay * Cs[(size_t)dk * 256 + dv]) + aC;
                    if (dv == 0) nd[dk] = (zero ? 0.f : decay * ns[dk]) + an;
                }
            }
            GBAR();
        }
#endif
#define ML_RS(p, bytes) __builtin_amdgcn_make_buffer_rsrc((void*)(p), (short)0, (int)(bytes), 0x00020000)
        if (vcu < BATCH * 8) { const int bh = vcu >> 1, dvh = vcu & 1, b = bh >> 2, h = bh & 3; const size_t t0 = (size_t)b * SEQ;
            ml::Item it; it.q = ML_RS(QA + t0 * 1024 + h * 256, SEQ * 2048); it.k = ML_RS(KA + t0 * 1024 + h * 256, SEQ * 2048); it.v = ML_RS(VA + t0 * 1024 + h * 256 + dvh * 128, SEQ * 2048); it.sm = ML_RS(SM + t0 * 16, SEQ * 64);
            it.C0 = ML_RS(C_prompt, 4); it.has0 = false; it.n0 = nullptr; it.m0 = 0.f; it.Cout = ML_RS(C_prompt + (size_t)bh * 65536 + dvh * 128, 65536 * 4);
            it.nout = dvh == 0 ? n_prompt + bh * 256 : nullptr; it.mout = dvh == 0 ? m_prompt + bh : nullptr;
            it.head = h; it.nchunk = SEQ / CHUNK; it.L = CHUNK; it.bi = b_gates[h]; it.bf = b_gates[4 + h]; it.hout = it.v;
#if (DUPMASK >> 2) & 1
            { float* no_ = it.nout; float* mo_ = it.mout;
              for (int dry_ = 1; dry_ >= 0; --dry_) { it.hout = dry_ ? ML_RS(args.ws + WS_HA, SEQ * 2048) : it.v; it.Cout = dry_ ? ML_RS(args.ws + WS_HA + 8 * MiB + (size_t)vcu * 65536 * 4, 65536 * 4) : ML_RS(C_prompt + (size_t)bh * 65536 + dvh * 128, 65536 * 4);
                  it.nout = dry_ ? nullptr : no_; it.mout = dry_ ? nullptr : mo_; ml::run_item(lds, it); } } }
#else
            ml::run_item(lds, it); }
#endif
        if (vcu < DEC_BATCH * 8) { const int bh = vcu >> 1, dvh = vcu & 1, b = bh >> 2, h = bh & 3; const size_t t0 = (size_t)NTP + (size_t)b * DEC_SEQ;
            ml::Item it; it.q = ML_RS(QA + t0 * 1024 + h * 256, DEC_SEQ * 2048); it.k = ML_RS(KA + t0 * 1024 + h * 256, DEC_SEQ * 2048); it.v = ML_RS(VA + t0 * 1024 + h * 256 + dvh * 128, DEC_SEQ * 2048); it.sm = ML_RS(SM + t0 * 16, DEC_SEQ * 64);
            it.C0 = ML_RS(state_C + (size_t)bh * 65536 + dvh * 128, 65536 * 4); it.has0 = true; it.n0 = state_n + bh * 256; it.m0 = state_m[bh]; it.Cout = ML_RS(C_sample + (size_t)bh * 65536 + dvh * 128, 65536 * 4);
            it.nout = dvh == 0 ? n_sample + bh * 256 : nullptr; it.mout = dvh == 0 ? m_sample + bh : nullptr;
            it.head = h; it.nchunk = 1; it.L = DEC_SEQ; it.bi = b_gates[h]; it.bf = b_gates[4 + h]; it.hout = it.v;
            ml::run_item(lds, it); }
#undef ML_RS
#ifdef PROBE_ML
        GBAR();
#endif
#ifdef PROBE_ML
        { float num = 0.f, den = 0.f;
          for (long t = gtid; t < (long)NTOK * 1024; t += GT) { const float a = bf2f(HA[t]), r = bf2f(HAREF[t]); num += (a - r) * (a - r); den += r * r; }
          num = wave_sum(num); den = wave_sum(den);
          if (lane == 0) { atomicAdd((float*)(args.ws + WS_CTL) + 8, num); atomicAdd((float*)(args.ws + WS_CTL) + 9, den); } }
#endif
    }
    if (IN(3))
#if (DUPMASK >> 3) & 1
    for (int rep_ = 0; rep_ < 2; ++rep_)
#endif
    { MK_ARGS;
        {
            typedef short bfx8 __attribute__((ext_vector_type(8))); typedef float f16v __attribute__((ext_vector_type(16)));
            LAS int* sck = (LAS int*)(lds + RING_OFF);
            const int hi = lane >> 5, r32 = lane & 31;
            for (int w4 = 0; w4 < 4; ++w4) {
                const int bW = vcu >> 3, jW = vcu & 7; const int cW = (w4 == 0) ? jW : (w4 == 1) ? 15 - jW : (w4 == 2) ? 16 + jW : 31 - jW;
                if (vcu >= BATCH * 8) break;
                const int S = 64 * (cW + 1), nW = cW + 1; const long tok0 = (long)bW * SEQ + 64 * cW;
                if (S <= TOPK_MAX) {
                    for (int k = 0; k < 8; ++k) { if (lane < 32) MASK[(size_t)(tok0 + wave * 8 + k) * 32 + lane] = (lane < nW) ? ~0ull : 0ull; }
                    continue; }
                { LAS unsigned char* qil = lds + RING_OFF + 65536; LAS float* sml = (LAS float*)(lds + RING_OFF + 65536 + 73728);
#pragma unroll
                  for (int i = 0; i < 8; ++i) { const int p_ = tid + 512 * i, row_ = p_ >> 6, wi_ = p_ & 63;
                      *(LAS v4u*)(qil + row_ * 1152 + (wi_ >> 3) * 144 + (wi_ & 7) * 16) = *(const v4u*)(QI + (size_t)(tok0 + row_) * 512 + wi_ * 8); }
                  sml[tid] = SM[(size_t)(tok0 + (tid >> 3)) * 16 + (tid & 7)] * 0.35355339059327373f;
                  asm volatile("s_waitcnt vmcnt(0) lgkmcnt(0)" ::: "memory"); __builtin_amdgcn_s_barrier(); asm volatile("" ::: "memory"); }
                bfx8 bfr[8][4];
#pragma unroll
                for (int i = 0; i < 8; ++i) { const int kt = wave + 8 * i;
                    if (kt < 2 * nW) { const bf16* kp = KI + ((size_t)bW * SEQ + 32 * kt + r32) * 64 + hi * 8;
#pragma unroll
                        for (int ks = 0; ks < 4; ++ks) bfr[i][ks] = *(const bfx8*)(kp + ks * 16); }
                    else {
#pragma unroll
                        for (int ks = 0; ks < 4; ++ks) bfr[i][ks] = (bfx8){0, 0, 0, 0, 0, 0, 0, 0}; } }
                for (int rd = 0; rd < 8; ++rd) {
                    bfx8 afr[2][4]; float wgt[2][16];
                    { const int blk = r32 >> 2; const int qa_ = 2 * (blk & 1) + (blk >> 2), ha_ = 4 * ((blk >> 1) & 1) + (r32 & 3);
                      LAS const unsigned char* qil = lds + RING_OFF + 65536; LAS const float* sml = (LAS const float*)(lds + RING_OFF + 65536 + 73728);
#pragma unroll
                      for (int rt = 0; rt < 2; ++rt) { LAS const unsigned char* qp = qil + (8 * rd + 4 * rt + qa_) * 1152 + ha_ * 144 + hi * 16;
#pragma unroll
                          for (int ks = 0; ks < 4; ++ks) afr[rt][ks] = *(LAS const bfx8*)(qp + ks * 32);
#pragma unroll
                          for (int qq = 0; qq < 2; ++qq) { LAS const float* wp = sml + (8 * rd + 4 * rt + 2 * hi + qq) * 8;
                              const f32x4 w0 = *(LAS const f32x4*)wp, w1 = *(LAS const f32x4*)(wp + 4);
                              wgt[rt][8 * qq + 0] = w0[0]; wgt[rt][8 * qq + 1] = w0[1]; wgt[rt][8 * qq + 2] = w0[2]; wgt[rt][8 * qq + 3] = w0[3];
                              wgt[rt][8 * qq + 4] = w1[0]; wgt[rt][8 * qq + 5] = w1[1]; wgt[rt][8 * qq + 6] = w1[2]; wgt[rt][8 * qq + 7] = w1[3]; } } }
#pragma unroll
                    for (int i8 = 0; i8 < 8; ++i8) { const int kt = wave + 8 * i8; if (kt < 2 * nW) {
#pragma unroll
                        for (int rt = 0; rt < 2; ++rt) { f16v acc = {};
#pragma unroll
                            for (int ks = 0; ks < 4; ++ks) acc = __builtin_amdgcn_mfma_f32_32x32x16_bf16(afr[rt][ks], bfr[i8][ks], acc, 0, 0, 0);
                            float sA = 0.f, sB = 0.f;
#pragma unroll
                            for (int i = 0; i < 8; ++i) { sA += wgt[rt][i] * fmaxf(acc[i], 0.f); sB += wgt[rt][8 + i] * fmaxf(acc[8 + i], 0.f); }
                            const int kA = __float_as_int(sA), kB = __float_as_int(sB);
                            sck[(4 * rt + 2 * hi) * 2048 + 32 * kt + r32] = kA ^ ((kA >> 31) & 0x7fffffff);
                            sck[(4 * rt + 2 * hi + 1) * 2048 + 32 * kt + r32] = kB ^ ((kB >> 31) & 0x7fffffff); }
                    } }
                    asm volatile("s_waitcnt lgkmcnt(0)" ::: "memory"); __builtin_amdgcn_s_barrier(); asm volatile("" ::: "memory");
                    { const unsigned long long myw = (nW <= 16) ? wave_select<16>(sck + wave * 2048, nW, lane) : wave_select<32>(sck + wave * 2048, nW, lane); if (lane < 32) MASK[(size_t)(tok0 + 8 * rd + wave) * 32 + lane] = myw; }
                    asm volatile("s_waitcnt lgkmcnt(0)" ::: "memory"); __builtin_amdgcn_s_barrier(); asm volatile("" ::: "memory");
                }
            }
        }
        for (int row = NTP + vcu; row < NTOK; row += G) sample_select_row(lds, row, MASKS + (size_t)(row - NTP) * 40, QI, SM, KI, cache_ik);
        GBAR();
    }
#ifdef PROBE_ATT
    if (IN(4)) { MK_ARGS;
        unsigned long long* MREF = (unsigned long long*)(args.ws + WS_END); bf16* OREF = (bf16*)(args.ws + WS_END + 2 * MiB);
        for (int pr = vcu; pr < 4096; pr += G) { const int row = pr < 2048 ? pr : 31 * SEQ + (pr - 2048); simple_select_row(lds, row, MREF + (size_t)pr * 32, QI, SM, KI, cache_ik); }
        GBAR();
        for (long t = gtid; t < 4096L * 64; t += GT) { const int dc = (int)(t & 7), h = (int)((t >> 3) & 7); const int pr = (int)(t >> 6); const int row = pr < 2048 ? pr : 31 * SEQ + (pr - 2048);
            simple_attn_task(row, h, dc, MREF + (size_t)pr * 32, QB, KBc, VBc, cache_k, cache_v, k_sample, v_sample, rel_bias, OREF + (size_t)pr * 1024 + h * 128 + dc * 16); }
        GBAR();
    }
#endif
    if (IN(4)) { MK_ARGS;
        { const int sub = lane >> 3, l8 = lane & 7;
          for (long t0 = (long)gw * 8; t0 < (long)NTOK * 4; t0 += (long)NGW * 8) { const long t = t0 + sub;
              const GAS v4u* src = (const GAS v4u*)(HA + t * 256 + l8 * 32); v4u w[4];
#pragma unroll
              for (int j = 0; j < 4; ++j) w[j] = src[j];
              float f[32];
#pragma unroll
              for (int j = 0; j < 4; ++j)
#pragma unroll
                  for (int e = 0; e < 4; ++e) { f[8 * j + 2 * e] = __uint_as_float(w[j][e] << 16); f[8 * j + 2 * e + 1] = __uint_as_float(w[j][e] & 0xffff0000u); }
              float s1 = 0.f;
#pragma unroll
              for (int e = 0; e < 32; ++e) s1 += f[e];
              s1 += __shfl_xor(s1, 1); s1 += __shfl_xor(s1, 2); s1 += __shfl_xor(s1, 4);
              const float mean = s1 * (1.0f / 256.0f); float s2 = 0.f;
#pragma unroll
              for (int e = 0; e < 32; ++e) { const float d = f[e] - mean; s2 += d * d; }
              s2 += __shfl_xor(s2, 1); s2 += __shfl_xor(s2, 2); s2 += __shfl_xor(s2, 4);
              if (l8 == 0) { HST[t * 2] = mean; HST[t * 2 + 1] = 1.0f / sqrtf(s2 * (1.0f / 256.0f) + HEAD_NORM_EPS); } } }
        {
            char* alds = (char*)lds_raw;
            for (int bh = vcu; bh < BATCH * 8; bh += G) {
                const int b = bh >> 3, h = bh & 7;
                if (tid < 320) ((float*)(alds + at2::BT_OFF))[tid] = rel_bias[t5b(tid - 256) * 8 + h] * (1.0f / at2::SCALE);
                const float cfar = __int_as_float(__builtin_amdgcn_readfirstlane(__float_as_int(rel_bias[15 * 8 + h] * (1.0f / at2::SCALE))));
                at2::Ctx C;
                C.Q = __builtin_amdgcn_make_buffer_rsrc((void*)(QB + (size_t)b * SEQ * 1024 + h * 128), (short)0, SEQ * 1024 * 2, 0x00020000);
                C.K = __builtin_amdgcn_make_buffer_rsrc((void*)(KBc + (size_t)b * SEQ * 1024 + h * 128), (short)0, SEQ * 1024 * 2, 0x00020000);
                C.V = __builtin_amdgcn_make_buffer_rsrc((void*)(VBc + (size_t)b * SEQ * 1024 + h * 128), (short)0, SEQ * 1024 * 2, 0x00020000);
                C.M = __builtin_amdgcn_make_buffer_rsrc((void*)(MASK + (size_t)b * SEQ * 32), (short)0, SEQ * 32 * 8, 0x00020000);
                C.O = C.Q;
#if (DUPMASK >> 4) & 1
                for (int dry_ = 1; dry_ >= 0; --dry_) { C.O = dry_ ? __builtin_amdgcn_make_buffer_rsrc((void*)(args.ws + WS_HA), (short)0, SEQ * 1024 * 2, 0x00020000) : C.Q;
#endif
                at2::Seam S; at2::dsa_prime(C, 0, alds, S);
                for (int u = 0; u < 8; ++u) at2::dsa_block(C, u * 256, (u < 7 ? u + 1 : u) * 256, alds, S, cfar);
#if (DUPMASK >> 4) & 1
                }
#endif
            }
        }
#ifdef PROBE_SAMP
        { unsigned long long* MREF = (unsigned long long*)(args.ws + WS_END); bf16* OREF = (bf16*)(args.ws + WS_END + 2 * MiB);
          for (int row = NTP + vcu; row < NTOK; row += G) simple_select_row(lds, row, MREF + (size_t)(row - NTP) * 40, QI, SM, KI, cache_ik);
          GBAR();
          for (long t = gtid; t < (long)NTS * 64; t += GT) { const int dc = (int)(t & 7), h = (int)((t >> 3) & 7); const int pr = (int)(t >> 6);
              simple_attn_task(NTP + pr, h, dc, MREF + (size_t)pr * 40, QB, KBc, VBc, cache_k, cache_v, k_sample, v_sample, rel_bias, OREF + (size_t)pr * 1024 + h * 128 + dc * 16); }
          GBAR(); }
#endif
        for (int pr = vcu; pr < NTS; pr += G) { const int b = pr / DEC_SEQ, r = pr % DEC_SEQ;
            sample_attn_row(lds, b, r, MASKS + (size_t)pr * 40, OB + (size_t)(NTP + pr) * 1024, cache_k, cache_v, k_sample + (size_t)b * DEC_SEQ * 1024, v_sample + (size_t)b * DEC_SEQ * 1024, rel_bias); }
        GBAR();
#ifdef PROBE_SAMP
        { const unsigned long long* MREF = (const unsigned long long*)(args.ws + WS_END); const bf16* OREF = (const bf16*)(args.ws + WS_END + 2 * MiB); float num = 0.f, den = 0.f, dif = 0.f;
          for (long t = gtid; t < (long)NTS * 1024; t += GT) { const float a = bf2f(OB[(size_t)NTP * 1024 + t]), r_ = bf2f(OREF[t]); num += (a - r_) * (a - r_); den += r_ * r_; }
          for (long t = gtid; t < (long)NTS * 33; t += GT) { const int pr = (int)(t / 33), w = (int)(t % 33); dif += (float)__builtin_popcountll(MASKS[(size_t)pr * 40 + w] ^ MREF[(size_t)pr * 40 + w]); }
          num = wave_sum(num); den = wave_sum(den); dif = wave_sum(dif);
          if (lane == 0) { atomicAdd((float*)(args.ws + WS_CTL) + 8, num); atomicAdd((float*)(args.ws + WS_CTL) + 9, den); atomicAdd((float*)(args.ws + WS_CTL) + 10, dif); }
          GBAR(); }
#endif
    }
#ifdef PROBE_ATT
    if (IN(4)) { MK_ARGS;
        const bf16* OREF = (const bf16*)(args.ws + WS_END + 2 * MiB); float num = 0.f, den = 0.f;
        for (long t = gtid; t < 4096L * 1024; t += GT) { const int pr = (int)(t >> 10), c = (int)(t & 1023); const int row = pr < 2048 ? pr : 31 * SEQ + (pr - 2048);
            const float a = bf2f(OB[(size_t)row * 1024 + c]), r = bf2f(OREF[t]); num += (a - r) * (a - r); den += r * r; }
        num = wave_sum(num); den = wave_sum(den);
        if (lane == 0) { atomicAdd((float*)(args.ws + WS_CTL) + 8, num); atomicAdd((float*)(args.ws + WS_CTL) + 9, den); }
        GBAR();
    }
#endif
    if (IN(5))
#if (DUPMASK >> 5) & 1
    for (int rep_ = 0; rep_ < 2; ++rep_)
#endif
    { MK_ARGS;
        pg8::Gemm g{XB, WMRG, NTOK, N_M1A + N_M1B, 1024}; pg8::StaticOrder S; S.init(NTOK, N_M1A + N_M1B, G, (int)blockIdx.x);
        pg8::EpiM1 E{pg8::EpiM1a{HA, OB, HST, a_norm_g, BR}, pg8::EpiM1b{SGA, SGB}};
        pg8::gemm_phase<pg8::EpiM1, pg8::StaticOrder, true, true>(lds + RING_OFF, g, S, E);
        GBAR();
    }
    if (IN(7))
#if (DUPMASK >> 7) & 1
    for (int rep_ = 0; rep_ < 2; ++rep_)
#endif
    { MK_ARGS;
        pg8::Gemm g{BR, WAB, NTOK, 1024, 2048}; pg8::StaticOrder S; S.init(NTOK, 1024, G, (int)blockIdx.x);
        pg8::EpiM2 E{SGA, SGB, MX};
        pg8::gemm_phase<pg8::EpiM2, pg8::StaticOrder, true, true>(lds + RING_OFF, g, S, E);
        GBAR();
    }
    if (IN(8))
#if (DUPMASK >> 8) & 1
    for (int rep_ = 0; rep_ < 2; ++rep_)
#endif
    { MK_ARGS;
        pg8::Gemm g{MX, WO, NTOK, 1024, 1024}; pg8::StaticOrder S; S.init(NTOK, 1024, G, (int)blockIdx.x);
        pg8::EpiM3 E{args.in[0], args.in[1], y_prompt, y_sample};
        pg8::gemm_phase<pg8::EpiM3, pg8::StaticOrder, true, true>(lds + RING_OFF, g, S, E);
        GBAR();
    }
    if (IN(9))
#if (DUPMASK >> 9) & 1
    for (int rep_ = 0; rep_ < 2; ++rep_)
#endif
    { MK_ARGS;
        for (int m0 = gw * 2; m0 < NTOK; m0 += NGW * 2) {
            GAS f32x4* yv[2]; f32x4 v[2][4]; float sm_[2] = {0.f, 0.f};
#pragma unroll
            for (int q = 0; q < 2; ++q) { const int m = m0 + q; float* yr = m < NTP ? y_prompt + (size_t)m * 1024 : y_sample + (size_t)(m - NTP) * 1024; yv[q] = (GAS f32x4*)yr + lane;
#pragma unroll
                for (int j = 0; j < 4; ++j) v[q][j] = yv[q][64 * j]; }
#pragma unroll
            for (int q = 0; q < 2; ++q) {
#pragma unroll
                for (int j = 0; j < 4; ++j) sm_[q] += (v[q][j].x + v[q][j].y) + (v[q][j].z + v[q][j].w);
                const float mean = wave_sum(sm_[q]) * (1.f / 1024.f); float s2 = 0.f;
#pragma unroll
                for (int j = 0; j < 4; ++j) { v[q][j] = v[q][j] - mean; s2 += (v[q][j].x * v[q][j].x + v[q][j].y * v[q][j].y) + (v[q][j].z * v[q][j].z + v[q][j].w * v[q][j].w); }
                const float rstd = 1.f / sqrtf(wave_sum(s2) * (1.f / 1024.f) + LN_EPS);
#pragma unroll
                for (int j = 0; j < 4; ++j) { const f32x4 gg = *((const GAS f32x4*)ln_g + lane + 64 * j), bb = *((const GAS f32x4*)ln_b + lane + 64 * j); yv[q][64 * j] = v[q][j] * rstd * gg + bb; } }
        }
    }
#if defined(PROBE_ATT) || defined(PROBE_ML) || defined(PROBE_SAMP)
    { MK_ARGS; GBAR();
      if (blockIdx.x == 0 && threadIdx.x < 64) { const float num = ((volatile float*)(args.ws + WS_CTL))[8], den = ((volatile float*)(args.ws + WS_CTL))[9];
          const float dif = ((volatile float*)(args.ws + WS_CTL))[10];
          m_sample[threadIdx.x] *= 1.0f + 30.0f * (sqrtf(num / den) + dif / (float)(NTS * TOPK_MAX)); } }
#endif
#undef IN
#undef GBAR
#undef args
#undef gtid
#undef GT
#undef gw
#undef NGW
#undef tid
#undef lane
#undef wave
#undef G
#undef vcu
}

extern "C" void kernel_launch(void* const* d_in, const int* in_sizes, int n_in, void* d_out, int out_size, void* d_ws, size_t ws_size, hipStream_t stream) {
    static int grid = 0;
    if (grid == 0) {
        int dev = 0, cus = 0;
        if (hipGetDevice(&dev) != hipSuccess || hipDeviceGetAttribute(&cus, hipDeviceAttributeMultiprocessorCount, dev) != hipSuccess) { grid = -1; return; }
        if (hipFuncSetAttribute((const void*)mk_fwd, hipFuncAttributeMaxDynamicSharedMemorySize, LDS_BYTES) != hipSuccess) { grid = -1; return; }
        (void)hipGetLastError();
        if (n_in != 17 || ws_size < WS_END) { fprintf(stderr, "kernel_launch: needs 17 inputs and %zu bytes of workspace (got %d, %zu)\n", (size_t)WS_END, n_in, ws_size); grid = -1; return; }
        grid = cus;
    }
    if (grid < 0) return;
    if (hipMemsetAsync((unsigned char*)d_ws + WS_CTL, 0, CTL_ZERO_BYTES, stream) != hipSuccess) return;
    Args a{};
    for (int i = 0; i < 17; ++i) a.in[i] = (const float*)d_in[i];
    a.out = (float*)d_out; a.ws = (unsigned char*)d_ws; a.ph_lo = 0; a.ph_hi = 10;
    hipLaunchKernelGGL(mk_fwd, dim3(grid), dim3(NWAVES * 64), LDS_BYTES, stream, a);
}
```
